# Optimizing an MI355X kernel written in HIP

```python
import math
import jax
import jax.numpy as jnp
from jax import lax
import numpy as np

D_MODEL = 1024
BATCH = 8
SEQ = 4096
DEPTH = 1

A_HEADS = 16
A_HEAD_DIM = 64
A_WIDTH = A_HEADS * A_HEAD_DIM
DILATED_PATTERNS = ((128, 1), (512, 4), (2048, 16))
N_BUCKETS = 32
MAX_EXACT = N_BUCKETS // 2
MAX_DISTANCE = 2048
M_HEADS = 4
M_WIDTH = 2 * D_MODEL
M_HEAD_DIM = M_WIDTH // M_HEADS
CONV_K = 4
QKV_BLOCK = 4
CHUNK = 64
EPS = 1e-6
N_IN = 4 * A_WIDTH + 3 * M_WIDTH + 2 * D_MODEL
SPLIT_POINTS = (A_WIDTH, 2 * A_WIDTH, 3 * A_WIDTH, 4 * A_WIDTH, 4 * A_WIDTH + M_WIDTH, 4 * A_WIDTH + 2 * M_WIDTH, 4 * A_WIDTH + 3 * M_WIDTH)

kernel_name = 'hybrid_dilated_attn_mlstm_gated'


def rmsnorm(x, g):
    xf = x.astype(jnp.float32)
    y = xf * lax.rsqrt(jnp.mean(xf * xf, axis=-1, keepdims=True) + EPS)
    return (y * g.astype(jnp.float32)).astype(x.dtype)


def t5_bucket(dist):
    large = MAX_EXACT + (jnp.log(jnp.maximum(dist, MAX_EXACT).astype(jnp.float32) / MAX_EXACT)
                         / math.log(MAX_DISTANCE / MAX_EXACT) * (N_BUCKETS - MAX_EXACT)).astype(jnp.int32)
    return jnp.where(dist < MAX_EXACT, dist, jnp.minimum(large, N_BUCKETS - 1))


def dilated_band_attention(q, k, v, rel_bias, window, dilation):
    B, S, H, dh = q.shape
    band = window // dilation
    span = band * dilation
    s_pad = -(-S // span) * span
    L = s_pad // dilation
    nb = L // band

    def to_blocks(t):
        t = jnp.pad(t, ((0, 0), (0, s_pad - S), (0, 0), (0, 0)))
        t = t.reshape(B, L, dilation, H, dh).transpose(0, 2, 3, 1, 4)
        return t.reshape(B, dilation, H, nb, band, dh)

    def with_prev(t):
        prev = jnp.pad(t, ((0, 0), (0, 0), (0, 0), (1, 0), (0, 0), (0, 0)))[:, :, :, :-1]
        return jnp.concatenate([prev, t], axis=4)

    qb = to_blocks(q)
    kc = with_prev(to_blocks(k))
    vc = with_prev(to_blocks(v))
    logits = jnp.einsum('brhnqc,brhnkc->brhnqk', qb, kc, preferred_element_type=jnp.float32) * (dh ** -0.5)
    qi = jnp.arange(band)[:, None]
    kj = jnp.arange(2 * band)[None, :]
    delta = qi + band - kj
    bias = rel_bias.astype(jnp.float32)[t5_bucket(jnp.clip(delta, 0, band) * dilation)]
    bias = jnp.transpose(bias, (2, 0, 1))[:, None]
    key_pos = jnp.arange(nb)[:, None, None] * band + kj[None] - band
    valid = (delta >= 0) & (delta <= band) & (key_pos >= 0)
    logits = jnp.where(valid, logits + bias, -jnp.inf)
    m = jnp.max(logits, axis=-1)
    p = jnp.exp(logits - m[..., None])
    s = jnp.sum(p, axis=-1)
    o = jnp.einsum('brhnqk,brhnkc->brhnqc', p, vc.astype(jnp.float32)) / s[..., None]

    def from_blocks(t):
        t = t.reshape((B, dilation, H, L) + t.shape[5:])
        t = jnp.moveaxis(t, 3, 1)
        return t.reshape((B, s_pad, H) + t.shape[4:])[:, :S]

    return from_blocks(o), from_blocks(m), from_blocks(s)


def dilated_attention(q, k, v, rel_bias):
    B, S, H, dh = q.shape
    outs = [dilated_band_attention(q, k, v, rel_bias, w, d) for (w, d) in DILATED_PATTERNS]
    o = jnp.stack([t[0] for t in outs])
    m = jnp.stack([t[1] for t in outs])
    s = jnp.stack([t[2] for t in outs])
    wgt = jnp.exp(m - jnp.max(m, axis=0, keepdims=True)) * s
    out = jnp.sum(wgt[..., None] * o, axis=0) / jnp.sum(wgt, axis=0)[..., None]
    return out.reshape(B, S, H * dh)


def causal_depthwise_conv(x, w, b):
    S = x.shape[1]
    xp = jnp.pad(x, ((0, 0), (CONV_K - 1, 0), (0, 0)))
    y = b
    for tap in range(CONV_K):
        y = y + xp[:, tap:tap + S] * w[tap]
    return y


def block_diag_proj(x, w):
    B, S, C = x.shape
    return jnp.einsum('bsgi,gio->bsgo', x.reshape(B, S, C // QKV_BLOCK, QKV_BLOCK), w).reshape(B, S, C)


def mlstm_chunkwise(q, k, v, li, lf):
    B, S, H, dh = q.shape
    nc = S // CHUNK

    def chunks(t):
        t = t.astype(jnp.float32).reshape((B, nc, CHUNK, H) + t.shape[3:])
        return jnp.moveaxis(jnp.moveaxis(t, 1, 0), 3, 2)

    qc, kc, vc = chunks(q), chunks(k) * (dh ** -0.5), chunks(v)
    lic, lfc = chunks(li), chunks(lf)
    tril = jnp.tril(jnp.ones((CHUNK, CHUNK), dtype=bool))

    def step(carry, xs):
        C, n, m = carry
        qt, kt, vt, it, ft = xs
        b = jnp.cumsum(ft, axis=-1)
        g = b[..., -1]
        D = jnp.where(tril, b[..., :, None] - b[..., None, :] + it[..., None, :], -jnp.inf)
        inter = b + m[..., None]
        m_t = jnp.maximum(inter, jnp.max(D, axis=-1))
        qk = jnp.einsum('bhtd,bhsd->bhts', qt, kt) * jnp.exp(D - m_t[..., None])
        w_inter = jnp.exp(inter - m_t)
        num = w_inter[..., None] * jnp.einsum('bhtd,bhde->bhte', qt, C) + jnp.einsum('bhts,bhse->bhte', qk, vt)
        den = w_inter * jnp.einsum('bhtd,bhd->bht', qt, n) + jnp.sum(qk, axis=-1)
        h = num / jnp.maximum(jnp.abs(den), jnp.exp(-m_t))[..., None]
        to_end = g[..., None] - b + it
        m_new = jnp.maximum(g + m, jnp.max(to_end, axis=-1))
        w_s = jnp.exp(to_end - m_new[..., None])
        decay = jnp.exp(g + m - m_new)
        C_new = decay[..., None, None] * C + jnp.einsum('bhsd,bhse->bhde', kt * w_s[..., None], vt)
        n_new = decay[..., None] * n + jnp.einsum('bhs,bhsd->bhd', w_s, kt)
        return (C_new, n_new, m_new), h

    init = (jnp.zeros((B, H, dh, dh), jnp.float32), jnp.zeros((B, H, dh), jnp.float32), jnp.zeros((B, H), jnp.float32))
    _, h = lax.scan(step, init, (qc, kc, vc, lic, lfc))
    return jnp.transpose(h, (1, 0, 3, 2, 4)).reshape(B, S, H, dh)


def mlstm_branch(x_m, z_m, o_m, conv_w, conv_b, wq, wk, wv, w_if, b_if, head_norm_g, skip):
    B, S, _ = x_m.shape
    x_c = jax.nn.silu(causal_depthwise_conv(x_m, conv_w, conv_b))
    q = block_diag_proj(x_c, wq)
    k = block_diag_proj(x_c, wk)
    v = block_diag_proj(x_m, wv)
    gate_pre = (jnp.concatenate([q, k, v], axis=-1) @ w_if + b_if).astype(jnp.float32)
    li = gate_pre[..., :M_HEADS]
    lf = jax.nn.log_sigmoid(gate_pre[..., M_HEADS:])
    heads = lambda t: t.reshape(B, S, M_HEADS, M_HEAD_DIM)
    h = mlstm_chunkwise(heads(q), heads(k), heads(v), li, lf)
    h = jax.nn.sigmoid(heads(o_m).astype(jnp.float32)) * h
    mu = jnp.mean(h, axis=-1, keepdims=True)
    var = jnp.mean(jnp.square(h - mu), axis=-1, keepdims=True)
    h = (h - mu) * lax.rsqrt(var + EPS) * head_norm_g.astype(jnp.float32).reshape(M_HEADS, M_HEAD_DIM)
    h = h.reshape(B, S, M_WIDTH) + skip * x_c
    return h * jax.nn.silu(z_m)


def setup_inputs(seed: int = 0) -> dict:
    key = jax.random.key(seed)
    ks = jax.random.split(key, 20)
    nrm = lambda k, shape, scale: jax.random.normal(k, shape, jnp.float32) * scale
    n_blocks = M_WIDTH // QKV_BLOCK
    x = nrm(ks[0], (BATCH, SEQ, D_MODEL), 1.0)
    norm_in_g = 1.0 + nrm(ks[1], (DEPTH, D_MODEL), 0.02)
    w_in = nrm(ks[2], (DEPTH, D_MODEL, N_IN), D_MODEL ** -0.5)
    gate_b = nrm(ks[3], (DEPTH, 2 * D_MODEL), 0.01)
    conv_w = nrm(ks[4], (DEPTH, CONV_K, M_WIDTH), CONV_K ** -0.5)
    conv_b = nrm(ks[5], (DEPTH, M_WIDTH), 0.01)
    wq_m = nrm(ks[6], (DEPTH, n_blocks, QKV_BLOCK, QKV_BLOCK), QKV_BLOCK ** -0.5)
    wk_m = nrm(ks[7], (DEPTH, n_blocks, QKV_BLOCK, QKV_BLOCK), QKV_BLOCK ** -0.5)
    wv_m = nrm(ks[8], (DEPTH, n_blocks, QKV_BLOCK, QKV_BLOCK), QKV_BLOCK ** -0.5)
    w_if = nrm(ks[9], (DEPTH, 3 * M_WIDTH, 2 * M_HEADS), (3 * M_WIDTH) ** -0.5)
    b_if = jnp.concatenate([nrm(ks[10], (DEPTH, M_HEADS), 0.1),
                            jnp.linspace(3.0, 6.0, M_HEADS)[None] + nrm(ks[11], (DEPTH, M_HEADS), 0.01)], axis=-1)
    head_norm_g = 1.0 + nrm(ks[12], (DEPTH, M_WIDTH), 0.02)
    skip_m = 1.0 + nrm(ks[13], (DEPTH, M_WIDTH), 0.02)
    w_pa = nrm(ks[14], (DEPTH, A_WIDTH, D_MODEL), A_WIDTH ** -0.5)
    w_pb = nrm(ks[15], (DEPTH, M_WIDTH, D_MODEL), M_WIDTH ** -0.5)
    w_out = nrm(ks[16], (DEPTH, D_MODEL, D_MODEL), D_MODEL ** -0.5)
    rel_bias = nrm(ks[17], (N_BUCKETS, A_HEADS), 0.3)
    norm_out_g = 1.0 + nrm(ks[18], (D_MODEL,), 0.02)
    return {'x': x, 'norm_in_g': norm_in_g, 'w_in': w_in, 'gate_b': gate_b, 'conv_w': conv_w, 'conv_b': conv_b,
            'wq_m': wq_m, 'wk_m': wk_m, 'wv_m': wv_m, 'w_if': w_if, 'b_if': b_if, 'head_norm_g': head_norm_g,
            'skip_m': skip_m, 'w_pa': w_pa, 'w_pb': w_pb, 'w_out': w_out, 'rel_bias': rel_bias, 'norm_out_g': norm_out_g}


def reference(x, norm_in_g, w_in, gate_b, conv_w, conv_b, wq_m, wk_m, wv_m, w_if, b_if, head_norm_g,
              skip_m, w_pa, w_pb, w_out, rel_bias, norm_out_g):
    B, S, _ = x.shape
    h = x
    for layer in range(DEPTH):
        xn = rmsnorm(h, norm_in_g[layer])
        proj = xn @ w_in[layer]
        q_a, k_a, v_a, z_a, x_m, z_m, o_m, gates = jnp.split(proj, SPLIT_POINTS, axis=-1)
        to_heads = lambda t: t.reshape(B, S, A_HEADS, A_HEAD_DIM)
        y_a = dilated_attention(to_heads(q_a), to_heads(k_a), to_heads(v_a), rel_bias)
        y_a = (y_a * jax.nn.silu(z_a)) @ w_pa[layer]
        y_m = mlstm_branch(x_m, z_m, o_m, conv_w[layer], conv_b[layer], wq_m[layer], wk_m[layer], wv_m[layer],
                           w_if[layer], b_if[layer], head_norm_g[layer], skip_m[layer]) @ w_pb[layer]
        g = jax.nn.sigmoid(gates.astype(jnp.float32) + gate_b[layer])
        g_a, g_m = jnp.split(g, 2, axis=-1)
        merged = g_a * y_a + g_m * y_m
        h = h + (merged @ w_out[layer]).astype(h.dtype)
    return rmsnorm(h, norm_out_g)
```

```cpp
#define MK_ONE_LAUNCH 1
#include <hip/hip_runtime.h>
#include <hip/hip_cooperative_groups.h>
#include <cstdio>
#include <cstdint>
namespace cg = cooperative_groups;
#define LAS __attribute__((address_space(3)))
#define GAS __attribute__((address_space(1)))
typedef unsigned short bf16;
typedef unsigned v4u __attribute__((ext_vector_type(4)));
typedef unsigned v2u __attribute__((ext_vector_type(2)));
typedef float f32x4 __attribute__((ext_vector_type(4)));
typedef float f32x16 __attribute__((ext_vector_type(16)));
typedef short bf16x8 __attribute__((ext_vector_type(8)));
typedef short s16x4 __attribute__((ext_vector_type(4)));
typedef float f32x2_t __attribute__((ext_vector_type(2)));
typedef __bf16 bf16x2_t __attribute__((ext_vector_type(2)));

constexpr int NWAVES = 8, NTHR = 512;
constexpr int BATCH = 8, SEQ = 4096, DM = 1024, MTOK = BATCH * SEQ;
constexpr int AH = 16, AHD = 64, AW = 1024;
constexpr int MH = 4, MHD = 512, MW = 2048;
constexpr int NIN = 12288;
constexpr int C_QA = 0, C_KA = 1024, C_VA = 2048, C_ZA = 3072, C_XM = 4096, C_ZM = 6144, C_OM = 8192, C_G = 10240;
constexpr int CHUNK = 64, NCHUNK = SEQ / CHUNK;
constexpr float EPS = 1e-6f;
constexpr float LOG2E = 1.4426950408889634f;
constexpr float QSCALE = 0.125f * 1.4426950408889634f;

constexpr size_t MiB = 1u << 20;
constexpr size_t WS_CTL = 0;
constexpr size_t WS_WIN = 1 * MiB;
constexpr size_t WS_WPA = 25 * MiB;
constexpr size_t WS_WPB = 27 * MiB;
constexpr size_t WS_WOUT = 31 * MiB;
constexpr size_t WS_TAB = 33 * MiB;
constexpr size_t WS_GP = 34 * MiB;
constexpr size_t WS_SCAL = 38 * MiB;
constexpr size_t WS_HALO = 40 * MiB;
constexpr size_t WS_ST = 34 * MiB;
constexpr size_t WS_XN = 46 * MiB;
constexpr size_t WS_R0 = 110 * MiB;
constexpr size_t WS_R1 = 238 * MiB;
constexpr size_t WS_R2 = 366 * MiB;
constexpr size_t WS_S = 494 * MiB;
constexpr size_t WS_END = 512 * MiB;
constexpr size_t WS_QA = 110 * MiB, WS_KA = 174 * MiB, WS_VA = 238 * MiB;
constexpr size_t WS_O1 = 302 * MiB;
constexpr size_t WS_A1 = 110 * MiB;
constexpr size_t WS_G = 174 * MiB;
constexpr size_t WS_MRG = 302 * MiB;
constexpr int TAB_WC = 0;
constexpr int TAB_WM = 2048 * 8;
constexpr int TAB_G = 2 * 2048 * 8;
constexpr int TAB_BIAS = TAB_G + 512 * 16;
constexpr int TAB_END = TAB_BIAS + 3 * 16 * 132;

__device__ const unsigned char BUCKET[3][132] = {
 {0,1,2,3,4,5,6,7,8,9,10,11,12,13,14,15,16,16,16,16,16,16,17,17,17,17,17,17,17,17,18,18,18,18,18,18,18,18,18,18,19,19,19,19,19,19,19,19,19,19,19,19,19,19,20,20,20,20,20,20,20,20,20,20,20,20,20,20,20,20,20,20,20,21,21,21,21,21,21,21,21,21,21,21,21,21,21,21,21,21,21,21,21,21,21,21,21,21,21,22,22,22,22,22,22,22,22,22,22,22,22,22,22,22,22,22,22,22,22,22,22,22,22,22,22,22,22,22,22,0,0,0},
 {0,4,8,12,16,16,17,17,18,18,19,19,19,19,20,20,20,20,20,21,21,21,21,21,21,22,22,22,22,22,22,22,22,22,23,23,23,23,23,23,23,23,23,23,23,23,24,24,24,24,24,24,24,24,24,24,24,24,24,24,24,24,25,25,25,25,25,25,25,25,25,25,25,25,25,25,25,25,25,25,25,25,25,26,26,26,26,26,26,26,26,26,26,26,26,26,26,26,26,26,26,26,26,26,26,26,26,26,26,26,26,26,26,27,27,27,27,27,27,27,27,27,27,27,27,27,27,27,27,0,0,0},
 {0,16,18,19,20,21,21,22,22,23,23,23,24,24,24,24,25,25,25,25,25,26,26,26,26,26,26,26,26,27,27,27,27,27,27,27,27,27,27,28,28,28,28,28,28,28,28,28,28,28,28,28,29,29,29,29,29,29,29,29,29,29,29,29,29,29,29,29,29,29,30,30,30,30,30,30,30,30,30,30,30,30,30,30,30,30,30,30,30,30,30,30,30,30,30,31,31,31,31,31,31,31,31,31,31,31,31,31,31,31,31,31,31,31,31,31,31,31,31,31,31,31,31,31,31,31,31,31,31,0,0,0}};

#define DI __device__ __forceinline__
DI unsigned pk2(float lo, float hi) { f32x2_t v = {lo, hi}; bf16x2_t b = __builtin_convertvector(v, bf16x2_t); return __builtin_bit_cast(unsigned, b); }
DI float bflo(unsigned u) { return __uint_as_float(u << 16); }
DI float bfhi(unsigned u) { return __uint_as_float(u & 0xffff0000u); }
DI float sigmoidf_(float x) { return 1.0f / (1.0f + __expf(-x)); }
DI float siluf_(float x) { return x / (1.0f + __expf(-x)); }
DI float wave_sum(float v) {
#pragma unroll
    for (int o = 1; o < 64; o <<= 1) v += __shfl_xor(v, o);
    return v;
}
DI int wg_tid(int wv) { return wv * 64 + (int)__builtin_amdgcn_mbcnt_hi(~0u, __builtin_amdgcn_mbcnt_lo(~0u, 0u)); }
DI int crow(int r, int hi) { return (r & 3) + 8 * (r >> 2) + 4 * hi; }
#define MFMA32(a, b, c) __builtin_amdgcn_mfma_f32_32x32x16_bf16((a), (b), (c), 0, 0, 0)
DI s16x4 tr_read(const LAS unsigned char* p) { return __builtin_bit_cast(s16x4, __builtin_amdgcn_ds_read_tr16_b64_v4i16((LAS s16x4*)p)); }
DI bf16x8 cat8(s16x4 lo, s16x4 hi) { return __builtin_shufflevector(lo, hi, 0, 1, 2, 3, 4, 5, 6, 7); }
DI bf16x8 pack8(float a0, float a1, float a2, float a3, float a4, float a5, float a6, float a7) {
    v4u p; p.x = pk2(a0, a1); p.y = pk2(a2, a3); p.z = pk2(a4, a5); p.w = pk2(a6, a7); return __builtin_bit_cast(bf16x8, p);
}
namespace pg8 {
#define PG8_LAS __attribute__((address_space(3)))
typedef unsigned short bf16_t;
typedef short bf16x8 __attribute__((ext_vector_type(8)));
typedef float f32x4 __attribute__((ext_vector_type(4)));
typedef unsigned u32x4 __attribute__((ext_vector_type(4)));
constexpr int BM = 256, BK = 64, HALF = 128, HTB = HALF * BK * 2  , STAGE_BYTES = 8 * HTB, NXCD = 8, WGM = 8;

__host__ __device__ __forceinline__ int lds_byte(int r, int c) { const int st = (r >> 4) * 2 + (c >> 5), rr = r & 15, cc = c & 31, ob = rr * 64 + cc * 2; return st * 1024 + (ob ^ (((ob >> 9) & 1) << 5)); }
__host__ __device__ __forceinline__ void stage_rc(int b, int& R, int& C) { const int st = b / 1024, sb = b % 1024, swz = sb ^ (((sb >> 9) & 1) << 5); R = (st >> 1) * 16 + swz / 64; C = (st & 1) * 32 + (swz % 64) / 2; }
__host__ __device__ __forceinline__ int perm32(int rho) { const int n = rho >> 4, i = rho & 15; return 8 * (i >> 2) + 4 * n + (i & 3); }

struct Unit { int pm, pn; };
struct Gemm { const bf16_t* A; const bf16_t* Bt; int M, N, K; };

struct StaticOrder {
    int nM, nN, nwg, G, c;
    __host__ __device__ void init(int M, int N, int G_, int c_) { nM = M / BM; nN = N / BM; nwg = nM * nN; G = G_; c = c_; }
    __host__ __device__ bool next(int i, Unit& u) const {
        const long L = (long)i * G + c; if (L >= nwg) return false;
        int wgid = (int)L; { const int q = nwg / NXCD, r = nwg % NXCD, xcd = wgid % NXCD, off = wgid / NXCD; wgid = (xcd < r ? xcd * (q + 1) : r * (q + 1) + (xcd - r) * q) + off; }
        const int nig = WGM * nN, gid = wgid / nig, fm = gid * WGM, gsz = (nM - fm) < WGM ? (nM - fm) : WGM;
        u.pm = fm + ((wgid % nig) % gsz); u.pn = (wgid % nig) / gsz; return true;
    }
    __device__ __forceinline__ void a_ready(const Unit&) const {}
    __device__ __forceinline__ void done(const Unit&) const {}
};

}
namespace pg8 {
#define EPI_OPERATOR \
    static constexpr bool PERM = true, AFTER_DRAIN = false; \
    __device__ __forceinline__ void operator()(const f32x4 (&acc)[2][2][4][2], const Unit& u, int wr, int wc, int fr, int fq) const { \
        const int row0 = u.pm * BM + wr * 64 + fr, col0 = u.pn * BM + wc * 32 + 8 * fq; \
        _Pragma("unroll") for (int ai = 0; ai < 2; ++ai) \
        _Pragma("unroll") for (int m = 0; m < 4; ++m) \
        _Pragma("unroll") for (int bj = 0; bj < 2; ++bj) store8(row0 + ai * HALF + m * 16, col0 + bj * HALF, acc[ai][bj][m][0], acc[ai][bj][m][1]); \
    }
DI ::v4u pack_bf16x8(f32x4 v0, f32x4 v1) { ::v4u w; w.x = ::pk2(v0[0], v0[1]); w.y = ::pk2(v0[2], v0[3]); w.z = ::pk2(v1[0], v1[1]); w.w = ::pk2(v1[2], v1[3]); return w; }
DI void unpack_bf16x8(::v4u w, f32x4& v0, f32x4& v1) { v0 = (f32x4){::bflo(w.x), ::bfhi(w.x), ::bflo(w.y), ::bfhi(w.y)}; v1 = (f32x4){::bflo(w.z), ::bfhi(w.z), ::bflo(w.w), ::bfhi(w.w)}; }

struct EpiXM {
    bf16_t* xm; bf16_t* halo;
    DI void store8(int row, int col, f32x4 v0, f32x4 v1) const {
        const ::v4u w = pack_bf16x8(v0, v1);
        *(::v4u*)(xm + (size_t)row * 2048 + col) = w;
        const int r = row & 63;
        if (r >= 61) *(::v4u*)(halo + ((size_t)(row >> 6) * 3 + (r - 61)) * 2048 + col) = w;
    }
    EPI_OPERATOR
};
struct EpiSig {
    bf16_t* out; int ldc; const float* bias;
    DI void store8(int row, int col, f32x4 v0, f32x4 v1) const {
        if (bias) { v0 += *(const f32x4*)(bias + col); v1 += *(const f32x4*)(bias + col + 4); }
#pragma unroll
        for (int i = 0; i < 4; ++i) { v0[i] = ::sigmoidf_(v0[i]); v1[i] = ::sigmoidf_(v1[i]); }
        *(::v4u*)(out + (size_t)row * ldc + col) = pack_bf16x8(v0, v1);
    }
    EPI_OPERATOR
};
struct EpiZM {
    bf16_t* buf;
    DI void store8(int row, int col, f32x4 v0, f32x4 v1) const {
        ::v4u* p = (::v4u*)(buf + (size_t)row * 2048 + col);
        f32x4 h0, h1; unpack_bf16x8(*p, h0, h1);
#pragma unroll
        for (int i = 0; i < 4; ++i) { h0[i] *= ::siluf_(v0[i]); h1[i] *= ::siluf_(v1[i]); }
        *p = pack_bf16x8(h0, h1);
    }
    EPI_OPERATOR
};
struct EpiQKV {
    bf16_t* q; size_t stride;
    DI void store8(int row, int col, f32x4 v0, f32x4 v1) const {
        const int t = col >> 10, c = col & 1023;
        bf16_t* base = q + (size_t)t * stride;
        if (t == 0) { v0 *= ::QSCALE; v1 *= ::QSCALE; }
        *(::v4u*)(base + (size_t)row * 1024 + c) = pack_bf16x8(v0, v1);
    }
    EPI_OPERATOR
};
struct EpiZA {
    const bf16_t* o0; const bf16_t* o1; const bf16_t* o2; const float* st; bf16_t* a1;
    DI void store8(int row, int col, f32x4 v0, f32x4 v1) const {
        const int head = col >> 6;
        const ::f32x2_t s0 = *(const ::f32x2_t*)(st + ((size_t)(0 * ::MTOK + row) * 16 + head) * 2);
        const ::f32x2_t s1 = *(const ::f32x2_t*)(st + ((size_t)(1 * ::MTOK + row) * 16 + head) * 2);
        const ::f32x2_t s2 = *(const ::f32x2_t*)(st + ((size_t)(2 * ::MTOK + row) * 16 + head) * 2);
        const float mx = fmaxf(s0.x, fmaxf(s1.x, s2.x));
        float w0 = __builtin_amdgcn_exp2f(s0.x - mx) * s0.y, w1 = __builtin_amdgcn_exp2f(s1.x - mx) * s1.y, w2 = __builtin_amdgcn_exp2f(s2.x - mx) * s2.y;
        const float inv = 1.0f / (w0 + w1 + w2); w0 *= inv; w1 *= inv; w2 *= inv;
        const size_t off = (size_t)row * 1024 + col;
        f32x4 a0, a1v, b0, b1, c0, c1;
        unpack_bf16x8(*(const ::v4u*)(o0 + off), a0, a1v); unpack_bf16x8(*(const ::v4u*)(o1 + off), b0, b1); unpack_bf16x8(*(const ::v4u*)(o2 + off), c0, c1);
        f32x4 r0 = a0 * w0 + b0 * w1 + c0 * w2, r1 = a1v * w0 + b1 * w1 + c1 * w2;
#pragma unroll
        for (int i = 0; i < 4; ++i) { r0[i] *= ::siluf_(v0[i]); r1[i] *= ::siluf_(v1[i]); }
        *(::v4u*)(a1 + off) = pack_bf16x8(r0, r1);
    }
    EPI_OPERATOR
};
struct EpiYA {
    bf16_t* g;
    DI void store8(int row, int col, f32x4 v0, f32x4 v1) const {
        ::v4u* p = (::v4u*)(g + (size_t)row * 2048 + col);
        f32x4 h0, h1; unpack_bf16x8(*p, h0, h1);
        *p = pack_bf16x8(h0 * v0, h1 * v1);
    }
    EPI_OPERATOR
};
struct EpiYM {
    const bf16_t* g; bf16_t* mrg;
    DI void store8(int row, int col, f32x4 v0, f32x4 v1) const {
        f32x4 t0, t1, g0, g1;
        unpack_bf16x8(*(const ::v4u*)(g + (size_t)row * 2048 + col), t0, t1);
        unpack_bf16x8(*(const ::v4u*)(g + (size_t)row * 2048 + 1024 + col), g0, g1);
        *(::v4u*)(mrg + (size_t)row * 1024 + col) = pack_bf16x8(t0 + g0 * v0, t1 + g1 * v1);
    }
    EPI_OPERATOR
};
struct EpiOut {
    const float* x; float* out;
    DI void store8(int row, int col, f32x4 v0, f32x4 v1) const {
        const size_t off = (size_t)row * 1024 + col;
        *(f32x4*)(out + off) = *(const f32x4*)(x + off) + v0;
        *(f32x4*)(out + off + 4) = *(const f32x4*)(x + off + 4) + v1;
    }
    EPI_OPERATOR
};
}
namespace pg8 {
template <class Epi, class Sched, bool ALIGN_EPI = false, bool SP2 = false>
__device__ __forceinline__ void gemm_phase(PG8_LAS unsigned char* lds, const Gemm g, const Sched& S, const Epi& E, const int tid_in) {
    const int tid = tid_in, wid = __builtin_amdgcn_readfirstlane(tid >> 6), lane = tid & 63, wr = wid >> 2, wc = wid & 3, fr = lane & 15, fq = lane >> 4;
    const int K = g.K, nt = K / BK;
    unsigned voffA[2], voffB[2];
#pragma unroll
    for (int i = 0; i < 2; ++i) { int R, C; stage_rc(tid * 16 + i * 8192, R, C); const int Rb = Epi::PERM ? ((R & ~31) + perm32(R & 31)) : R;
        voffA[i] = (unsigned)(R * K + C) * 2u; voffB[i] = (unsigned)(Rb * K + C) * 2u; }
    const size_t kstep = (size_t)(BK * 2);
    const size_t hstep = (size_t)HALF * K * 2;
    const size_t tstep = 2 * hstep;
    const unsigned ldsw = (unsigned)wid * 1024u;
    const int aoff = lds_byte(wr * 64 + fr, fq * 8), boff = lds_byte(wc * 32 + fr, fq * 8);
#define PG8_SA(b, h) (((b) * 2 + (h)) * HTB)
#define PG8_SB(b, h) ((4 + (b) * 2 + (h)) * HTB)
#define PG8_STAGE(bufoff, gbase, voff) do { _Pragma("unroll") for (int _i = 0; _i < 2; ++_i) \
        __builtin_amdgcn_global_load_lds((const unsigned*)((const char*)(gbase) + (voff)[_i]), (PG8_LAS unsigned*)(lds + (bufoff) + ldsw + _i * 8192), 16, 0, 0); } while (0)
#define PG8_LDA(dst, b, h) do { _Pragma("unroll") for (int m = 0; m < 4; ++m) _Pragma("unroll") for (int k = 0; k < 2; ++k) dst[m][k] = *(const PG8_LAS bf16x8*)(lds + PG8_SA(b, h) + aoff + m * 2048 + k * 1024); } while (0)
#define PG8_LDB(dst, b, h) do { _Pragma("unroll") for (int n = 0; n < 2; ++n) _Pragma("unroll") for (int k = 0; k < 2; ++k) dst[n][k] = *(const PG8_LAS bf16x8*)(lds + PG8_SB(b, h) + boff + n * 2048 + k * 1024); } while (0)
#define PG8_MMA(ai, bj, At, Bt) do { __builtin_amdgcn_s_setprio(1); _Pragma("unroll") for (int m = 0; m < 4; ++m) _Pragma("unroll") for (int n = 0; n < 2; ++n) _Pragma("unroll") for (int k = 0; k < 2; ++k) \
        acc[ai][bj][m][n] = __builtin_amdgcn_mfma_f32_16x16x32_bf16(Bt[n][k], At[m][k], acc[ai][bj][m][n], 0, 0, 0); __builtin_amdgcn_s_setprio(0); } while (0)
#define PG8_WAIT_V(n) asm volatile("s_waitcnt vmcnt(" #n ")" ::: "memory")
#define PG8_WAIT_L(n) asm volatile("s_waitcnt lgkmcnt(" #n ")" ::: "memory")
#define PG8_BAR __builtin_amdgcn_s_barrier()
#define PG8_SCHED __builtin_amdgcn_sched_barrier(0)
    Unit cur, nxt; int ui = 0;
    if (!S.next(0, cur)) return;
    f32x4 acc[2][2][4][2];
#pragma unroll
    for (int a = 0; a < 2; ++a)
#pragma unroll
        for (int b = 0; b < 2; ++b)
#pragma unroll
            for (int m = 0; m < 4; ++m)
#pragma unroll
                for (int n = 0; n < 2; ++n) acc[a][b][m][n] = (f32x4){0.f, 0.f, 0.f, 0.f};
    bf16x8 At[4][2], B0[2][2], B1[2][2];
    const char* cA = (const char*)g.A + (size_t)cur.pm * tstep; const char* cB = (const char*)g.Bt + (size_t)cur.pn * tstep;
    S.a_ready(cur);
    if constexpr (SP2) {
        PG8_STAGE(PG8_SB(0, 0), cB, voffB); PG8_STAGE(PG8_SB(0, 1), cB + hstep, voffB); PG8_STAGE(PG8_SA(0, 0), cA, voffA); PG8_STAGE(PG8_SA(0, 1), cA + hstep, voffA);
        if (wr == 1) PG8_BAR;
        PG8_WAIT_V(2); PG8_BAR;
        PG8_STAGE(PG8_SB(1, 0), cB + kstep, voffB); PG8_STAGE(PG8_SA(1, 0), cA + kstep, voffA); PG8_STAGE(PG8_SB(1, 1), cB + hstep + kstep, voffB);
        PG8_WAIT_V(6); PG8_BAR;
    } else {
        PG8_STAGE(PG8_SB(0, 0), cB, voffB); PG8_STAGE(PG8_SA(0, 0), cA, voffA); PG8_STAGE(PG8_SB(0, 1), cB + hstep, voffB); PG8_STAGE(PG8_SA(0, 1), cA + hstep, voffA);
        if (wr == 1) PG8_BAR;
        PG8_WAIT_V(4); PG8_BAR;
        PG8_STAGE(PG8_SB(1, 0), cB + kstep, voffB); PG8_STAGE(PG8_SA(1, 0), cA + kstep, voffA); PG8_STAGE(PG8_SB(1, 1), cB + hstep + kstep, voffB);
        PG8_WAIT_V(6); PG8_BAR;
    }
    for (;;) {
        const bool has_next = S.next(ui + 1, nxt);
        const char* nA = has_next ? (const char*)g.A + (size_t)nxt.pm * tstep : cA; const char* nB = has_next ? (const char*)g.Bt + (size_t)nxt.pn * tstep : cB;
        for (int t = 0; t < nt; t += 2) {
            const bool last = (t == nt - 2);
            const char* a1 = cA + (size_t)(t + 1) * kstep;
            const char* a2 = last ? nA : cA + (size_t)(t + 2) * kstep; const char* b2 = last ? nB : cB + (size_t)(t + 2) * kstep;
            const char* a3 = a2 + kstep; const char* b3 = b2 + kstep;
            if (last && has_next) S.a_ready(nxt);
            if constexpr (SP2) {
            PG8_LDB(B0, 0, 0); PG8_LDB(B1, 0, 1); PG8_SCHED; PG8_LDA(At, 0, 0); PG8_STAGE(PG8_SA(1, 1), a1 + hstep, voffA);
            PG8_WAIT_V(8); PG8_WAIT_L(0); PG8_BAR; PG8_MMA(0, 0, At, B0); PG8_MMA(0, 1, At, B1); PG8_BAR; PG8_SCHED;
            PG8_LDA(At, 0, 1); PG8_STAGE(PG8_SB(0, 0), b2, voffB); PG8_STAGE(PG8_SB(0, 1), b2 + hstep, voffB); PG8_STAGE(PG8_SA(0, 0), a2, voffA);
            PG8_WAIT_V(8); PG8_WAIT_L(0); PG8_BAR; PG8_MMA(1, 0, At, B0); PG8_MMA(1, 1, At, B1); PG8_BAR; PG8_SCHED;
            PG8_LDB(B0, 1, 0); PG8_LDB(B1, 1, 1); PG8_SCHED; PG8_LDA(At, 1, 0); PG8_STAGE(PG8_SA(0, 1), a2 + hstep, voffA);
            PG8_WAIT_V(8); PG8_WAIT_L(0); PG8_BAR; PG8_MMA(0, 0, At, B0); PG8_MMA(0, 1, At, B1); PG8_BAR; PG8_SCHED;
            PG8_LDA(At, 1, 1); PG8_STAGE(PG8_SB(1, 0), b3, voffB); PG8_STAGE(PG8_SB(1, 1), b3 + hstep, voffB); PG8_STAGE(PG8_SA(1, 0), a3, voffA);
            PG8_WAIT_V(8); PG8_WAIT_L(0); PG8_BAR; PG8_MMA(1, 0, At, B0); PG8_MMA(1, 1, At, B1); PG8_BAR; PG8_SCHED;
            } else {
            PG8_LDB(B0, 0, 0); PG8_SCHED; PG8_LDA(At, 0, 0); PG8_STAGE(PG8_SA(1, 1), a1 + hstep, voffA);
            PG8_WAIT_L(8); PG8_BAR; PG8_WAIT_L(0); PG8_MMA(0, 0, At, B0); PG8_BAR; PG8_SCHED;
            PG8_LDB(B1, 0, 1); PG8_STAGE(PG8_SB(0, 0), b2, voffB);
            PG8_BAR; PG8_WAIT_L(0); PG8_MMA(0, 1, At, B1); PG8_BAR;
            PG8_LDA(At, 0, 1); PG8_STAGE(PG8_SA(0, 0), a2, voffA);
            PG8_BAR; PG8_WAIT_L(0); PG8_MMA(1, 0, At, B0); PG8_BAR; PG8_SCHED;
            PG8_STAGE(PG8_SB(0, 1), b2 + hstep, voffB);
            PG8_WAIT_V(6); PG8_BAR; PG8_MMA(1, 1, At, B1); PG8_BAR;
            PG8_LDB(B0, 1, 0); PG8_SCHED; PG8_LDA(At, 1, 0); PG8_STAGE(PG8_SA(0, 1), a2 + hstep, voffA);
            PG8_WAIT_L(8); PG8_BAR; PG8_WAIT_L(0); PG8_MMA(0, 0, At, B0); PG8_BAR; PG8_SCHED;
            PG8_LDB(B1, 1, 1); PG8_STAGE(PG8_SB(1, 0), b3, voffB);
            PG8_BAR; PG8_WAIT_L(0); PG8_MMA(0, 1, At, B1); PG8_BAR;
            PG8_LDA(At, 1, 1); PG8_STAGE(PG8_SA(1, 0), a3, voffA);
            PG8_BAR; PG8_WAIT_L(0); PG8_MMA(1, 0, At, B0); PG8_BAR; PG8_SCHED;
            PG8_STAGE(PG8_SB(1, 1), b3 + hstep, voffB);
            PG8_WAIT_V(6); PG8_BAR; PG8_MMA(1, 1, At, B1); PG8_BAR;
            }
        }
        if constexpr (ALIGN_EPI) { if (wr == 0) PG8_BAR; }
        if constexpr (!Epi::AFTER_DRAIN) { E(acc, cur, wr, wc, fr, fq); S.done(cur); }
        if (!has_next) break;
#pragma unroll
        for (int a = 0; a < 2; ++a)
#pragma unroll
            for (int b = 0; b < 2; ++b)
#pragma unroll
                for (int m = 0; m < 4; ++m)
#pragma unroll
                    for (int n = 0; n < 2; ++n) acc[a][b][m][n] = (f32x4){0.f, 0.f, 0.f, 0.f};
        cur = nxt; cA = nA; cB = nB; ++ui;
        if constexpr (ALIGN_EPI) { if (wr == 1) PG8_BAR; }
    }
    PG8_WAIT_V(0);
    if constexpr (!ALIGN_EPI) { if (wr == 0) PG8_BAR; }
    PG8_BAR;
    if constexpr (Epi::AFTER_DRAIN) { E.fused(acc, cur, wr, wc, fr, fq, lds, wid, lane); S.done(cur); }
#undef PG8_SA
#undef PG8_SB
#undef PG8_STAGE
#undef PG8_LDA
#undef PG8_LDB
#undef PG8_MMA
#undef PG8_WAIT_V
#undef PG8_WAIT_L
#undef PG8_BAR
#undef PG8_SCHED
}
}
namespace att {
constexpr int KP = 144;
constexpr int K_OFF = 0, V_OFF = 384 * KP, B_OFF = 2 * 384 * KP, LDS_BYTES = B_OFF + 132 * 4;
struct Tensors { const bf16* Q; const bf16* K; const bf16* V; bf16* Oa; bf16* Ob; float* st; const float* biasL2; };

DI void unit(LAS unsigned char* lds, const Tensors& T, int u, int tid_in) {
    int tid_ = tid_in; asm volatile("" : "+v"(tid_));
    const int tid = tid_, lane = tid & 63, l31 = lane & 31, hi = lane >> 5, w = __builtin_amdgcn_readfirstlane(tid >> 6);
    const int bh = u / 48, rem = u % 48, p = rem >> 4, w16 = rem & 15;
    const int b = bh >> 4, h = bh & 15;
    const int dsh = 2 * p, nqb = 16 >> dsh, r = w16 / nqb, qblk = w16 % nqb;
    const size_t rowb = (size_t)b * SEQ;
    {
#pragma unroll
        for (int k = 0; k < 6; ++k) {
            const int id = tid + 512 * k, j = id >> 3, pc = id & 7;
            int pos = 256 * qblk - 128 + j; pos = pos < 0 ? 0 : pos;
            const size_t off = (rowb + r + ((size_t)pos << dsh)) * 1024 + h * 64 + pc * 8;
            const v4u kv = *(const v4u*)(T.K + off); const v4u vv = *(const v4u*)(T.V + off);
            *(LAS v4u*)(lds + K_OFF + j * KP + pc * 16) = kv;
            *(LAS v4u*)(lds + V_OFF + j * KP + pc * 16) = vv;
        }
        if (tid < 132) ((LAS float*)(lds + B_OFF))[tid] = T.biasL2[(p * 16 + h) * 132 + tid];
    }
    const int qpos = 256 * qblk + 32 * w + l31;
    const size_t qrow = rowb + r + ((size_t)qpos << dsh);
    bf16x8 qf[4];
#pragma unroll
    for (int d0 = 0; d0 < 4; ++d0) qf[d0] = *(const bf16x8*)(T.Q + qrow * 1024 + h * 64 + d0 * 16 + hi * 8);
    __syncthreads();
    f32x16 st[5];
#pragma unroll
    for (int kt = 0; kt < 5; ++kt) {
        f32x16 a = {};
#pragma unroll
        for (int d0 = 0; d0 < 4; ++d0) {
            const bf16x8 kf = *(const LAS bf16x8*)(lds + K_OFF + (32 * w + 32 * kt + l31) * KP + (16 * d0 + 8 * hi) * 2);
            a = MFMA32(kf, qf[d0], a);
        }
        st[kt] = a;
    }
    const LAS float* bl = (const LAS float*)(lds + B_OFF);
    float mx = -1e30f;
#pragma unroll
    for (int kt = 0; kt < 5; ++kt)
#pragma unroll
        for (int rr = 0; rr < 16; ++rr) {
            const int kl = crow(rr, hi);
            const int delta = 128 + l31 - 32 * kt - kl;
            const int pk = 256 * qblk - 128 + 32 * w + 32 * kt + kl;
            const bool valid = (delta >= 0) && (delta <= 128) && (pk >= 0);
            const int dc = delta < 0 ? 0 : (delta > 128 ? 128 : delta);
            const float s = valid ? st[kt][rr] + bl[dc] : -1e30f;
            st[kt][rr] = s; mx = fmaxf(mx, s);
        }
    mx = fmaxf(mx, __shfl_xor(mx, 32));
    float lsum = 0.f;
#pragma unroll
    for (int kt = 0; kt < 5; ++kt)
#pragma unroll
        for (int rr = 0; rr < 16; ++rr) { const float e = __builtin_amdgcn_exp2f(st[kt][rr] - mx); st[kt][rr] = e; lsum += e; }
    lsum += __shfl_xor(lsum, 32);
    f32x16 o[2]; o[0] = (f32x16){}; o[1] = (f32x16){};
    const int i16 = lane & 15, q4 = i16 >> 2, p4 = i16 & 3, gidx = (lane >> 4) & 1;
#pragma unroll
    for (int kt = 0; kt < 5; ++kt)
#pragma unroll
        for (int s2 = 0; s2 < 2; ++s2) {
            const bf16x8 pb = pack8(st[kt][8 * s2 + 0], st[kt][8 * s2 + 1], st[kt][8 * s2 + 2], st[kt][8 * s2 + 3], st[kt][8 * s2 + 4], st[kt][8 * s2 + 5], st[kt][8 * s2 + 6], st[kt][8 * s2 + 7]);
            const int jrow = 32 * w + 32 * kt + 16 * s2 + 4 * hi + q4;
#pragma unroll
            for (int dt = 0; dt < 2; ++dt) {
                const LAS unsigned char* a0 = lds + V_OFF + jrow * KP + (32 * dt + 16 * gidx + 4 * p4) * 2;
                const bf16x8 va = cat8(tr_read(a0), tr_read(a0 + 8 * KP));
                o[dt] = MFMA32(va, pb, o[dt]);
            }
        }
    const float inv = 1.0f / lsum;
    bf16* orow = (p == 0 ? T.Oa : T.Ob + (size_t)(p - 1) * MTOK * AW) + qrow * 1024 + h * 64;
#pragma unroll
    for (int dt = 0; dt < 2; ++dt)
#pragma unroll
        for (int g4 = 0; g4 < 4; ++g4) {
            v2u wv; wv.x = pk2(o[dt][4 * g4] * inv, o[dt][4 * g4 + 1] * inv); wv.y = pk2(o[dt][4 * g4 + 2] * inv, o[dt][4 * g4 + 3] * inv);
            *(v2u*)(orow + 32 * dt + 8 * g4 + 4 * hi) = wv;
        }
    if (hi == 0) { f32x2_t sv = {mx, lsum}; *(f32x2_t*)(T.st + ((size_t)p * MTOK + qrow) * 32 + h * 2) = sv; }
    __syncthreads();
}
DI void phase(LAS unsigned char* lds, const Tensors& T, int G, int blk, int wv) {
    for (int u = blk; u < BATCH * AH * 48; u += G) unit(lds, T, u, wg_tid(wv));
}
}
namespace mpre {
constexpr int TP = 144;
constexpr int XC_OFF = 0, XM_OFF = 256 * TP, QT_OFF = 2 * 256 * TP, RED_OFF = 3 * 256 * TP, GRED_OFF = RED_OFF + 4 * 4096, LDS_BYTES = GRED_OFF + 4 * 64 * 8 * 4;
struct Tensors { bf16* xm; const bf16* halo; bf16* xcT; bf16* xmT; float* gp; bf16* S; const float* convw; const float* convb; const bf16* WcT; const bf16* WmT; const float* G; };

DI void unit(LAS unsigned char* lds, const Tensors& T, int u, int tid_in) {
    int tid_ = tid_in; asm volatile("" : "+v"(tid_));
    const int tid = tid_, lane = tid & 63, l31 = lane & 31, hi = lane >> 5, w = __builtin_amdgcn_readfirstlane(tid >> 6);
    const int h = u & 3, c = (u >> 2) & 63, b = u >> 8;
    const int g6 = lane, tp = w;
    const size_t tok0 = (size_t)b * SEQ + 64 * c;
    const int ti = w & 1, si = (w >> 1) & 1, kh = w >> 2;
    f32x16 sacc = {};
    f32x16 gacc = {};
    const int kq = w >> 1;
    const int i16 = lane & 15, q4 = i16 >> 2, p4 = i16 & 3, gidx = (lane >> 4) & 1;
#pragma unroll 1
    for (int hh = 0; hh < 2; ++hh) {
        const int gg = 128 * h + 64 * hh + g6, ch = 4 * gg;
        v2u xr[11];
#pragma unroll
        for (int k = 0; k < 11; ++k) {
            const int tl = 8 * tp - 3 + k;
            if (tl >= 0) xr[k] = *(const v2u*)(T.xm + (tok0 + tl) * 2048 + ch);
            else if (c > 0) xr[k] = *(const v2u*)(T.halo + ((size_t)(b * 64 + c - 1) * 3 + (3 + tl)) * 2048 + ch);
            else xr[k] = (v2u){0u, 0u};
        }
        float xmv[11][4];
#pragma unroll
        for (int k = 0; k < 11; ++k) { xmv[k][0] = bflo(xr[k].x); xmv[k][1] = bfhi(xr[k].x); xmv[k][2] = bflo(xr[k].y); xmv[k][3] = bfhi(xr[k].y); }
        float cw[4][4], cb[4], Gm[4][4];
        {
            const f32x4 b4 = *(const f32x4*)(T.convb + ch); cb[0] = b4[0]; cb[1] = b4[1]; cb[2] = b4[2]; cb[3] = b4[3];
#pragma unroll
            for (int tap = 0; tap < 4; ++tap) { const f32x4 w4 = *(const f32x4*)(T.convw + tap * 2048 + ch); cw[tap][0] = w4[0]; cw[tap][1] = w4[1]; cw[tap][2] = w4[2]; cw[tap][3] = w4[3]; }
#pragma unroll
            for (int i = 0; i < 4; ++i) { const f32x4 g4 = *(const f32x4*)(T.G + gg * 16 + i * 4); Gm[i][0] = g4[0]; Gm[i][1] = g4[1]; Gm[i][2] = g4[2]; Gm[i][3] = g4[3]; }
        }
        asm volatile("s_waitcnt vmcnt(0)" ::: "memory");
        __syncthreads();
        unsigned xcp[4][4], xmp[4][4], qtp[4][4];
        float prev_xc[4], prev_q[4];
#pragma unroll
        for (int tl = 0; tl < 8; ++tl) {
            float xc[4], qt[4];
#pragma unroll
            for (int i = 0; i < 4; ++i) {
                float a = cb[i];
#pragma unroll
                for (int tap = 0; tap < 4; ++tap) a += cw[tap][i] * xmv[tl + tap][i];
                xc[i] = siluf_(a);
            }
#pragma unroll
            for (int i2 = 0; i2 < 4; ++i2) qt[i2] = xc[0] * Gm[0][i2] + xc[1] * Gm[1][i2] + xc[2] * Gm[2][i2] + xc[3] * Gm[3][i2];
            { v2u qo; qo.x = pk2(qt[0], qt[1]); qo.y = pk2(qt[2], qt[3]); *(v2u*)(T.xm + (tok0 + 8 * tp + tl) * 2048 + ch) = qo; }
            if (tl & 1) {
#pragma unroll
                for (int i = 0; i < 4; ++i) { xcp[i][tl >> 1] = pk2(prev_xc[i], xc[i]); qtp[i][tl >> 1] = pk2(prev_q[i], qt[i]); xmp[i][tl >> 1] = pk2(xmv[tl + 2][i], xmv[tl + 3][i]); }
            } else {
#pragma unroll
                for (int i = 0; i < 4; ++i) { prev_xc[i] = xc[i]; prev_q[i] = qt[i]; }
            }
        }
#pragma unroll
        for (int i = 0; i < 4; ++i) {
            const int off = (4 * g6 + i) * TP + 16 * tp;
            *(LAS v4u*)(lds + XC_OFF + off) = (v4u){xcp[i][0], xcp[i][1], xcp[i][2], xcp[i][3]};
            *(LAS v4u*)(lds + XM_OFF + off) = (v4u){xmp[i][0], xmp[i][1], xmp[i][2], xmp[i][3]};
            *(LAS v4u*)(lds + QT_OFF + off) = (v4u){qtp[i][0], qtp[i][1], qtp[i][2], qtp[i][3]};
        }
        __syncthreads();
#pragma unroll
        for (int k = 0; k < 4; ++k) {
            const int id = tid + 512 * k, row = id >> 3, pc = id & 7;
            const size_t goff = ((size_t)b * 2048 + 512 * h + 256 * hh + row) * SEQ + 64 * c + 8 * pc;
            *(v4u*)(T.xcT + goff) = *(const LAS v4u*)(lds + XC_OFF + row * TP + 16 * pc);
            *(v4u*)(T.xmT + goff) = *(const LAS v4u*)(lds + XM_OFF + row * TP + 16 * pc);
        }
#pragma unroll
        for (int ks = 0; ks < 8; ++ks) {
            const int crow0 = 128 * kh + 16 * ks + 8 * hi + q4;
            const LAS unsigned char* pa = lds + XC_OFF + crow0 * TP + (32 * si + 16 * gidx + 4 * p4) * 2;
            const LAS unsigned char* pb = lds + QT_OFF + crow0 * TP + (32 * ti + 16 * gidx + 4 * p4) * 2;
            const bf16x8 af = cat8(tr_read(pa), tr_read(pa + 4 * TP));
            const bf16x8 bfr = cat8(tr_read(pb), tr_read(pb + 4 * TP));
            sacc = MFMA32(af, bfr, sacc);
        }
#pragma unroll
        for (int ks = 0; ks < 4; ++ks) {
            const int crow1 = 64 * kq + 16 * ks + 8 * hi + q4;
            const LAS unsigned char* pc_ = lds + XC_OFF + crow1 * TP + (32 * ti + 16 * gidx + 4 * p4) * 2;
            const LAS unsigned char* pm_ = lds + XM_OFF + crow1 * TP + (32 * ti + 16 * gidx + 4 * p4) * 2;
            const bf16x8 ac = cat8(tr_read(pc_), tr_read(pc_ + 4 * TP));
            const bf16x8 am = cat8(tr_read(pm_), tr_read(pm_ + 4 * TP));
            const int c0 = 512 * h + 256 * hh + 64 * kq + 16 * ks + 8 * hi;
            const bf16x8 bc = *(const bf16x8*)(T.WcT + (l31 & 7) * 2048 + c0);
            const bf16x8 bm = *(const bf16x8*)(T.WmT + (l31 & 7) * 2048 + c0);
            gacc = MFMA32(ac, bc, gacc);
            gacc = MFMA32(am, bm, gacc);
        }
    }
    if (l31 < 8) {
#pragma unroll
        for (int r = 0; r < 16; ++r) ((LAS float*)(lds + GRED_OFF))[(kq * 64 + 32 * ti + crow(r, hi)) * 8 + l31] = gacc[r];
    }
    __syncthreads();
    if (kh == 1) {
#pragma unroll
        for (int g4 = 0; g4 < 4; ++g4) *(LAS f32x4*)(lds + RED_OFF + ((w & 3) * 4 + g4) * 1024 + lane * 16) = (f32x4){sacc[4 * g4], sacc[4 * g4 + 1], sacc[4 * g4 + 2], sacc[4 * g4 + 3]};
    }
    __syncthreads();
    { const LAS float* gr = (const LAS float*)(lds + GRED_OFF);
      T.gp[((size_t)h * MTOK + tok0) * 8 + tid] = gr[tid] + gr[512 + tid] + gr[1024 + tid] + gr[1536 + tid]; }
    if (kh == 0) {
        bf16* sp = T.S + ((size_t)((b * 4 + h) * 64 + c) * 64 + 32 * ti + l31) * 64 + 32 * si;
#pragma unroll
        for (int g4 = 0; g4 < 4; ++g4) {
            const f32x4 o = *(const LAS f32x4*)(lds + RED_OFF + ((w & 3) * 4 + g4) * 1024 + lane * 16);
            v2u wv; wv.x = pk2(sacc[4 * g4] + o[0], sacc[4 * g4 + 1] + o[1]); wv.y = pk2(sacc[4 * g4 + 2] + o[2], sacc[4 * g4 + 3] + o[3]);
            *(v2u*)(sp + 8 * g4 + 4 * hi) = wv;
        }
    }
    __syncthreads();
}
DI void phase(LAS unsigned char* lds, const Tensors& T, int G, int blk, int wv) {
    for (int u = blk; u < BATCH * NCHUNK * MH; u += G) unit(lds, T, u, wg_tid(wv));
}
}
namespace mscan {
constexpr int QP = 1040, KP = 144;
constexpr int Q_OFF = 0, K_OFF = 64 * QP, V_OFF = K_OFF + 512 * KP, S_OFF = V_OFF + 64 * KP, SC_OFF = S_OFF + 64 * KP;
constexpr int SC_A = SC_OFF, SC_M = SC_OFF + 256, SC_THR = SC_OFF + 512, SC_DEN = SC_OFF + 768, SC_CW = SC_OFF + 1024, SC_NS = SC_OFF + 1280, SC_TMP = SC_NS + 2048, LDS_BYTES = SC_TMP + 128;
static_assert(LDS_BYTES <= 163840, "scan LDS");
struct Tensors { const bf16* q; const bf16* xcT; const bf16* xmT; const bf16* S; const float* gp; const float* bif; float* scal; bf16* hm; };

DI float logsigmoid_(float x) { return fminf(x, 0.f) - log1pf(__expf(-fabsf(x))); }

DI void unit(LAS unsigned char* lds, const Tensors& T, int bh, int es, int tid_in) {
    int tid_ = tid_in; asm volatile("" : "+v"(tid_));
    const int tid = tid_, lane = tid & 63, l31 = lane & 31, hi = lane >> 5, wid = __builtin_amdgcn_readfirstlane(tid >> 6);
    const int eg = wid & 1, dq = wid >> 1;
    const int b = bh >> 2, h = bh & 3;
    LAS float* sA = (LAS float*)(lds + SC_A); LAS float* sM = (LAS float*)(lds + SC_M); LAS float* sThr = (LAS float*)(lds + SC_THR);
    LAS float* sDen = (LAS float*)(lds + SC_DEN); LAS float* sCw = (LAS float*)(lds + SC_CW); LAS float* sNs = (LAS float*)(lds + SC_NS); LAS float* sTmp = (LAS float*)(lds + SC_TMP);
    float* scal = T.scal + (size_t)bh * 3 * SEQ;
    {
        float li[8], cs[8];
        const float bi = T.bif[h], bf_ = T.bif[4 + h];
        float run = 0.f;
        const float* gpb = T.gp + (size_t)b * SEQ * 8 + h;
        const unsigned toff = (unsigned)tid * 64u;
#pragma unroll
        for (int k = 0; k < 8; ++k) { li[k] = bi; cs[k] = bf_; }
#pragma unroll
        for (int hh = 0; hh < 4; ++hh) {
            const float* p = gpb + (size_t)hh * MTOK * 8;
#pragma unroll
            for (int k = 0; k < 8; ++k) { li[k] += p[toff + k * 8]; cs[k] += p[toff + k * 8 + 4]; }
        }
#pragma unroll
        for (int k = 0; k < 8; ++k) { run += logsigmoid_(cs[k]); cs[k] = run; }
        float inc = run;
#pragma unroll
        for (int o = 1; o < 64; o <<= 1) { const float t = __shfl_up(inc, o); if (lane >= o) inc += t; }
        if (lane == 63) sTmp[wid] = inc;
        __syncthreads();
        float base = inc - run;
        for (int w2 = 0; w2 < wid; ++w2) base += sTmp[w2];
        __syncthreads();
        float av[8], mloc = -3.0e38f, cm[8];
#pragma unroll
        for (int k = 0; k < 8; ++k) { cs[k] += base; av[k] = li[k] - cs[k]; mloc = fmaxf(mloc, av[k]); cm[k] = mloc; }
        float minc = mloc;
#pragma unroll
        for (int o = 1; o < 64; o <<= 1) { const float t = __shfl_up(minc, o); if (lane >= o) minc = fmaxf(minc, t); }
        if (lane == 63) sTmp[wid] = minc;
        __syncthreads();
        float mbase = __shfl_up(minc, 1); if (lane == 0) mbase = -3.0e38f;
        for (int w2 = 0; w2 < wid; ++w2) mbase = fmaxf(mbase, sTmp[w2]);
#pragma unroll
        for (int k = 0; k < 8; ++k) {
            const float Mt = fmaxf(mbase, cm[k]);
            scal[0 * SEQ + 8 * tid + k] = av[k]; scal[1 * SEQ + 8 * tid + k] = Mt; scal[2 * SEQ + 8 * tid + k] = __expf(-(cs[k] + Mt));
        }
        sNs[tid] = 0.f;
        __threadfence();
        __syncthreads();
    }
    f32x16 cst[4];
#pragma unroll
    for (int i = 0; i < 4; ++i) cst[i] = (f32x16){};
    float Mc = 0.f;
    const bf16* qg = T.q + (size_t)b * SEQ * 2048 + 512 * h;
    const bf16* kg = T.xcT + ((size_t)b * 2048 + 512 * h) * SEQ;
    const bf16* vg = T.xmT + ((size_t)b * 2048 + 512 * h + 64 * es) * SEQ;
    const bf16* sg = T.S + (size_t)(bh * 64) * 4096;
    bf16* hg = T.hm + (size_t)b * SEQ * 2048 + 512 * h + 64 * es;
    const unsigned voffq = (unsigned)((tid >> 6) * 4096 + (tid & 63) * 16), voffk = (unsigned)((tid >> 3) * 8192 + (tid & 7) * 16), voffs = (unsigned)(tid * 16);
#pragma unroll 1
    for (int c = 0; c < NCHUNK; ++c) {
        {
            const char* qb = (const char*)qg + (size_t)c * (64 * 4096);
            const char* kb = (const char*)kg + (size_t)c * 128;
            const char* vb = (const char*)vg + (size_t)c * 128;
            const char* sb = (const char*)sg + (size_t)c * 8192;
#pragma unroll
            for (int k = 0; k < 8; ++k) {
                *(LAS v4u*)(lds + Q_OFF + ((tid >> 6) + 8 * k) * QP + (tid & 63) * 16) = *(const v4u*)(qb + (size_t)k * 32768 + voffq);
                *(LAS v4u*)(lds + K_OFF + ((tid >> 3) + 64 * k) * KP + (tid & 7) * 16) = *(const v4u*)(kb + (size_t)k * (64 * 8192) + voffk);
            }
            *(LAS v4u*)(lds + V_OFF + (tid >> 3) * KP + (tid & 7) * 16) = *(const v4u*)(vb + voffk);
            *(LAS v4u*)(lds + S_OFF + (tid >> 3) * KP + (tid & 7) * 16) = *(const v4u*)(sb + voffs);
        }
        if (tid < 64) { sA[tid] = scal[0 * SEQ + 64 * c + tid]; sM[tid] = scal[1 * SEQ + 64 * c + tid]; sThr[tid] = scal[2 * SEQ + 64 * c + tid]; }
        __syncthreads();
        if (c == 0) Mc = sM[0];
        const float Mc2 = sM[63];
        {
            const int t = tid >> 3, g8 = tid & 7;
            const float Mt = sM[t];
            float qn = 0.f;
#pragma unroll
            for (int k = 0; k < 8; ++k) {
                const v4u qv = *(const LAS v4u*)(lds + Q_OFF + t * QP + (64 * g8 + 8 * k) * 2);
                const f32x4 n0 = *(const LAS f32x4*)(sNs + 64 * g8 + 8 * k), n1 = *(const LAS f32x4*)(sNs + 64 * g8 + 8 * k + 4);
                qn += bflo(qv.x) * n0[0] + bfhi(qv.x) * n0[1] + bflo(qv.y) * n0[2] + bfhi(qv.y) * n0[3] + bflo(qv.z) * n1[0] + bfhi(qv.z) * n1[1] + bflo(qv.w) * n1[2] + bfhi(qv.w) * n1[3];
                if (k & 1) __builtin_amdgcn_sched_barrier(0);
            }
            float ps = 0.f;
            {
                const v4u sv = *(const LAS v4u*)(lds + S_OFF + t * KP + (8 * g8) * 2);
                const float sf[8] = {bflo(sv.x), bfhi(sv.x), bflo(sv.y), bfhi(sv.y), bflo(sv.z), bfhi(sv.z), bflo(sv.w), bfhi(sv.w)};
#pragma unroll
                for (int j = 0; j < 8; ++j) { const int s = 8 * g8 + j; const float wgt = (s <= t) ? __expf(sA[s] - Mt) : 0.f; ps += sf[j] * wgt; }
            }
            float d = __expf(Mc - Mt) * qn + ps;
            d += __shfl_xor(d, 1); d += __shfl_xor(d, 2); d += __shfl_xor(d, 4);
            if (g8 == 0) sDen[t] = d;
            if (tid < 64) sCw[tid] = __expf(sA[tid] - Mc2);
        }
        f32x16 ao[2]; ao[0] = (f32x16){}; ao[1] = (f32x16){};
#pragma unroll
        for (int i = 0; i < 4; ++i)
#pragma unroll
            for (int s = 0; s < 2; ++s) {
                const bf16x8 cb = pack8(cst[i][8 * s + 0], cst[i][8 * s + 1], cst[i][8 * s + 2], cst[i][8 * s + 3], cst[i][8 * s + 4], cst[i][8 * s + 5], cst[i][8 * s + 6], cst[i][8 * s + 7]);
#pragma unroll
                for (int tt = 0; tt < 2; ++tt) {
                    const LAS unsigned char* qa = lds + Q_OFF + (32 * tt + l31) * QP + (128 * dq + 32 * i + 16 * s + 4 * hi) * 2;
                    const s16x4 lo = *(const LAS s16x4*)qa, hi4 = *(const LAS s16x4*)(qa + 16);
                    ao[tt] = MFMA32(cb, cat8(lo, hi4), ao[tt]);
                }
                __builtin_amdgcn_sched_barrier(0);
            }
#pragma unroll
        for (int tt = 0; tt < 2; ++tt) {
            const int t = 32 * tt + l31;
            const float Mt = sM[t];
            const float rs = __expf(Mc - Mt);
#pragma unroll
            for (int r = 0; r < 16; ++r) ao[tt][r] *= rs;
            const bf16x8 vf = *(const LAS bf16x8*)(lds + V_OFF + (32 * eg + l31) * KP + (16 * dq + 8 * hi) * 2);
            const v4u sv = *(const LAS v4u*)(lds + S_OFF + t * KP + (16 * dq + 8 * hi) * 2);
            const float sf[8] = {bflo(sv.x), bfhi(sv.x), bflo(sv.y), bfhi(sv.y), bflo(sv.z), bfhi(sv.z), bflo(sv.w), bfhi(sv.w)};
            float pw[8];
#pragma unroll
            for (int j = 0; j < 8; ++j) { const int s = 16 * dq + 8 * hi + j; pw[j] = (s <= t) ? sf[j] * __expf(sA[s] - Mt) : 0.f; }
            ao[tt] = MFMA32(vf, pack8(pw[0], pw[1], pw[2], pw[3], pw[4], pw[5], pw[6], pw[7]), ao[tt]);
        }
        __syncthreads();
#pragma unroll
        for (int g = 0; g < 4; ++g)
#pragma unroll
            for (int tt = 0; tt < 2; ++tt)
                *(LAS f32x4*)(lds + Q_OFF + ((((dq * 2 + eg) * 4 + g) * 2 + tt) * 1024) + lane * 16) = (f32x4){ao[tt][4 * g], ao[tt][4 * g + 1], ao[tt][4 * g + 2], ao[tt][4 * g + 3]};
        const float decay = __expf(Mc - Mc2);
        {
            float nsv = sNs[tid] * decay;
#pragma unroll
            for (int k = 0; k < 8; ++k) {
                const v4u kv = *(const LAS v4u*)(lds + K_OFF + tid * KP + 16 * k);
                const f32x4 c0 = *(const LAS f32x4*)(sCw + 8 * k), c1 = *(const LAS f32x4*)(sCw + 8 * k + 4);
                nsv += bflo(kv.x) * c0[0] + bfhi(kv.x) * c0[1] + bflo(kv.y) * c0[2] + bfhi(kv.y) * c0[3] + bflo(kv.z) * c1[0] + bfhi(kv.z) * c1[1] + bflo(kv.w) * c1[2] + bfhi(kv.w) * c1[3];
                if (k & 1) __builtin_amdgcn_sched_barrier(0);
            }
            sNs[tid] = nsv;
        }
#pragma unroll
        for (int i = 0; i < 4; ++i)
#pragma unroll
            for (int r = 0; r < 16; ++r) cst[i][r] *= decay;
#pragma unroll
        for (int ks = 0; ks < 4; ++ks) {
            const v4u vv = *(const LAS v4u*)(lds + V_OFF + (32 * eg + l31) * KP + (16 * ks + 8 * hi) * 2);
            const f32x4 c0 = *(const LAS f32x4*)(sCw + 16 * ks + 8 * hi), c1 = *(const LAS f32x4*)(sCw + 16 * ks + 8 * hi + 4);
            const bf16x8 vw = pack8(bflo(vv.x) * c0[0], bfhi(vv.x) * c0[1], bflo(vv.y) * c0[2], bfhi(vv.y) * c0[3], bflo(vv.z) * c1[0], bfhi(vv.z) * c1[1], bflo(vv.w) * c1[2], bfhi(vv.w) * c1[3]);
#pragma unroll
            for (int i = 0; i < 4; ++i) {
                const bf16x8 kf = *(const LAS bf16x8*)(lds + K_OFF + (128 * dq + 32 * i + l31) * KP + (16 * ks + 8 * hi) * 2);
                cst[i] = MFMA32(kf, vw, cst[i]);
            }
            __builtin_amdgcn_sched_barrier(0);
        }
        __syncthreads();
#pragma unroll
        for (int tt = 0; tt < 2; ++tt) {
            f32x4 nm = {0.f, 0.f, 0.f, 0.f};
#pragma unroll
            for (int src = 0; src < 4; ++src) nm += *(const LAS f32x4*)(lds + Q_OFF + ((((src * 2 + eg) * 4 + dq) * 2 + tt) * 1024) + lane * 16);
            const int t = 32 * tt + l31;
            const float dn = fmaxf(fabsf(sDen[t]), sThr[t]);
            const float inv = 1.0f / dn;
            v2u wv; wv.x = pk2(nm[0] * inv, nm[1] * inv); wv.y = pk2(nm[2] * inv, nm[3] * inv);
            *(v2u*)(hg + (size_t)(64 * c + t) * 2048 + 32 * eg + 8 * dq + 4 * hi) = wv;
        }
        Mc = Mc2;
        __syncthreads();
    }
}
DI void phase(LAS unsigned char* lds, const Tensors& T, int G, int blk, int wv) {
#pragma unroll 1
    for (int u = blk; u < 256; u += G) {
        const int xcd = u & 7, j = u >> 3;
        unit(lds, T, xcd * 4 + (j >> 3), j & 7, wg_tid(wv));
    }
}
}
namespace mpost {
constexpr int GSTR = 576;
constexpr int XC_OFF = 0, WV_OFF = 128 * GSTR, LDS_BYTES = WV_OFF + 128 * 64;
struct Tensors { bf16* hm; const bf16* om; const bf16* xcT; const float* wv; const float* hng; const float* skip; };

DI void unit(LAS unsigned char* lds, const Tensors& T, int u, int tid_in) {
    int tid_ = tid_in; asm volatile("" : "+v"(tid_));
    const int tid = tid_;
    const int h = u & 3, c = (u >> 2) & 63, b = u >> 8;
#pragma unroll
    for (int k = 0; k < 2; ++k) {
        const int id = tid + 512 * k, pb = id & 7, g = id >> 3;
        const bf16* src = T.xcT + ((size_t)b * 2048 + 512 * h + 4 * g) * SEQ + 64 * c + 8 * pb;
        const v4u r0 = *(const v4u*)(src), r1 = *(const v4u*)(src + SEQ), r2 = *(const v4u*)(src + 2 * SEQ), r3 = *(const v4u*)(src + 3 * SEQ);
        const unsigned a0[4] = {r0.x, r0.y, r0.z, r0.w}, a1[4] = {r1.x, r1.y, r1.z, r1.w}, a2[4] = {r2.x, r2.y, r2.z, r2.w}, a3[4] = {r3.x, r3.y, r3.z, r3.w};
#pragma unroll
        for (int m = 0; m < 4; ++m) {
            v2u e0, e1;
            e0.x = (a0[m] & 0xffffu) | (a1[m] << 16); e0.y = (a2[m] & 0xffffu) | (a3[m] << 16);
            e1.x = (a0[m] >> 16) | (a1[m] & 0xffff0000u); e1.y = (a2[m] >> 16) | (a3[m] & 0xffff0000u);
            *(LAS v2u*)(lds + XC_OFF + g * GSTR + (8 * pb + 2 * m) * 8) = e0;
            *(LAS v2u*)(lds + XC_OFF + g * GSTR + (8 * pb + 2 * m + 1) * 8) = e1;
        }
    }
    *(LAS f32x4*)(lds + WV_OFF + tid * 16) = *(const f32x4*)(T.wv + (size_t)(128 * h) * 16 + tid * 4);
    __syncthreads();
    const int t5 = tid >> 4, seg = tid & 15;
#pragma unroll 1
    for (int pass = 0; pass < 2; ++pass) {
        const int t = t5 + 32 * pass;
        const size_t rowu = ((size_t)b * SEQ + 64 * c + 32 * pass) * 2048 + 512 * h;
        char* hmb = (char*)(T.hm + rowu); const char* omb = (const char*)(T.om + rowu);
        const char* gnb = (const char*)(T.hng + 512 * h); const char* skb = (const char*)(T.skip + 512 * h);
        const unsigned voff = (unsigned)(t5 * 4096 + seg * 8), soff = (unsigned)(seg * 16);
        float uv[32];
        float sum = 0.f;
#pragma unroll
        for (int k = 0; k < 8; ++k) {
            const int gi = seg + 16 * k;
            const v2u hx = *(const v2u*)(hmb + voff + k * 128);
            const v2u og = *(const v2u*)(omb + voff + k * 128);
            const float hv[4] = {bflo(hx.x), bfhi(hx.x), bflo(hx.y), bfhi(hx.y)};
            const float ov[4] = {bflo(og.x), bfhi(og.x), bflo(og.y), bfhi(og.y)};
            const LAS f32x4* wp = (const LAS f32x4*)(lds + WV_OFF + gi * 64);
            const f32x4 w0 = wp[0], w1 = wp[1], w2 = wp[2], w3 = wp[3];
#pragma unroll
            for (int o = 0; o < 4; ++o) {
                const float v = hv[0] * w0[o] + hv[1] * w1[o] + hv[2] * w2[o] + hv[3] * w3[o];
                const float x = v * ov[o];
                uv[4 * k + o] = x; sum += x;
            }
            if (k & 1) __builtin_amdgcn_sched_barrier(0);
        }
        sum += __shfl_xor(sum, 1); sum += __shfl_xor(sum, 2); sum += __shfl_xor(sum, 4); sum += __shfl_xor(sum, 8);
        const float mean = sum * (1.0f / 512.0f);
        float sq = 0.f;
#pragma unroll
        for (int i = 0; i < 32; ++i) { const float d = uv[i] - mean; sq += d * d; }
        sq += __shfl_xor(sq, 1); sq += __shfl_xor(sq, 2); sq += __shfl_xor(sq, 4); sq += __shfl_xor(sq, 8);
        const float rstd = 1.0f / sqrtf(sq * (1.0f / 512.0f) + EPS);
#pragma unroll
        for (int k = 0; k < 8; ++k) {
            const int gi = seg + 16 * k;
            const f32x4 gn = *(const f32x4*)(gnb + soff + k * 256), sk = *(const f32x4*)(skb + soff + k * 256);
            const v2u xc = *(const LAS v2u*)(lds + XC_OFF + gi * GSTR + t * 8);
            const float xv[4] = {bflo(xc.x), bfhi(xc.x), bflo(xc.y), bfhi(xc.y)};
            float r[4];
#pragma unroll
            for (int o = 0; o < 4; ++o) r[o] = (uv[4 * k + o] - mean) * rstd * gn[o] + sk[o] * xv[o];
            v2u wv; wv.x = pk2(r[0], r[1]); wv.y = pk2(r[2], r[3]);
            *(v2u*)(hmb + voff + k * 128) = wv;
        }
    }
    __syncthreads();
}
DI void phase(LAS unsigned char* lds, const Tensors& T, int G, int blk, int wv) {
    for (int u = blk; u < BATCH * NCHUNK * MH; u += G) unit(lds, T, u, wg_tid(wv));
}
}

DI void transpose_item(const float* W, int K, int N, bf16* WT, const float* kscale, LAS float* scr, int item, int lane) {
    const int nblk = N / 32, kb = item / nblk, nb = item % nblk, k0 = 64 * kb, n0 = 32 * nb;
#pragma unroll 8
    for (int i = 0; i < 32; ++i) { const int kk = 2 * i + (lane >> 5); float v = W[(size_t)(k0 + kk) * N + n0 + (lane & 31)]; if (kscale) v *= kscale[k0 + kk]; scr[kk * 33 + (lane & 31)] = v; }
    asm volatile("s_waitcnt lgkmcnt(0)" ::: "memory");
    const int cc = lane & 7;
#pragma unroll
    for (int j = 0; j < 4; ++j) { const int n = (lane >> 3) + 8 * j; const LAS float* s = scr + (8 * cc) * 33 + n;
        v4u o; o.x = pk2(s[0 * 33], s[1 * 33]); o.y = pk2(s[2 * 33], s[3 * 33]); o.z = pk2(s[4 * 33], s[5 * 33]); o.w = pk2(s[6 * 33], s[7 * 33]);
        *(v4u*)(WT + (size_t)(n0 + n) * K + k0 + 8 * cc) = o; }
    asm volatile("s_waitcnt lgkmcnt(0)" ::: "memory");
}
DI void rms_row_to_bf16(const float* xrow, bf16* orow, int lane) {
    const f32x4* xr = (const f32x4*)xrow + lane;
    f32x4 v[4]; float s = 0.f;
#pragma unroll
    for (int j = 0; j < 4; ++j) { v[j] = xr[64 * j]; s += (v[j][0] * v[j][0] + v[j][1] * v[j][1]) + (v[j][2] * v[j][2] + v[j][3] * v[j][3]); }
    const float r = 1.0f / sqrtf(wave_sum(s) * (1.0f / 1024.0f) + EPS);
    v2u* o8 = (v2u*)orow + lane;
#pragma unroll
    for (int j = 0; j < 4; ++j) { v2u w; w.x = pk2(v[j][0] * r, v[j][1] * r); w.y = pk2(v[j][2] * r, v[j][3] * r); o8[64 * j] = w; }
}
DI void rms_row_inplace(float* row, const float* g, int lane) {
    f32x4* xr = (f32x4*)row + lane; const f32x4* gr = (const f32x4*)g + lane;
    f32x4 v[4]; float s = 0.f;
#pragma unroll
    for (int j = 0; j < 4; ++j) { v[j] = xr[64 * j]; s += (v[j][0] * v[j][0] + v[j][1] * v[j][1]) + (v[j][2] * v[j][2] + v[j][3] * v[j][3]); }
    const float r = 1.0f / sqrtf(wave_sum(s) * (1.0f / 1024.0f) + EPS);
#pragma unroll
    for (int j = 0; j < 4; ++j) xr[64 * j] = v[j] * r * gr[64 * j];
}
constexpr int N_PHASES = 15;
constexpr int LDS_TOTAL = 163840;
static_assert(pg8::STAGE_BYTES <= LDS_TOTAL && att::LDS_BYTES <= LDS_TOTAL && mpre::LDS_BYTES <= LDS_TOTAL && mscan::LDS_BYTES <= LDS_TOTAL && mpost::LDS_BYTES <= LDS_TOTAL, "LDS map");

struct Args { const float* in[18]; float* out; unsigned char* ws; int ph_lo, ph_hi; };

DI void prologue(const Args& a, LAS unsigned char* lds, int G, int blk, int wvi) {
    const int tid = wg_tid(wvi), lane = tid & 63, wave = __builtin_amdgcn_readfirstlane(tid >> 6);
    unsigned char* ws = a.ws;
    LAS float* scr = (LAS float*)(lds + wave * 16384);
    const int gw = blk * NWAVES + wave, NGW = G * NWAVES;
    constexpr int I_IN = (DM / 64) * (NIN / 32), I_PA = (AW / 64) * (DM / 32), I_PB = (MW / 64) * (DM / 32), I_OUT = (DM / 64) * (DM / 32);
    constexpr int NITEMS = I_IN + I_PA + I_PB + I_OUT;
    for (int it = gw; it < NITEMS; it += NGW) {
        int r = it;
        if (r < I_IN) { transpose_item(a.in[2], DM, NIN, (bf16*)(ws + WS_WIN), a.in[1], scr, r, lane); continue; } r -= I_IN;
        if (r < I_PA) { transpose_item(a.in[13], AW, DM, (bf16*)(ws + WS_WPA), nullptr, scr, r, lane); continue; } r -= I_PA;
        if (r < I_PB) { transpose_item(a.in[14], MW, DM, (bf16*)(ws + WS_WPB), nullptr, scr, r, lane); continue; } r -= I_PB;
        transpose_item(a.in[15], DM, DM, (bf16*)(ws + WS_WOUT), nullptr, scr, r, lane);
    }
    for (int m = gw; m < MTOK; m += NGW) rms_row_to_bf16(a.in[0] + (size_t)m * DM, (bf16*)(ws + WS_XN) + (size_t)m * DM, lane);
    float* tab = (float*)(ws + WS_TAB);
    const float* wq = a.in[6]; const float* wk = a.in[7]; const float* wv = a.in[8]; const float* wif = a.in[9]; const float* rb = a.in[16];
    const int gt = blk * NTHR + tid, NGT = G * NTHR;
    for (int i = gt; i < 2048 * 8; i += NGT) {
        const int c = i >> 3, j = i & 7, g = c >> 2, ii = c & 3;
        float sc = 0.f, sm = 0.f;
#pragma unroll
        for (int o = 0; o < 4; ++o) {
            sc += wq[g * 16 + ii * 4 + o] * wif[(size_t)(4 * g + o) * 8 + j] + wk[g * 16 + ii * 4 + o] * wif[(size_t)(2048 + 4 * g + o) * 8 + j];
            sm += wv[g * 16 + ii * 4 + o] * wif[(size_t)(4096 + 4 * g + o) * 8 + j];
        }
        ((bf16*)(tab + TAB_WC))[j * 2048 + c] = (bf16)(pk2(sc, 0.f) & 0xffffu); ((bf16*)(tab + TAB_WM))[j * 2048 + c] = (bf16)(pk2(sm, 0.f) & 0xffffu);
    }
    for (int i = gt; i < 512 * 16; i += NGT) {
        const int g = i >> 4, ii = (i >> 2) & 3, i2 = i & 3;
        float s = 0.f;
#pragma unroll
        for (int o = 0; o < 4; ++o) s += wq[g * 16 + ii * 4 + o] * wk[g * 16 + i2 * 4 + o];
        tab[TAB_G + i] = s * 0.04419417382415922f;
    }
    for (int i = gt; i < 3 * 16 * 132; i += NGT) {
        const int d = i % 132, ph = i / 132, p = ph >> 4, hh = ph & 15;
        tab[TAB_BIAS + i] = rb[BUCKET[p][d] * 16 + hh] * LOG2E;
    }
}

DI void grid_sync_(int tid) {
    asm volatile("s_waitcnt vmcnt(0) lgkmcnt(0)" ::: "memory");
    __builtin_amdgcn_fence(__ATOMIC_RELEASE, "workgroup");
    __builtin_amdgcn_s_barrier();
    if (tid == 0) {
        __builtin_amdgcn_fence(__ATOMIC_ACQUIRE, "workgroup");
        __builtin_amdgcn_fence(__ATOMIC_RELEASE, "agent");
        const __attribute__((address_space(4))) char* ia = (const __attribute__((address_space(4))) char*)__builtin_amdgcn_implicitarg_ptr();
        const unsigned long long p = *(const __attribute__((address_space(4))) unsigned long long*)(ia + 88);
        unsigned* bar = (unsigned*)(p + 32);
        const unsigned nwg = *(const unsigned*)(p + 40);
        const unsigned old = __hip_atomic_fetch_add(bar, 1u, __ATOMIC_RELAXED, __HIP_MEMORY_SCOPE_AGENT);
        if ((old & 0xffffu) == nwg - 1u) (void)__hip_atomic_fetch_add(bar, 65536u - nwg, __ATOMIC_RELAXED, __HIP_MEMORY_SCOPE_AGENT);
        const unsigned gen = old & 0xffff0000u;
        while ((__hip_atomic_load(bar, __ATOMIC_RELAXED, __HIP_MEMORY_SCOPE_AGENT) & 0xffff0000u) == gen) __builtin_amdgcn_s_sleep(1);
        __builtin_amdgcn_fence(__ATOMIC_ACQUIRE, "agent");
        __builtin_amdgcn_fence(__ATOMIC_RELEASE, "workgroup");
    }
    __builtin_amdgcn_s_barrier();
    __builtin_amdgcn_fence(__ATOMIC_ACQUIRE, "workgroup");
}

__global__ void __launch_bounds__(NTHR) mk_fwd(Args a) {
    extern __shared__ __attribute__((aligned(16))) unsigned char lds_raw[];
    LAS unsigned char* lds = (LAS unsigned char*)lds_raw;
    const int G = gridDim.x, blk = blockIdx.x;
    const int wv = __builtin_amdgcn_readfirstlane(threadIdx.x >> 6);
    unsigned char* ws = a.ws;
    const int lo = a.ph_lo, hi = a.ph_hi;
    bf16* XN = (bf16*)(ws + WS_XN); bf16* WIN = (bf16*)(ws + WS_WIN);
#ifndef PH_MASK
#define PH_MASK 0x7fff
#endif
#define IN(k) (((PH_MASK >> (k)) & 1) && lo <= (k) && (k) < hi)
#define SEAM(k) do { if (IN(k) && IN((k) + 1)) grid_sync_(wg_tid(wv)); } while (0)
#define GEMM_PHASE(EPI, E, Aop, Bop, NN, KK) do { pg8::Gemm g{(const pg8::bf16_t*)(Aop), (const pg8::bf16_t*)(Bop), MTOK, (NN), (KK)}; pg8::StaticOrder S; S.init(MTOK, (NN), G, blk); \
        pg8::gemm_phase<EPI, pg8::StaticOrder, true, true>(lds, g, S, E, wg_tid(wv)); } while (0)

    if (IN(0)) { prologue(a, lds, G, blk, wv); } SEAM(0);
    if (IN(1)) {
        pg8::EpiXM E{(bf16*)(ws + WS_R0), (bf16*)(ws + WS_HALO)};
        GEMM_PHASE(pg8::EpiXM, E, XN, WIN + (size_t)C_XM * DM, MW, DM);
    } SEAM(1);
    if (IN(2)) {
        const float* tab = (const float*)(ws + WS_TAB);
        mpre::Tensors T{(bf16*)(ws + WS_R0), (const bf16*)(ws + WS_HALO), (bf16*)(ws + WS_R1), (bf16*)a.out, (float*)(ws + WS_GP), (bf16*)(ws + WS_S), a.in[4], a.in[5], (const bf16*)(tab + TAB_WC), (const bf16*)(tab + TAB_WM), tab + TAB_G};
        mpre::phase(lds, T, G, blk, wv);
    } SEAM(2);
    if (IN(3)) {
        mscan::Tensors T{(const bf16*)(ws + WS_R0), (const bf16*)(ws + WS_R1), (const bf16*)a.out, (const bf16*)(ws + WS_S), (const float*)(ws + WS_GP), a.in[10], (float*)(ws + WS_SCAL), (bf16*)(ws + WS_R2)};
        mscan::phase(lds, T, G, blk, wv);
    } SEAM(3);
    if (IN(4)) {
        pg8::EpiSig E{(bf16*)(ws + WS_R0), MW, nullptr};
        GEMM_PHASE(pg8::EpiSig, E, XN, WIN + (size_t)C_OM * DM, MW, DM);
    } SEAM(4);
    if (IN(5)) {
        mpost::Tensors T{(bf16*)(ws + WS_R2), (const bf16*)(ws + WS_R0), (const bf16*)(ws + WS_R1), a.in[8], a.in[11], a.in[12]};
        mpost::phase(lds, T, G, blk, wv);
    } SEAM(5);
    if (IN(6)) {
        pg8::EpiZM E{(bf16*)(ws + WS_R2)};
        GEMM_PHASE(pg8::EpiZM, E, XN, WIN + (size_t)C_ZM * DM, MW, DM);
    } SEAM(6);
    if (IN(7)) {
        pg8::EpiQKV E{(bf16*)(ws + WS_QA), (size_t)(WS_KA - WS_QA) / 2};
        GEMM_PHASE(pg8::EpiQKV, E, XN, WIN + (size_t)C_QA * DM, 3 * AW, DM);
    } SEAM(7);
    if (IN(8)) {
        att::Tensors T{(const bf16*)(ws + WS_QA), (const bf16*)(ws + WS_KA), (const bf16*)(ws + WS_VA), (bf16*)(ws + WS_O1), (bf16*)a.out, (float*)(ws + WS_ST), (const float*)(ws + WS_TAB) + TAB_BIAS};
        att::phase(lds, T, G, blk, wv);
    } SEAM(8);
    if (IN(9)) {
        pg8::EpiZA E{(const bf16*)(ws + WS_O1), (const bf16*)a.out, (const bf16*)a.out + (size_t)MTOK * AW, (const float*)(ws + WS_ST), (bf16*)(ws + WS_A1)};
        GEMM_PHASE(pg8::EpiZA, E, XN, WIN + (size_t)C_ZA * DM, AW, DM);
    } SEAM(9);
    if (IN(10)) {
        pg8::EpiSig E{(bf16*)(ws + WS_G), 2 * DM, a.in[3]};
        GEMM_PHASE(pg8::EpiSig, E, XN, WIN + (size_t)C_G * DM, 2 * DM, DM);
    } SEAM(10);
    if (IN(11)) {
        pg8::EpiYA E{(bf16*)(ws + WS_G)};
        GEMM_PHASE(pg8::EpiYA, E, ws + WS_A1, ws + WS_WPA, DM, AW);
    } SEAM(11);
    if (IN(12)) {
        pg8::EpiYM E{(const bf16*)(ws + WS_G), (bf16*)(ws + WS_MRG)};
        GEMM_PHASE(pg8::EpiYM, E, ws + WS_R2, ws + WS_WPB, DM, MW);
    } SEAM(12);
    if (IN(13)) {
        pg8::EpiOut E{a.in[0], a.out};
        GEMM_PHASE(pg8::EpiOut, E, ws + WS_MRG, ws + WS_WOUT, DM, DM);
    } SEAM(13);
    if (IN(14)) {
        const int lane = wg_tid(wv) & 63, wave = wv;
        for (int m = blk * NWAVES + wave; m < MTOK; m += G * NWAVES) rms_row_inplace(a.out + (size_t)m * DM, a.in[17], lane);
    }
#undef IN
#undef SEAM
#undef GEMM_PHASE
}

#ifndef MK_ONE_LAUNCH
#define MK_ONE_LAUNCH 0
#endif
extern "C" void kernel_launch(void* const* d_in, const int* in_sizes, int n_in, void* d_out, int out_size, void* d_ws, size_t ws_size, hipStream_t stream) {
    static int grid = 0;
    if (grid == 0) {
        if (n_in != 18 || in_sizes[0] != MTOK * DM || out_size != MTOK * DM || ws_size < WS_END) { fprintf(stderr, "kernel_launch: unexpected shapes (n_in %d, ws %zu)\n", n_in, ws_size); grid = -1; return; }
        int dev = 0, cus = 0, per_cu = 0;
        (void)hipGetDevice(&dev); (void)hipDeviceGetAttribute(&cus, hipDeviceAttributeMultiprocessorCount, dev);
        if (hipFuncSetAttribute((const void*)mk_fwd, hipFuncAttributeMaxDynamicSharedMemorySize, LDS_TOTAL) != hipSuccess) { fprintf(stderr, "kernel_launch: hipFuncSetAttribute failed\n"); grid = -1; return; }
        if (hipOccupancyMaxActiveBlocksPerMultiprocessor(&per_cu, (const void*)mk_fwd, NTHR, LDS_TOTAL) != hipSuccess || per_cu < 1) { fprintf(stderr, "kernel_launch: occupancy query says %d\n", per_cu); per_cu = 1; }
        (void)hipGetLastError();
        grid = cus * (per_cu > 1 ? 1 : per_cu);
    }
    if (grid < 0) return;
    Args a{};
    for (int i = 0; i < 18; ++i) a.in[i] = (const float*)d_in[i];
    a.out = (float*)d_out; a.ws = (unsigned char*)d_ws;
#if MK_ONE_LAUNCH
    a.ph_lo = 0; a.ph_hi = N_PHASES;
    void* args[] = {&a};
    hipError_t e = hipLaunchCooperativeKernel((const void*)mk_fwd, dim3(grid), dim3(NTHR), args, LDS_TOTAL, stream);
    if (e != hipSuccess) fprintf(stderr, "cooperative launch failed: %s (grid %d)\n", hipGetErrorString(e), grid);
#else
    for (int p = 0; p < N_PHASES; ++p) {
        a.ph_lo = p; a.ph_hi = p + 1;
        hipLaunchKernelGGL(mk_fwd, dim3(grid), dim3(NTHR), LDS_TOTAL, stream, a);
    }
#endif
}
```

```cpp
#define MK_ONE_LAUNCH 1
#include <hip/hip_runtime.h>
#include <hip/hip_cooperative_groups.h>
#include <cstdio>
#include <cstdint>
namespace cg = cooperative_groups;
#define LAS __attribute__((address_space(3)))
#define GAS __attribute__((address_space(1)))
typedef unsigned short bf16;
typedef unsigned v4u __attribute__((ext_vector_type(4)));
typedef unsigned v2u __attribute__((ext_vector_type(2)));
typedef float f32x4 __attribute__((ext_vector_type(4)));
typedef float f32x16 __attribute__((ext_vector_type(16)));
typedef short bf16x8 __attribute__((ext_vector_type(8)));
typedef short s16x4 __attribute__((ext_vector_type(4)));
typedef float f32x2_t __attribute__((ext_vector_type(2)));
typedef __bf16 bf16x2_t __attribute__((ext_vector_type(2)));

constexpr int NWAVES = 8, NTHR = 512;
constexpr int BATCH = 8, SEQ = 4096, DM = 1024, MTOK = BATCH * SEQ;
constexpr int AH = 16, AHD = 64, AW = 1024;
constexpr int MH = 4, MHD = 512, MW = 2048;
constexpr int NIN = 12288;
constexpr int C_QA = 0, C_KA = 1024, C_VA = 2048, C_ZA = 3072, C_XM = 4096, C_ZM = 6144, C_OM = 8192, C_G = 10240;
constexpr int CHUNK = 64, NCHUNK = SEQ / CHUNK;
constexpr float EPS = 1e-6f;
constexpr float LOG2E = 1.4426950408889634f;
constexpr float QSCALE = 0.125f * 1.4426950408889634f;

constexpr size_t MiB = 1u << 20;
constexpr size_t WS_CTL = 0;
constexpr size_t WS_WIN = 1 * MiB;
constexpr size_t WS_WPA = 25 * MiB;
constexpr size_t WS_WPB = 27 * MiB;
constexpr size_t WS_WOUT = 31 * MiB;
constexpr size_t WS_TAB = 33 * MiB;
constexpr size_t WS_GP = 34 * MiB;
constexpr size_t WS_SCAL = 38 * MiB;
constexpr size_t WS_HALO = 40 * MiB;
constexpr size_t WS_ST = 34 * MiB;
constexpr size_t WS_XN = 46 * MiB;
constexpr size_t WS_R0 = 110 * MiB;
constexpr size_t WS_R1 = 238 * MiB;
constexpr size_t WS_R2 = 366 * MiB;
constexpr size_t WS_S = 494 * MiB;
constexpr size_t WS_END = 512 * MiB;
constexpr size_t WS_QA = 238 * MiB, WS_KA = 302 * MiB, WS_VA = 366 * MiB;
constexpr size_t WS_O1 = 430 * MiB;
constexpr size_t WS_A1 = 238 * MiB;
constexpr size_t WS_G = 302 * MiB;
constexpr size_t WS_MRG = 430 * MiB;
constexpr int TAB_WC = 0;
constexpr int TAB_WM = 2048 * 8;
constexpr int TAB_G = 2 * 2048 * 8;
constexpr int TAB_BIAS = TAB_G + 512 * 16;
constexpr int TAB_END = TAB_BIAS + 3 * 16 * 132;

__device__ const unsigned char BUCKET[3][132] = {
 {0,1,2,3,4,5,6,7,8,9,10,11,12,13,14,15,16,16,16,16,16,16,17,17,17,17,17,17,17,17,18,18,18,18,18,18,18,18,18,18,19,19,19,19,19,19,19,19,19,19,19,19,19,19,20,20,20,20,20,20,20,20,20,20,20,20,20,20,20,20,20,20,20,21,21,21,21,21,21,21,21,21,21,21,21,21,21,21,21,21,21,21,21,21,21,21,21,21,21,22,22,22,22,22,22,22,22,22,22,22,22,22,22,22,22,22,22,22,22,22,22,22,22,22,22,22,22,22,22,0,0,0},
 {0,4,8,12,16,16,17,17,18,18,19,19,19,19,20,20,20,20,20,21,21,21,21,21,21,22,22,22,22,22,22,22,22,22,23,23,23,23,23,23,23,23,23,23,23,23,24,24,24,24,24,24,24,24,24,24,24,24,24,24,24,24,25,25,25,25,25,25,25,25,25,25,25,25,25,25,25,25,25,25,25,25,25,26,26,26,26,26,26,26,26,26,26,26,26,26,26,26,26,26,26,26,26,26,26,26,26,26,26,26,26,26,26,27,27,27,27,27,27,27,27,27,27,27,27,27,27,27,27,0,0,0},
 {0,16,18,19,20,21,21,22,22,23,23,23,24,24,24,24,25,25,25,25,25,26,26,26,26,26,26,26,26,27,27,27,27,27,27,27,27,27,27,28,28,28,28,28,28,28,28,28,28,28,28,28,29,29,29,29,29,29,29,29,29,29,29,29,29,29,29,29,29,29,30,30,30,30,30,30,30,30,30,30,30,30,30,30,30,30,30,30,30,30,30,30,30,30,30,31,31,31,31,31,31,31,31,31,31,31,31,31,31,31,31,31,31,31,31,31,31,31,31,31,31,31,31,31,31,31,31,31,31,0,0,0}};

#define DI __device__ __forceinline__
DI unsigned pk2(float lo, float hi) { f32x2_t v = {lo, hi}; bf16x2_t b = __builtin_convertvector(v, bf16x2_t); return __builtin_bit_cast(unsigned, b); }
DI float bflo(unsigned u) { return __uint_as_float(u << 16); }
DI float bfhi(unsigned u) { return __uint_as_float(u & 0xffff0000u); }
DI float sigmoidf_(float x) { return 1.0f / (1.0f + __expf(-x)); }
DI float siluf_(float x) { return x / (1.0f + __expf(-x)); }
DI float wave_sum(float v) {
#pragma unroll
    for (int o = 1; o < 64; o <<= 1) v += __shfl_xor(v, o);
    return v;
}
DI int wg_tid(int wv) { return wv * 64 + (int)__builtin_amdgcn_mbcnt_hi(~0u, __builtin_amdgcn_mbcnt_lo(~0u, 0u)); }
DI int crow(int r, int hi) { return (r & 3) + 8 * (r >> 2) + 4 * hi; }
#define MFMA32(a, b, c) __builtin_amdgcn_mfma_f32_32x32x16_bf16((a), (b), (c), 0, 0, 0)
DI s16x4 tr_read(const LAS unsigned char* p) { return __builtin_bit_cast(s16x4, __builtin_amdgcn_ds_read_tr16_b64_v4i16((LAS s16x4*)p)); }
DI bf16x8 cat8(s16x4 lo, s16x4 hi) { return __builtin_shufflevector(lo, hi, 0, 1, 2, 3, 4, 5, 6, 7); }
DI bf16x8 pack8(float a0, float a1, float a2, float a3, float a4, float a5, float a6, float a7) {
    v4u p; p.x = pk2(a0, a1); p.y = pk2(a2, a3); p.z = pk2(a4, a5); p.w = pk2(a6, a7); return __builtin_bit_cast(bf16x8, p);
}
namespace pg8 {
#define PG8_LAS __attribute__((address_space(3)))
typedef unsigned short bf16_t;
typedef short bf16x8 __attribute__((ext_vector_type(8)));
typedef float f32x4 __attribute__((ext_vector_type(4)));
typedef unsigned u32x4 __attribute__((ext_vector_type(4)));
constexpr int BM = 256, BK = 64, HALF = 128, HTB = HALF * BK * 2  , STAGE_BYTES = 8 * HTB, NXCD = 8, WGM = 8;

__host__ __device__ __forceinline__ int lds_byte(int r, int c) { const int st = (r >> 4) * 2 + (c >> 5), rr = r & 15, cc = c & 31, ob = rr * 64 + cc * 2; return st * 1024 + (ob ^ (((ob >> 9) & 1) << 5)); }
__host__ __device__ __forceinline__ void stage_rc(int b, int& R, int& C) { const int st = b / 1024, sb = b % 1024, swz = sb ^ (((sb >> 9) & 1) << 5); R = (st >> 1) * 16 + swz / 64; C = (st & 1) * 32 + (swz % 64) / 2; }
__host__ __device__ __forceinline__ int perm32(int rho) { const int n = rho >> 4, i = rho & 15; return 8 * (i >> 2) + 4 * n + (i & 3); }

struct Unit { int pm, pn; };
struct Gemm { const bf16_t* A; const bf16_t* Bt; int M, N, K; };

struct StaticOrder {
    int nM, nN, nwg, G, c;
    __host__ __device__ void init(int M, int N, int G_, int c_) { nM = M / BM; nN = N / BM; nwg = nM * nN; G = G_; c = c_; }
    __host__ __device__ bool next(int i, Unit& u) const {
        const long L = (long)i * G + c; if (L >= nwg) return false;
        int wgid = (int)L; { const int q = nwg / NXCD, r = nwg % NXCD, xcd = wgid % NXCD, off = wgid / NXCD; wgid = (xcd < r ? xcd * (q + 1) : r * (q + 1) + (xcd - r) * q) + off; }
        const int nig = WGM * nN, gid = wgid / nig, fm = gid * WGM, gsz = (nM - fm) < WGM ? (nM - fm) : WGM;
        u.pm = fm + ((wgid % nig) % gsz); u.pn = (wgid % nig) / gsz; return true;
    }
    __device__ __forceinline__ void a_ready(const Unit&) const {}
    __device__ __forceinline__ void done(const Unit&) const {}
};

}
namespace pg8 {
#define EPI_OPERATOR \
    static constexpr bool PERM = true, AFTER_DRAIN = false; \
    __device__ __forceinline__ void operator()(const f32x4 (&acc)[2][2][4][2], const Unit& u, int wr, int wc, int fr, int fq) const { \
        const int row0 = u.pm * BM + wr * 64 + fr, col0 = u.pn * BM + wc * 32 + 8 * fq; \
        _Pragma("unroll") for (int ai = 0; ai < 2; ++ai) \
        _Pragma("unroll") for (int m = 0; m < 4; ++m) \
        _Pragma("unroll") for (int bj = 0; bj < 2; ++bj) store8(row0 + ai * HALF + m * 16, col0 + bj * HALF, acc[ai][bj][m][0], acc[ai][bj][m][1]); \
    }
DI ::v4u pack_bf16x8(f32x4 v0, f32x4 v1) { ::v4u w; w.x = ::pk2(v0[0], v0[1]); w.y = ::pk2(v0[2], v0[3]); w.z = ::pk2(v1[0], v1[1]); w.w = ::pk2(v1[2], v1[3]); return w; }
DI void unpack_bf16x8(::v4u w, f32x4& v0, f32x4& v1) { v0 = (f32x4){::bflo(w.x), ::bfhi(w.x), ::bflo(w.y), ::bfhi(w.y)}; v1 = (f32x4){::bflo(w.z), ::bfhi(w.z), ::bflo(w.w), ::bfhi(w.w)}; }

struct EpiXM {
    bf16_t* xm; bf16_t* halo;
    DI void store8(int row, int col, f32x4 v0, f32x4 v1) const {
        const ::v4u w = pack_bf16x8(v0, v1);
        *(::v4u*)(xm + (size_t)row * 2048 + col) = w;
        const int r = row & 63;
        if (r >= 61) *(::v4u*)(halo + ((size_t)(row >> 6) * 3 + (r - 61)) * 2048 + col) = w;
    }
    EPI_OPERATOR
};
struct EpiSig {
    bf16_t* out; int ldc; const float* bias;
    DI void store8(int row, int col, f32x4 v0, f32x4 v1) const {
        if (bias) { v0 += *(const f32x4*)(bias + col); v1 += *(const f32x4*)(bias + col + 4); }
#pragma unroll
        for (int i = 0; i < 4; ++i) { v0[i] = ::sigmoidf_(v0[i]); v1[i] = ::sigmoidf_(v1[i]); }
        *(::v4u*)(out + (size_t)row * ldc + col) = pack_bf16x8(v0, v1);
    }
    EPI_OPERATOR
};
struct EpiZM {
    bf16_t* buf;
    DI void store8(int row, int col, f32x4 v0, f32x4 v1) const {
        ::v4u* p = (::v4u*)(buf + (size_t)row * 2048 + col);
        f32x4 h0, h1; unpack_bf16x8(*p, h0, h1);
#pragma unroll
        for (int i = 0; i < 4; ++i) { h0[i] *= ::siluf_(v0[i]); h1[i] *= ::siluf_(v1[i]); }
        *p = pack_bf16x8(h0, h1);
    }
    EPI_OPERATOR
};
struct EpiQKV {
    bf16_t* q; size_t stride;
    DI void store8(int row, int col, f32x4 v0, f32x4 v1) const {
        const int t = col >> 10, c = col & 1023;
        bf16_t* base = q + (size_t)t * stride;
        if (t == 0) { v0 *= ::QSCALE; v1 *= ::QSCALE; }
        *(::v4u*)(base + (size_t)row * 1024 + c) = pack_bf16x8(v0, v1);
    }
    EPI_OPERATOR
};
struct EpiZA {
    const bf16_t* o0; const bf16_t* o1; const bf16_t* o2; const float* st; bf16_t* a1;
    DI void store8(int row, int col, f32x4 v0, f32x4 v1) const {
        const int head = col >> 6;
        const ::f32x2_t s0 = *(const ::f32x2_t*)(st + ((size_t)(0 * ::MTOK + row) * 16 + head) * 2);
        const ::f32x2_t s1 = *(const ::f32x2_t*)(st + ((size_t)(1 * ::MTOK + row) * 16 + head) * 2);
        const ::f32x2_t s2 = *(const ::f32x2_t*)(st + ((size_t)(2 * ::MTOK + row) * 16 + head) * 2);
        const float mx = fmaxf(s0.x, fmaxf(s1.x, s2.x));
        float w0 = __builtin_amdgcn_exp2f(s0.x - mx) * s0.y, w1 = __builtin_amdgcn_exp2f(s1.x - mx) * s1.y, w2 = __builtin_amdgcn_exp2f(s2.x - mx) * s2.y;
        const float inv = 1.0f / (w0 + w1 + w2); w0 *= inv; w1 *= inv; w2 *= inv;
        const size_t off = (size_t)row * 1024 + col;
        f32x4 a0, a1v, b0, b1, c0, c1;
        unpack_bf16x8(*(const ::v4u*)(o0 + off), a0, a1v); unpack_bf16x8(*(const ::v4u*)(o1 + off), b0, b1); unpack_bf16x8(*(const ::v4u*)(o2 + off), c0, c1);
        f32x4 r0 = a0 * w0 + b0 * w1 + c0 * w2, r1 = a1v * w0 + b1 * w1 + c1 * w2;
#pragma unroll
        for (int i = 0; i < 4; ++i) { r0[i] *= ::siluf_(v0[i]); r1[i] *= ::siluf_(v1[i]); }
        *(::v4u*)(a1 + off) = pack_bf16x8(r0, r1);
    }
    EPI_OPERATOR
};
struct EpiYA {
    bf16_t* g;
    DI void store8(int row, int col, f32x4 v0, f32x4 v1) const {
        ::v4u* p = (::v4u*)(g + (size_t)row * 2048 + col);
        f32x4 h0, h1; unpack_bf16x8(*p, h0, h1);
        *p = pack_bf16x8(h0 * v0, h1 * v1);
    }
    EPI_OPERATOR
};
struct EpiYM {
    const bf16_t* g; bf16_t* mrg;
    DI void store8(int row, int col, f32x4 v0, f32x4 v1) const {
        f32x4 t0, t1, g0, g1;
        unpack_bf16x8(*(const ::v4u*)(g + (size_t)row * 2048 + col), t0, t1);
        unpack_bf16x8(*(const ::v4u*)(g + (size_t)row * 2048 + 1024 + col), g0, g1);
        *(::v4u*)(mrg + (size_t)row * 1024 + col) = pack_bf16x8(t0 + g0 * v0, t1 + g1 * v1);
    }
    EPI_OPERATOR
};
struct EpiOut {
    const float* x; float* out;
    DI void store8(int row, int col, f32x4 v0, f32x4 v1) const {
        const size_t off = (size_t)row * 1024 + col;
        *(f32x4*)(out + off) = *(const f32x4*)(x + off) + v0;
        *(f32x4*)(out + off + 4) = *(const f32x4*)(x + off + 4) + v1;
    }
    EPI_OPERATOR
};
}
namespace pg8 {
template <class Epi, class Sched, bool ALIGN_EPI = false, bool SP2 = false>
__device__ __forceinline__ void gemm_phase(PG8_LAS unsigned char* lds, const Gemm g, const Sched& S, const Epi& E, const int tid_in) {
    const int tid = tid_in, wid = __builtin_amdgcn_readfirstlane(tid >> 6), lane = tid & 63, wr = wid >> 2, wc = wid & 3, fr = lane & 15, fq = lane >> 4;
    const int K = g.K, nt = K / BK;
    unsigned voffA[2], voffB[2];
#pragma unroll
    for (int i = 0; i < 2; ++i) { int R, C; stage_rc(tid * 16 + i * 8192, R, C); const int Rb = Epi::PERM ? ((R & ~31) + perm32(R & 31)) : R;
        voffA[i] = (unsigned)(R * K + C) * 2u; voffB[i] = (unsigned)(Rb * K + C) * 2u; }
    const size_t kstep = (size_t)(BK * 2);
    const size_t hstep = (size_t)HALF * K * 2;
    const size_t tstep = 2 * hstep;
    const unsigned ldsw = (unsigned)wid * 1024u;
    const int aoff = lds_byte(wr * 64 + fr, fq * 8), boff = lds_byte(wc * 32 + fr, fq * 8);
#define PG8_SA(b, h) (((b) * 2 + (h)) * HTB)
#define PG8_SB(b, h) ((4 + (b) * 2 + (h)) * HTB)
#define PG8_STAGE(bufoff, gbase, voff) do { _Pragma("unroll") for (int _i = 0; _i < 2; ++_i) \
        __builtin_amdgcn_global_load_lds((const unsigned*)((const char*)(gbase) + (voff)[_i]), (PG8_LAS unsigned*)(lds + (bufoff) + ldsw + _i * 8192), 16, 0, 0); } while (0)
#define PG8_LDA(dst, b, h) do { _Pragma("unroll") for (int m = 0; m < 4; ++m) _Pragma("unroll") for (int k = 0; k < 2; ++k) dst[m][k] = *(const PG8_LAS bf16x8*)(lds + PG8_SA(b, h) + aoff + m * 2048 + k * 1024); } while (0)
#define PG8_LDB(dst, b, h) do { _Pragma("unroll") for (int n = 0; n < 2; ++n) _Pragma("unroll") for (int k = 0; k < 2; ++k) dst[n][k] = *(const PG8_LAS bf16x8*)(lds + PG8_SB(b, h) + boff + n * 2048 + k * 1024); } while (0)
#define PG8_MMA(ai, bj, At, Bt) do { __builtin_amdgcn_s_setprio(1); _Pragma("unroll") for (int m = 0; m < 4; ++m) _Pragma("unroll") for (int n = 0; n < 2; ++n) _Pragma("unroll") for (int k = 0; k < 2; ++k) \
        acc[ai][bj][m][n] = __builtin_amdgcn_mfma_f32_16x16x32_bf16(Bt[n][k], At[m][k], acc[ai][bj][m][n], 0, 0, 0); __builtin_amdgcn_s_setprio(0); } while (0)
#define PG8_WAIT_V(n) asm volatile("s_waitcnt vmcnt(" #n ")" ::: "memory")
#define PG8_WAIT_L(n) asm volatile("s_waitcnt lgkmcnt(" #n ")" ::: "memory")
#define PG8_BAR __builtin_amdgcn_s_barrier()
#define PG8_SCHED __builtin_amdgcn_sched_barrier(0)
    Unit cur, nxt; int ui = 0;
    if (!S.next(0, cur)) return;
    f32x4 acc[2][2][4][2];
#pragma unroll
    for (int a = 0; a < 2; ++a)
#pragma unroll
        for (int b = 0; b < 2; ++b)
#pragma unroll
            for (int m = 0; m < 4; ++m)
#pragma unroll
                for (int n = 0; n < 2; ++n) acc[a][b][m][n] = (f32x4){0.f, 0.f, 0.f, 0.f};
    bf16x8 At[4][2], B0[2][2], B1[2][2];
    const char* cA = (const char*)g.A + (size_t)cur.pm * tstep; const char* cB = (const char*)g.Bt + (size_t)cur.pn * tstep;
    S.a_ready(cur);
    if constexpr (SP2) {
        PG8_STAGE(PG8_SB(0, 0), cB, voffB); PG8_STAGE(PG8_SB(0, 1), cB + hstep, voffB); PG8_STAGE(PG8_SA(0, 0), cA, voffA); PG8_STAGE(PG8_SA(0, 1), cA + hstep, voffA);
        if (wr == 1) PG8_BAR;
        PG8_WAIT_V(2); PG8_BAR;
        PG8_STAGE(PG8_SB(1, 0), cB + kstep, voffB); PG8_STAGE(PG8_SA(1, 0), cA + kstep, voffA); PG8_STAGE(PG8_SB(1, 1), cB + hstep + kstep, voffB);
        PG8_WAIT_V(6); PG8_BAR;
    } else {
        PG8_STAGE(PG8_SB(0, 0), cB, voffB); PG8_STAGE(PG8_SA(0, 0), cA, voffA); PG8_STAGE(PG8_SB(0, 1), cB + hstep, voffB); PG8_STAGE(PG8_SA(0, 1), cA + hstep, voffA);
        if (wr == 1) PG8_BAR;
        PG8_WAIT_V(4); PG8_BAR;
        PG8_STAGE(PG8_SB(1, 0), cB + kstep, voffB); PG8_STAGE(PG8_SA(1, 0), cA + kstep, voffA); PG8_STAGE(PG8_SB(1, 1), cB + hstep + kstep, voffB);
        PG8_WAIT_V(6); PG8_BAR;
    }
    for (;;) {
        const bool has_next = S.next(ui + 1, nxt);
        const char* nA = has_next ? (const char*)g.A + (size_t)nxt.pm * tstep : cA; const char* nB = has_next ? (const char*)g.Bt + (size_t)nxt.pn * tstep : cB;
        for (int t = 0; t < nt; t += 2) {
            const bool last = (t == nt - 2);
            const char* a1 = cA + (size_t)(t + 1) * kstep;
            const char* a2 = last ? nA : cA + (size_t)(t + 2) * kstep; const char* b2 = last ? nB : cB + (size_t)(t + 2) * kstep;
            const char* a3 = a2 + kstep; const char* b3 = b2 + kstep;
            if (last && has_next) S.a_ready(nxt);
            if constexpr (SP2) {
            PG8_LDB(B0, 0, 0); PG8_LDB(B1, 0, 1); PG8_SCHED; PG8_LDA(At, 0, 0); PG8_STAGE(PG8_SA(1, 1), a1 + hstep, voffA);
            PG8_WAIT_V(8); PG8_WAIT_L(0); PG8_BAR; PG8_MMA(0, 0, At, B0); PG8_MMA(0, 1, At, B1); PG8_BAR; PG8_SCHED;
            PG8_LDA(At, 0, 1); PG8_STAGE(PG8_SB(0, 0), b2, voffB); PG8_STAGE(PG8_SB(0, 1), b2 + hstep, voffB); PG8_STAGE(PG8_SA(0, 0), a2, voffA);
            PG8_WAIT_V(8); PG8_WAIT_L(0); PG8_BAR; PG8_MMA(1, 0, At, B0); PG8_MMA(1, 1, At, B1); PG8_BAR; PG8_SCHED;
            PG8_LDB(B0, 1, 0); PG8_LDB(B1, 1, 1); PG8_SCHED; PG8_LDA(At, 1, 0); PG8_STAGE(PG8_SA(0, 1), a2 + hstep, voffA);
            PG8_WAIT_V(8); PG8_WAIT_L(0); PG8_BAR; PG8_MMA(0, 0, At, B0); PG8_MMA(0, 1, At, B1); PG8_BAR; PG8_SCHED;
            PG8_LDA(At, 1, 1); PG8_STAGE(PG8_SB(1, 0), b3, voffB); PG8_STAGE(PG8_SB(1, 1), b3 + hstep, voffB); PG8_STAGE(PG8_SA(1, 0), a3, voffA);
            PG8_WAIT_V(8); PG8_WAIT_L(0); PG8_BAR; PG8_MMA(1, 0, At, B0); PG8_MMA(1, 1, At, B1); PG8_BAR; PG8_SCHED;
            } else {
            PG8_LDB(B0, 0, 0); PG8_SCHED; PG8_LDA(At, 0, 0); PG8_STAGE(PG8_SA(1, 1), a1 + hstep, voffA);
            PG8_WAIT_L(8); PG8_BAR; PG8_WAIT_L(0); PG8_MMA(0, 0, At, B0); PG8_BAR; PG8_SCHED;
            PG8_LDB(B1, 0, 1); PG8_STAGE(PG8_SB(0, 0), b2, voffB);
            PG8_BAR; PG8_WAIT_L(0); PG8_MMA(0, 1, At, B1); PG8_BAR;
            PG8_LDA(At, 0, 1); PG8_STAGE(PG8_SA(0, 0), a2, voffA);
            PG8_BAR; PG8_WAIT_L(0); PG8_MMA(1, 0, At, B0); PG8_BAR; PG8_SCHED;
            PG8_STAGE(PG8_SB(0, 1), b2 + hstep, voffB);
            PG8_WAIT_V(6); PG8_BAR; PG8_MMA(1, 1, At, B1); PG8_BAR;
            PG8_LDB(B0, 1, 0); PG8_SCHED; PG8_LDA(At, 1, 0); PG8_STAGE(PG8_SA(0, 1), a2 + hstep, voffA);
            PG8_WAIT_L(8); PG8_BAR; PG8_WAIT_L(0); PG8_MMA(0, 0, At, B0); PG8_BAR; PG8_SCHED;
            PG8_LDB(B1, 1, 1); PG8_STAGE(PG8_SB(1, 0), b3, voffB);
            PG8_BAR; PG8_WAIT_L(0); PG8_MMA(0, 1, At, B1); PG8_BAR;
            PG8_LDA(At, 1, 1); PG8_STAGE(PG8_SA(1, 0), a3, voffA);
            PG8_BAR; PG8_WAIT_L(0); PG8_MMA(1, 0, At, B0); PG8_BAR; PG8_SCHED;
            PG8_STAGE(PG8_SB(1, 1), b3 + hstep, voffB);
            PG8_WAIT_V(6); PG8_BAR; PG8_MMA(1, 1, At, B1); PG8_BAR;
            }
        }
        if constexpr (ALIGN_EPI) { if (wr == 0) PG8_BAR; }
        if constexpr (!Epi::AFTER_DRAIN) { E(acc, cur, wr, wc, fr, fq); S.done(cur); }
        if (!has_next) break;
#pragma unroll
        for (int a = 0; a < 2; ++a)
#pragma unroll
            for (int b = 0; b < 2; ++b)
#pragma unroll
                for (int m = 0; m < 4; ++m)
#pragma unroll
                    for (int n = 0; n < 2; ++n) acc[a][b][m][n] = (f32x4){0.f, 0.f, 0.f, 0.f};
        cur = nxt; cA = nA; cB = nB; ++ui;
        if constexpr (ALIGN_EPI) { if (wr == 1) PG8_BAR; }
    }
    PG8_WAIT_V(0);
    if constexpr (!ALIGN_EPI) { if (wr == 0) PG8_BAR; }
    PG8_BAR;
    if constexpr (Epi::AFTER_DRAIN) { E.fused(acc, cur, wr, wc, fr, fq, lds, wid, lane); S.done(cur); }
#undef PG8_SA
#undef PG8_SB
#undef PG8_STAGE
#undef PG8_LDA
#undef PG8_LDB
#undef PG8_MMA
#undef PG8_WAIT_V
#undef PG8_WAIT_L
#undef PG8_BAR
#undef PG8_SCHED
}
}
namespace att {
constexpr int KP = 144;
constexpr int K_OFF = 0, V_OFF = 384 * KP, B_OFF = 2 * 384 * KP, LDS_BYTES = B_OFF + 132 * 4;
struct Tensors { const bf16* Q; const bf16* K; const bf16* V; bf16* Oa; bf16* Ob; float* st; const float* biasL2; };

DI void unit(LAS unsigned char* lds, const Tensors& T, int u, int tid_in) {
    int tid_ = tid_in; asm volatile("" : "+v"(tid_));
    const int tid = tid_, lane = tid & 63, l31 = lane & 31, hi = lane >> 5, w = __builtin_amdgcn_readfirstlane(tid >> 6);
    const int bh = u / 48, rem = u % 48, p = rem >> 4, w16 = rem & 15;
    const int b = bh >> 4, h = bh & 15;
    const int dsh = 2 * p, nqb = 16 >> dsh, r = w16 / nqb, qblk = w16 % nqb;
    const size_t rowb = (size_t)b * SEQ;
    {
#pragma unroll
        for (int k = 0; k < 6; ++k) {
            const int id = tid + 512 * k, j = id >> 3, pc = id & 7;
            int pos = 256 * qblk - 128 + j; pos = pos < 0 ? 0 : pos;
            const size_t off = (rowb + r + ((size_t)pos << dsh)) * 1024 + h * 64 + pc * 8;
            const v4u kv = *(const v4u*)(T.K + off); const v4u vv = *(const v4u*)(T.V + off);
            *(LAS v4u*)(lds + K_OFF + j * KP + pc * 16) = kv;
            *(LAS v4u*)(lds + V_OFF + j * KP + pc * 16) = vv;
        }
        if (tid < 132) ((LAS float*)(lds + B_OFF))[tid] = T.biasL2[(p * 16 + h) * 132 + tid];
    }
    const int qpos = 256 * qblk + 32 * w + l31;
    const size_t qrow = rowb + r + ((size_t)qpos << dsh);
    bf16x8 qf[4];
#pragma unroll
    for (int d0 = 0; d0 < 4; ++d0) qf[d0] = *(const bf16x8*)(T.Q + qrow * 1024 + h * 64 + d0 * 16 + hi * 8);
    __syncthreads();
    f32x16 st[5];
#pragma unroll
    for (int kt = 0; kt < 5; ++kt) {
        f32x16 a = {};
#pragma unroll
        for (int d0 = 0; d0 < 4; ++d0) {
            const bf16x8 kf = *(const LAS bf16x8*)(lds + K_OFF + (32 * w + 32 * kt + l31) * KP + (16 * d0 + 8 * hi) * 2);
            a = MFMA32(kf, qf[d0], a);
        }
        st[kt] = a;
    }
    const LAS float* bl = (const LAS float*)(lds + B_OFF);
    float mx = -1e30f;
#pragma unroll
    for (int kt = 0; kt < 5; ++kt)
#pragma unroll
        for (int rr = 0; rr < 16; ++rr) {
            const int kl = crow(rr, hi);
            const int delta = 128 + l31 - 32 * kt - kl;
            const int pk = 256 * qblk - 128 + 32 * w + 32 * kt + kl;
            const bool valid = (delta >= 0) && (delta <= 128) && (pk >= 0);
            const int dc = delta < 0 ? 0 : (delta > 128 ? 128 : delta);
            const float s = valid ? st[kt][rr] + bl[dc] : -1e30f;
            st[kt][rr] = s; mx = fmaxf(mx, s);
        }
    mx = fmaxf(mx, __shfl_xor(mx, 32));
    float lsum = 0.f;
#pragma unroll
    for (int kt = 0; kt < 5; ++kt)
#pragma unroll
        for (int rr = 0; rr < 16; ++rr) { const float e = __builtin_amdgcn_exp2f(st[kt][rr] - mx); st[kt][rr] = e; lsum += e; }
    lsum += __shfl_xor(lsum, 32);
    f32x16 o[2]; o[0] = (f32x16){}; o[1] = (f32x16){};
    const int i16 = lane & 15, q4 = i16 >> 2, p4 = i16 & 3, gidx = (lane >> 4) & 1;
#pragma unroll
    for (int kt = 0; kt < 5; ++kt)
#pragma unroll
        for (int s2 = 0; s2 < 2; ++s2) {
            const bf16x8 pb = pack8(st[kt][8 * s2 + 0], st[kt][8 * s2 + 1], st[kt][8 * s2 + 2], st[kt][8 * s2 + 3], st[kt][8 * s2 + 4], st[kt][8 * s2 + 5], st[kt][8 * s2 + 6], st[kt][8 * s2 + 7]);
            const int jrow = 32 * w + 32 * kt + 16 * s2 + 4 * hi + q4;
#pragma unroll
            for (int dt = 0; dt < 2; ++dt) {
                const LAS unsigned char* a0 = lds + V_OFF + jrow * KP + (32 * dt + 16 * gidx + 4 * p4) * 2;
                const bf16x8 va = cat8(tr_read(a0), tr_read(a0 + 8 * KP));
                o[dt] = MFMA32(va, pb, o[dt]);
            }
        }
    const float inv = 1.0f / lsum;
    bf16* orow = (p == 0 ? T.Oa : T.Ob + (size_t)(p - 1) * MTOK * AW) + qrow * 1024 + h * 64;
#pragma unroll
    for (int dt = 0; dt < 2; ++dt)
#pragma unroll
        for (int g4 = 0; g4 < 4; ++g4) {
            v2u wv; wv.x = pk2(o[dt][4 * g4] * inv, o[dt][4 * g4 + 1] * inv); wv.y = pk2(o[dt][4 * g4 + 2] * inv, o[dt][4 * g4 + 3] * inv);
            *(v2u*)(orow + 32 * dt + 8 * g4 + 4 * hi) = wv;
        }
    if (hi == 0) { f32x2_t sv = {mx, lsum}; *(f32x2_t*)(T.st + ((size_t)p * MTOK + qrow) * 32 + h * 2) = sv; }
    __syncthreads();
}
DI void phase(LAS unsigned char* lds, const Tensors& T, int G, int blk, int wv) {
    for (int u = blk; u < BATCH * AH * 48; u += G) unit(lds, T, u, wg_tid(wv));
}
}
namespace mpre {
constexpr int TP = 144;
constexpr int XC_OFF = 0, XM_OFF = 256 * TP, QT_OFF = 2 * 256 * TP, RED_OFF = 3 * 256 * TP, GRED_OFF = RED_OFF + 4 * 4096, LDS_BYTES = GRED_OFF + 4 * 64 * 8 * 4;
struct Tensors { const bf16* xm; const bf16* halo; bf16* kimg; bf16* vimg; bf16* qimg; float* gp; bf16* S; const float* convw; const float* convb; const bf16* WcT; const bf16* WmT; const float* G; };

DI void unit(LAS unsigned char* lds, const Tensors& T, int u, int tid_in) {
    int tid_ = tid_in; asm volatile("" : "+v"(tid_));
    const int tid = tid_, lane = tid & 63, l31 = lane & 31, hi = lane >> 5, w = __builtin_amdgcn_readfirstlane(tid >> 6);
    const int h = u & 3, c = (u >> 2) & 63, b = u >> 8;
    const int g6 = lane, tp = w;
    const size_t tok0 = (size_t)b * SEQ + 64 * c;
    const int ti = w & 1, si = (w >> 1) & 1, kh = w >> 2;
    f32x16 sacc = {};
    f32x16 gacc = {};
    const int kq = w >> 1;
    const int i16 = lane & 15, q4 = i16 >> 2, p4 = i16 & 3, gidx = (lane >> 4) & 1;
#pragma unroll 1
    for (int hh = 0; hh < 2; ++hh) {
        const int gg = 128 * h + 64 * hh + g6, ch = 4 * gg;
        v2u xr[11];
#pragma unroll
        for (int k = 0; k < 11; ++k) {
            const int tl = 8 * tp - 3 + k;
            if (tl >= 0) xr[k] = *(const v2u*)(T.xm + (tok0 + tl) * 2048 + ch);
            else if (c > 0) xr[k] = *(const v2u*)(T.halo + ((size_t)(b * 64 + c - 1) * 3 + (3 + tl)) * 2048 + ch);
            else xr[k] = (v2u){0u, 0u};
        }
        float xmv[11][4];
#pragma unroll
        for (int k = 0; k < 11; ++k) { xmv[k][0] = bflo(xr[k].x); xmv[k][1] = bfhi(xr[k].x); xmv[k][2] = bflo(xr[k].y); xmv[k][3] = bfhi(xr[k].y); }
        float cw[4][4], cb[4], Gm[4][4];
        {
            const f32x4 b4 = *(const f32x4*)(T.convb + ch); cb[0] = b4[0]; cb[1] = b4[1]; cb[2] = b4[2]; cb[3] = b4[3];
#pragma unroll
            for (int tap = 0; tap < 4; ++tap) { const f32x4 w4 = *(const f32x4*)(T.convw + tap * 2048 + ch); cw[tap][0] = w4[0]; cw[tap][1] = w4[1]; cw[tap][2] = w4[2]; cw[tap][3] = w4[3]; }
#pragma unroll
            for (int i = 0; i < 4; ++i) { const f32x4 g4 = *(const f32x4*)(T.G + gg * 16 + i * 4); Gm[i][0] = g4[0]; Gm[i][1] = g4[1]; Gm[i][2] = g4[2]; Gm[i][3] = g4[3]; }
        }
        __syncthreads();
        unsigned xcp[4][4], xmp[4][4], qtp[4][4];
        float prev_xc[4], prev_q[4];
#pragma unroll
        for (int tl = 0; tl < 8; ++tl) {
            float xc[4], qt[4];
#pragma unroll
            for (int i = 0; i < 4; ++i) {
                float a = cb[i];
#pragma unroll
                for (int tap = 0; tap < 4; ++tap) a += cw[tap][i] * xmv[tl + tap][i];
                xc[i] = siluf_(a);
            }
#pragma unroll
            for (int i2 = 0; i2 < 4; ++i2) qt[i2] = xc[0] * Gm[0][i2] + xc[1] * Gm[1][i2] + xc[2] * Gm[2][i2] + xc[3] * Gm[3][i2];
            if (tl & 1) {
#pragma unroll
                for (int i = 0; i < 4; ++i) { xcp[i][tl >> 1] = pk2(prev_xc[i], xc[i]); qtp[i][tl >> 1] = pk2(prev_q[i], qt[i]); xmp[i][tl >> 1] = pk2(xmv[tl + 2][i], xmv[tl + 3][i]); }
            } else {
#pragma unroll
                for (int i = 0; i < 4; ++i) { prev_xc[i] = xc[i]; prev_q[i] = qt[i]; }
            }
        }
#pragma unroll
        for (int i = 0; i < 4; ++i) {
            const int off = (4 * g6 + i) * TP + 16 * tp;
            *(LAS v4u*)(lds + XC_OFF + off) = (v4u){xcp[i][0], xcp[i][1], xcp[i][2], xcp[i][3]};
            *(LAS v4u*)(lds + XM_OFF + off) = (v4u){xmp[i][0], xmp[i][1], xmp[i][2], xmp[i][3]};
            *(LAS v4u*)(lds + QT_OFF + off) = (v4u){qtp[i][0], qtp[i][1], qtp[i][2], qtp[i][3]};
        }
        __syncthreads();
        {
            const size_t ibase = ((size_t)((b * 4 + h) * 64 + c) * 64 + 32 * hh) * 1024;
#pragma unroll
            for (int k = 0; k < 4; ++k) {
                const int id = tid + 512 * k, f = id >> 6, L = id & 63;
                const int row = 32 * (f >> 2) + (L & 31), colb = (16 * (f & 3) + 4 * (L >> 5)) * 2;
                const v2u k0 = *(const LAS v2u*)(lds + XC_OFF + row * TP + colb), k1 = *(const LAS v2u*)(lds + XC_OFF + row * TP + colb + 16);
                const v2u v0 = *(const LAS v2u*)(lds + XM_OFF + row * TP + colb), v1 = *(const LAS v2u*)(lds + XM_OFF + row * TP + colb + 16);
                *(v4u*)((char*)T.kimg + ibase + (size_t)id * 16) = (v4u){k0.x, k0.y, k1.x, k1.y};
                *(v4u*)((char*)T.vimg + ibase + (size_t)id * 16) = (v4u){v0.x, v0.y, v1.x, v1.y};
            }
#pragma unroll
            for (int k = 0; k < 4; ++k) {
                const int f = 4 * w + k, tt = f & 1, cb0 = 16 * (f >> 1) + 4 * hi + q4;
                const LAS unsigned char* pq = lds + QT_OFF + cb0 * TP + (32 * tt + 16 * gidx + 4 * p4) * 2;
                const s16x4 lo = tr_read(pq), hi4 = tr_read(pq + 8 * TP);
                *(bf16x8*)((char*)T.qimg + ibase + (size_t)f * 1024 + lane * 16) = cat8(lo, hi4);
            }
        }
#pragma unroll
        for (int ks = 0; ks < 8; ++ks) {
            const int crow0 = 128 * kh + 16 * ks + 8 * hi + q4;
            const LAS unsigned char* pa = lds + XC_OFF + crow0 * TP + (32 * si + 16 * gidx + 4 * p4) * 2;
            const LAS unsigned char* pb = lds + QT_OFF + crow0 * TP + (32 * ti + 16 * gidx + 4 * p4) * 2;
            const bf16x8 af = cat8(tr_read(pa), tr_read(pa + 4 * TP));
            const bf16x8 bfr = cat8(tr_read(pb), tr_read(pb + 4 * TP));
            sacc = MFMA32(af, bfr, sacc);
        }
#pragma unroll
        for (int ks = 0; ks < 4; ++ks) {
            const int crow1 = 64 * kq + 16 * ks + 8 * hi + q4;
            const LAS unsigned char* pc_ = lds + XC_OFF + crow1 * TP + (32 * ti + 16 * gidx + 4 * p4) * 2;
            const LAS unsigned char* pm_ = lds + XM_OFF + crow1 * TP + (32 * ti + 16 * gidx + 4 * p4) * 2;
            const bf16x8 ac = cat8(tr_read(pc_), tr_read(pc_ + 4 * TP));
            const bf16x8 am = cat8(tr_read(pm_), tr_read(pm_ + 4 * TP));
            const int c0 = 512 * h + 256 * hh + 64 * kq + 16 * ks + 8 * hi;
            const bf16x8 bc = *(const bf16x8*)(T.WcT + (l31 & 7) * 2048 + c0);
            const bf16x8 bm = *(const bf16x8*)(T.WmT + (l31 & 7) * 2048 + c0);
            gacc = MFMA32(ac, bc, gacc);
            gacc = MFMA32(am, bm, gacc);
        }
    }
    if (l31 < 8) {
#pragma unroll
        for (int r = 0; r < 16; ++r) ((LAS float*)(lds + GRED_OFF))[(kq * 64 + 32 * ti + crow(r, hi)) * 8 + l31] = gacc[r];
    }
    __syncthreads();
    if (kh == 1) {
#pragma unroll
        for (int g4 = 0; g4 < 4; ++g4) *(LAS f32x4*)(lds + RED_OFF + ((w & 3) * 4 + g4) * 1024 + lane * 16) = (f32x4){sacc[4 * g4], sacc[4 * g4 + 1], sacc[4 * g4 + 2], sacc[4 * g4 + 3]};
    }
    __syncthreads();
    { const LAS float* gr = (const LAS float*)(lds + GRED_OFF);
      T.gp[((size_t)h * MTOK + tok0) * 8 + tid] = gr[tid] + gr[512 + tid] + gr[1024 + tid] + gr[1536 + tid]; }
    if (kh == 0) {
        float tot[16];
#pragma unroll
        for (int g4 = 0; g4 < 4; ++g4) {
            const f32x4 o = *(const LAS f32x4*)(lds + RED_OFF + ((w & 3) * 4 + g4) * 1024 + lane * 16);
            tot[4 * g4] = sacc[4 * g4] + o[0]; tot[4 * g4 + 1] = sacc[4 * g4 + 1] + o[1]; tot[4 * g4 + 2] = sacc[4 * g4 + 2] + o[2]; tot[4 * g4 + 3] = sacc[4 * g4 + 3] + o[3];
        }
        char* sp = (char*)T.S + (size_t)((b * 4 + h) * 64 + c) * 8192;
#pragma unroll
        for (int kk = 0; kk < 2; ++kk)
            *(bf16x8*)(sp + ((2 * si + kk) * 2 + ti) * 1024 + lane * 16) = pack8(tot[8 * kk], tot[8 * kk + 1], tot[8 * kk + 2], tot[8 * kk + 3], tot[8 * kk + 4], tot[8 * kk + 5], tot[8 * kk + 6], tot[8 * kk + 7]);
    }
    __syncthreads();
}
DI void phase(LAS unsigned char* lds, const Tensors& T, int G, int blk, int wv) {
    for (int u = blk; u < BATCH * NCHUNK * MH; u += G) unit(lds, T, u, wg_tid(wv));
}
}
namespace mscan {
constexpr int P_OFF = 0;
constexpr int DEN_OFF = 131072;
constexpr int NS_OFF = DEN_OFF + 2048;
constexpr int TMP_OFF = NS_OFF + 4096, LDS_BYTES = TMP_OFF + 128;
static_assert(LDS_BYTES <= 163840, "scan LDS");
struct Tensors { const bf16* q; const bf16* k; const bf16* v; const bf16* S; const float* gp; const float* bif; float* scal; bf16* hm; };

DI float logsigmoid_(float x) { return fminf(x, 0.f) - log1pf(__expf(-fabsf(x))); }
DI void unpack8(bf16x8 f, float (&o)[8]) {
    const v4u u = __builtin_bit_cast(v4u, f);
    o[0] = bflo(u.x); o[1] = bfhi(u.x); o[2] = bflo(u.y); o[3] = bfhi(u.y); o[4] = bflo(u.z); o[5] = bfhi(u.z); o[6] = bflo(u.w); o[7] = bfhi(u.w);
}

DI void unit(LAS unsigned char* lds, const Tensors& T, int bh, int es, int tid_in) {
    int tid_ = tid_in; asm volatile("" : "+v"(tid_));
    const int tid = tid_, lane = tid & 63, l31 = lane & 31, hi = lane >> 5, wid = __builtin_amdgcn_readfirstlane(tid >> 6);
    const int eg = wid & 1, dq = wid >> 1;
    const int b = bh >> 2, h = bh & 3;
    LAS float* sTmp = (LAS float*)(lds + TMP_OFF);
    float* scal = T.scal + (size_t)bh * 3 * SEQ;
    {
        float li[8], cs[8];
        const float bi = T.bif[h], bf_ = T.bif[4 + h];
        float run = 0.f;
        const float* gpb = T.gp + (size_t)b * SEQ * 8 + h;
        const unsigned toff = (unsigned)tid * 64u;
#pragma unroll
        for (int k = 0; k < 8; ++k) { li[k] = bi; cs[k] = bf_; }
#pragma unroll
        for (int hh = 0; hh < 4; ++hh) {
            const float* p = gpb + (size_t)hh * MTOK * 8;
#pragma unroll
            for (int k = 0; k < 8; ++k) { li[k] += p[toff + k * 8]; cs[k] += p[toff + k * 8 + 4]; }
        }
#pragma unroll
        for (int k = 0; k < 8; ++k) { run += logsigmoid_(cs[k]); cs[k] = run; }
        float inc = run;
#pragma unroll
        for (int o = 1; o < 64; o <<= 1) { const float t = __shfl_up(inc, o); if (lane >= o) inc += t; }
        if (lane == 63) sTmp[wid] = inc;
        __syncthreads();
        float base = inc - run;
        for (int w2 = 0; w2 < wid; ++w2) base += sTmp[w2];
        __syncthreads();
        float av[8], mloc = -3.0e38f, cm[8];
#pragma unroll
        for (int k = 0; k < 8; ++k) { cs[k] += base; av[k] = li[k] - cs[k]; mloc = fmaxf(mloc, av[k]); cm[k] = mloc; }
        float minc = mloc;
#pragma unroll
        for (int o = 1; o < 64; o <<= 1) { const float t = __shfl_up(minc, o); if (lane >= o) minc = fmaxf(minc, t); }
        if (lane == 63) sTmp[wid] = minc;
        __syncthreads();
        float mbase = __shfl_up(minc, 1); if (lane == 0) mbase = -3.0e38f;
        for (int w2 = 0; w2 < wid; ++w2) mbase = fmaxf(mbase, sTmp[w2]);
#pragma unroll
        for (int k = 0; k < 8; ++k) {
            const float Mt = fmaxf(mbase, cm[k]);
            scal[0 * SEQ + 8 * tid + k] = av[k]; scal[1 * SEQ + 8 * tid + k] = Mt; scal[2 * SEQ + 8 * tid + k] = __expf(-(cs[k] + Mt));
        }
        ((LAS float*)(lds + NS_OFF))[tid] = 0.f; ((LAS float*)(lds + NS_OFF))[512 + tid] = 0.f;
        __threadfence();
        __syncthreads();
    }
    f32x16 cst[4];
#pragma unroll
    for (int i = 0; i < 4; ++i) cst[i] = (f32x16){};
    const char* qb = (const char*)T.q + (size_t)bh * NCHUNK * 65536 + (size_t)dq * 16384;
    const char* kb = (const char*)T.k + (size_t)bh * NCHUNK * 65536 + (size_t)dq * 16384;
    const char* vb = (const char*)T.v + (size_t)bh * NCHUNK * 65536 + (size_t)(es * 2 + eg) * 4096;
    const char* sb = (const char*)T.S + (size_t)bh * NCHUNK * 8192 + (size_t)dq * 2048;
    const unsigned loff = (unsigned)lane * 16u;
    const float* sa = scal; const float* sm = scal + SEQ; const float* sthr = scal + 2 * SEQ;
    bf16* hg = T.hm + (size_t)b * SEQ * 2048 + 512 * h + 64 * es;
    int zv = 0; asm volatile("" : "+v"(zv));
    float Mc = sm[zv];
    bf16x8 qf[16]; bf16x8 sf[2]; f32x4 aown0, aown1; float Mt0, Mt1;
#pragma unroll
    for (int f = 0; f < 16; ++f) qf[f] = *(const bf16x8*)(qb + f * 1024 + loff);
    sf[0] = *(const bf16x8*)(sb + loff); sf[1] = *(const bf16x8*)(sb + 1024 + loff);
    aown0 = *(const f32x4*)(sa + 16 * dq + 4 * hi); aown1 = *(const f32x4*)(sa + 16 * dq + 8 + 4 * hi);
    Mt0 = sm[l31]; Mt1 = sm[32 + l31];
#pragma unroll 1
    for (int c = 0; c < NCHUNK; ++c) {
        const int cur = c & 1;
        LAS float* nsc = (LAS float*)(lds + NS_OFF) + cur * 512; LAS float* nsn = (LAS float*)(lds + NS_OFF) + (cur ^ 1) * 512;
        LAS float* denp = (LAS float*)(lds + DEN_OFF) + cur * 256;
        LAS unsigned char* pbuf = lds + P_OFF + cur * 65536;
        const char* kc = kb + (size_t)c * 65536; const char* vc = vb + (size_t)c * 65536;
        const float Mc2 = sm[64 * c + 63 + zv];
        bf16x8 kfa[4][2];
#pragma unroll
        for (int i = 0; i < 4; ++i)
#pragma unroll
            for (int ks = 0; ks < 2; ++ks) kfa[i][ks] = *(const bf16x8*)(kc + (i * 4 + ks) * 1024 + loff);
        const bf16x8 vown = *(const bf16x8*)(vc + dq * 1024 + loff);
        bf16x8 pf[2]; float psum_own = 0.f;
        {
            const float aw[8] = {aown0[0], aown0[1], aown0[2], aown0[3], aown1[0], aown1[1], aown1[2], aown1[3]};
#pragma unroll
            for (int tt = 0; tt < 2; ++tt) {
                const int t = 32 * tt + l31; const float Mt = tt ? Mt1 : Mt0;
                float sv[8]; unpack8(sf[tt], sv);
                float pw[8]; float ps = 0.f;
#pragma unroll
                for (int j = 0; j < 8; ++j) { const int s = 16 * dq + 8 * (j >> 2) + 4 * hi + (j & 3); pw[j] = (s <= t) ? sv[j] * __expf(aw[j] - Mt) : 0.f; ps += pw[j]; }
                pf[tt] = pack8(pw[0], pw[1], pw[2], pw[3], pw[4], pw[5], pw[6], pw[7]);
                if (tt == eg) psum_own = ps;
            }
        }
        {
            float qn = 0.f;
#pragma unroll
            for (int i = 0; i < 4; ++i)
#pragma unroll
                for (int s = 0; s < 2; ++s) {
                    float qv[8]; unpack8(eg ? qf[(i * 2 + s) * 2 + 1] : qf[(i * 2 + s) * 2], qv);
                    const f32x4 n0 = *(const LAS f32x4*)(nsc + 128 * dq + 32 * i + 16 * s + 4 * hi), n1 = *(const LAS f32x4*)(nsc + 128 * dq + 32 * i + 16 * s + 8 + 4 * hi);
                    qn += qv[0] * n0[0] + qv[1] * n0[1] + qv[2] * n0[2] + qv[3] * n0[3] + qv[4] * n1[0] + qv[5] * n1[1] + qv[6] * n1[2] + qv[7] * n1[3];
                }
            const float Mt = eg ? Mt1 : Mt0;
            float d = __expf(Mc - Mt) * qn + psum_own;
            d += __shfl_xor(d, 32);
            if (hi == 0) denp[dq * 64 + 32 * eg + l31] = d;
        }
        f32x16 ao[2]; ao[0] = (f32x16){}; ao[1] = (f32x16){};
#pragma unroll
        for (int i = 0; i < 4; ++i)
#pragma unroll
            for (int s = 0; s < 2; ++s) {
                const bf16x8 cb = pack8(cst[i][8 * s + 0], cst[i][8 * s + 1], cst[i][8 * s + 2], cst[i][8 * s + 3], cst[i][8 * s + 4], cst[i][8 * s + 5], cst[i][8 * s + 6], cst[i][8 * s + 7]);
                ao[0] = MFMA32(cb, qf[(i * 2 + s) * 2], ao[0]);
                ao[1] = MFMA32(cb, qf[(i * 2 + s) * 2 + 1], ao[1]);
            }
        {
            const float rs0 = __expf(Mc - Mt0), rs1 = __expf(Mc - Mt1);
#pragma unroll
            for (int r = 0; r < 16; ++r) { ao[0][r] *= rs0; ao[1][r] *= rs1; }
        }
        ao[0] = MFMA32(vown, pf[0], ao[0]);
        ao[1] = MFMA32(vown, pf[1], ao[1]);
#pragma unroll
        for (int g = 0; g < 4; ++g)
#pragma unroll
            for (int tt = 0; tt < 2; ++tt)
                *(LAS f32x4*)(pbuf + ((((dq * 2 + eg) * 4 + g) * 2 + tt) * 1024) + lane * 16) = (f32x4){ao[tt][4 * g], ao[tt][4 * g + 1], ao[tt][4 * g + 2], ao[tt][4 * g + 3]};
        {
            const int cn = (c + 1 < NCHUNK) ? c + 1 : c;
            const char* qn_ = qb + (size_t)cn * 65536; const char* sn_ = sb + (size_t)cn * 8192;
#pragma unroll
            for (int f = 0; f < 16; ++f) qf[f] = *(const bf16x8*)(qn_ + f * 1024 + loff);
            sf[0] = *(const bf16x8*)(sn_ + loff); sf[1] = *(const bf16x8*)(sn_ + 1024 + loff);
            aown0 = *(const f32x4*)(sa + 64 * cn + 16 * dq + 4 * hi); aown1 = *(const f32x4*)(sa + 64 * cn + 16 * dq + 8 + 4 * hi);
            Mt0 = sm[64 * cn + l31]; Mt1 = sm[64 * cn + 32 + l31];
        }
        const float decay = __expf(Mc - Mc2);
#pragma unroll
        for (int i = 0; i < 4; ++i)
#pragma unroll
            for (int r = 0; r < 16; ++r) cst[i][r] *= decay;
        float nacc[2] = {0.f, 0.f};
#pragma unroll
        for (int ks = 0; ks < 4; ++ks) {
            const f32x4 a0 = *(const f32x4*)(sa + 64 * c + 16 * ks + 4 * hi), a1 = *(const f32x4*)(sa + 64 * c + 16 * ks + 8 + 4 * hi);
            float cw[8] = {__expf(a0[0] - Mc2), __expf(a0[1] - Mc2), __expf(a0[2] - Mc2), __expf(a0[3] - Mc2), __expf(a1[0] - Mc2), __expf(a1[1] - Mc2), __expf(a1[2] - Mc2), __expf(a1[3] - Mc2)};
            const bf16x8 vf = *(const bf16x8*)(vc + ks * 1024 + loff);
            float vv[8]; unpack8(vf, vv);
            const bf16x8 vw = pack8(vv[0] * cw[0], vv[1] * cw[1], vv[2] * cw[2], vv[3] * cw[3], vv[4] * cw[4], vv[5] * cw[5], vv[6] * cw[6], vv[7] * cw[7]);
#pragma unroll
            for (int i = 0; i < 4; ++i) {
                const bf16x8 kf = (ks < 2) ? kfa[i][ks & 1] : *(const bf16x8*)(kc + (i * 4 + ks) * 1024 + loff);
                cst[i] = MFMA32(kf, vw, cst[i]);
                if ((i >> 1) == eg) {
                    float kv[8]; unpack8(kf, kv);
                    nacc[i & 1] += kv[0] * cw[0] + kv[1] * cw[1] + kv[2] * cw[2] + kv[3] * cw[3] + kv[4] * cw[4] + kv[5] * cw[5] + kv[6] * cw[6] + kv[7] * cw[7];
                }
            }
        }
#pragma unroll
        for (int ii = 0; ii < 2; ++ii) {
            float v = nacc[ii]; v += __shfl_xor(v, 32);
            const int dk = 128 * dq + 32 * (2 * eg + ii) + l31;
            if (hi == 0) nsn[dk] = decay * nsc[dk] + v;
        }
        __syncthreads();
#pragma unroll
        for (int tt = 0; tt < 2; ++tt) {
            f32x4 nm = {0.f, 0.f, 0.f, 0.f};
#pragma unroll
            for (int src = 0; src < 4; ++src) nm += *(const LAS f32x4*)(pbuf + ((((src * 2 + eg) * 4 + dq) * 2 + tt) * 1024) + lane * 16);
            const int t = 32 * tt + l31;
            const float den = denp[t] + denp[64 + t] + denp[128 + t] + denp[192 + t];
            const float dn = fmaxf(fabsf(den), sthr[64 * c + t]);
            const float inv = 1.0f / dn;
            v2u wv; wv.x = pk2(nm[0] * inv, nm[1] * inv); wv.y = pk2(nm[2] * inv, nm[3] * inv);
            *(v2u*)(hg + (size_t)(64 * c + t) * 2048 + 32 * eg + 8 * dq + 4 * hi) = wv;
        }
        Mc = Mc2;
    }
    __syncthreads();
}
DI void phase(LAS unsigned char* lds, const Tensors& T, int G, int blk, int wv) {
#pragma unroll 1
    for (int u = blk; u < 256; u += G) {
        const int xcd = u & 7, j = u >> 3;
        unit(lds, T, xcd * 4 + (j >> 3), j & 7, wg_tid(wv));
    }
}
}
namespace mpost {
constexpr int GSTR = 576;
constexpr int XC_OFF = 0, WV_OFF = 128 * GSTR, LDS_BYTES = WV_OFF + 128 * 64;
struct Tensors { bf16* hm; const bf16* om; const bf16* kimg; const float* wv; const float* hng; const float* skip; };

DI void unit(LAS unsigned char* lds, const Tensors& T, int u, int tid_in) {
    int tid_ = tid_in; asm volatile("" : "+v"(tid_));
    const int tid = tid_;
    const int h = u & 3, c = (u >> 2) & 63, b = u >> 8;
#pragma unroll
    for (int k = 0; k < 2; ++k) {
        const int id = tid + 512 * k, pb = id & 7, g = id >> 3, ks = pb >> 1, hi_ = pb & 1;
        const char* src = (const char*)T.kimg + ((size_t)((b * 4 + h) * 64 + c) * 64 + (g >> 3) * 4 + ks) * 1024 + (4 * (g & 7) + 32 * hi_) * 16;
        const v4u r0 = *(const v4u*)(src), r1 = *(const v4u*)(src + 16), r2 = *(const v4u*)(src + 32), r3 = *(const v4u*)(src + 48);
        const unsigned a0[4] = {r0.x, r0.y, r0.z, r0.w}, a1[4] = {r1.x, r1.y, r1.z, r1.w}, a2[4] = {r2.x, r2.y, r2.z, r2.w}, a3[4] = {r3.x, r3.y, r3.z, r3.w};
#pragma unroll
        for (int m = 0; m < 4; ++m) {
            const int tok = 16 * ks + 8 * (m >> 1) + 4 * hi_ + 2 * (m & 1);
            v2u e0, e1;
            e0.x = (a0[m] & 0xffffu) | (a1[m] << 16); e0.y = (a2[m] & 0xffffu) | (a3[m] << 16);
            e1.x = (a0[m] >> 16) | (a1[m] & 0xffff0000u); e1.y = (a2[m] >> 16) | (a3[m] & 0xffff0000u);
            *(LAS v2u*)(lds + XC_OFF + g * GSTR + tok * 8) = e0;
            *(LAS v2u*)(lds + XC_OFF + g * GSTR + (tok + 1) * 8) = e1;
        }
    }
    *(LAS f32x4*)(lds + WV_OFF + tid * 16) = *(const f32x4*)(T.wv + (size_t)(128 * h) * 16 + tid * 4);
    __syncthreads();
    const int t5 = tid >> 4, seg = tid & 15;
#pragma unroll 1
    for (int pass = 0; pass < 2; ++pass) {
        const int t = t5 + 32 * pass;
        const size_t rowu = ((size_t)b * SEQ + 64 * c + 32 * pass) * 2048 + 512 * h;
        char* hmb = (char*)(T.hm + rowu); const char* omb = (const char*)(T.om + rowu);
        const char* gnb = (const char*)(T.hng + 512 * h); const char* skb = (const char*)(T.skip + 512 * h);
        const unsigned voff = (unsigned)(t5 * 4096 + seg * 8), soff = (unsigned)(seg * 16);
        float uv[32];
        float sum = 0.f;
#pragma unroll
        for (int k = 0; k < 8; ++k) {
            const int gi = seg + 16 * k;
            const v2u hx = *(const v2u*)(hmb + voff + k * 128);
            const v2u og = *(const v2u*)(omb + voff + k * 128);
            const float hv[4] = {bflo(hx.x), bfhi(hx.x), bflo(hx.y), bfhi(hx.y)};
            const float ov[4] = {bflo(og.x), bfhi(og.x), bflo(og.y), bfhi(og.y)};
            const LAS f32x4* wp = (const LAS f32x4*)(lds + WV_OFF + gi * 64);
            const f32x4 w0 = wp[0], w1 = wp[1], w2 = wp[2], w3 = wp[3];
#pragma unroll
            for (int o = 0; o < 4; ++o) {
                const float v = hv[0] * w0[o] + hv[1] * w1[o] + hv[2] * w2[o] + hv[3] * w3[o];
                const float x = v * ov[o];
                uv[4 * k + o] = x; sum += x;
            }
            if (k & 1) __builtin_amdgcn_sched_barrier(0);
        }
        sum += __shfl_xor(sum, 1); sum += __shfl_xor(sum, 2); sum += __shfl_xor(sum, 4); sum += __shfl_xor(sum, 8);
        const float mean = sum * (1.0f / 512.0f);
        float sq = 0.f;
#pragma unroll
        for (int i = 0; i < 32; ++i) { const float d = uv[i] - mean; sq += d * d; }
        sq += __shfl_xor(sq, 1); sq += __shfl_xor(sq, 2); sq += __shfl_xor(sq, 4); sq += __shfl_xor(sq, 8);
        const float rstd = 1.0f / sqrtf(sq * (1.0f / 512.0f) + EPS);
#pragma unroll
        for (int k = 0; k < 8; ++k) {
            const int gi = seg + 16 * k;
            const f32x4 gn = *(const f32x4*)(gnb + soff + k * 256), sk = *(const f32x4*)(skb + soff + k * 256);
            const v2u xc = *(const LAS v2u*)(lds + XC_OFF + gi * GSTR + t * 8);
            const float xv[4] = {bflo(xc.x), bfhi(xc.x), bflo(xc.y), bfhi(xc.y)};
            float r[4];
#pragma unroll
            for (int o = 0; o < 4; ++o) r[o] = (uv[4 * k + o] - mean) * rstd * gn[o] + sk[o] * xv[o];
            v2u wv; wv.x = pk2(r[0], r[1]); wv.y = pk2(r[2], r[3]);
            *(v2u*)(hmb + voff + k * 128) = wv;
        }
    }
    __syncthreads();
}
DI void phase(LAS unsigned char* lds, const Tensors& T, int G, int blk, int wv) {
    for (int u = blk; u < BATCH * NCHUNK * MH; u += G) unit(lds, T, u, wg_tid(wv));
}
}

DI void transpose_item(const float* W, int K, int N, bf16* WT, const float* kscale, LAS float* scr, int item, int lane) {
    const int nblk = N / 32, kb = item / nblk, nb = item % nblk, k0 = 64 * kb, n0 = 32 * nb;
#pragma unroll 8
    for (int i = 0; i < 32; ++i) { const int kk = 2 * i + (lane >> 5); float v = W[(size_t)(k0 + kk) * N + n0 + (lane & 31)]; if (kscale) v *= kscale[k0 + kk]; scr[kk * 33 + (lane & 31)] = v; }
    asm volatile("s_waitcnt lgkmcnt(0)" ::: "memory");
    const int cc = lane & 7;
#pragma unroll
    for (int j = 0; j < 4; ++j) { const int n = (lane >> 3) + 8 * j; const LAS float* s = scr + (8 * cc) * 33 + n;
        v4u o; o.x = pk2(s[0 * 33], s[1 * 33]); o.y = pk2(s[2 * 33], s[3 * 33]); o.z = pk2(s[4 * 33], s[5 * 33]); o.w = pk2(s[6 * 33], s[7 * 33]);
        *(v4u*)(WT + (size_t)(n0 + n) * K + k0 + 8 * cc) = o; }
    asm volatile("s_waitcnt lgkmcnt(0)" ::: "memory");
}
DI void rms_row_to_bf16(const float* xrow, bf16* orow, int lane) {
    const f32x4* xr = (const f32x4*)xrow + lane;
    f32x4 v[4]; float s = 0.f;
#pragma unroll
    for (int j = 0; j < 4; ++j) { v[j] = xr[64 * j]; s += (v[j][0] * v[j][0] + v[j][1] * v[j][1]) + (v[j][2] * v[j][2] + v[j][3] * v[j][3]); }
    const float r = 1.0f / sqrtf(wave_sum(s) * (1.0f / 1024.0f) + EPS);
    v2u* o8 = (v2u*)orow + lane;
#pragma unroll
    for (int j = 0; j < 4; ++j) { v2u w; w.x = pk2(v[j][0] * r, v[j][1] * r); w.y = pk2(v[j][2] * r, v[j][3] * r); o8[64 * j] = w; }
}
DI void rms_row_inplace(float* row, const float* g, int lane) {
    f32x4* xr = (f32x4*)row + lane; const f32x4* gr = (const f32x4*)g + lane;
    f32x4 v[4]; float s = 0.f;
#pragma unroll
    for (int j = 0; j < 4; ++j) { v[j] = xr[64 * j]; s += (v[j][0] * v[j][0] + v[j][1] * v[j][1]) + (v[j][2] * v[j][2] + v[j][3] * v[j][3]); }
    const float r = 1.0f / sqrtf(wave_sum(s) * (1.0f / 1024.0f) + EPS);
#pragma unroll
    for (int j = 0; j < 4; ++j) xr[64 * j] = v[j] * r * gr[64 * j];
}
constexpr int N_PHASES = 15;
constexpr int LDS_TOTAL = 163840;
static_assert(pg8::STAGE_BYTES <= LDS_TOTAL && att::LDS_BYTES <= LDS_TOTAL && mpre::LDS_BYTES <= LDS_TOTAL && mscan::LDS_BYTES <= LDS_TOTAL && mpost::LDS_BYTES <= LDS_TOTAL, "LDS map");

struct Args { const float* in[18]; float* out; unsigned char* ws; int ph_lo, ph_hi; };

DI void prologue(const Args& a, LAS unsigned char* lds, int G, int blk, int wvi) {
    const int tid = wg_tid(wvi), lane = tid & 63, wave = __builtin_amdgcn_readfirstlane(tid >> 6);
    unsigned char* ws = a.ws;
    LAS float* scr = (LAS float*)(lds + wave * 16384);
    const int gw = blk * NWAVES + wave, NGW = G * NWAVES;
    constexpr int I_IN = (DM / 64) * (NIN / 32), I_PA = (AW / 64) * (DM / 32), I_PB = (MW / 64) * (DM / 32), I_OUT = (DM / 64) * (DM / 32);
    constexpr int NITEMS = I_IN + I_PA + I_PB + I_OUT;
    for (int it = gw; it < NITEMS; it += NGW) {
        int r = it;
        if (r < I_IN) { transpose_item(a.in[2], DM, NIN, (bf16*)(ws + WS_WIN), a.in[1], scr, r, lane); continue; } r -= I_IN;
        if (r < I_PA) { transpose_item(a.in[13], AW, DM, (bf16*)(ws + WS_WPA), nullptr, scr, r, lane); continue; } r -= I_PA;
        if (r < I_PB) { transpose_item(a.in[14], MW, DM, (bf16*)(ws + WS_WPB), nullptr, scr, r, lane); continue; } r -= I_PB;
        transpose_item(a.in[15], DM, DM, (bf16*)(ws + WS_WOUT), nullptr, scr, r, lane);
    }
    for (int m = gw; m < MTOK; m += NGW) rms_row_to_bf16(a.in[0] + (size_t)m * DM, (bf16*)(ws + WS_XN) + (size_t)m * DM, lane);
    float* tab = (float*)(ws + WS_TAB);
    const float* wq = a.in[6]; const float* wk = a.in[7]; const float* wv = a.in[8]; const float* wif = a.in[9]; const float* rb = a.in[16];
    const int gt = blk * NTHR + tid, NGT = G * NTHR;
    for (int i = gt; i < 2048 * 8; i += NGT) {
        const int c = i >> 3, j = i & 7, g = c >> 2, ii = c & 3;
        float sc = 0.f, sm = 0.f;
#pragma unroll
        for (int o = 0; o < 4; ++o) {
            sc += wq[g * 16 + ii * 4 + o] * wif[(size_t)(4 * g + o) * 8 + j] + wk[g * 16 + ii * 4 + o] * wif[(size_t)(2048 + 4 * g + o) * 8 + j];
            sm += wv[g * 16 + ii * 4 + o] * wif[(size_t)(4096 + 4 * g + o) * 8 + j];
        }
        ((bf16*)(tab + TAB_WC))[j * 2048 + c] = (bf16)(pk2(sc, 0.f) & 0xffffu); ((bf16*)(tab + TAB_WM))[j * 2048 + c] = (bf16)(pk2(sm, 0.f) & 0xffffu);
    }
    for (int i = gt; i < 512 * 16; i += NGT) {
        const int g = i >> 4, ii = (i >> 2) & 3, i2 = i & 3;
        float s = 0.f;
#pragma unroll
        for (int o = 0; o < 4; ++o) s += wq[g * 16 + ii * 4 + o] * wk[g * 16 + i2 * 4 + o];
        tab[TAB_G + i] = s * 0.04419417382415922f;
    }
    for (int i = gt; i < 3 * 16 * 132; i += NGT) {
        const int d = i % 132, ph = i / 132, p = ph >> 4, hh = ph & 15;
        tab[TAB_BIAS + i] = rb[BUCKET[p][d] * 16 + hh] * LOG2E;
    }
}

DI void grid_sync_(int tid) {
    asm volatile("s_waitcnt vmcnt(0) lgkmcnt(0)" ::: "memory");
    __builtin_amdgcn_fence(__ATOMIC_RELEASE, "workgroup");
    __builtin_amdgcn_s_barrier();
    if (tid == 0) {
        __builtin_amdgcn_fence(__ATOMIC_ACQUIRE, "workgroup");
        __builtin_amdgcn_fence(__ATOMIC_RELEASE, "agent");
        const __attribute__((address_space(4))) char* ia = (const __attribute__((address_space(4))) char*)__builtin_amdgcn_implicitarg_ptr();
        const unsigned long long p = *(const __attribute__((address_space(4))) unsigned long long*)(ia + 88);
        unsigned* bar = (unsigned*)(p + 32);
        const unsigned nwg = *(const unsigned*)(p + 40);
        const unsigned old = __hip_atomic_fetch_add(bar, 1u, __ATOMIC_RELAXED, __HIP_MEMORY_SCOPE_AGENT);
        if ((old & 0xffffu) == nwg - 1u) (void)__hip_atomic_fetch_add(bar, 65536u - nwg, __ATOMIC_RELAXED, __HIP_MEMORY_SCOPE_AGENT);
        const unsigned gen = old & 0xffff0000u;
        while ((__hip_atomic_load(bar, __ATOMIC_RELAXED, __HIP_MEMORY_SCOPE_AGENT) & 0xffff0000u) == gen) __builtin_amdgcn_s_sleep(1);
        __builtin_amdgcn_fence(__ATOMIC_ACQUIRE, "agent");
        __builtin_amdgcn_fence(__ATOMIC_RELEASE, "workgroup");
    }
    __builtin_amdgcn_s_barrier();
    __builtin_amdgcn_fence(__ATOMIC_ACQUIRE, "workgroup");
}

__global__ void __launch_bounds__(NTHR) mk_fwd(Args a) {
    extern __shared__ __attribute__((aligned(16))) unsigned char lds_raw[];
    LAS unsigned char* lds = (LAS unsigned char*)lds_raw;
    const int G = gridDim.x, blk = blockIdx.x;
    const int wv = __builtin_amdgcn_readfirstlane(threadIdx.x >> 6);
    unsigned char* ws = a.ws;
    const int lo = a.ph_lo, hi = a.ph_hi;
    bf16* XN = (bf16*)(ws + WS_XN); bf16* WIN = (bf16*)(ws + WS_WIN);
#ifndef PH_MASK
#define PH_MASK 0x7fff
#endif
#define IN(k) (((PH_MASK >> (k)) & 1) && lo <= (k) && (k) < hi)
#ifndef REP_MASK
#define REP_MASK 0
#endif
#define REPEAT(k, body) do { body; if ((REP_MASK >> (k)) & 1) { grid_sync_(wg_tid(wv)); body; } } while (0)
#define SEAM(k) do { if (IN(k) && IN((k) + 1)) grid_sync_(wg_tid(wv)); } while (0)
#define GEMM_PHASE(EPI, E, Aop, Bop, NN, KK) do { pg8::Gemm g{(const pg8::bf16_t*)(Aop), (const pg8::bf16_t*)(Bop), MTOK, (NN), (KK)}; pg8::StaticOrder S; S.init(MTOK, (NN), G, blk); \
        pg8::gemm_phase<EPI, pg8::StaticOrder, true, true>(lds, g, S, E, wg_tid(wv)); } while (0)

    if (IN(0)) { REPEAT(0, prologue(a, lds, G, blk, wv)); } SEAM(0);
    if (IN(1)) {
        pg8::EpiXM E{(bf16*)(ws + WS_R0), (bf16*)(ws + WS_HALO)};
        REPEAT(1, GEMM_PHASE(pg8::EpiXM, E, XN, WIN + (size_t)C_XM * DM, MW, DM));
    } SEAM(1);
    if (IN(2)) {
        const float* tab = (const float*)(ws + WS_TAB);
        mpre::Tensors T{(const bf16*)(ws + WS_R0), (const bf16*)(ws + WS_HALO), (bf16*)(ws + WS_R1), (bf16*)a.out, (bf16*)(ws + WS_R2), (float*)(ws + WS_GP), (bf16*)(ws + WS_S), a.in[4], a.in[5], (const bf16*)(tab + TAB_WC), (const bf16*)(tab + TAB_WM), tab + TAB_G};
        mpre::phase(lds, T, G, blk, wv);
    } SEAM(2);
    if (IN(3)) {
        mscan::Tensors T{(const bf16*)(ws + WS_R2), (const bf16*)(ws + WS_R1), (const bf16*)a.out, (const bf16*)(ws + WS_S), (const float*)(ws + WS_GP), a.in[10], (float*)(ws + WS_SCAL), (bf16*)(ws + WS_R0)};
        REPEAT(3, mscan::phase(lds, T, G, blk, wv));
    } SEAM(3);
    if (IN(4)) {
        pg8::EpiSig E{(bf16*)(ws + WS_R2), MW, nullptr};
        REPEAT(4, GEMM_PHASE(pg8::EpiSig, E, XN, WIN + (size_t)C_OM * DM, MW, DM));
    } SEAM(4);
    if (IN(5)) {
        mpost::Tensors T{(bf16*)(ws + WS_R0), (const bf16*)(ws + WS_R2), (const bf16*)(ws + WS_R1), a.in[8], a.in[11], a.in[12]};
        mpost::phase(lds, T, G, blk, wv);
    } SEAM(5);
    if (IN(6)) {
        pg8::EpiZM E{(bf16*)(ws + WS_R0)};
        GEMM_PHASE(pg8::EpiZM, E, XN, WIN + (size_t)C_ZM * DM, MW, DM);
    } SEAM(6);
    if (IN(7)) {
        pg8::EpiQKV E{(bf16*)(ws + WS_QA), (size_t)(WS_KA - WS_QA) / 2};
        REPEAT(7, GEMM_PHASE(pg8::EpiQKV, E, XN, WIN + (size_t)C_QA * DM, 3 * AW, DM));
    } SEAM(7);
    if (IN(8)) {
        att::Tensors T{(const bf16*)(ws + WS_QA), (const bf16*)(ws + WS_KA), (const bf16*)(ws + WS_VA), (bf16*)(ws + WS_O1), (bf16*)a.out, (float*)(ws + WS_ST), (const float*)(ws + WS_TAB) + TAB_BIAS};
        REPEAT(8, att::phase(lds, T, G, blk, wv));
    } SEAM(8);
    if (IN(9)) {
        pg8::EpiZA E{(const bf16*)(ws + WS_O1), (const bf16*)a.out, (const bf16*)a.out + (size_t)MTOK * AW, (const float*)(ws + WS_ST), (bf16*)(ws + WS_A1)};
        REPEAT(9, GEMM_PHASE(pg8::EpiZA, E, XN, WIN + (size_t)C_ZA * DM, AW, DM));
    } SEAM(9);
    if (IN(10)) {
        pg8::EpiSig E{(bf16*)(ws + WS_G), 2 * DM, a.in[3]};
        REPEAT(10, GEMM_PHASE(pg8::EpiSig, E, XN, WIN + (size_t)C_G * DM, 2 * DM, DM));
    } SEAM(10);
    if (IN(11)) {
        pg8::EpiYA E{(bf16*)(ws + WS_G)};
        GEMM_PHASE(pg8::EpiYA, E, ws + WS_A1, ws + WS_WPA, DM, AW);
    } SEAM(11);
    if (IN(12)) {
        pg8::EpiYM E{(const bf16*)(ws + WS_G), (bf16*)(ws + WS_MRG)};
        REPEAT(12, GEMM_PHASE(pg8::EpiYM, E, ws + WS_R0, ws + WS_WPB, DM, MW));
    } SEAM(12);
    if (IN(13)) {
        pg8::EpiOut E{a.in[0], a.out};
        REPEAT(13, GEMM_PHASE(pg8::EpiOut, E, ws + WS_MRG, ws + WS_WOUT, DM, DM));
    } SEAM(13);
    if (IN(14)) {
        const int lane = wg_tid(wv) & 63, wave = wv;
        for (int m = blk * NWAVES + wave; m < MTOK; m += G * NWAVES) rms_row_inplace(a.out + (size_t)m * DM, a.in[17], lane);
    }
#undef IN
#undef SEAM
#undef GEMM_PHASE
}

#ifndef MK_ONE_LAUNCH
#define MK_ONE_LAUNCH 0
#endif
extern "C" void kernel_launch(void* const* d_in, const int* in_sizes, int n_in, void* d_out, int out_size, void* d_ws, size_t ws_size, hipStream_t stream) {
    static int grid = 0;
    if (grid == 0) {
        if (n_in != 18 || in_sizes[0] != MTOK * DM || out_size != MTOK * DM || ws_size < WS_END) { fprintf(stderr, "kernel_launch: unexpected shapes (n_in %d, ws %zu)\n", n_in, ws_size); grid = -1; return; }
        int dev = 0, cus = 0, per_cu = 0;
        (void)hipGetDevice(&dev); (void)hipDeviceGetAttribute(&cus, hipDeviceAttributeMultiprocessorCount, dev);
        if (hipFuncSetAttribute((const void*)mk_fwd, hipFuncAttributeMaxDynamicSharedMemorySize, LDS_TOTAL) != hipSuccess) { fprintf(stderr, "kernel_launch: hipFuncSetAttribute failed\n"); grid = -1; return; }
        if (hipOccupancyMaxActiveBlocksPerMultiprocessor(&per_cu, (const void*)mk_fwd, NTHR, LDS_TOTAL) != hipSuccess || per_cu < 1) { fprintf(stderr, "kernel_launch: occupancy query says %d\n", per_cu); per_cu = 1; }
        (void)hipGetLastError();
        grid = cus * (per_cu > 1 ? 1 : per_cu);
    }
    if (grid < 0) return;
    Args a{};
    for (int i = 0; i < 18; ++i) a.in[i] = (const float*)d_in[i];
    a.out = (float*)d_out; a.ws = (unsigned char*)d_ws;
#if MK_ONE_LAUNCH
    a.ph_lo = 0; a.ph_hi = N_PHASES;
    void* args[] = {&a};
    hipError_t e = hipLaunchCooperativeKernel((const void*)mk_fwd, dim3(grid), dim3(NTHR), args, LDS_TOTAL, stream);
    if (e != hipSuccess) fprintf(stderr, "cooperative launch failed: %s (grid %d)\n", hipGetErrorString(e), grid);
#else
    for (int p = 0; p < N_PHASES; ++p) {
        a.ph_lo = p; a.ph_hi = p + 1;
        hipLaunchKernelGGL(mk_fwd, dim3(grid), dim3(NTHR), LDS_TOTAL, stream, a);
    }
#endif
}
```

```cpp
#define MK_ONE_LAUNCH 1
#include <hip/hip_runtime.h>
#include <hip/hip_cooperative_groups.h>
#include <cstdio>
#include <cstdint>
namespace cg = cooperative_groups;
#define LAS __attribute__((address_space(3)))
#define GAS __attribute__((address_space(1)))
typedef unsigned short bf16;
typedef unsigned v4u __attribute__((ext_vector_type(4)));
typedef unsigned v2u __attribute__((ext_vector_type(2)));
typedef float f32x4 __attribute__((ext_vector_type(4)));
typedef float f32x16 __attribute__((ext_vector_type(16)));
typedef short bf16x8 __attribute__((ext_vector_type(8)));
typedef short s16x4 __attribute__((ext_vector_type(4)));
typedef float f32x2_t __attribute__((ext_vector_type(2)));
typedef __bf16 bf16x2_t __attribute__((ext_vector_type(2)));

constexpr int NWAVES = 8, NTHR = 512;
constexpr int BATCH = 8, SEQ = 4096, DM = 1024, MTOK = BATCH * SEQ;
constexpr int AH = 16, AHD = 64, AW = 1024;
constexpr int MH = 4, MHD = 512, MW = 2048;
constexpr int NIN = 12288;
constexpr int C_QA = 0, C_KA = 1024, C_VA = 2048, C_ZA = 3072, C_XM = 4096, C_ZM = 6144, C_OM = 8192, C_G = 10240;
constexpr int CHUNK = 64, NCHUNK = SEQ / CHUNK;
constexpr float EPS = 1e-6f;
constexpr float LOG2E = 1.4426950408889634f;
constexpr float QSCALE = 0.125f * 1.4426950408889634f;

constexpr size_t MiB = 1u << 20;
constexpr size_t WS_CTL = 0;
constexpr size_t WS_WIN = 1 * MiB;
constexpr size_t WS_WPA = 25 * MiB;
constexpr size_t WS_WPB = 27 * MiB;
constexpr size_t WS_WOUT = 31 * MiB;
constexpr size_t WS_TAB = 33 * MiB;
constexpr size_t WS_GP = 34 * MiB;
constexpr size_t WS_SCAL = 38 * MiB;
constexpr size_t WS_HALO = 40 * MiB;
constexpr size_t WS_ST = 34 * MiB;
constexpr size_t WS_XN = 46 * MiB;
constexpr size_t WS_R0 = 110 * MiB;
constexpr size_t WS_R1 = 238 * MiB;
constexpr size_t WS_R2 = 366 * MiB;
constexpr size_t WS_S = 494 * MiB;
constexpr size_t WS_END = 512 * MiB;
constexpr size_t WS_QA = 238 * MiB, WS_KA = 302 * MiB, WS_VA = 366 * MiB;
constexpr size_t WS_O1 = 430 * MiB;
constexpr size_t WS_A1 = 238 * MiB;
constexpr size_t WS_G = 302 * MiB;
constexpr size_t WS_MRG = 430 * MiB;
constexpr int TAB_WC = 0;
constexpr int TAB_WM = 2048 * 8;
constexpr int TAB_G = 2 * 2048 * 8;
constexpr int TAB_BIAS = TAB_G + 512 * 16;
constexpr int TAB_END = TAB_BIAS + 3 * 16 * 132;

__device__ const unsigned char BUCKET[3][132] = {
 {0,1,2,3,4,5,6,7,8,9,10,11,12,13,14,15,16,16,16,16,16,16,17,17,17,17,17,17,17,17,18,18,18,18,18,18,18,18,18,18,19,19,19,19,19,19,19,19,19,19,19,19,19,19,20,20,20,20,20,20,20,20,20,20,20,20,20,20,20,20,20,20,20,21,21,21,21,21,21,21,21,21,21,21,21,21,21,21,21,21,21,21,21,21,21,21,21,21,21,22,22,22,22,22,22,22,22,22,22,22,22,22,22,22,22,22,22,22,22,22,22,22,22,22,22,22,22,22,22,0,0,0},
 {0,4,8,12,16,16,17,17,18,18,19,19,19,19,20,20,20,20,20,21,21,21,21,21,21,22,22,22,22,22,22,22,22,22,23,23,23,23,23,23,23,23,23,23,23,23,24,24,24,24,24,24,24,24,24,24,24,24,24,24,24,24,25,25,25,25,25,25,25,25,25,25,25,25,25,25,25,25,25,25,25,25,25,26,26,26,26,26,26,26,26,26,26,26,26,26,26,26,26,26,26,26,26,26,26,26,26,26,26,26,26,26,26,27,27,27,27,27,27,27,27,27,27,27,27,27,27,27,27,0,0,0},
 {0,16,18,19,20,21,21,22,22,23,23,23,24,24,24,24,25,25,25,25,25,26,26,26,26,26,26,26,26,27,27,27,27,27,27,27,27,27,27,28,28,28,28,28,28,28,28,28,28,28,28,28,29,29,29,29,29,29,29,29,29,29,29,29,29,29,29,29,29,29,30,30,30,30,30,30,30,30,30,30,30,30,30,30,30,30,30,30,30,30,30,30,30,30,30,31,31,31,31,31,31,31,31,31,31,31,31,31,31,31,31,31,31,31,31,31,31,31,31,31,31,31,31,31,31,31,31,31,31,0,0,0}};

#define DI __device__ __forceinline__
DI unsigned pk2(float lo, float hi) { f32x2_t v = {lo, hi}; bf16x2_t b = __builtin_convertvector(v, bf16x2_t); return __builtin_bit_cast(unsigned, b); }
DI float bflo(unsigned u) { return __uint_as_float(u << 16); }
DI float bfhi(unsigned u) { return __uint_as_float(u & 0xffff0000u); }
DI float sigmoidf_(float x) { return 1.0f / (1.0f + __expf(-x)); }
DI float siluf_(float x) { return x / (1.0f + __expf(-x)); }
DI float wave_sum(float v) {
#pragma unroll
    for (int o = 1; o < 64; o <<= 1) v += __shfl_xor(v, o);
    return v;
}
DI int wg_tid(int wv) { return wv * 64 + (int)__builtin_amdgcn_mbcnt_hi(~0u, __builtin_amdgcn_mbcnt_lo(~0u, 0u)); }
DI int wg_tid_local(int wv) { int z; asm volatile("v_mov_b32 %0, 0" : "=v"(z)); return wv * 64 + (int)__builtin_amdgcn_mbcnt_hi(~0u, __builtin_amdgcn_mbcnt_lo(~0u, (unsigned)z)); }
DI float bperm(float v, int srclane) { return __int_as_float(__builtin_amdgcn_ds_bpermute(srclane << 2, __float_as_int(v))); }
DI int crow(int r, int hi) { return (r & 3) + 8 * (r >> 2) + 4 * hi; }
#define MFMA32(a, b, c) __builtin_amdgcn_mfma_f32_32x32x16_bf16((a), (b), (c), 0, 0, 0)
DI s16x4 tr_read(const LAS unsigned char* p) { return __builtin_bit_cast(s16x4, __builtin_amdgcn_ds_read_tr16_b64_v4i16((LAS s16x4*)p)); }
DI bf16x8 cat8(s16x4 lo, s16x4 hi) { return __builtin_shufflevector(lo, hi, 0, 1, 2, 3, 4, 5, 6, 7); }
DI bf16x8 pack8(float a0, float a1, float a2, float a3, float a4, float a5, float a6, float a7) {
    v4u p; p.x = pk2(a0, a1); p.y = pk2(a2, a3); p.z = pk2(a4, a5); p.w = pk2(a6, a7); return __builtin_bit_cast(bf16x8, p);
}
namespace pg8 {
#define PG8_LAS __attribute__((address_space(3)))
typedef unsigned short bf16_t;
typedef short bf16x8 __attribute__((ext_vector_type(8)));
typedef float f32x4 __attribute__((ext_vector_type(4)));
typedef unsigned u32x4 __attribute__((ext_vector_type(4)));
constexpr int BM = 256, BK = 64, HALF = 128, HTB = HALF * BK * 2  , STAGE_BYTES = 8 * HTB, NXCD = 8, WGM = 8;

__host__ __device__ __forceinline__ int lds_byte(int r, int c) { const int st = (r >> 4) * 2 + (c >> 5), rr = r & 15, cc = c & 31, ob = rr * 64 + cc * 2; return st * 1024 + (ob ^ (((ob >> 9) & 1) << 5)); }
__host__ __device__ __forceinline__ void stage_rc(int b, int& R, int& C) { const int st = b / 1024, sb = b % 1024, swz = sb ^ (((sb >> 9) & 1) << 5); R = (st >> 1) * 16 + swz / 64; C = (st & 1) * 32 + (swz % 64) / 2; }
__host__ __device__ __forceinline__ int perm32(int rho) { const int n = rho >> 4, i = rho & 15; return 8 * (i >> 2) + 4 * n + (i & 3); }

struct Unit { int pm, pn; };
struct Gemm { const bf16_t* A; const bf16_t* Bt; int M, N, K; };

struct StaticOrder {
    int nM, nN, nwg, G, c;
    __host__ __device__ void init(int M, int N, int G_, int c_) { nM = M / BM; nN = N / BM; nwg = nM * nN; G = G_; c = c_; }
    __host__ __device__ bool next(int i, Unit& u) const {
        const long L = (long)i * G + c; if (L >= nwg) return false;
        int wgid = (int)L; { const int q = nwg / NXCD, r = nwg % NXCD, xcd = wgid % NXCD, off = wgid / NXCD; wgid = (xcd < r ? xcd * (q + 1) : r * (q + 1) + (xcd - r) * q) + off; }
        const int nig = WGM * nN, gid = wgid / nig, fm = gid * WGM, gsz = (nM - fm) < WGM ? (nM - fm) : WGM;
        u.pm = fm + ((wgid % nig) % gsz); u.pn = (wgid % nig) / gsz; return true;
    }
    __device__ __forceinline__ void a_ready(const Unit&) const {}
    __device__ __forceinline__ void done(const Unit&) const {}
};

}
namespace pg8 {
#define EPI_OPERATOR \
    static constexpr bool PERM = true, AFTER_DRAIN = false; \
    __device__ __forceinline__ void operator()(const f32x4 (&acc)[2][2][4][2], const Unit& u, int wr, int wc, int fr, int fq) const { \
        const int row0 = u.pm * BM + wr * 64 + fr, col0 = u.pn * BM + wc * 32 + 8 * fq; \
        _Pragma("unroll") for (int ai = 0; ai < 2; ++ai) \
        _Pragma("unroll") for (int m = 0; m < 4; ++m) \
        _Pragma("unroll") for (int bj = 0; bj < 2; ++bj) store8(row0 + ai * HALF + m * 16, col0 + bj * HALF, acc[ai][bj][m][0], acc[ai][bj][m][1]); \
    }
DI ::v4u pack_bf16x8(f32x4 v0, f32x4 v1) { ::v4u w; w.x = ::pk2(v0[0], v0[1]); w.y = ::pk2(v0[2], v0[3]); w.z = ::pk2(v1[0], v1[1]); w.w = ::pk2(v1[2], v1[3]); return w; }
DI void unpack_bf16x8(::v4u w, f32x4& v0, f32x4& v1) { v0 = (f32x4){::bflo(w.x), ::bfhi(w.x), ::bflo(w.y), ::bfhi(w.y)}; v1 = (f32x4){::bflo(w.z), ::bfhi(w.z), ::bflo(w.w), ::bfhi(w.w)}; }

struct EpiXM {
    bf16_t* xm; bf16_t* halo;
    DI void store8(int row, int col, f32x4 v0, f32x4 v1) const {
        const ::v4u w = pack_bf16x8(v0, v1);
        *(::v4u*)(xm + (size_t)row * 2048 + col) = w;
        const int r = row & 63;
        if (r >= 61) *(::v4u*)(halo + ((size_t)(row >> 6) * 3 + (r - 61)) * 2048 + col) = w;
    }
    EPI_OPERATOR
};
struct EpiSig {
    bf16_t* out; int ldc; const float* bias;
    DI void store8(int row, int col, f32x4 v0, f32x4 v1) const {
        if (bias) { v0 += *(const f32x4*)(bias + col); v1 += *(const f32x4*)(bias + col + 4); }
#pragma unroll
        for (int i = 0; i < 4; ++i) { v0[i] = ::sigmoidf_(v0[i]); v1[i] = ::sigmoidf_(v1[i]); }
        *(::v4u*)(out + (size_t)row * ldc + col) = pack_bf16x8(v0, v1);
    }
    EPI_OPERATOR
};
struct EpiZM {
    bf16_t* buf;
    DI void store8(int row, int col, f32x4 v0, f32x4 v1) const {
        ::v4u* p = (::v4u*)(buf + (size_t)row * 2048 + col);
        f32x4 h0, h1; unpack_bf16x8(*p, h0, h1);
#pragma unroll
        for (int i = 0; i < 4; ++i) { h0[i] *= ::siluf_(v0[i]); h1[i] *= ::siluf_(v1[i]); }
        *p = pack_bf16x8(h0, h1);
    }
    EPI_OPERATOR
};
struct EpiQKV {
    bf16_t* q; size_t stride;
    DI void store8(int row, int col, f32x4 v0, f32x4 v1) const {
        const int t = col >> 10, c = col & 1023;
        bf16_t* base = q + (size_t)t * stride;
        if (t == 0) { v0 *= ::QSCALE; v1 *= ::QSCALE; }
        *(::v4u*)(base + (size_t)row * 1024 + c) = pack_bf16x8(v0, v1);
    }
    EPI_OPERATOR
};
struct EpiZA {
    const bf16_t* o0; const bf16_t* o1; const bf16_t* o2; const float* st; bf16_t* a1;
    DI void store8(int row, int col, f32x4 v0, f32x4 v1) const {
        const int head = col >> 6;
        const ::f32x2_t s0 = *(const ::f32x2_t*)(st + ((size_t)(0 * ::MTOK + row) * 16 + head) * 2);
        const ::f32x2_t s1 = *(const ::f32x2_t*)(st + ((size_t)(1 * ::MTOK + row) * 16 + head) * 2);
        const ::f32x2_t s2 = *(const ::f32x2_t*)(st + ((size_t)(2 * ::MTOK + row) * 16 + head) * 2);
        const float mx = fmaxf(s0.x, fmaxf(s1.x, s2.x));
        float w0 = __builtin_amdgcn_exp2f(s0.x - mx) * s0.y, w1 = __builtin_amdgcn_exp2f(s1.x - mx) * s1.y, w2 = __builtin_amdgcn_exp2f(s2.x - mx) * s2.y;
        const float inv = 1.0f / (w0 + w1 + w2); w0 *= inv; w1 *= inv; w2 *= inv;
        const size_t off = (size_t)row * 1024 + col;
        f32x4 a0, a1v, b0, b1, c0, c1;
        unpack_bf16x8(*(const ::v4u*)(o0 + off), a0, a1v); unpack_bf16x8(*(const ::v4u*)(o1 + off), b0, b1); unpack_bf16x8(*(const ::v4u*)(o2 + off), c0, c1);
        f32x4 r0 = a0 * w0 + b0 * w1 + c0 * w2, r1 = a1v * w0 + b1 * w1 + c1 * w2;
#pragma unroll
        for (int i = 0; i < 4; ++i) { r0[i] *= ::siluf_(v0[i]); r1[i] *= ::siluf_(v1[i]); }
        *(::v4u*)(a1 + off) = pack_bf16x8(r0, r1);
    }
    EPI_OPERATOR
};
struct EpiYA {
    bf16_t* g;
    DI void store8(int row, int col, f32x4 v0, f32x4 v1) const {
        ::v4u* p = (::v4u*)(g + (size_t)row * 2048 + col);
        f32x4 h0, h1; unpack_bf16x8(*p, h0, h1);
        *p = pack_bf16x8(h0 * v0, h1 * v1);
    }
    EPI_OPERATOR
};
struct EpiYM {
    const bf16_t* g; bf16_t* mrg;
    DI void store8(int row, int col, f32x4 v0, f32x4 v1) const {
        f32x4 t0, t1, g0, g1;
        unpack_bf16x8(*(const ::v4u*)(g + (size_t)row * 2048 + col), t0, t1);
        unpack_bf16x8(*(const ::v4u*)(g + (size_t)row * 2048 + 1024 + col), g0, g1);
        *(::v4u*)(mrg + (size_t)row * 1024 + col) = pack_bf16x8(t0 + g0 * v0, t1 + g1 * v1);
    }
    EPI_OPERATOR
};
struct EpiOut {
    const float* x; float* out;
    DI void store8(int row, int col, f32x4 v0, f32x4 v1) const {
        const size_t off = (size_t)row * 1024 + col;
        *(f32x4*)(out + off) = *(const f32x4*)(x + off) + v0;
        *(f32x4*)(out + off + 4) = *(const f32x4*)(x + off + 4) + v1;
    }
    EPI_OPERATOR
};
}
namespace pg8 {
template <class Epi, class Sched, bool ALIGN_EPI = false, bool SP2 = false>
__device__ __forceinline__ void gemm_phase(PG8_LAS unsigned char* lds, const Gemm g, const Sched& S, const Epi& E, const int tid_in) {
    const int tid = tid_in, wid = __builtin_amdgcn_readfirstlane(tid >> 6), lane = tid & 63, wr = wid >> 2, wc = wid & 3, fr = lane & 15, fq = lane >> 4;
    const int K = g.K, nt = K / BK;
    unsigned voffA[2], voffB[2];
#pragma unroll
    for (int i = 0; i < 2; ++i) { int R, C; stage_rc(tid * 16 + i * 8192, R, C); const int Rb = Epi::PERM ? ((R & ~31) + perm32(R & 31)) : R;
        voffA[i] = (unsigned)(R * K + C) * 2u; voffB[i] = (unsigned)(Rb * K + C) * 2u; }
    const size_t kstep = (size_t)(BK * 2);
    const size_t hstep = (size_t)HALF * K * 2;
    const size_t tstep = 2 * hstep;
    const unsigned ldsw = (unsigned)wid * 1024u;
    const int aoff = lds_byte(wr * 64 + fr, fq * 8), boff = lds_byte(wc * 32 + fr, fq * 8);
#define PG8_SA(b, h) (((b) * 2 + (h)) * HTB)
#define PG8_SB(b, h) ((4 + (b) * 2 + (h)) * HTB)
#define PG8_STAGE(bufoff, gbase, voff) do { _Pragma("unroll") for (int _i = 0; _i < 2; ++_i) \
        __builtin_amdgcn_global_load_lds((const unsigned*)((const char*)(gbase) + (voff)[_i]), (PG8_LAS unsigned*)(lds + (bufoff) + ldsw + _i * 8192), 16, 0, 0); } while (0)
#define PG8_LDA(dst, b, h) do { _Pragma("unroll") for (int m = 0; m < 4; ++m) _Pragma("unroll") for (int k = 0; k < 2; ++k) dst[m][k] = *(const PG8_LAS bf16x8*)(lds + PG8_SA(b, h) + aoff + m * 2048 + k * 1024); } while (0)
#define PG8_LDB(dst, b, h) do { _Pragma("unroll") for (int n = 0; n < 2; ++n) _Pragma("unroll") for (int k = 0; k < 2; ++k) dst[n][k] = *(const PG8_LAS bf16x8*)(lds + PG8_SB(b, h) + boff + n * 2048 + k * 1024); } while (0)
#define PG8_MMA(ai, bj, At, Bt) do { __builtin_amdgcn_s_setprio(1); _Pragma("unroll") for (int m = 0; m < 4; ++m) _Pragma("unroll") for (int n = 0; n < 2; ++n) _Pragma("unroll") for (int k = 0; k < 2; ++k) \
        acc[ai][bj][m][n] = __builtin_amdgcn_mfma_f32_16x16x32_bf16(Bt[n][k], At[m][k], acc[ai][bj][m][n], 0, 0, 0); __builtin_amdgcn_s_setprio(0); } while (0)
#define PG8_WAIT_V(n) asm volatile("s_waitcnt vmcnt(" #n ")" ::: "memory")
#define PG8_WAIT_L(n) asm volatile("s_waitcnt lgkmcnt(" #n ")" ::: "memory")
#define PG8_BAR __builtin_amdgcn_s_barrier()
#define PG8_SCHED __builtin_amdgcn_sched_barrier(0)
    Unit cur, nxt; int ui = 0;
    if (!S.next(0, cur)) return;
    f32x4 acc[2][2][4][2];
#pragma unroll
    for (int a = 0; a < 2; ++a)
#pragma unroll
        for (int b = 0; b < 2; ++b)
#pragma unroll
            for (int m = 0; m < 4; ++m)
#pragma unroll
                for (int n = 0; n < 2; ++n) acc[a][b][m][n] = (f32x4){0.f, 0.f, 0.f, 0.f};
    bf16x8 At[4][2], B0[2][2], B1[2][2];
    const char* cA = (const char*)g.A + (size_t)cur.pm * tstep; const char* cB = (const char*)g.Bt + (size_t)cur.pn * tstep;
    S.a_ready(cur);
    if constexpr (SP2) {
        PG8_STAGE(PG8_SB(0, 0), cB, voffB); PG8_STAGE(PG8_SB(0, 1), cB + hstep, voffB); PG8_STAGE(PG8_SA(0, 0), cA, voffA); PG8_STAGE(PG8_SA(0, 1), cA + hstep, voffA);
        if (wr == 1) PG8_BAR;
        PG8_WAIT_V(2); PG8_BAR;
        PG8_STAGE(PG8_SB(1, 0), cB + kstep, voffB); PG8_STAGE(PG8_SA(1, 0), cA + kstep, voffA); PG8_STAGE(PG8_SB(1, 1), cB + hstep + kstep, voffB);
        PG8_WAIT_V(6); PG8_BAR;
    } else {
        PG8_STAGE(PG8_SB(0, 0), cB, voffB); PG8_STAGE(PG8_SA(0, 0), cA, voffA); PG8_STAGE(PG8_SB(0, 1), cB + hstep, voffB); PG8_STAGE(PG8_SA(0, 1), cA + hstep, voffA);
        if (wr == 1) PG8_BAR;
        PG8_WAIT_V(4); PG8_BAR;
        PG8_STAGE(PG8_SB(1, 0), cB + kstep, voffB); PG8_STAGE(PG8_SA(1, 0), cA + kstep, voffA); PG8_STAGE(PG8_SB(1, 1), cB + hstep + kstep, voffB);
        PG8_WAIT_V(6); PG8_BAR;
    }
    for (;;) {
        const bool has_next = S.next(ui + 1, nxt);
        const char* nA = has_next ? (const char*)g.A + (size_t)nxt.pm * tstep : cA; const char* nB = has_next ? (const char*)g.Bt + (size_t)nxt.pn * tstep : cB;
        for (int t = 0; t < nt; t += 2) {
            const bool last = (t == nt - 2);
            const char* a1 = cA + (size_t)(t + 1) * kstep;
            const char* a2 = last ? nA : cA + (size_t)(t + 2) * kstep; const char* b2 = last ? nB : cB + (size_t)(t + 2) * kstep;
            const char* a3 = a2 + kstep; const char* b3 = b2 + kstep;
            if (last && has_next) S.a_ready(nxt);
            if constexpr (SP2) {
            PG8_LDB(B0, 0, 0); PG8_LDB(B1, 0, 1); PG8_SCHED; PG8_LDA(At, 0, 0); PG8_STAGE(PG8_SA(1, 1), a1 + hstep, voffA);
            PG8_WAIT_V(8); PG8_WAIT_L(0); PG8_BAR; PG8_MMA(0, 0, At, B0); PG8_MMA(0, 1, At, B1); PG8_BAR; PG8_SCHED;
            PG8_LDA(At, 0, 1); PG8_STAGE(PG8_SB(0, 0), b2, voffB); PG8_STAGE(PG8_SB(0, 1), b2 + hstep, voffB); PG8_STAGE(PG8_SA(0, 0), a2, voffA);
            PG8_WAIT_V(8); PG8_WAIT_L(0); PG8_BAR; PG8_MMA(1, 0, At, B0); PG8_MMA(1, 1, At, B1); PG8_BAR; PG8_SCHED;
            PG8_LDB(B0, 1, 0); PG8_LDB(B1, 1, 1); PG8_SCHED; PG8_LDA(At, 1, 0); PG8_STAGE(PG8_SA(0, 1), a2 + hstep, voffA);
            PG8_WAIT_V(8); PG8_WAIT_L(0); PG8_BAR; PG8_MMA(0, 0, At, B0); PG8_MMA(0, 1, At, B1); PG8_BAR; PG8_SCHED;
            PG8_LDA(At, 1, 1); PG8_STAGE(PG8_SB(1, 0), b3, voffB); PG8_STAGE(PG8_SB(1, 1), b3 + hstep, voffB); PG8_STAGE(PG8_SA(1, 0), a3, voffA);
            PG8_WAIT_V(8); PG8_WAIT_L(0); PG8_BAR; PG8_MMA(1, 0, At, B0); PG8_MMA(1, 1, At, B1); PG8_BAR; PG8_SCHED;
            } else {
            PG8_LDB(B0, 0, 0); PG8_SCHED; PG8_LDA(At, 0, 0); PG8_STAGE(PG8_SA(1, 1), a1 + hstep, voffA);
            PG8_WAIT_L(8); PG8_BAR; PG8_WAIT_L(0); PG8_MMA(0, 0, At, B0); PG8_BAR; PG8_SCHED;
            PG8_LDB(B1, 0, 1); PG8_STAGE(PG8_SB(0, 0), b2, voffB);
            PG8_BAR; PG8_WAIT_L(0); PG8_MMA(0, 1, At, B1); PG8_BAR;
            PG8_LDA(At, 0, 1); PG8_STAGE(PG8_SA(0, 0), a2, voffA);
            PG8_BAR; PG8_WAIT_L(0); PG8_MMA(1, 0, At, B0); PG8_BAR; PG8_SCHED;
            PG8_STAGE(PG8_SB(0, 1), b2 + hstep, voffB);
            PG8_WAIT_V(6); PG8_BAR; PG8_MMA(1, 1, At, B1); PG8_BAR;
            PG8_LDB(B0, 1, 0); PG8_SCHED; PG8_LDA(At, 1, 0); PG8_STAGE(PG8_SA(0, 1), a2 + hstep, voffA);
            PG8_WAIT_L(8); PG8_BAR; PG8_WAIT_L(0); PG8_MMA(0, 0, At, B0); PG8_BAR; PG8_SCHED;
            PG8_LDB(B1, 1, 1); PG8_STAGE(PG8_SB(1, 0), b3, voffB);
            PG8_BAR; PG8_WAIT_L(0); PG8_MMA(0, 1, At, B1); PG8_BAR;
            PG8_LDA(At, 1, 1); PG8_STAGE(PG8_SA(1, 0), a3, voffA);
            PG8_BAR; PG8_WAIT_L(0); PG8_MMA(1, 0, At, B0); PG8_BAR; PG8_SCHED;
            PG8_STAGE(PG8_SB(1, 1), b3 + hstep, voffB);
            PG8_WAIT_V(6); PG8_BAR; PG8_MMA(1, 1, At, B1); PG8_BAR;
            }
        }
        if constexpr (ALIGN_EPI) { if (wr == 0) PG8_BAR; }
        if constexpr (!Epi::AFTER_DRAIN) { E(acc, cur, wr, wc, fr, fq); S.done(cur); }
        if (!has_next) break;
#pragma unroll
        for (int a = 0; a < 2; ++a)
#pragma unroll
            for (int b = 0; b < 2; ++b)
#pragma unroll
                for (int m = 0; m < 4; ++m)
#pragma unroll
                    for (int n = 0; n < 2; ++n) acc[a][b][m][n] = (f32x4){0.f, 0.f, 0.f, 0.f};
        cur = nxt; cA = nA; cB = nB; ++ui;
        if constexpr (ALIGN_EPI) { if (wr == 1) PG8_BAR; }
    }
    PG8_WAIT_V(0);
    if constexpr (!ALIGN_EPI) { if (wr == 0) PG8_BAR; }
    PG8_BAR;
    if constexpr (Epi::AFTER_DRAIN) { E.fused(acc, cur, wr, wc, fr, fq, lds, wid, lane); S.done(cur); }
#undef PG8_SA
#undef PG8_SB
#undef PG8_STAGE
#undef PG8_LDA
#undef PG8_LDB
#undef PG8_MMA
#undef PG8_WAIT_V
#undef PG8_WAIT_L
#undef PG8_BAR
#undef PG8_SCHED
}
}
namespace att {
constexpr int KP = 144;
constexpr int K_OFF = 0, V_OFF = 384 * KP, B_OFF = 2 * 384 * KP, LDS_BYTES = B_OFF + 132 * 4;
struct Tensors { const bf16* Q; const bf16* K; const bf16* V; bf16* Oa; bf16* Ob; float* st; const float* biasL2; };

DI void unit(LAS unsigned char* lds, const Tensors& T, int u, int tid_in) {
    const int tid_ = wg_tid_local(tid_in);
    const int tid = tid_, lane = tid & 63, l31 = lane & 31, hi = lane >> 5, w = __builtin_amdgcn_readfirstlane(tid >> 6);
    const int bh = u / 48, rem = u % 48, p = rem >> 4, w16 = rem & 15;
    const int b = bh >> 4, h = bh & 15;
    const int dsh = 2 * p, nqb = 16 >> dsh, r = w16 / nqb, qblk = w16 % nqb;
    const size_t rowb = (size_t)b * SEQ;
    {
#pragma unroll
        for (int k = 0; k < 6; ++k) {
            const int id = tid + 512 * k, j = id >> 3, pc = id & 7;
            int pos = 256 * qblk - 128 + j; pos = pos < 0 ? 0 : pos;
            const size_t off = (rowb + r + ((size_t)pos << dsh)) * 1024 + h * 64 + pc * 8;
            const v4u kv = *(const v4u*)(T.K + off); const v4u vv = *(const v4u*)(T.V + off);
            *(LAS v4u*)(lds + K_OFF + j * KP + pc * 16) = kv;
            *(LAS v4u*)(lds + V_OFF + j * KP + pc * 16) = vv;
        }
        if (tid < 132) ((LAS float*)(lds + B_OFF))[tid] = T.biasL2[(p * 16 + h) * 132 + tid];
    }
    const int qpos = 256 * qblk + 32 * w + l31;
    const size_t qrow = rowb + r + ((size_t)qpos << dsh);
    bf16x8 qf[4];
#pragma unroll
    for (int d0 = 0; d0 < 4; ++d0) qf[d0] = *(const bf16x8*)(T.Q + qrow * 1024 + h * 64 + d0 * 16 + hi * 8);
    __syncthreads();
    f32x16 st[5];
#pragma unroll
    for (int kt = 0; kt < 5; ++kt) {
        f32x16 a = {};
#pragma unroll
        for (int d0 = 0; d0 < 4; ++d0) {
            const bf16x8 kf = *(const LAS bf16x8*)(lds + K_OFF + (32 * w + 32 * kt + l31) * KP + (16 * d0 + 8 * hi) * 2);
            a = MFMA32(kf, qf[d0], a);
        }
        st[kt] = a;
    }
    const LAS float* bl = (const LAS float*)(lds + B_OFF);
    float mx = -1e30f;
#pragma unroll
    for (int kt = 0; kt < 5; ++kt)
#pragma unroll
        for (int rr = 0; rr < 16; ++rr) {
            const int kl = crow(rr, hi);
            const int delta = 128 + l31 - 32 * kt - kl;
            const int pk = 256 * qblk - 128 + 32 * w + 32 * kt + kl;
            const bool valid = (delta >= 0) && (delta <= 128) && (pk >= 0);
            const int dc = delta < 0 ? 0 : (delta > 128 ? 128 : delta);
            const float s = valid ? st[kt][rr] + bl[dc] : -1e30f;
            st[kt][rr] = s; mx = fmaxf(mx, s);
        }
    mx = fmaxf(mx, __shfl_xor(mx, 32));
    float lsum = 0.f;
#pragma unroll
    for (int kt = 0; kt < 5; ++kt)
#pragma unroll
        for (int rr = 0; rr < 16; ++rr) { const float e = __builtin_amdgcn_exp2f(st[kt][rr] - mx); st[kt][rr] = e; lsum += e; }
    lsum += __shfl_xor(lsum, 32);
    f32x16 o[2]; o[0] = (f32x16){}; o[1] = (f32x16){};
    const int i16 = lane & 15, q4 = i16 >> 2, p4 = i16 & 3, gidx = (lane >> 4) & 1;
#pragma unroll
    for (int kt = 0; kt < 5; ++kt)
#pragma unroll
        for (int s2 = 0; s2 < 2; ++s2) {
            const bf16x8 pb = pack8(st[kt][8 * s2 + 0], st[kt][8 * s2 + 1], st[kt][8 * s2 + 2], st[kt][8 * s2 + 3], st[kt][8 * s2 + 4], st[kt][8 * s2 + 5], st[kt][8 * s2 + 6], st[kt][8 * s2 + 7]);
            const int jrow = 32 * w + 32 * kt + 16 * s2 + 4 * hi + q4;
#pragma unroll
            for (int dt = 0; dt < 2; ++dt) {
                const LAS unsigned char* a0 = lds + V_OFF + jrow * KP + (32 * dt + 16 * gidx + 4 * p4) * 2;
                const bf16x8 va = cat8(tr_read(a0), tr_read(a0 + 8 * KP));
                o[dt] = MFMA32(va, pb, o[dt]);
            }
        }
    const float inv = 1.0f / lsum;
    bf16* orow = (p == 0 ? T.Oa : T.Ob + (size_t)(p - 1) * MTOK * AW) + qrow * 1024 + h * 64;
#pragma unroll
    for (int dt = 0; dt < 2; ++dt)
#pragma unroll
        for (int g4 = 0; g4 < 4; ++g4) {
            v2u wv; wv.x = pk2(o[dt][4 * g4] * inv, o[dt][4 * g4 + 1] * inv); wv.y = pk2(o[dt][4 * g4 + 2] * inv, o[dt][4 * g4 + 3] * inv);
            *(v2u*)(orow + 32 * dt + 8 * g4 + 4 * hi) = wv;
        }
    if (hi == 0) { f32x2_t sv = {mx, lsum}; *(f32x2_t*)(T.st + ((size_t)p * MTOK + qrow) * 32 + h * 2) = sv; }
    __syncthreads();
}
DI void phase(LAS unsigned char* lds, const Tensors& T, int G, int blk, int wv) {
    for (int u = blk; u < BATCH * AH * 48; u += G) unit(lds, T, u, wv);
}
}
namespace mpre {
constexpr int TP = 144;
constexpr int XC_OFF = 0, XM_OFF = 256 * TP, QT_OFF = 2 * 256 * TP, RED_OFF = 3 * 256 * TP, GRED_OFF = RED_OFF + 4 * 4096, LDS_BYTES = GRED_OFF + 4 * 64 * 8 * 4;
struct Tensors { const bf16* xm; const bf16* halo; bf16* kimg; bf16* vimg; bf16* qimg; float* gp; bf16* S; const float* convw; const float* convb; const bf16* WcT; const bf16* WmT; const float* G; };

DI void unit(LAS unsigned char* lds, const Tensors& T, int u, int tid_in) {
    const int tid_ = wg_tid_local(tid_in);
    const int tid = tid_, lane = tid & 63, l31 = lane & 31, hi = lane >> 5, w = __builtin_amdgcn_readfirstlane(tid >> 6);
    const int h = u & 3, c = (u >> 2) & 63, b = u >> 8;
    const int g6 = lane, tp = w;
    const size_t tok0 = (size_t)b * SEQ + 64 * c;
    const int ti = w & 1, si = (w >> 1) & 1, kh = w >> 2;
    f32x16 sacc = {};
    f32x16 gacc = {};
    const int kq = w >> 1;
    const int i16 = lane & 15, q4 = i16 >> 2, p4 = i16 & 3, gidx = (lane >> 4) & 1;
#pragma unroll 1
    for (int hh = 0; hh < 2; ++hh) {
        const int gg = 128 * h + 64 * hh + g6, ch = 4 * gg;
        v2u xr[11];
#pragma unroll
        for (int k = 0; k < 11; ++k) {
            const int tl = 8 * tp - 3 + k;
            if (tl >= 0) xr[k] = *(const v2u*)(T.xm + (tok0 + tl) * 2048 + ch);
            else if (c > 0) xr[k] = *(const v2u*)(T.halo + ((size_t)(b * 64 + c - 1) * 3 + (3 + tl)) * 2048 + ch);
            else xr[k] = (v2u){0u, 0u};
        }
        float xmv[11][4];
#pragma unroll
        for (int k = 0; k < 11; ++k) { xmv[k][0] = bflo(xr[k].x); xmv[k][1] = bfhi(xr[k].x); xmv[k][2] = bflo(xr[k].y); xmv[k][3] = bfhi(xr[k].y); }
        float cw[4][4], cb[4], Gm[4][4];
        {
            const f32x4 b4 = *(const f32x4*)(T.convb + ch); cb[0] = b4[0]; cb[1] = b4[1]; cb[2] = b4[2]; cb[3] = b4[3];
#pragma unroll
            for (int tap = 0; tap < 4; ++tap) { const f32x4 w4 = *(const f32x4*)(T.convw + tap * 2048 + ch); cw[tap][0] = w4[0]; cw[tap][1] = w4[1]; cw[tap][2] = w4[2]; cw[tap][3] = w4[3]; }
#pragma unroll
            for (int i = 0; i < 4; ++i) { const f32x4 g4 = *(const f32x4*)(T.G + gg * 16 + i * 4); Gm[i][0] = g4[0]; Gm[i][1] = g4[1]; Gm[i][2] = g4[2]; Gm[i][3] = g4[3]; }
        }
        __syncthreads();
        unsigned xcp[4][4], xmp[4][4], qtp[4][4];
        float prev_xc[4], prev_q[4];
#pragma unroll
        for (int tl = 0; tl < 8; ++tl) {
            float xc[4], qt[4];
#pragma unroll
            for (int i = 0; i < 4; ++i) {
                float a = cb[i];
#pragma unroll
                for (int tap = 0; tap < 4; ++tap) a += cw[tap][i] * xmv[tl + tap][i];
                xc[i] = siluf_(a);
            }
#pragma unroll
            for (int i2 = 0; i2 < 4; ++i2) qt[i2] = xc[0] * Gm[0][i2] + xc[1] * Gm[1][i2] + xc[2] * Gm[2][i2] + xc[3] * Gm[3][i2];
            if (tl & 1) {
#pragma unroll
                for (int i = 0; i < 4; ++i) { xcp[i][tl >> 1] = pk2(prev_xc[i], xc[i]); qtp[i][tl >> 1] = pk2(prev_q[i], qt[i]); xmp[i][tl >> 1] = pk2(xmv[tl + 2][i], xmv[tl + 3][i]); }
            } else {
#pragma unroll
                for (int i = 0; i < 4; ++i) { prev_xc[i] = xc[i]; prev_q[i] = qt[i]; }
            }
        }
#pragma unroll
        for (int i = 0; i < 4; ++i) {
            const int off = (4 * g6 + i) * TP + 16 * tp;
            *(LAS v4u*)(lds + XC_OFF + off) = (v4u){xcp[i][0], xcp[i][1], xcp[i][2], xcp[i][3]};
            *(LAS v4u*)(lds + XM_OFF + off) = (v4u){xmp[i][0], xmp[i][1], xmp[i][2], xmp[i][3]};
            *(LAS v4u*)(lds + QT_OFF + off) = (v4u){qtp[i][0], qtp[i][1], qtp[i][2], qtp[i][3]};
        }
        __syncthreads();
        {
            const size_t ibase = ((size_t)((b * 4 + h) * 64 + c) * 64 + 32 * hh) * 1024;
#pragma unroll
            for (int k = 0; k < 4; ++k) {
                const int id = tid + 512 * k, f = id >> 6, L = id & 63;
                const int row = 32 * (f >> 2) + (L & 31), colb = (16 * (f & 3) + 4 * (L >> 5)) * 2;
                const v2u k0 = *(const LAS v2u*)(lds + XC_OFF + row * TP + colb), k1 = *(const LAS v2u*)(lds + XC_OFF + row * TP + colb + 16);
                const v2u v0 = *(const LAS v2u*)(lds + XM_OFF + row * TP + colb), v1 = *(const LAS v2u*)(lds + XM_OFF + row * TP + colb + 16);
                *(v4u*)((char*)T.kimg + ibase + (size_t)id * 16) = (v4u){k0.x, k0.y, k1.x, k1.y};
                *(v4u*)((char*)T.vimg + ibase + (size_t)id * 16) = (v4u){v0.x, v0.y, v1.x, v1.y};
            }
#pragma unroll
            for (int k = 0; k < 4; ++k) {
                const int f = 4 * w + k, tt = f & 1, cb0 = 16 * (f >> 1) + 4 * hi + q4;
                const LAS unsigned char* pq = lds + QT_OFF + cb0 * TP + (32 * tt + 16 * gidx + 4 * p4) * 2;
                const s16x4 lo = tr_read(pq), hi4 = tr_read(pq + 8 * TP);
                *(bf16x8*)((char*)T.qimg + ibase + (size_t)f * 1024 + lane * 16) = cat8(lo, hi4);
            }
        }
#pragma unroll
        for (int ks = 0; ks < 8; ++ks) {
            const int crow0 = 128 * kh + 16 * ks + 8 * hi + q4;
            const LAS unsigned char* pa = lds + XC_OFF + crow0 * TP + (32 * si + 16 * gidx + 4 * p4) * 2;
            const LAS unsigned char* pb = lds + QT_OFF + crow0 * TP + (32 * ti + 16 * gidx + 4 * p4) * 2;
            const bf16x8 af = cat8(tr_read(pa), tr_read(pa + 4 * TP));
            const bf16x8 bfr = cat8(tr_read(pb), tr_read(pb + 4 * TP));
            sacc = MFMA32(af, bfr, sacc);
        }
#pragma unroll
        for (int ks = 0; ks < 4; ++ks) {
            const int crow1 = 64 * kq + 16 * ks + 8 * hi + q4;
            const LAS unsigned char* pc_ = lds + XC_OFF + crow1 * TP + (32 * ti + 16 * gidx + 4 * p4) * 2;
            const LAS unsigned char* pm_ = lds + XM_OFF + crow1 * TP + (32 * ti + 16 * gidx + 4 * p4) * 2;
            const bf16x8 ac = cat8(tr_read(pc_), tr_read(pc_ + 4 * TP));
            const bf16x8 am = cat8(tr_read(pm_), tr_read(pm_ + 4 * TP));
            const int c0 = 512 * h + 256 * hh + 64 * kq + 16 * ks + 8 * hi;
            const bf16x8 bc = *(const bf16x8*)(T.WcT + (l31 & 7) * 2048 + c0);
            const bf16x8 bm = *(const bf16x8*)(T.WmT + (l31 & 7) * 2048 + c0);
            gacc = MFMA32(ac, bc, gacc);
            gacc = MFMA32(am, bm, gacc);
        }
    }
    if (l31 < 8) {
#pragma unroll
        for (int r = 0; r < 16; ++r) ((LAS float*)(lds + GRED_OFF))[(kq * 64 + 32 * ti + crow(r, hi)) * 8 + l31] = gacc[r];
    }
    __syncthreads();
    if (kh == 1) {
#pragma unroll
        for (int g4 = 0; g4 < 4; ++g4) *(LAS f32x4*)(lds + RED_OFF + ((w & 3) * 4 + g4) * 1024 + lane * 16) = (f32x4){sacc[4 * g4], sacc[4 * g4 + 1], sacc[4 * g4 + 2], sacc[4 * g4 + 3]};
    }
    __syncthreads();
    { const LAS float* gr = (const LAS float*)(lds + GRED_OFF);
      T.gp[((size_t)h * MTOK + tok0) * 8 + tid] = gr[tid] + gr[512 + tid] + gr[1024 + tid] + gr[1536 + tid]; }
    if (kh == 0) {
        float tot[16];
#pragma unroll
        for (int g4 = 0; g4 < 4; ++g4) {
            const f32x4 o = *(const LAS f32x4*)(lds + RED_OFF + ((w & 3) * 4 + g4) * 1024 + lane * 16);
            tot[4 * g4] = sacc[4 * g4] + o[0]; tot[4 * g4 + 1] = sacc[4 * g4 + 1] + o[1]; tot[4 * g4 + 2] = sacc[4 * g4 + 2] + o[2]; tot[4 * g4 + 3] = sacc[4 * g4 + 3] + o[3];
        }
        char* sp = (char*)T.S + (size_t)((b * 4 + h) * 64 + c) * 8192;
#pragma unroll
        for (int kk = 0; kk < 2; ++kk)
            *(bf16x8*)(sp + ((2 * si + kk) * 2 + ti) * 1024 + lane * 16) = pack8(tot[8 * kk], tot[8 * kk + 1], tot[8 * kk + 2], tot[8 * kk + 3], tot[8 * kk + 4], tot[8 * kk + 5], tot[8 * kk + 6], tot[8 * kk + 7]);
    }
    __syncthreads();
}
DI void phase(LAS unsigned char* lds, const Tensors& T, int G, int blk, int wv) {
    for (int u = blk; u < BATCH * NCHUNK * MH; u += G) unit(lds, T, u, wv);
}
}
namespace mscan {
constexpr int P_OFF = 0;
constexpr int DEN_OFF = 131072;
constexpr int NS_OFF = DEN_OFF + 2048;
constexpr int TMP_OFF = NS_OFF + 4096, SCW_OFF = TMP_OFF + 128, LDS_BYTES = SCW_OFF + 8 * 512;
static_assert(LDS_BYTES <= 163840, "scan LDS");
struct Tensors { const bf16* q; const bf16* k; const bf16* v; const bf16* S; const float* gp; const float* bif; float* scal; bf16* hm; };

DI float logsigmoid_(float x) { return fminf(x, 0.f) - log1pf(__expf(-fabsf(x))); }
DI void unpack8(bf16x8 f, float (&o)[8]) {
    const v4u u = __builtin_bit_cast(v4u, f);
    o[0] = bflo(u.x); o[1] = bfhi(u.x); o[2] = bflo(u.y); o[3] = bfhi(u.y); o[4] = bflo(u.z); o[5] = bfhi(u.z); o[6] = bflo(u.w); o[7] = bfhi(u.w);
}

DI void unit(LAS unsigned char* lds, const Tensors& T, int bh, int es, int tid_in) {
    const int tid_ = wg_tid_local(tid_in);
    const int tid = tid_, lane = tid & 63, l31 = lane & 31, hi = lane >> 5, wid = __builtin_amdgcn_readfirstlane(tid >> 6);
    const int eg = wid & 1, dq = wid >> 1;
    const int b = bh >> 2, h = bh & 3;
    LAS float* sTmp = (LAS float*)(lds + TMP_OFF);
    float* scal = T.scal + (size_t)bh * 3 * SEQ;
    {
        float li[8], cs[8];
        const float bi = T.bif[h], bf_ = T.bif[4 + h];
        float run = 0.f;
        const float* gpb = T.gp + (size_t)b * SEQ * 8 + h;
        const unsigned toff = (unsigned)tid * 64u;
#pragma unroll
        for (int k = 0; k < 8; ++k) { li[k] = bi; cs[k] = bf_; }
#pragma unroll
        for (int hh = 0; hh < 4; ++hh) {
            const float* p = gpb + (size_t)hh * MTOK * 8;
#pragma unroll
            for (int k = 0; k < 8; ++k) { li[k] += p[toff + k * 8]; cs[k] += p[toff + k * 8 + 4]; }
        }
#pragma unroll
        for (int k = 0; k < 8; ++k) { run += logsigmoid_(cs[k]); cs[k] = run; }
        float inc = run;
#pragma unroll
        for (int o = 1; o < 64; o <<= 1) { const float t = bperm(inc, lane >= o ? lane - o : lane); if (lane >= o) inc += t; }
        if (lane == 63) sTmp[wid] = inc;
        __syncthreads();
        float base = inc - run;
        for (int w2 = 0; w2 < wid; ++w2) base += sTmp[w2];
        __syncthreads();
        float av[8], mloc = -3.0e38f, cm[8];
#pragma unroll
        for (int k = 0; k < 8; ++k) { cs[k] += base; av[k] = li[k] - cs[k]; mloc = fmaxf(mloc, av[k]); cm[k] = mloc; }
        float minc = mloc;
#pragma unroll
        for (int o = 1; o < 64; o <<= 1) { const float t = bperm(minc, lane >= o ? lane - o : lane); if (lane >= o) minc = fmaxf(minc, t); }
        if (lane == 63) sTmp[wid] = minc;
        __syncthreads();
        float mbase = bperm(minc, lane > 0 ? lane - 1 : 0); if (lane == 0) mbase = -3.0e38f;
        for (int w2 = 0; w2 < wid; ++w2) mbase = fmaxf(mbase, sTmp[w2]);
#pragma unroll
        for (int k = 0; k < 8; ++k) {
            const float Mt = fmaxf(mbase, cm[k]);
            scal[0 * SEQ + 8 * tid + k] = av[k]; scal[1 * SEQ + 8 * tid + k] = Mt; scal[2 * SEQ + 8 * tid + k] = __expf(-(cs[k] + Mt));
        }
        ((LAS float*)(lds + NS_OFF))[tid] = 0.f; ((LAS float*)(lds + NS_OFF))[512 + tid] = 0.f;
        __threadfence();
        __syncthreads();
    }
    f32x16 cst[4];
#pragma unroll
    for (int i = 0; i < 4; ++i) cst[i] = (f32x16){};
    const char* qb = (const char*)T.q + (size_t)bh * NCHUNK * 65536 + (size_t)dq * 16384;
    const char* kb = (const char*)T.k + (size_t)bh * NCHUNK * 65536 + (size_t)dq * 16384;
    const char* vb = (const char*)T.v + (size_t)bh * NCHUNK * 65536 + (size_t)(es * 2 + eg) * 4096;
    const char* sb = (const char*)T.S + (size_t)bh * NCHUNK * 8192 + (size_t)dq * 2048;
    const unsigned loff = (unsigned)lane * 16u;
    const float* sa = scal; const float* sm = scal + SEQ; const float* sthr = scal + 2 * SEQ;
    bf16* hg = T.hm + (size_t)b * SEQ * 2048 + 512 * h + 64 * es;
    int zv = 0; asm volatile("" : "+v"(zv));
    float Mc = sm[zv];
    LAS float* sca = (LAS float*)(lds + SCW_OFF) + wid * 128;
    bf16x8 fb[16]; bf16x8 sf[2]; bf16x8 vfr[4];
    float a_l, m_l, thr_l;
#pragma unroll
    for (int f = 0; f < 16; ++f) fb[f] = *(const bf16x8*)(qb + f * 1024 + loff);
    sf[0] = *(const bf16x8*)(sb + loff); sf[1] = *(const bf16x8*)(sb + 1024 + loff);
#pragma unroll
    for (int ks = 0; ks < 4; ++ks) vfr[ks] = *(const bf16x8*)(vb + ks * 1024 + loff);
    a_l = sa[lane]; m_l = sm[lane]; thr_l = sthr[lane];
#pragma unroll 1
    for (int c = 0; c < NCHUNK; ++c) {
        const int cur = c & 1;
        LAS float* nsc = (LAS float*)(lds + NS_OFF) + cur * 512; LAS float* nsn = (LAS float*)(lds + NS_OFF) + (cur ^ 1) * 512;
        LAS float* denp = (LAS float*)(lds + DEN_OFF) + cur * 256;
        LAS unsigned char* pbuf = lds + P_OFF + cur * 65536;
        const char* kc = kb + (size_t)c * 65536;
        const int cn = (c + 1 < NCHUNK) ? c + 1 : c;
        const char* qn_ = qb + (size_t)cn * 65536; const char* sn_ = sb + (size_t)cn * 8192; const char* vn_ = vb + (size_t)cn * 65536;
        const float Mc2 = bperm(m_l, 63 + zv);
        const float Mt0 = bperm(m_l, l31), Mt1 = bperm(m_l, 32 + l31);
        const float thr0 = bperm(thr_l, l31), thr1 = bperm(thr_l, 32 + l31);
        sca[lane] = a_l; sca[64 + lane] = __expf(a_l - Mc2);
        a_l = sa[64 * cn + lane]; m_l = sm[64 * cn + lane]; thr_l = sthr[64 * cn + lane];
        bf16x8 pf[2]; float psum_own = 0.f;
        {
            const f32x4 aown0 = *(const LAS f32x4*)(sca + 16 * dq + 4 * hi), aown1 = *(const LAS f32x4*)(sca + 16 * dq + 8 + 4 * hi);
            const float aw[8] = {aown0[0], aown0[1], aown0[2], aown0[3], aown1[0], aown1[1], aown1[2], aown1[3]};
#pragma unroll
            for (int tt = 0; tt < 2; ++tt) {
                const int t = 32 * tt + l31; const float Mt = tt ? Mt1 : Mt0;
                float sv[8]; unpack8(sf[tt], sv);
                float pw[8]; float ps = 0.f;
#pragma unroll
                for (int j = 0; j < 8; ++j) { const int s = 16 * dq + 8 * (j >> 2) + 4 * hi + (j & 3); pw[j] = (s <= t) ? sv[j] * __expf(aw[j] - Mt) : 0.f; ps += pw[j]; }
                pf[tt] = pack8(pw[0], pw[1], pw[2], pw[3], pw[4], pw[5], pw[6], pw[7]);
                if (tt == eg) psum_own = ps;
            }
            sf[0] = *(const bf16x8*)(sn_ + loff); sf[1] = *(const bf16x8*)(sn_ + 1024 + loff);
        }
        f32x16 ao[2]; ao[0] = (f32x16){}; ao[1] = (f32x16){};
        float qn = 0.f;
#pragma unroll
        for (int i = 0; i < 4; ++i)
#pragma unroll
            for (int s = 0; s < 2; ++s) {
                const int g0 = (i * 2 + s) * 2;
                const bf16x8 cb = pack8(cst[i][8 * s + 0], cst[i][8 * s + 1], cst[i][8 * s + 2], cst[i][8 * s + 3], cst[i][8 * s + 4], cst[i][8 * s + 5], cst[i][8 * s + 6], cst[i][8 * s + 7]);
                ao[0] = MFMA32(cb, fb[g0], ao[0]);
                ao[1] = MFMA32(cb, fb[g0 + 1], ao[1]);
                {
                    float qv[8]; unpack8(eg ? fb[g0 + 1] : fb[g0], qv);
                    const f32x4 n0 = *(const LAS f32x4*)(nsc + 128 * dq + 32 * i + 16 * s + 4 * hi), n1 = *(const LAS f32x4*)(nsc + 128 * dq + 32 * i + 16 * s + 8 + 4 * hi);
                    qn += qv[0] * n0[0] + qv[1] * n0[1] + qv[2] * n0[2] + qv[3] * n0[3] + qv[4] * n1[0] + qv[5] * n1[1] + qv[6] * n1[2] + qv[7] * n1[3];
                }
                fb[g0] = *(const bf16x8*)(kc + (((g0) & 3) * 4 + ((g0) >> 2)) * 1024 + loff);
                fb[g0 + 1] = *(const bf16x8*)(kc + (((g0 + 1) & 3) * 4 + ((g0 + 1) >> 2)) * 1024 + loff);
                __builtin_amdgcn_sched_barrier(0);
            }
        {
            const float Mt = eg ? Mt1 : Mt0;
            float d = __expf(Mc - Mt) * qn + psum_own;
            d += bperm(d, lane ^ 32);
            if (hi == 0) denp[dq * 64 + 32 * eg + l31] = d;
            const float rs0 = __expf(Mc - Mt0), rs1 = __expf(Mc - Mt1);
#pragma unroll
            for (int r = 0; r < 16; ++r) { ao[0][r] *= rs0; ao[1][r] *= rs1; }
        }
        ao[0] = MFMA32(dq == 0 ? vfr[0] : dq == 1 ? vfr[1] : dq == 2 ? vfr[2] : vfr[3], pf[0], ao[0]);
        ao[1] = MFMA32(dq == 0 ? vfr[0] : dq == 1 ? vfr[1] : dq == 2 ? vfr[2] : vfr[3], pf[1], ao[1]);
#pragma unroll
        for (int g = 0; g < 4; ++g)
#pragma unroll
            for (int tt = 0; tt < 2; ++tt)
                *(LAS f32x4*)(pbuf + ((((dq * 2 + eg) * 4 + g) * 2 + tt) * 1024) + lane * 16) = (f32x4){ao[tt][4 * g], ao[tt][4 * g + 1], ao[tt][4 * g + 2], ao[tt][4 * g + 3]};
        const float decay = __expf(Mc - Mc2);
#pragma unroll
        for (int i = 0; i < 4; ++i)
#pragma unroll
            for (int r = 0; r < 16; ++r) cst[i][r] *= decay;
        float nacc[2] = {0.f, 0.f};
#pragma unroll
        for (int ks = 0; ks < 4; ++ks) {
            const f32x4 c0 = *(const LAS f32x4*)(sca + 64 + 16 * ks + 4 * hi), c1 = *(const LAS f32x4*)(sca + 64 + 16 * ks + 8 + 4 * hi);
            const float cw[8] = {c0[0], c0[1], c0[2], c0[3], c1[0], c1[1], c1[2], c1[3]};
            float vv[8]; unpack8(vfr[ks], vv);
            const bf16x8 vw = pack8(vv[0] * cw[0], vv[1] * cw[1], vv[2] * cw[2], vv[3] * cw[3], vv[4] * cw[4], vv[5] * cw[5], vv[6] * cw[6], vv[7] * cw[7]);
            vfr[ks] = *(const bf16x8*)(vn_ + ks * 1024 + loff);
#pragma unroll
            for (int i = 0; i < 4; ++i) {
                const int g = ks * 4 + i;
                cst[i] = MFMA32(fb[g], vw, cst[i]);
                if ((i >> 1) == eg) {
                    float kv[8]; unpack8(fb[g], kv);
                    nacc[i & 1] += kv[0] * cw[0] + kv[1] * cw[1] + kv[2] * cw[2] + kv[3] * cw[3] + kv[4] * cw[4] + kv[5] * cw[5] + kv[6] * cw[6] + kv[7] * cw[7];
                }
                fb[g] = *(const bf16x8*)(qn_ + g * 1024 + loff);
                __builtin_amdgcn_sched_barrier(0);
            }
        }
#pragma unroll
        for (int ii = 0; ii < 2; ++ii) {
            float v = nacc[ii]; v += bperm(v, lane ^ 32);
            const int dk = 128 * dq + 32 * (2 * eg + ii) + l31;
            if (hi == 0) nsn[dk] = decay * nsc[dk] + v;
        }
        __syncthreads();
#pragma unroll
        for (int tt = 0; tt < 2; ++tt) {
            f32x4 nm = {0.f, 0.f, 0.f, 0.f};
#pragma unroll
            for (int src = 0; src < 4; ++src) nm += *(const LAS f32x4*)(pbuf + ((((src * 2 + eg) * 4 + dq) * 2 + tt) * 1024) + lane * 16);
            const int t = 32 * tt + l31;
            const float den = denp[t] + denp[64 + t] + denp[128 + t] + denp[192 + t];
            const float dn = fmaxf(fabsf(den), tt ? thr1 : thr0);
            const float inv = 1.0f / dn;
            v2u wv; wv.x = pk2(nm[0] * inv, nm[1] * inv); wv.y = pk2(nm[2] * inv, nm[3] * inv);
            *(v2u*)(hg + (size_t)(64 * c + t) * 2048 + 32 * eg + 8 * dq + 4 * hi) = wv;
        }
        Mc = Mc2;
    }
    __syncthreads();
}
DI void phase(LAS unsigned char* lds, const Tensors& T, int G, int blk, int wv) {
#pragma unroll 1
    for (int u = blk; u < 256; u += G) {
        const int xcd = u & 7, j = u >> 3;
        unit(lds, T, xcd * 4 + (j >> 3), j & 7, wv);
    }
}
}
namespace mpost {
constexpr int GSTR = 576;
constexpr int XC_OFF = 0, WV_OFF = 128 * GSTR, LDS_BYTES = WV_OFF + 128 * 64;
struct Tensors { bf16* hm; const bf16* om; const bf16* kimg; const float* wv; const float* hng; const float* skip; };

DI void unit(LAS unsigned char* lds, const Tensors& T, int u, int tid_in) {
    const int tid_ = wg_tid_local(tid_in);
    const int tid = tid_;
    const int h = u & 3, c = (u >> 2) & 63, b = u >> 8;
#pragma unroll
    for (int k = 0; k < 2; ++k) {
        const int id = tid + 512 * k, pb = id & 7, g = id >> 3, ks = pb >> 1, hi_ = pb & 1;
        const char* src = (const char*)T.kimg + ((size_t)((b * 4 + h) * 64 + c) * 64 + (g >> 3) * 4 + ks) * 1024 + (4 * (g & 7) + 32 * hi_) * 16;
        const v4u r0 = *(const v4u*)(src), r1 = *(const v4u*)(src + 16), r2 = *(const v4u*)(src + 32), r3 = *(const v4u*)(src + 48);
        const unsigned a0[4] = {r0.x, r0.y, r0.z, r0.w}, a1[4] = {r1.x, r1.y, r1.z, r1.w}, a2[4] = {r2.x, r2.y, r2.z, r2.w}, a3[4] = {r3.x, r3.y, r3.z, r3.w};
#pragma unroll
        for (int m = 0; m < 4; ++m) {
            const int tok = 16 * ks + 8 * (m >> 1) + 4 * hi_ + 2 * (m & 1);
            v2u e0, e1;
            e0.x = (a0[m] & 0xffffu) | (a1[m] << 16); e0.y = (a2[m] & 0xffffu) | (a3[m] << 16);
            e1.x = (a0[m] >> 16) | (a1[m] & 0xffff0000u); e1.y = (a2[m] >> 16) | (a3[m] & 0xffff0000u);
            *(LAS v2u*)(lds + XC_OFF + g * GSTR + tok * 8) = e0;
            *(LAS v2u*)(lds + XC_OFF + g * GSTR + (tok + 1) * 8) = e1;
        }
    }
    *(LAS f32x4*)(lds + WV_OFF + tid * 16) = *(const f32x4*)(T.wv + (size_t)(128 * h) * 16 + tid * 4);
    __syncthreads();
    const int t5 = tid >> 4, seg = tid & 15;
#pragma unroll 1
    for (int pass = 0; pass < 2; ++pass) {
        const int t = t5 + 32 * pass;
        const size_t rowu = ((size_t)b * SEQ + 64 * c + 32 * pass) * 2048 + 512 * h;
        char* hmb = (char*)(T.hm + rowu); const char* omb = (const char*)(T.om + rowu);
        const char* gnb = (const char*)(T.hng + 512 * h); const char* skb = (const char*)(T.skip + 512 * h);
        const unsigned voff = (unsigned)(t5 * 4096 + seg * 8), soff = (unsigned)(seg * 16);
        float uv[32];
        float sum = 0.f;
#pragma unroll
        for (int k = 0; k < 8; ++k) {
            const int gi = seg + 16 * k;
            const v2u hx = *(const v2u*)(hmb + voff + k * 128);
            const v2u og = *(const v2u*)(omb + voff + k * 128);
            const float hv[4] = {bflo(hx.x), bfhi(hx.x), bflo(hx.y), bfhi(hx.y)};
            const float ov[4] = {bflo(og.x), bfhi(og.x), bflo(og.y), bfhi(og.y)};
            const LAS f32x4* wp = (const LAS f32x4*)(lds + WV_OFF + gi * 64);
            const f32x4 w0 = wp[0], w1 = wp[1], w2 = wp[2], w3 = wp[3];
#pragma unroll
            for (int o = 0; o < 4; ++o) {
                const float v = hv[0] * w0[o] + hv[1] * w1[o] + hv[2] * w2[o] + hv[3] * w3[o];
                const float x = v * ov[o];
                uv[4 * k + o] = x; sum += x;
            }
            if (k & 1) __builtin_amdgcn_sched_barrier(0);
        }
        sum += __shfl_xor(sum, 1); sum += __shfl_xor(sum, 2); sum += __shfl_xor(sum, 4); sum += __shfl_xor(sum, 8);
        const float mean = sum * (1.0f / 512.0f);
        float sq = 0.f;
#pragma unroll
        for (int i = 0; i < 32; ++i) { const float d = uv[i] - mean; sq += d * d; }
        sq += __shfl_xor(sq, 1); sq += __shfl_xor(sq, 2); sq += __shfl_xor(sq, 4); sq += __shfl_xor(sq, 8);
        const float rstd = 1.0f / sqrtf(sq * (1.0f / 512.0f) + EPS);
#pragma unroll
        for (int k = 0; k < 8; ++k) {
            const int gi = seg + 16 * k;
            const f32x4 gn = *(const f32x4*)(gnb + soff + k * 256), sk = *(const f32x4*)(skb + soff + k * 256);
            const v2u xc = *(const LAS v2u*)(lds + XC_OFF + gi * GSTR + t * 8);
            const float xv[4] = {bflo(xc.x), bfhi(xc.x), bflo(xc.y), bfhi(xc.y)};
            float r[4];
#pragma unroll
            for (int o = 0; o < 4; ++o) r[o] = (uv[4 * k + o] - mean) * rstd * gn[o] + sk[o] * xv[o];
            v2u wv; wv.x = pk2(r[0], r[1]); wv.y = pk2(r[2], r[3]);
            *(v2u*)(hmb + voff + k * 128) = wv;
        }
    }
    __syncthreads();
}
DI void phase(LAS unsigned char* lds, const Tensors& T, int G, int blk, int wv) {
    for (int u = blk; u < BATCH * NCHUNK * MH; u += G) unit(lds, T, u, wv);
}
}

DI void transpose_item(const float* W, int K, int N, bf16* WT, const float* kscale, LAS float* scr, int item, int lane) {
    const int nblk = N / 32, kb = item / nblk, nb = item % nblk, k0 = 64 * kb, n0 = 32 * nb;
#pragma unroll 8
    for (int i = 0; i < 32; ++i) { const int kk = 2 * i + (lane >> 5); float v = W[(size_t)(k0 + kk) * N + n0 + (lane & 31)]; if (kscale) v *= kscale[k0 + kk]; scr[kk * 33 + (lane & 31)] = v; }
    asm volatile("s_waitcnt lgkmcnt(0)" ::: "memory");
    const int cc = lane & 7;
#pragma unroll
    for (int j = 0; j < 4; ++j) { const int n = (lane >> 3) + 8 * j; const LAS float* s = scr + (8 * cc) * 33 + n;
        v4u o; o.x = pk2(s[0 * 33], s[1 * 33]); o.y = pk2(s[2 * 33], s[3 * 33]); o.z = pk2(s[4 * 33], s[5 * 33]); o.w = pk2(s[6 * 33], s[7 * 33]);
        *(v4u*)(WT + (size_t)(n0 + n) * K + k0 + 8 * cc) = o; }
    asm volatile("s_waitcnt lgkmcnt(0)" ::: "memory");
}
DI void rms_row_to_bf16(const float* xrow, bf16* orow, int lane) {
    const f32x4* xr = (const f32x4*)xrow + lane;
    f32x4 v[4]; float s = 0.f;
#pragma unroll
    for (int j = 0; j < 4; ++j) { v[j] = xr[64 * j]; s += (v[j][0] * v[j][0] + v[j][1] * v[j][1]) + (v[j][2] * v[j][2] + v[j][3] * v[j][3]); }
    const float r = 1.0f / sqrtf(wave_sum(s) * (1.0f / 1024.0f) + EPS);
    v2u* o8 = (v2u*)orow + lane;
#pragma unroll
    for (int j = 0; j < 4; ++j) { v2u w; w.x = pk2(v[j][0] * r, v[j][1] * r); w.y = pk2(v[j][2] * r, v[j][3] * r); o8[64 * j] = w; }
}
DI void rms_row_inplace(float* row, const float* g, int lane) {
    f32x4* xr = (f32x4*)row + lane; const f32x4* gr = (const f32x4*)g + lane;
    f32x4 v[4]; float s = 0.f;
#pragma unroll
    for (int j = 0; j < 4; ++j) { v[j] = xr[64 * j]; s += (v[j][0] * v[j][0] + v[j][1] * v[j][1]) + (v[j][2] * v[j][2] + v[j][3] * v[j][3]); }
    const float r = 1.0f / sqrtf(wave_sum(s) * (1.0f / 1024.0f) + EPS);
#pragma unroll
    for (int j = 0; j < 4; ++j) xr[64 * j] = v[j] * r * gr[64 * j];
}
constexpr int N_PHASES = 15;
constexpr int LDS_TOTAL = 163840;
static_assert(pg8::STAGE_BYTES <= LDS_TOTAL && att::LDS_BYTES <= LDS_TOTAL && mpre::LDS_BYTES <= LDS_TOTAL && mscan::LDS_BYTES <= LDS_TOTAL && mpost::LDS_BYTES <= LDS_TOTAL, "LDS map");

struct Args { const float* in[18]; float* out; unsigned char* ws; int ph_lo, ph_hi; };

DI void prologue(const Args& a, LAS unsigned char* lds, int G, int blk, int wvi) {
    const int tid = wg_tid(wvi), lane = tid & 63, wave = __builtin_amdgcn_readfirstlane(tid >> 6);
    unsigned char* ws = a.ws;
    LAS float* scr = (LAS float*)(lds + wave * 16384);
    const int gw = blk * NWAVES + wave, NGW = G * NWAVES;
    constexpr int I_IN = (DM / 64) * (NIN / 32), I_PA = (AW / 64) * (DM / 32), I_PB = (MW / 64) * (DM / 32), I_OUT = (DM / 64) * (DM / 32);
    constexpr int NITEMS = I_IN + I_PA + I_PB + I_OUT;
    for (int it = gw; it < NITEMS; it += NGW) {
        int r = it;
        if (r < I_IN) { transpose_item(a.in[2], DM, NIN, (bf16*)(ws + WS_WIN), a.in[1], scr, r, lane); continue; } r -= I_IN;
        if (r < I_PA) { transpose_item(a.in[13], AW, DM, (bf16*)(ws + WS_WPA), nullptr, scr, r, lane); continue; } r -= I_PA;
        if (r < I_PB) { transpose_item(a.in[14], MW, DM, (bf16*)(ws + WS_WPB), nullptr, scr, r, lane); continue; } r -= I_PB;
        transpose_item(a.in[15], DM, DM, (bf16*)(ws + WS_WOUT), nullptr, scr, r, lane);
    }
    for (int m = gw; m < MTOK; m += NGW) rms_row_to_bf16(a.in[0] + (size_t)m * DM, (bf16*)(ws + WS_XN) + (size_t)m * DM, lane);
    float* tab = (float*)(ws + WS_TAB);
    const float* wq = a.in[6]; const float* wk = a.in[7]; const float* wv = a.in[8]; const float* wif = a.in[9]; const float* rb = a.in[16];
    const int gt = blk * NTHR + tid, NGT = G * NTHR;
    for (int i = gt; i < 2048 * 8; i += NGT) {
        const int c = i >> 3, j = i & 7, g = c >> 2, ii = c & 3;
        float sc = 0.f, sm = 0.f;
#pragma unroll
        for (int o = 0; o < 4; ++o) {
            sc += wq[g * 16 + ii * 4 + o] * wif[(size_t)(4 * g + o) * 8 + j] + wk[g * 16 + ii * 4 + o] * wif[(size_t)(2048 + 4 * g + o) * 8 + j];
            sm += wv[g * 16 + ii * 4 + o] * wif[(size_t)(4096 + 4 * g + o) * 8 + j];
        }
        ((bf16*)(tab + TAB_WC))[j * 2048 + c] = (bf16)(pk2(sc, 0.f) & 0xffffu); ((bf16*)(tab + TAB_WM))[j * 2048 + c] = (bf16)(pk2(sm, 0.f) & 0xffffu);
    }
    for (int i = gt; i < 512 * 16; i += NGT) {
        const int g = i >> 4, ii = (i >> 2) & 3, i2 = i & 3;
        float s = 0.f;
#pragma unroll
        for (int o = 0; o < 4; ++o) s += wq[g * 16 + ii * 4 + o] * wk[g * 16 + i2 * 4 + o];
        tab[TAB_G + i] = s * 0.04419417382415922f;
    }
    for (int i = gt; i < 3 * 16 * 132; i += NGT) {
        const int d = i % 132, ph = i / 132, p = ph >> 4, hh = ph & 15;
        tab[TAB_BIAS + i] = rb[BUCKET[p][d] * 16 + hh] * LOG2E;
    }
}

DI void grid_sync_(int tid) {
    asm volatile("s_waitcnt vmcnt(0) lgkmcnt(0)" ::: "memory");
    __builtin_amdgcn_fence(__ATOMIC_RELEASE, "workgroup");
    __builtin_amdgcn_s_barrier();
    if (tid == 0) {
        __builtin_amdgcn_fence(__ATOMIC_ACQUIRE, "workgroup");
        __builtin_amdgcn_fence(__ATOMIC_RELEASE, "agent");
        const __attribute__((address_space(4))) char* ia = (const __attribute__((address_space(4))) char*)__builtin_amdgcn_implicitarg_ptr();
        const unsigned long long p = *(const __attribute__((address_space(4))) unsigned long long*)(ia + 88);
        unsigned* bar = (unsigned*)(p + 32);
        const unsigned nwg = *(const unsigned*)(p + 40);
        const unsigned old = __hip_atomic_fetch_add(bar, 1u, __ATOMIC_RELAXED, __HIP_MEMORY_SCOPE_AGENT);
        if ((old & 0xffffu) == nwg - 1u) (void)__hip_atomic_fetch_add(bar, 65536u - nwg, __ATOMIC_RELAXED, __HIP_MEMORY_SCOPE_AGENT);
        const unsigned gen = old & 0xffff0000u;
        while ((__hip_atomic_load(bar, __ATOMIC_RELAXED, __HIP_MEMORY_SCOPE_AGENT) & 0xffff0000u) == gen) __builtin_amdgcn_s_sleep(1);
        __builtin_amdgcn_fence(__ATOMIC_ACQUIRE, "agent");
        __builtin_amdgcn_fence(__ATOMIC_RELEASE, "workgroup");
    }
    __builtin_amdgcn_s_barrier();
    __builtin_amdgcn_fence(__ATOMIC_ACQUIRE, "workgroup");
}

__global__ void __launch_bounds__(NTHR) mk_fwd(Args a) {
    extern __shared__ __attribute__((aligned(16))) unsigned char lds_raw[];
    LAS unsigned char* lds = (LAS unsigned char*)lds_raw;
    const int G = gridDim.x, blk = blockIdx.x;
    const int wv = __builtin_amdgcn_readfirstlane(threadIdx.x >> 6);
    unsigned char* ws = a.ws;
    const int lo = a.ph_lo, hi = a.ph_hi;
    bf16* XN = (bf16*)(ws + WS_XN); bf16* WIN = (bf16*)(ws + WS_WIN);
#ifndef PH_MASK
#define PH_MASK 0x7fff
#endif
#define IN(k) (((PH_MASK >> (k)) & 1) && lo <= (k) && (k) < hi)
#ifndef REP_MASK
#define REP_MASK 0
#endif
#define REPEAT(k, body) do { body; if ((REP_MASK >> (k)) & 1) { grid_sync_(wg_tid(wv)); body; } } while (0)
#define SEAM(k) do { if (IN(k) && IN((k) + 1)) grid_sync_(wg_tid(wv)); } while (0)
#define GEMM_PHASE(EPI, E, Aop, Bop, NN, KK) do { pg8::Gemm g{(const pg8::bf16_t*)(Aop), (const pg8::bf16_t*)(Bop), MTOK, (NN), (KK)}; pg8::StaticOrder S; S.init(MTOK, (NN), G, blk); \
        pg8::gemm_phase<EPI, pg8::StaticOrder, true, true>(lds, g, S, E, wg_tid(wv)); } while (0)

    if (IN(0)) { REPEAT(0, prologue(a, lds, G, blk, wv)); } SEAM(0);
    if (IN(1)) {
        pg8::EpiXM E{(bf16*)(ws + WS_R0), (bf16*)(ws + WS_HALO)};
        REPEAT(1, GEMM_PHASE(pg8::EpiXM, E, XN, WIN + (size_t)C_XM * DM, MW, DM));
    } SEAM(1);
    if (IN(2)) {
        const float* tab = (const float*)(ws + WS_TAB);
        mpre::Tensors T{(const bf16*)(ws + WS_R0), (const bf16*)(ws + WS_HALO), (bf16*)(ws + WS_R1), (bf16*)a.out, (bf16*)(ws + WS_R2), (float*)(ws + WS_GP), (bf16*)(ws + WS_S), a.in[4], a.in[5], (const bf16*)(tab + TAB_WC), (const bf16*)(tab + TAB_WM), tab + TAB_G};
        mpre::phase(lds, T, G, blk, wv);
    } SEAM(2);
    if (IN(3)) {
        mscan::Tensors T{(const bf16*)(ws + WS_R2), (const bf16*)(ws + WS_R1), (const bf16*)a.out, (const bf16*)(ws + WS_S), (const float*)(ws + WS_GP), a.in[10], (float*)(ws + WS_SCAL), (bf16*)(ws + WS_R0)};
        REPEAT(3, mscan::phase(lds, T, G, blk, wv));
    } SEAM(3);
    if (IN(4)) {
        pg8::EpiSig E{(bf16*)(ws + WS_R2), MW, nullptr};
        REPEAT(4, GEMM_PHASE(pg8::EpiSig, E, XN, WIN + (size_t)C_OM * DM, MW, DM));
    } SEAM(4);
    if (IN(5)) {
        mpost::Tensors T{(bf16*)(ws + WS_R0), (const bf16*)(ws + WS_R2), (const bf16*)(ws + WS_R1), a.in[8], a.in[11], a.in[12]};
        mpost::phase(lds, T, G, blk, wv);
    } SEAM(5);
    if (IN(6)) {
        pg8::EpiZM E{(bf16*)(ws + WS_R0)};
        GEMM_PHASE(pg8::EpiZM, E, XN, WIN + (size_t)C_ZM * DM, MW, DM);
    } SEAM(6);
    if (IN(7)) {
        pg8::EpiQKV E{(bf16*)(ws + WS_QA), (size_t)(WS_KA - WS_QA) / 2};
        REPEAT(7, GEMM_PHASE(pg8::EpiQKV, E, XN, WIN + (size_t)C_QA * DM, 3 * AW, DM));
    } SEAM(7);
    if (IN(8)) {
        att::Tensors T{(const bf16*)(ws + WS_QA), (const bf16*)(ws + WS_KA), (const bf16*)(ws + WS_VA), (bf16*)(ws + WS_O1), (bf16*)a.out, (float*)(ws + WS_ST), (const float*)(ws + WS_TAB) + TAB_BIAS};
        REPEAT(8, att::phase(lds, T, G, blk, wv));
    } SEAM(8);
    if (IN(9)) {
        pg8::EpiZA E{(const bf16*)(ws + WS_O1), (const bf16*)a.out, (const bf16*)a.out + (size_t)MTOK * AW, (const float*)(ws + WS_ST), (bf16*)(ws + WS_A1)};
        REPEAT(9, GEMM_PHASE(pg8::EpiZA, E, XN, WIN + (size_t)C_ZA * DM, AW, DM));
    } SEAM(9);
    if (IN(10)) {
        pg8::EpiSig E{(bf16*)(ws + WS_G), 2 * DM, a.in[3]};
        REPEAT(10, GEMM_PHASE(pg8::EpiSig, E, XN, WIN + (size_t)C_G * DM, 2 * DM, DM));
    } SEAM(10);
    if (IN(11)) {
        pg8::EpiYA E{(bf16*)(ws + WS_G)};
        GEMM_PHASE(pg8::EpiYA, E, ws + WS_A1, ws + WS_WPA, DM, AW);
    } SEAM(11);
    if (IN(12)) {
        pg8::EpiYM E{(const bf16*)(ws + WS_G), (bf16*)(ws + WS_MRG)};
        REPEAT(12, GEMM_PHASE(pg8::EpiYM, E, ws + WS_R0, ws + WS_WPB, DM, MW));
    } SEAM(12);
    if (IN(13)) {
        pg8::EpiOut E{a.in[0], a.out};
        REPEAT(13, GEMM_PHASE(pg8::EpiOut, E, ws + WS_MRG, ws + WS_WOUT, DM, DM));
    } SEAM(13);
    if (IN(14)) {
        const int lane = wg_tid(wv) & 63, wave = wv;
        for (int m = blk * NWAVES + wave; m < MTOK; m += G * NWAVES) rms_row_inplace(a.out + (size_t)m * DM, a.in[17], lane);
    }
#undef IN
#undef SEAM
#undef GEMM_PHASE
}

#ifndef MK_ONE_LAUNCH
#define MK_ONE_LAUNCH 0
#endif
extern "C" void kernel_launch(void* const* d_in, const int* in_sizes, int n_in, void* d_out, int out_size, void* d_ws, size_t ws_size, hipStream_t stream) {
    static int grid = 0;
    if (grid == 0) {
        if (n_in != 18 || in_sizes[0] != MTOK * DM || out_size != MTOK * DM || ws_size < WS_END) { fprintf(stderr, "kernel_launch: unexpected shapes (n_in %d, ws %zu)\n", n_in, ws_size); grid = -1; return; }
        int dev = 0, cus = 0, per_cu = 0;
        (void)hipGetDevice(&dev); (void)hipDeviceGetAttribute(&cus, hipDeviceAttributeMultiprocessorCount, dev);
        if (hipFuncSetAttribute((const void*)mk_fwd, hipFuncAttributeMaxDynamicSharedMemorySize, LDS_TOTAL) != hipSuccess) { fprintf(stderr, "kernel_launch: hipFuncSetAttribute failed\n"); grid = -1; return; }
        if (hipOccupancyMaxActiveBlocksPerMultiprocessor(&per_cu, (const void*)mk_fwd, NTHR, LDS_TOTAL) != hipSuccess || per_cu < 1) { fprintf(stderr, "kernel_launch: occupancy query says %d\n", per_cu); per_cu = 1; }
        (void)hipGetLastError();
        grid = cus * (per_cu > 1 ? 1 : per_cu);
    }
    if (grid < 0) return;
    Args a{};
    for (int i = 0; i < 18; ++i) a.in[i] = (const float*)d_in[i];
    a.out = (float*)d_out; a.ws = (unsigned char*)d_ws;
#if MK_ONE_LAUNCH
    a.ph_lo = 0; a.ph_hi = N_PHASES;
    void* args[] = {&a};
    hipError_t e = hipLaunchCooperativeKernel((const void*)mk_fwd, dim3(grid), dim3(NTHR), args, LDS_TOTAL, stream);
    if (e != hipSuccess) fprintf(stderr, "cooperative launch failed: %s (grid %d)\n", hipGetErrorString(e), grid);
#else
    for (int p = 0; p < N_PHASES; ++p) {
        a.ph_lo = p; a.ph_hi = p + 1;
        hipLaunchKernelGGL(mk_fwd, dim3(grid), dim3(NTHR), LDS_TOTAL, stream, a);
    }
#endif
}
```

```cpp
#define MK_ONE_LAUNCH 1
#include <hip/hip_runtime.h>
#include <hip/hip_cooperative_groups.h>
#include <cstdio>
#include <cstdint>
namespace cg = cooperative_groups;
#define LAS __attribute__((address_space(3)))
#define GAS __attribute__((address_space(1)))
typedef unsigned short bf16;
typedef unsigned v4u __attribute__((ext_vector_type(4)));
typedef unsigned v2u __attribute__((ext_vector_type(2)));
typedef float f32x4 __attribute__((ext_vector_type(4)));
typedef float f32x16 __attribute__((ext_vector_type(16)));
typedef short bf16x8 __attribute__((ext_vector_type(8)));
typedef short s16x4 __attribute__((ext_vector_type(4)));
typedef float f32x2_t __attribute__((ext_vector_type(2)));
typedef __bf16 bf16x2_t __attribute__((ext_vector_type(2)));

constexpr int NWAVES = 8, NTHR = 512;
constexpr int BATCH = 8, SEQ = 4096, DM = 1024, MTOK = BATCH * SEQ;
constexpr int AH = 16, AHD = 64, AW = 1024;
constexpr int MH = 4, MHD = 512, MW = 2048;
constexpr int NIN = 12288;
constexpr int C_QA = 0, C_KA = 1024, C_VA = 2048, C_ZA = 3072, C_XM = 4096, C_ZM = 6144, C_OM = 8192, C_G = 10240;
constexpr int CHUNK = 64, NCHUNK = SEQ / CHUNK;
constexpr float EPS = 1e-6f;
constexpr float LOG2E = 1.4426950408889634f;
constexpr float QSCALE = 0.125f * 1.4426950408889634f;

constexpr size_t MiB = 1u << 20;
constexpr size_t WS_CTL = 0;
constexpr size_t WS_WIN = 1 * MiB;
constexpr size_t WS_WPA = 25 * MiB;
constexpr size_t WS_WPB = 27 * MiB;
constexpr size_t WS_WOUT = 31 * MiB;
constexpr size_t WS_TAB = 33 * MiB;
constexpr size_t WS_GP = 34 * MiB;
constexpr size_t WS_SCAL = 38 * MiB;
constexpr size_t WS_HALO = 40 * MiB;
constexpr size_t WS_ST = 34 * MiB;
constexpr size_t WS_XN = 46 * MiB;
constexpr size_t WS_R0 = 110 * MiB;
constexpr size_t WS_R1 = 238 * MiB;
constexpr size_t WS_R2 = 366 * MiB;
constexpr size_t WS_S = 494 * MiB;
constexpr size_t WS_END = 512 * MiB;
constexpr size_t WS_QA = 238 * MiB, WS_KA = 302 * MiB, WS_VA = 366 * MiB;
constexpr size_t WS_O1 = 430 * MiB;
constexpr size_t WS_A1 = 238 * MiB;
constexpr size_t WS_G = 302 * MiB;
constexpr size_t WS_MRG = 430 * MiB;
constexpr int TAB_WC = 0;
constexpr int TAB_WM = 2048 * 8;
constexpr int TAB_G = 2 * 2048 * 8;
constexpr int TAB_BIAS = TAB_G + 512 * 16;
constexpr int TAB_END = TAB_BIAS + 3 * 16 * 132;

__device__ const unsigned char BUCKET[3][132] = {
 {0,1,2,3,4,5,6,7,8,9,10,11,12,13,14,15,16,16,16,16,16,16,17,17,17,17,17,17,17,17,18,18,18,18,18,18,18,18,18,18,19,19,19,19,19,19,19,19,19,19,19,19,19,19,20,20,20,20,20,20,20,20,20,20,20,20,20,20,20,20,20,20,20,21,21,21,21,21,21,21,21,21,21,21,21,21,21,21,21,21,21,21,21,21,21,21,21,21,21,22,22,22,22,22,22,22,22,22,22,22,22,22,22,22,22,22,22,22,22,22,22,22,22,22,22,22,22,22,22,0,0,0},
 {0,4,8,12,16,16,17,17,18,18,19,19,19,19,20,20,20,20,20,21,21,21,21,21,21,22,22,22,22,22,22,22,22,22,23,23,23,23,23,23,23,23,23,23,23,23,24,24,24,24,24,24,24,24,24,24,24,24,24,24,24,24,25,25,25,25,25,25,25,25,25,25,25,25,25,25,25,25,25,25,25,25,25,26,26,26,26,26,26,26,26,26,26,26,26,26,26,26,26,26,26,26,26,26,26,26,26,26,26,26,26,26,26,27,27,27,27,27,27,27,27,27,27,27,27,27,27,27,27,0,0,0},
 {0,16,18,19,20,21,21,22,22,23,23,23,24,24,24,24,25,25,25,25,25,26,26,26,26,26,26,26,26,27,27,27,27,27,27,27,27,27,27,28,28,28,28,28,28,28,28,28,28,28,28,28,29,29,29,29,29,29,29,29,29,29,29,29,29,29,29,29,29,29,30,30,30,30,30,30,30,30,30,30,30,30,30,30,30,30,30,30,30,30,30,30,30,30,30,31,31,31,31,31,31,31,31,31,31,31,31,31,31,31,31,31,31,31,31,31,31,31,31,31,31,31,31,31,31,31,31,31,31,0,0,0}};

#define DI __device__ __forceinline__
DI unsigned pk2(float lo, float hi) { f32x2_t v = {lo, hi}; bf16x2_t b = __builtin_convertvector(v, bf16x2_t); return __builtin_bit_cast(unsigned, b); }
DI float bflo(unsigned u) { return __uint_as_float(u << 16); }
DI float bfhi(unsigned u) { return __uint_as_float(u & 0xffff0000u); }
DI float sigmoidf_(float x) { return 1.0f / (1.0f + __expf(-x)); }
DI float siluf_(float x) { return x / (1.0f + __expf(-x)); }
DI float wave_sum(float v) {
#pragma unroll
    for (int o = 1; o < 64; o <<= 1) v += __shfl_xor(v, o);
    return v;
}
DI int wg_tid(int wv) { return wv * 64 + (int)__builtin_amdgcn_mbcnt_hi(~0u, __builtin_amdgcn_mbcnt_lo(~0u, 0u)); }
DI int wg_tid_local(int wv) { int z; asm volatile("v_mov_b32 %0, 0" : "=v"(z)); return wv * 64 + (int)__builtin_amdgcn_mbcnt_hi(~0u, __builtin_amdgcn_mbcnt_lo(~0u, (unsigned)z)); }
DI float bperm(float v, int srclane) { return __int_as_float(__builtin_amdgcn_ds_bpermute(srclane << 2, __float_as_int(v))); }
DI int crow(int r, int hi) { return (r & 3) + 8 * (r >> 2) + 4 * hi; }
#define MFMA32(a, b, c) __builtin_amdgcn_mfma_f32_32x32x16_bf16((a), (b), (c), 0, 0, 0)
DI s16x4 tr_read(const LAS unsigned char* p) { return __builtin_bit_cast(s16x4, __builtin_amdgcn_ds_read_tr16_b64_v4i16((LAS s16x4*)p)); }
DI bf16x8 cat8(s16x4 lo, s16x4 hi) { return __builtin_shufflevector(lo, hi, 0, 1, 2, 3, 4, 5, 6, 7); }
DI bf16x8 pack8(float a0, float a1, float a2, float a3, float a4, float a5, float a6, float a7) {
    v4u p; p.x = pk2(a0, a1); p.y = pk2(a2, a3); p.z = pk2(a4, a5); p.w = pk2(a6, a7); return __builtin_bit_cast(bf16x8, p);
}
namespace pg8 {
#define PG8_LAS __attribute__((address_space(3)))
typedef unsigned short bf16_t;
typedef short bf16x8 __attribute__((ext_vector_type(8)));
typedef float f32x4 __attribute__((ext_vector_type(4)));
typedef unsigned u32x4 __attribute__((ext_vector_type(4)));
constexpr int BM = 256, BK = 64, HALF = 128, HTB = HALF * BK * 2  , STAGE_BYTES = 8 * HTB, NXCD = 8, WGM = 8;

__host__ __device__ __forceinline__ int lds_byte(int r, int c) { const int st = (r >> 4) * 2 + (c >> 5), rr = r & 15, cc = c & 31, ob = rr * 64 + cc * 2; return st * 1024 + (ob ^ (((ob >> 9) & 1) << 5)); }
__host__ __device__ __forceinline__ void stage_rc(int b, int& R, int& C) { const int st = b / 1024, sb = b % 1024, swz = sb ^ (((sb >> 9) & 1) << 5); R = (st >> 1) * 16 + swz / 64; C = (st & 1) * 32 + (swz % 64) / 2; }
__host__ __device__ __forceinline__ int perm32(int rho) { const int n = rho >> 4, i = rho & 15; return 8 * (i >> 2) + 4 * n + (i & 3); }

struct Unit { int pm, pn; };
struct Gemm { const bf16_t* A; const bf16_t* Bt; int M, N, K; };

struct StaticOrder {
    int nM, nN, nwg, G, c;
    __host__ __device__ void init(int M, int N, int G_, int c_) { nM = M / BM; nN = N / BM; nwg = nM * nN; G = G_; c = c_; }
    __host__ __device__ bool next(int i, Unit& u) const {
        const long L = (long)i * G + c; if (L >= nwg) return false;
        int wgid = (int)L; { const int q = nwg / NXCD, r = nwg % NXCD, xcd = wgid % NXCD, off = wgid / NXCD; wgid = (xcd < r ? xcd * (q + 1) : r * (q + 1) + (xcd - r) * q) + off; }
        const int nig = WGM * nN, gid = wgid / nig, fm = gid * WGM, gsz = (nM - fm) < WGM ? (nM - fm) : WGM;
        u.pm = fm + ((wgid % nig) % gsz); u.pn = (wgid % nig) / gsz; return true;
    }
    __device__ __forceinline__ void a_ready(const Unit&) const {}
    __device__ __forceinline__ void done(const Unit&) const {}
};

}
namespace pg8 {
#define EPI_OPERATOR \
    static constexpr bool PERM = true, AFTER_DRAIN = false; \
    __device__ __forceinline__ void operator()(const f32x4 (&acc)[2][2][4][2], const Unit& u, int wr, int wc, int fr, int fq) const { \
        const int row0 = u.pm * BM + wr * 64 + fr, col0 = u.pn * BM + wc * 32 + 8 * fq; \
        _Pragma("unroll") for (int ai = 0; ai < 2; ++ai) \
        _Pragma("unroll") for (int m = 0; m < 4; ++m) \
        _Pragma("unroll") for (int bj = 0; bj < 2; ++bj) store8(row0 + ai * HALF + m * 16, col0 + bj * HALF, acc[ai][bj][m][0], acc[ai][bj][m][1]); \
    }
DI ::v4u pack_bf16x8(f32x4 v0, f32x4 v1) { ::v4u w; w.x = ::pk2(v0[0], v0[1]); w.y = ::pk2(v0[2], v0[3]); w.z = ::pk2(v1[0], v1[1]); w.w = ::pk2(v1[2], v1[3]); return w; }
DI void unpack_bf16x8(::v4u w, f32x4& v0, f32x4& v1) { v0 = (f32x4){::bflo(w.x), ::bfhi(w.x), ::bflo(w.y), ::bfhi(w.y)}; v1 = (f32x4){::bflo(w.z), ::bfhi(w.z), ::bflo(w.w), ::bfhi(w.w)}; }

struct EpiXM {
    bf16_t* xm; bf16_t* halo;
    DI void store8(int row, int col, f32x4 v0, f32x4 v1) const {
        const ::v4u w = pack_bf16x8(v0, v1);
        *(::v4u*)(xm + (size_t)row * 2048 + col) = w;
        const int r = row & 63;
        if (r >= 61) *(::v4u*)(halo + ((size_t)(row >> 6) * 3 + (r - 61)) * 2048 + col) = w;
    }
    EPI_OPERATOR
};
struct EpiSig {
    bf16_t* out; int ldc; const float* bias;
    DI void store8(int row, int col, f32x4 v0, f32x4 v1) const {
        if (bias) { v0 += *(const f32x4*)(bias + col); v1 += *(const f32x4*)(bias + col + 4); }
#pragma unroll
        for (int i = 0; i < 4; ++i) { v0[i] = ::sigmoidf_(v0[i]); v1[i] = ::sigmoidf_(v1[i]); }
        *(::v4u*)(out + (size_t)row * ldc + col) = pack_bf16x8(v0, v1);
    }
    EPI_OPERATOR
};
struct EpiZM {
    bf16_t* buf;
    DI void store8(int row, int col, f32x4 v0, f32x4 v1) const {
        ::v4u* p = (::v4u*)(buf + (size_t)row * 2048 + col);
        f32x4 h0, h1; unpack_bf16x8(*p, h0, h1);
#pragma unroll
        for (int i = 0; i < 4; ++i) { h0[i] *= ::siluf_(v0[i]); h1[i] *= ::siluf_(v1[i]); }
        *p = pack_bf16x8(h0, h1);
    }
    EPI_OPERATOR
};
struct EpiQKV {
    bf16_t* q; size_t stride;
    DI void store8(int row, int col, f32x4 v0, f32x4 v1) const {
        const int t = col >> 10, c = col & 1023;
        bf16_t* base = q + (size_t)t * stride;
        if (t == 0) { v0 *= ::QSCALE; v1 *= ::QSCALE; }
        *(::v4u*)(base + (size_t)row * 1024 + c) = pack_bf16x8(v0, v1);
    }
    EPI_OPERATOR
};
struct EpiZA {
    const bf16_t* o0; const bf16_t* o1; const bf16_t* o2; const float* st; bf16_t* a1;
    DI void store8(int row, int col, f32x4 v0, f32x4 v1) const {
        const int head = col >> 6;
        const ::f32x2_t s0 = *(const ::f32x2_t*)(st + ((size_t)(0 * ::MTOK + row) * 16 + head) * 2);
        const ::f32x2_t s1 = *(const ::f32x2_t*)(st + ((size_t)(1 * ::MTOK + row) * 16 + head) * 2);
        const ::f32x2_t s2 = *(const ::f32x2_t*)(st + ((size_t)(2 * ::MTOK + row) * 16 + head) * 2);
        const float mx = fmaxf(s0.x, fmaxf(s1.x, s2.x));
        float w0 = __builtin_amdgcn_exp2f(s0.x - mx) * s0.y, w1 = __builtin_amdgcn_exp2f(s1.x - mx) * s1.y, w2 = __builtin_amdgcn_exp2f(s2.x - mx) * s2.y;
        const float inv = 1.0f / (w0 + w1 + w2); w0 *= inv; w1 *= inv; w2 *= inv;
        const size_t off = (size_t)row * 1024 + col;
        f32x4 a0, a1v, b0, b1, c0, c1;
        unpack_bf16x8(*(const ::v4u*)(o0 + off), a0, a1v); unpack_bf16x8(*(const ::v4u*)(o1 + off), b0, b1); unpack_bf16x8(*(const ::v4u*)(o2 + off), c0, c1);
        f32x4 r0 = a0 * w0 + b0 * w1 + c0 * w2, r1 = a1v * w0 + b1 * w1 + c1 * w2;
#pragma unroll
        for (int i = 0; i < 4; ++i) { r0[i] *= ::siluf_(v0[i]); r1[i] *= ::siluf_(v1[i]); }
        *(::v4u*)(a1 + off) = pack_bf16x8(r0, r1);
    }
    EPI_OPERATOR
};
struct EpiYA {
    bf16_t* g;
    DI void store8(int row, int col, f32x4 v0, f32x4 v1) const {
        ::v4u* p = (::v4u*)(g + (size_t)row * 2048 + col);
        f32x4 h0, h1; unpack_bf16x8(*p, h0, h1);
        *p = pack_bf16x8(h0 * v0, h1 * v1);
    }
    EPI_OPERATOR
};
struct EpiYM {
    const bf16_t* g; bf16_t* mrg;
    DI void store8(int row, int col, f32x4 v0, f32x4 v1) const {
        f32x4 t0, t1, g0, g1;
        unpack_bf16x8(*(const ::v4u*)(g + (size_t)row * 2048 + col), t0, t1);
        unpack_bf16x8(*(const ::v4u*)(g + (size_t)row * 2048 + 1024 + col), g0, g1);
        *(::v4u*)(mrg + (size_t)row * 1024 + col) = pack_bf16x8(t0 + g0 * v0, t1 + g1 * v1);
    }
    EPI_OPERATOR
};
struct EpiOut {
    const float* x; float* out;
    DI void store8(int row, int col, f32x4 v0, f32x4 v1) const {
        const size_t off = (size_t)row * 1024 + col;
        *(f32x4*)(out + off) = *(const f32x4*)(x + off) + v0;
        *(f32x4*)(out + off + 4) = *(const f32x4*)(x + off + 4) + v1;
    }
    EPI_OPERATOR
};
}
namespace pg8 {
template <class Epi, class Sched, bool ALIGN_EPI = false, bool SP2 = false>
__device__ __forceinline__ void gemm_phase(PG8_LAS unsigned char* lds, const Gemm g, const Sched& S, const Epi& E, const int tid_in) {
    const int tid = tid_in, wid = __builtin_amdgcn_readfirstlane(tid >> 6), lane = tid & 63, wr = wid >> 2, wc = wid & 3, fr = lane & 15, fq = lane >> 4;
    const int K = g.K, nt = K / BK;
    unsigned voffA[2], voffB[2];
#pragma unroll
    for (int i = 0; i < 2; ++i) { int R, C; stage_rc(tid * 16 + i * 8192, R, C); const int Rb = Epi::PERM ? ((R & ~31) + perm32(R & 31)) : R;
        voffA[i] = (unsigned)(R * K + C) * 2u; voffB[i] = (unsigned)(Rb * K + C) * 2u; }
    const size_t kstep = (size_t)(BK * 2);
    const size_t hstep = (size_t)HALF * K * 2;
    const size_t tstep = 2 * hstep;
    const unsigned ldsw = (unsigned)wid * 1024u;
    const int aoff = lds_byte(wr * 64 + fr, fq * 8), boff = lds_byte(wc * 32 + fr, fq * 8);
#define PG8_SA(b, h) (((b) * 2 + (h)) * HTB)
#define PG8_SB(b, h) ((4 + (b) * 2 + (h)) * HTB)
#define PG8_STAGE(bufoff, gbase, voff) do { _Pragma("unroll") for (int _i = 0; _i < 2; ++_i) \
        __builtin_amdgcn_global_load_lds((const unsigned*)((const char*)(gbase) + (voff)[_i]), (PG8_LAS unsigned*)(lds + (bufoff) + ldsw + _i * 8192), 16, 0, 0); } while (0)
#define PG8_LDA(dst, b, h) do { _Pragma("unroll") for (int m = 0; m < 4; ++m) _Pragma("unroll") for (int k = 0; k < 2; ++k) dst[m][k] = *(const PG8_LAS bf16x8*)(lds + PG8_SA(b, h) + aoff + m * 2048 + k * 1024); } while (0)
#define PG8_LDB(dst, b, h) do { _Pragma("unroll") for (int n = 0; n < 2; ++n) _Pragma("unroll") for (int k = 0; k < 2; ++k) dst[n][k] = *(const PG8_LAS bf16x8*)(lds + PG8_SB(b, h) + boff + n * 2048 + k * 1024); } while (0)
#define PG8_MMA(ai, bj, At, Bt) do { __builtin_amdgcn_s_setprio(1); _Pragma("unroll") for (int m = 0; m < 4; ++m) _Pragma("unroll") for (int n = 0; n < 2; ++n) _Pragma("unroll") for (int k = 0; k < 2; ++k) \
        acc[ai][bj][m][n] = __builtin_amdgcn_mfma_f32_16x16x32_bf16(Bt[n][k], At[m][k], acc[ai][bj][m][n], 0, 0, 0); __builtin_amdgcn_s_setprio(0); } while (0)
#define PG8_WAIT_V(n) asm volatile("s_waitcnt vmcnt(" #n ")" ::: "memory")
#define PG8_WAIT_L(n) asm volatile("s_waitcnt lgkmcnt(" #n ")" ::: "memory")
#define PG8_BAR __builtin_amdgcn_s_barrier()
#define PG8_SCHED __builtin_amdgcn_sched_barrier(0)
    Unit cur, nxt; int ui = 0;
    if (!S.next(0, cur)) return;
    f32x4 acc[2][2][4][2];
#pragma unroll
    for (int a = 0; a < 2; ++a)
#pragma unroll
        for (int b = 0; b < 2; ++b)
#pragma unroll
            for (int m = 0; m < 4; ++m)
#pragma unroll
                for (int n = 0; n < 2; ++n) acc[a][b][m][n] = (f32x4){0.f, 0.f, 0.f, 0.f};
    bf16x8 At[4][2], B0[2][2], B1[2][2];
    const char* cA = (const char*)g.A + (size_t)cur.pm * tstep; const char* cB = (const char*)g.Bt + (size_t)cur.pn * tstep;
    S.a_ready(cur);
    if constexpr (SP2) {
        PG8_STAGE(PG8_SB(0, 0), cB, voffB); PG8_STAGE(PG8_SB(0, 1), cB + hstep, voffB); PG8_STAGE(PG8_SA(0, 0), cA, voffA); PG8_STAGE(PG8_SA(0, 1), cA + hstep, voffA);
        if (wr == 1) PG8_BAR;
        PG8_WAIT_V(2); PG8_BAR;
        PG8_STAGE(PG8_SB(1, 0), cB + kstep, voffB); PG8_STAGE(PG8_SA(1, 0), cA + kstep, voffA); PG8_STAGE(PG8_SB(1, 1), cB + hstep + kstep, voffB);
        PG8_WAIT_V(6); PG8_BAR;
    } else {
        PG8_STAGE(PG8_SB(0, 0), cB, voffB); PG8_STAGE(PG8_SA(0, 0), cA, voffA); PG8_STAGE(PG8_SB(0, 1), cB + hstep, voffB); PG8_STAGE(PG8_SA(0, 1), cA + hstep, voffA);
        if (wr == 1) PG8_BAR;
        PG8_WAIT_V(4); PG8_BAR;
        PG8_STAGE(PG8_SB(1, 0), cB + kstep, voffB); PG8_STAGE(PG8_SA(1, 0), cA + kstep, voffA); PG8_STAGE(PG8_SB(1, 1), cB + hstep + kstep, voffB);
        PG8_WAIT_V(6); PG8_BAR;
    }
    for (;;) {
        const bool has_next = S.next(ui + 1, nxt);
        const char* nA = has_next ? (const char*)g.A + (size_t)nxt.pm * tstep : cA; const char* nB = has_next ? (const char*)g.Bt + (size_t)nxt.pn * tstep : cB;
        for (int t = 0; t < nt; t += 2) {
            const bool last = (t == nt - 2);
            const char* a1 = cA + (size_t)(t + 1) * kstep;
            const char* a2 = last ? nA : cA + (size_t)(t + 2) * kstep; const char* b2 = last ? nB : cB + (size_t)(t + 2) * kstep;
            const char* a3 = a2 + kstep; const char* b3 = b2 + kstep;
            if (last && has_next) S.a_ready(nxt);
            if constexpr (SP2) {
            PG8_LDB(B0, 0, 0); PG8_LDB(B1, 0, 1); PG8_SCHED; PG8_LDA(At, 0, 0); PG8_STAGE(PG8_SA(1, 1), a1 + hstep, voffA);
            PG8_WAIT_V(8); PG8_WAIT_L(0); PG8_BAR; PG8_MMA(0, 0, At, B0); PG8_MMA(0, 1, At, B1); PG8_BAR; PG8_SCHED;
            PG8_LDA(At, 0, 1); PG8_STAGE(PG8_SB(0, 0), b2, voffB); PG8_STAGE(PG8_SB(0, 1), b2 + hstep, voffB); PG8_STAGE(PG8_SA(0, 0), a2, voffA);
            PG8_WAIT_V(8); PG8_WAIT_L(0); PG8_BAR; PG8_MMA(1, 0, At, B0); PG8_MMA(1, 1, At, B1); PG8_BAR; PG8_SCHED;
            PG8_LDB(B0, 1, 0); PG8_LDB(B1, 1, 1); PG8_SCHED; PG8_LDA(At, 1, 0); PG8_STAGE(PG8_SA(0, 1), a2 + hstep, voffA);
            PG8_WAIT_V(8); PG8_WAIT_L(0); PG8_BAR; PG8_MMA(0, 0, At, B0); PG8_MMA(0, 1, At, B1); PG8_BAR; PG8_SCHED;
            PG8_LDA(At, 1, 1); PG8_STAGE(PG8_SB(1, 0), b3, voffB); PG8_STAGE(PG8_SB(1, 1), b3 + hstep, voffB); PG8_STAGE(PG8_SA(1, 0), a3, voffA);
            PG8_WAIT_V(8); PG8_WAIT_L(0); PG8_BAR; PG8_MMA(1, 0, At, B0); PG8_MMA(1, 1, At, B1); PG8_BAR; PG8_SCHED;
            } else {
            PG8_LDB(B0, 0, 0); PG8_SCHED; PG8_LDA(At, 0, 0); PG8_STAGE(PG8_SA(1, 1), a1 + hstep, voffA);
            PG8_WAIT_L(8); PG8_BAR; PG8_WAIT_L(0); PG8_MMA(0, 0, At, B0); PG8_BAR; PG8_SCHED;
            PG8_LDB(B1, 0, 1); PG8_STAGE(PG8_SB(0, 0), b2, voffB);
            PG8_BAR; PG8_WAIT_L(0); PG8_MMA(0, 1, At, B1); PG8_BAR;
            PG8_LDA(At, 0, 1); PG8_STAGE(PG8_SA(0, 0), a2, voffA);
            PG8_BAR; PG8_WAIT_L(0); PG8_MMA(1, 0, At, B0); PG8_BAR; PG8_SCHED;
            PG8_STAGE(PG8_SB(0, 1), b2 + hstep, voffB);
            PG8_WAIT_V(6); PG8_BAR; PG8_MMA(1, 1, At, B1); PG8_BAR;
            PG8_LDB(B0, 1, 0); PG8_SCHED; PG8_LDA(At, 1, 0); PG8_STAGE(PG8_SA(0, 1), a2 + hstep, voffA);
            PG8_WAIT_L(8); PG8_BAR; PG8_WAIT_L(0); PG8_MMA(0, 0, At, B0); PG8_BAR; PG8_SCHED;
            PG8_LDB(B1, 1, 1); PG8_STAGE(PG8_SB(1, 0), b3, voffB);
            PG8_BAR; PG8_WAIT_L(0); PG8_MMA(0, 1, At, B1); PG8_BAR;
            PG8_LDA(At, 1, 1); PG8_STAGE(PG8_SA(1, 0), a3, voffA);
            PG8_BAR; PG8_WAIT_L(0); PG8_MMA(1, 0, At, B0); PG8_BAR; PG8_SCHED;
            PG8_STAGE(PG8_SB(1, 1), b3 + hstep, voffB);
            PG8_WAIT_V(6); PG8_BAR; PG8_MMA(1, 1, At, B1); PG8_BAR;
            }
        }
        if constexpr (ALIGN_EPI) { if (wr == 0) PG8_BAR; }
        if constexpr (!Epi::AFTER_DRAIN) { E(acc, cur, wr, wc, fr, fq); S.done(cur); }
        if (!has_next) break;
#pragma unroll
        for (int a = 0; a < 2; ++a)
#pragma unroll
            for (int b = 0; b < 2; ++b)
#pragma unroll
                for (int m = 0; m < 4; ++m)
#pragma unroll
                    for (int n = 0; n < 2; ++n) acc[a][b][m][n] = (f32x4){0.f, 0.f, 0.f, 0.f};
        cur = nxt; cA = nA; cB = nB; ++ui;
        if constexpr (ALIGN_EPI) { if (wr == 1) PG8_BAR; }
    }
    PG8_WAIT_V(0);
    if constexpr (!ALIGN_EPI) { if (wr == 0) PG8_BAR; }
    PG8_BAR;
    if constexpr (Epi::AFTER_DRAIN) { E.fused(acc, cur, wr, wc, fr, fq, lds, wid, lane); S.done(cur); }
#undef PG8_SA
#undef PG8_SB
#undef PG8_STAGE
#undef PG8_LDA
#undef PG8_LDB
#undef PG8_MMA
#undef PG8_WAIT_V
#undef PG8_WAIT_L
#undef PG8_BAR
#undef PG8_SCHED
}
}
namespace att {
constexpr int KP = 144;
constexpr int K_OFF = 0, V_OFF = 384 * KP, B_OFF = 2 * 384 * KP, LDS_BYTES = B_OFF + 132 * 4;
struct Tensors { const bf16* Q; const bf16* K; const bf16* V; bf16* Oa; bf16* Ob; float* st; const float* biasL2; };

DI void unit(LAS unsigned char* lds, const Tensors& T, int u, int tid_in) {
    const int tid_ = wg_tid_local(tid_in);
    const int tid = tid_, lane = tid & 63, l31 = lane & 31, hi = lane >> 5, w = __builtin_amdgcn_readfirstlane(tid >> 6);
    const int bh = u / 48, rem = u % 48, p = rem >> 4, w16 = rem & 15;
    const int b = bh >> 4, h = bh & 15;
    const int dsh = 2 * p, nqb = 16 >> dsh, r = w16 / nqb, qblk = w16 % nqb;
    const size_t rowb = (size_t)b * SEQ;
    {
#pragma unroll
        for (int k = 0; k < 6; ++k) {
            const int id = tid + 512 * k, j = id >> 3, pc = id & 7;
            int pos = 256 * qblk - 128 + j; pos = pos < 0 ? 0 : pos;
            const size_t off = (rowb + r + ((size_t)pos << dsh)) * 1024 + h * 64 + pc * 8;
            const v4u kv = *(const v4u*)(T.K + off); const v4u vv = *(const v4u*)(T.V + off);
            *(LAS v4u*)(lds + K_OFF + j * KP + pc * 16) = kv;
            *(LAS v4u*)(lds + V_OFF + j * KP + pc * 16) = vv;
        }
        if (tid < 132) ((LAS float*)(lds + B_OFF))[tid] = T.biasL2[(p * 16 + h) * 132 + tid];
    }
    const int qpos = 256 * qblk + 32 * w + l31;
    const size_t qrow = rowb + r + ((size_t)qpos << dsh);
    bf16x8 qf[4];
#pragma unroll
    for (int d0 = 0; d0 < 4; ++d0) qf[d0] = *(const bf16x8*)(T.Q + qrow * 1024 + h * 64 + d0 * 16 + hi * 8);
    __syncthreads();
    f32x16 st[5];
#pragma unroll
    for (int kt = 0; kt < 5; ++kt) {
        f32x16 a = {};
#pragma unroll
        for (int d0 = 0; d0 < 4; ++d0) {
            const bf16x8 kf = *(const LAS bf16x8*)(lds + K_OFF + (32 * w + 32 * kt + l31) * KP + (16 * d0 + 8 * hi) * 2);
            a = MFMA32(kf, qf[d0], a);
        }
        st[kt] = a;
    }
    const LAS float* bl = (const LAS float*)(lds + B_OFF);
    float mx = -1e30f;
#pragma unroll
    for (int kt = 0; kt < 5; ++kt)
#pragma unroll
        for (int rr = 0; rr < 16; ++rr) {
            const int kl = crow(rr, hi);
            const int delta = 128 + l31 - 32 * kt - kl;
            const int pk = 256 * qblk - 128 + 32 * w + 32 * kt + kl;
            const bool valid = (delta >= 0) && (delta <= 128) && (pk >= 0);
            const int dc = delta < 0 ? 0 : (delta > 128 ? 128 : delta);
            const float s = valid ? st[kt][rr] + bl[dc] : -1e30f;
            st[kt][rr] = s; mx = fmaxf(mx, s);
        }
    mx = fmaxf(mx, __shfl_xor(mx, 32));
    float lsum = 0.f;
#pragma unroll
    for (int kt = 0; kt < 5; ++kt)
#pragma unroll
        for (int rr = 0; rr < 16; ++rr) { const float e = __builtin_amdgcn_exp2f(st[kt][rr] - mx); st[kt][rr] = e; lsum += e; }
    lsum += __shfl_xor(lsum, 32);
    f32x16 o[2]; o[0] = (f32x16){}; o[1] = (f32x16){};
    const int i16 = lane & 15, q4 = i16 >> 2, p4 = i16 & 3, gidx = (lane >> 4) & 1;
#pragma unroll
    for (int kt = 0; kt < 5; ++kt)
#pragma unroll
        for (int s2 = 0; s2 < 2; ++s2) {
            const bf16x8 pb = pack8(st[kt][8 * s2 + 0], st[kt][8 * s2 + 1], st[kt][8 * s2 + 2], st[kt][8 * s2 + 3], st[kt][8 * s2 + 4], st[kt][8 * s2 + 5], st[kt][8 * s2 + 6], st[kt][8 * s2 + 7]);
            const int jrow = 32 * w + 32 * kt + 16 * s2 + 4 * hi + q4;
#pragma unroll
            for (int dt = 0; dt < 2; ++dt) {
                const LAS unsigned char* a0 = lds + V_OFF + jrow * KP + (32 * dt + 16 * gidx + 4 * p4) * 2;
                const bf16x8 va = cat8(tr_read(a0), tr_read(a0 + 8 * KP));
                o[dt] = MFMA32(va, pb, o[dt]);
            }
        }
    const float inv = 1.0f / lsum;
    bf16* orow = (p == 0 ? T.Oa : T.Ob + (size_t)(p - 1) * MTOK * AW) + qrow * 1024 + h * 64;
#pragma unroll
    for (int dt = 0; dt < 2; ++dt)
#pragma unroll
        for (int g4 = 0; g4 < 4; ++g4) {
            v2u wv; wv.x = pk2(o[dt][4 * g4] * inv, o[dt][4 * g4 + 1] * inv); wv.y = pk2(o[dt][4 * g4 + 2] * inv, o[dt][4 * g4 + 3] * inv);
            *(v2u*)(orow + 32 * dt + 8 * g4 + 4 * hi) = wv;
        }
    if (hi == 0) { f32x2_t sv = {mx, lsum}; *(f32x2_t*)(T.st + ((size_t)p * MTOK + qrow) * 32 + h * 2) = sv; }
    __syncthreads();
}
DI void phase(LAS unsigned char* lds, const Tensors& T, int G, int blk, int wv) {
    for (int u = blk; u < BATCH * AH * 48; u += G) unit(lds, T, u, wv);
}
}
namespace mpre {
constexpr int TP = 144;
constexpr int XC_OFF = 0, XM_OFF = 256 * TP, QT_OFF = 2 * 256 * TP, RED_OFF = 3 * 256 * TP, GRED_OFF = RED_OFF + 4 * 4096, LDS_BYTES = GRED_OFF + 4 * 64 * 8 * 4;
struct Tensors { const bf16* xm; const bf16* halo; bf16* kimg; bf16* vimg; bf16* qimg; float* gp; bf16* S; const float* convw; const float* convb; const bf16* WcT; const bf16* WmT; const float* G; };

DI void unit(LAS unsigned char* lds, const Tensors& T, int u, int tid_in) {
    const int tid_ = wg_tid_local(tid_in);
    const int tid = tid_, lane = tid & 63, l31 = lane & 31, hi = lane >> 5, w = __builtin_amdgcn_readfirstlane(tid >> 6);
    const int h = u & 3, c = (u >> 2) & 63, b = u >> 8;
    const int g6 = lane, tp = w;
    const size_t tok0 = (size_t)b * SEQ + 64 * c;
    const int ti = w & 1, si = (w >> 1) & 1, kh = w >> 2;
    f32x16 sacc = {};
    f32x16 gacc = {};
    const int kq = w >> 1;
    const int i16 = lane & 15, q4 = i16 >> 2, p4 = i16 & 3, gidx = (lane >> 4) & 1;
#pragma unroll 1
    for (int hh = 0; hh < 2; ++hh) {
        const int gg = 128 * h + 64 * hh + g6, ch = 4 * gg;
        v2u xr[11];
#pragma unroll
        for (int k = 0; k < 11; ++k) {
            const int tl = 8 * tp - 3 + k;
            if (tl >= 0) xr[k] = *(const v2u*)(T.xm + (tok0 + tl) * 2048 + ch);
            else if (c > 0) xr[k] = *(const v2u*)(T.halo + ((size_t)(b * 64 + c - 1) * 3 + (3 + tl)) * 2048 + ch);
            else xr[k] = (v2u){0u, 0u};
        }
        float xmv[11][4];
#pragma unroll
        for (int k = 0; k < 11; ++k) { xmv[k][0] = bflo(xr[k].x); xmv[k][1] = bfhi(xr[k].x); xmv[k][2] = bflo(xr[k].y); xmv[k][3] = bfhi(xr[k].y); }
        float cw[4][4], cb[4], Gm[4][4];
        {
            const f32x4 b4 = *(const f32x4*)(T.convb + ch); cb[0] = b4[0]; cb[1] = b4[1]; cb[2] = b4[2]; cb[3] = b4[3];
#pragma unroll
            for (int tap = 0; tap < 4; ++tap) { const f32x4 w4 = *(const f32x4*)(T.convw + tap * 2048 + ch); cw[tap][0] = w4[0]; cw[tap][1] = w4[1]; cw[tap][2] = w4[2]; cw[tap][3] = w4[3]; }
#pragma unroll
            for (int i = 0; i < 4; ++i) { const f32x4 g4 = *(const f32x4*)(T.G + gg * 16 + i * 4); Gm[i][0] = g4[0]; Gm[i][1] = g4[1]; Gm[i][2] = g4[2]; Gm[i][3] = g4[3]; }
        }
        __syncthreads();
        unsigned xcp[4][4], xmp[4][4], qtp[4][4];
        float prev_xc[4], prev_q[4];
#pragma unroll
        for (int tl = 0; tl < 8; ++tl) {
            float xc[4], qt[4];
#pragma unroll
            for (int i = 0; i < 4; ++i) {
                float a = cb[i];
#pragma unroll
                for (int tap = 0; tap < 4; ++tap) a += cw[tap][i] * xmv[tl + tap][i];
                xc[i] = siluf_(a);
            }
#pragma unroll
            for (int i2 = 0; i2 < 4; ++i2) qt[i2] = xc[0] * Gm[0][i2] + xc[1] * Gm[1][i2] + xc[2] * Gm[2][i2] + xc[3] * Gm[3][i2];
            if (tl & 1) {
#pragma unroll
                for (int i = 0; i < 4; ++i) { xcp[i][tl >> 1] = pk2(prev_xc[i], xc[i]); qtp[i][tl >> 1] = pk2(prev_q[i], qt[i]); xmp[i][tl >> 1] = pk2(xmv[tl + 2][i], xmv[tl + 3][i]); }
            } else {
#pragma unroll
                for (int i = 0; i < 4; ++i) { prev_xc[i] = xc[i]; prev_q[i] = qt[i]; }
            }
        }
#pragma unroll
        for (int i = 0; i < 4; ++i) {
            const int off = (4 * g6 + i) * TP + 16 * tp;
            *(LAS v4u*)(lds + XC_OFF + off) = (v4u){xcp[i][0], xcp[i][1], xcp[i][2], xcp[i][3]};
            *(LAS v4u*)(lds + XM_OFF + off) = (v4u){xmp[i][0], xmp[i][1], xmp[i][2], xmp[i][3]};
            *(LAS v4u*)(lds + QT_OFF + off) = (v4u){qtp[i][0], qtp[i][1], qtp[i][2], qtp[i][3]};
        }
        __syncthreads();
        {
            const size_t ibase = ((size_t)((b * 4 + h) * 64 + c) * 64 + 32 * hh) * 1024;
#pragma unroll
            for (int k = 0; k < 4; ++k) {
                const int id = tid + 512 * k, f = id >> 6, L = id & 63;
                const int row = 32 * (f >> 2) + (L & 31), colb = (16 * (f & 3) + 4 * (L >> 5)) * 2;
                const v2u k0 = *(const LAS v2u*)(lds + XC_OFF + row * TP + colb), k1 = *(const LAS v2u*)(lds + XC_OFF + row * TP + colb + 16);
                const v2u v0 = *(const LAS v2u*)(lds + XM_OFF + row * TP + colb), v1 = *(const LAS v2u*)(lds + XM_OFF + row * TP + colb + 16);
                *(v4u*)((char*)T.kimg + ibase + (size_t)id * 16) = (v4u){k0.x, k0.y, k1.x, k1.y};
                *(v4u*)((char*)T.vimg + ibase + (size_t)id * 16) = (v4u){v0.x, v0.y, v1.x, v1.y};
            }
#pragma unroll
            for (int k = 0; k < 4; ++k) {
                const int f = 4 * w + k, tt = f & 1, cb0 = 16 * (f >> 1) + 4 * hi + q4;
                const LAS unsigned char* pq = lds + QT_OFF + cb0 * TP + (32 * tt + 16 * gidx + 4 * p4) * 2;
                const s16x4 lo = tr_read(pq), hi4 = tr_read(pq + 8 * TP);
                *(bf16x8*)((char*)T.qimg + ibase + (size_t)f * 1024 + lane * 16) = cat8(lo, hi4);
            }
        }
#pragma unroll
        for (int ks = 0; ks < 8; ++ks) {
            const int crow0 = 128 * kh + 16 * ks + 8 * hi + q4;
            const LAS unsigned char* pa = lds + XC_OFF + crow0 * TP + (32 * si + 16 * gidx + 4 * p4) * 2;
            const LAS unsigned char* pb = lds + QT_OFF + crow0 * TP + (32 * ti + 16 * gidx + 4 * p4) * 2;
            const bf16x8 af = cat8(tr_read(pa), tr_read(pa + 4 * TP));
            const bf16x8 bfr = cat8(tr_read(pb), tr_read(pb + 4 * TP));
            sacc = MFMA32(af, bfr, sacc);
        }
#pragma unroll
        for (int ks = 0; ks < 4; ++ks) {
            const int crow1 = 64 * kq + 16 * ks + 8 * hi + q4;
            const LAS unsigned char* pc_ = lds + XC_OFF + crow1 * TP + (32 * ti + 16 * gidx + 4 * p4) * 2;
            const LAS unsigned char* pm_ = lds + XM_OFF + crow1 * TP + (32 * ti + 16 * gidx + 4 * p4) * 2;
            const bf16x8 ac = cat8(tr_read(pc_), tr_read(pc_ + 4 * TP));
            const bf16x8 am = cat8(tr_read(pm_), tr_read(pm_ + 4 * TP));
            const int c0 = 512 * h + 256 * hh + 64 * kq + 16 * ks + 8 * hi;
            const bf16x8 bc = *(const bf16x8*)(T.WcT + (l31 & 7) * 2048 + c0);
            const bf16x8 bm = *(const bf16x8*)(T.WmT + (l31 & 7) * 2048 + c0);
            gacc = MFMA32(ac, bc, gacc);
            gacc = MFMA32(am, bm, gacc);
        }
    }
    if (l31 < 8) {
#pragma unroll
        for (int r = 0; r < 16; ++r) ((LAS float*)(lds + GRED_OFF))[(kq * 64 + 32 * ti + crow(r, hi)) * 8 + l31] = gacc[r];
    }
    __syncthreads();
    if (kh == 1) {
#pragma unroll
        for (int g4 = 0; g4 < 4; ++g4) *(LAS f32x4*)(lds + RED_OFF + ((w & 3) * 4 + g4) * 1024 + lane * 16) = (f32x4){sacc[4 * g4], sacc[4 * g4 + 1], sacc[4 * g4 + 2], sacc[4 * g4 + 3]};
    }
    __syncthreads();
    { const LAS float* gr = (const LAS float*)(lds + GRED_OFF);
      T.gp[((size_t)h * MTOK + tok0) * 8 + tid] = gr[tid] + gr[512 + tid] + gr[1024 + tid] + gr[1536 + tid]; }
    if (kh == 0) {
        float tot[16];
#pragma unroll
        for (int g4 = 0; g4 < 4; ++g4) {
            const f32x4 o = *(const LAS f32x4*)(lds + RED_OFF + ((w & 3) * 4 + g4) * 1024 + lane * 16);
            tot[4 * g4] = sacc[4 * g4] + o[0]; tot[4 * g4 + 1] = sacc[4 * g4 + 1] + o[1]; tot[4 * g4 + 2] = sacc[4 * g4 + 2] + o[2]; tot[4 * g4 + 3] = sacc[4 * g4 + 3] + o[3];
        }
        char* sp = (char*)T.S + (size_t)((b * 4 + h) * 64 + c) * 8192;
#pragma unroll
        for (int kk = 0; kk < 2; ++kk)
            *(bf16x8*)(sp + ((2 * si + kk) * 2 + ti) * 1024 + lane * 16) = pack8(tot[8 * kk], tot[8 * kk + 1], tot[8 * kk + 2], tot[8 * kk + 3], tot[8 * kk + 4], tot[8 * kk + 5], tot[8 * kk + 6], tot[8 * kk + 7]);
    }
    __syncthreads();
}
DI void phase(LAS unsigned char* lds, const Tensors& T, int G, int blk, int wv) {
    for (int u = blk; u < BATCH * NCHUNK * MH; u += G) unit(lds, T, u, wv);
}
}
namespace mscan {
constexpr int P_OFF = 0;
constexpr int DEN_OFF = 131072;
constexpr int NS_OFF = DEN_OFF + 2048;
constexpr int TMP_OFF = NS_OFF + 4096, SCW_OFF = TMP_OFF + 128, LDS_BYTES = SCW_OFF + 8 * 512;
static_assert(LDS_BYTES <= 163840, "scan LDS");
struct Tensors { const bf16* q; const bf16* k; const bf16* v; const bf16* S; const float* gp; const float* bif; float* scal; bf16* hm; };

DI float logsigmoid_(float x) { return fminf(x, 0.f) - log1pf(__expf(-fabsf(x))); }
DI void unpack8(bf16x8 f, float (&o)[8]) {
    const v4u u = __builtin_bit_cast(v4u, f);
    o[0] = bflo(u.x); o[1] = bfhi(u.x); o[2] = bflo(u.y); o[3] = bfhi(u.y); o[4] = bflo(u.z); o[5] = bfhi(u.z); o[6] = bflo(u.w); o[7] = bfhi(u.w);
}

DI void unit(LAS unsigned char* lds, const Tensors& T, int bh, int es, int tid_in) {
    const int tid_ = wg_tid_local(tid_in);
    const int tid = tid_, lane = tid & 63, l31 = lane & 31, hi = lane >> 5, wid = __builtin_amdgcn_readfirstlane(tid >> 6);
    const int eg = wid & 1, dq = wid >> 1;
    const int b = bh >> 2, h = bh & 3;
    LAS float* sTmp = (LAS float*)(lds + TMP_OFF);
    float* scal = T.scal + (size_t)bh * 3 * SEQ;
    {
        float li[8], cs[8];
        const float bi = T.bif[h], bf_ = T.bif[4 + h];
        float run = 0.f;
        const float* gpb = T.gp + (size_t)b * SEQ * 8 + h;
        const unsigned toff = (unsigned)tid * 64u;
#pragma unroll
        for (int k = 0; k < 8; ++k) { li[k] = bi; cs[k] = bf_; }
#pragma unroll
        for (int hh = 0; hh < 4; ++hh) {
            const float* p = gpb + (size_t)hh * MTOK * 8;
#pragma unroll
            for (int k = 0; k < 8; ++k) { li[k] += p[toff + k * 8]; cs[k] += p[toff + k * 8 + 4]; }
        }
#pragma unroll
        for (int k = 0; k < 8; ++k) { run += logsigmoid_(cs[k]); cs[k] = run; }
        float inc = run;
#pragma unroll
        for (int o = 1; o < 64; o <<= 1) { const float t = bperm(inc, lane >= o ? lane - o : lane); if (lane >= o) inc += t; }
        if (lane == 63) sTmp[wid] = inc;
        __syncthreads();
        float base = inc - run;
        for (int w2 = 0; w2 < wid; ++w2) base += sTmp[w2];
        __syncthreads();
        float av[8], mloc = -3.0e38f, cm[8];
#pragma unroll
        for (int k = 0; k < 8; ++k) { cs[k] += base; av[k] = li[k] - cs[k]; mloc = fmaxf(mloc, av[k]); cm[k] = mloc; }
        float minc = mloc;
#pragma unroll
        for (int o = 1; o < 64; o <<= 1) { const float t = bperm(minc, lane >= o ? lane - o : lane); if (lane >= o) minc = fmaxf(minc, t); }
        if (lane == 63) sTmp[wid] = minc;
        __syncthreads();
        float mbase = bperm(minc, lane > 0 ? lane - 1 : 0); if (lane == 0) mbase = -3.0e38f;
        for (int w2 = 0; w2 < wid; ++w2) mbase = fmaxf(mbase, sTmp[w2]);
#pragma unroll
        for (int k = 0; k < 8; ++k) {
            const float Mt = fmaxf(mbase, cm[k]);
            scal[0 * SEQ + 8 * tid + k] = av[k]; scal[1 * SEQ + 8 * tid + k] = Mt; scal[2 * SEQ + 8 * tid + k] = __expf(-(cs[k] + Mt));
        }
        ((LAS float*)(lds + NS_OFF))[tid] = 0.f; ((LAS float*)(lds + NS_OFF))[512 + tid] = 0.f;
        __threadfence();
        __syncthreads();
    }
    f32x16 cst[4];
#pragma unroll
    for (int i = 0; i < 4; ++i) cst[i] = (f32x16){};
    const char* qb = (const char*)T.q + (size_t)bh * NCHUNK * 65536 + (size_t)dq * 16384;
    const char* kb = (const char*)T.k + (size_t)bh * NCHUNK * 65536 + (size_t)dq * 16384;
    const char* vb = (const char*)T.v + (size_t)bh * NCHUNK * 65536 + (size_t)(es * 2 + eg) * 4096;
    const char* sb = (const char*)T.S + (size_t)bh * NCHUNK * 8192 + (size_t)dq * 2048;
    const unsigned loff = (unsigned)lane * 16u;
    const float* sa = scal; const float* sm = scal + SEQ; const float* sthr = scal + 2 * SEQ;
    bf16* hg = T.hm + (size_t)b * SEQ * 2048 + 512 * h + 64 * es;
    int zv = 0; asm volatile("" : "+v"(zv));
    float Mc = sm[zv];
    LAS float* sca = (LAS float*)(lds + SCW_OFF) + wid * 128;
    bf16x8 fb[16]; bf16x8 sf[2]; bf16x8 vfr[4];
    float a_l, m_l, thr_l;
#pragma unroll
    for (int f = 0; f < 16; ++f) fb[f] = *(const bf16x8*)(qb + f * 1024 + loff);
    sf[0] = *(const bf16x8*)(sb + loff); sf[1] = *(const bf16x8*)(sb + 1024 + loff);
#pragma unroll
    for (int ks = 0; ks < 4; ++ks) vfr[ks] = *(const bf16x8*)(vb + ks * 1024 + loff);
    a_l = sa[lane]; m_l = sm[lane]; thr_l = sthr[lane];
#pragma unroll 1
    for (int c = 0; c < NCHUNK; ++c) {
        const int cur = c & 1;
        LAS float* nsc = (LAS float*)(lds + NS_OFF) + cur * 512; LAS float* nsn = (LAS float*)(lds + NS_OFF) + (cur ^ 1) * 512;
        LAS float* denp = (LAS float*)(lds + DEN_OFF) + cur * 256;
        LAS unsigned char* pbuf = lds + P_OFF + cur * 65536;
        const char* kc = kb + (size_t)c * 65536;
        const int cn = (c + 1 < NCHUNK) ? c + 1 : c;
        const char* qn_ = qb + (size_t)cn * 65536; const char* sn_ = sb + (size_t)cn * 8192; const char* vn_ = vb + (size_t)cn * 65536;
        const float Mc2 = bperm(m_l, 63 + zv);
        const float Mt0 = bperm(m_l, l31), Mt1 = bperm(m_l, 32 + l31);
        const float thr0 = bperm(thr_l, l31), thr1 = bperm(thr_l, 32 + l31);
        sca[lane] = a_l; sca[64 + lane] = __expf(a_l - Mc2);
        a_l = sa[64 * cn + lane]; m_l = sm[64 * cn + lane]; thr_l = sthr[64 * cn + lane];
        bf16x8 pf[2]; float psum_own = 0.f;
        {
            const f32x4 aown0 = *(const LAS f32x4*)(sca + 16 * dq + 4 * hi), aown1 = *(const LAS f32x4*)(sca + 16 * dq + 8 + 4 * hi);
            const float aw[8] = {aown0[0], aown0[1], aown0[2], aown0[3], aown1[0], aown1[1], aown1[2], aown1[3]};
#pragma unroll
            for (int tt = 0; tt < 2; ++tt) {
                const int t = 32 * tt + l31; const float Mt = tt ? Mt1 : Mt0;
                float sv[8]; unpack8(sf[tt], sv);
                float pw[8]; float ps = 0.f;
#pragma unroll
                for (int j = 0; j < 8; ++j) { const int s = 16 * dq + 8 * (j >> 2) + 4 * hi + (j & 3); pw[j] = (s <= t) ? sv[j] * __expf(aw[j] - Mt) : 0.f; ps += pw[j]; }
                pf[tt] = pack8(pw[0], pw[1], pw[2], pw[3], pw[4], pw[5], pw[6], pw[7]);
                if (tt == eg) psum_own = ps;
            }
            sf[0] = *(const bf16x8*)(sn_ + loff); sf[1] = *(const bf16x8*)(sn_ + 1024 + loff);
        }
        f32x16 ao[2]; ao[0] = (f32x16){}; ao[1] = (f32x16){};
        float qn = 0.f;
#pragma unroll
        for (int i = 0; i < 4; ++i)
#pragma unroll
            for (int s = 0; s < 2; ++s) {
                const int g0 = (i * 2 + s) * 2;
                const bf16x8 cb = pack8(cst[i][8 * s + 0], cst[i][8 * s + 1], cst[i][8 * s + 2], cst[i][8 * s + 3], cst[i][8 * s + 4], cst[i][8 * s + 5], cst[i][8 * s + 6], cst[i][8 * s + 7]);
                ao[0] = MFMA32(cb, fb[g0], ao[0]);
                ao[1] = MFMA32(cb, fb[g0 + 1], ao[1]);
                {
                    float qv[8]; unpack8(eg ? fb[g0 + 1] : fb[g0], qv);
                    const f32x4 n0 = *(const LAS f32x4*)(nsc + 128 * dq + 32 * i + 16 * s + 4 * hi), n1 = *(const LAS f32x4*)(nsc + 128 * dq + 32 * i + 16 * s + 8 + 4 * hi);
                    qn += qv[0] * n0[0] + qv[1] * n0[1] + qv[2] * n0[2] + qv[3] * n0[3] + qv[4] * n1[0] + qv[5] * n1[1] + qv[6] * n1[2] + qv[7] * n1[3];
                }
                fb[g0] = *(const bf16x8*)(kc + (((g0) & 3) * 4 + ((g0) >> 2)) * 1024 + loff);
                fb[g0 + 1] = *(const bf16x8*)(kc + (((g0 + 1) & 3) * 4 + ((g0 + 1) >> 2)) * 1024 + loff);
                __builtin_amdgcn_sched_barrier(0);
            }
        {
            const float Mt = eg ? Mt1 : Mt0;
            float d = __expf(Mc - Mt) * qn + psum_own;
            d += bperm(d, lane ^ 32);
            if (hi == 0) denp[dq * 64 + 32 * eg + l31] = d;
            const float rs0 = __expf(Mc - Mt0), rs1 = __expf(Mc - Mt1);
#pragma unroll
            for (int r = 0; r < 16; ++r) { ao[0][r] *= rs0; ao[1][r] *= rs1; }
        }
        ao[0] = MFMA32(dq == 0 ? vfr[0] : dq == 1 ? vfr[1] : dq == 2 ? vfr[2] : vfr[3], pf[0], ao[0]);
        ao[1] = MFMA32(dq == 0 ? vfr[0] : dq == 1 ? vfr[1] : dq == 2 ? vfr[2] : vfr[3], pf[1], ao[1]);
#pragma unroll
        for (int g = 0; g < 4; ++g)
#pragma unroll
            for (int tt = 0; tt < 2; ++tt)
                *(LAS f32x4*)(pbuf + ((((dq * 2 + eg) * 4 + g) * 2 + tt) * 1024) + lane * 16) = (f32x4){ao[tt][4 * g], ao[tt][4 * g + 1], ao[tt][4 * g + 2], ao[tt][4 * g + 3]};
        const float decay = __expf(Mc - Mc2);
#pragma unroll
        for (int i = 0; i < 4; ++i)
#pragma unroll
            for (int r = 0; r < 16; ++r) cst[i][r] *= decay;
        float nacc[2] = {0.f, 0.f};
#pragma unroll
        for (int ks = 0; ks < 4; ++ks) {
            const f32x4 c0 = *(const LAS f32x4*)(sca + 64 + 16 * ks + 4 * hi), c1 = *(const LAS f32x4*)(sca + 64 + 16 * ks + 8 + 4 * hi);
            const float cw[8] = {c0[0], c0[1], c0[2], c0[3], c1[0], c1[1], c1[2], c1[3]};
            float vv[8]; unpack8(vfr[ks], vv);
            const bf16x8 vw = pack8(vv[0] * cw[0], vv[1] * cw[1], vv[2] * cw[2], vv[3] * cw[3], vv[4] * cw[4], vv[5] * cw[5], vv[6] * cw[6], vv[7] * cw[7]);
            vfr[ks] = *(const bf16x8*)(vn_ + ks * 1024 + loff);
#pragma unroll
            for (int i = 0; i < 4; ++i) {
                const int g = ks * 4 + i;
                cst[i] = MFMA32(fb[g], vw, cst[i]);
                if ((i >> 1) == eg) {
                    float kv[8]; unpack8(fb[g], kv);
                    nacc[i & 1] += kv[0] * cw[0] + kv[1] * cw[1] + kv[2] * cw[2] + kv[3] * cw[3] + kv[4] * cw[4] + kv[5] * cw[5] + kv[6] * cw[6] + kv[7] * cw[7];
                }
                fb[g] = *(const bf16x8*)(qn_ + g * 1024 + loff);
                __builtin_amdgcn_sched_barrier(0);
            }
        }
#pragma unroll
        for (int ii = 0; ii < 2; ++ii) {
            float v = nacc[ii]; v += bperm(v, lane ^ 32);
            const int dk = 128 * dq + 32 * (2 * eg + ii) + l31;
            if (hi == 0) nsn[dk] = decay * nsc[dk] + v;
        }
        __syncthreads();
#pragma unroll
        for (int tt = 0; tt < 2; ++tt) {
            f32x4 nm = {0.f, 0.f, 0.f, 0.f};
#pragma unroll
            for (int src = 0; src < 4; ++src) nm += *(const LAS f32x4*)(pbuf + ((((src * 2 + eg) * 4 + dq) * 2 + tt) * 1024) + lane * 16);
            const int t = 32 * tt + l31;
            const float den = denp[t] + denp[64 + t] + denp[128 + t] + denp[192 + t];
            const float dn = fmaxf(fabsf(den), tt ? thr1 : thr0);
            const float inv = 1.0f / dn;
            v2u wv; wv.x = pk2(nm[0] * inv, nm[1] * inv); wv.y = pk2(nm[2] * inv, nm[3] * inv);
            *(v2u*)(hg + (size_t)(64 * c + t) * 2048 + 32 * eg + 8 * dq + 4 * hi) = wv;
        }
        Mc = Mc2;
    }
    __syncthreads();
}
DI void phase(LAS unsigned char* lds, const Tensors& T, int G, int blk, int wv) {
#pragma unroll 1
    for (int u = blk; u < 256; u += G) {
        const int xcd = u & 7, j = u >> 3;
        unit(lds, T, xcd * 4 + (j >> 3), j & 7, wv);
    }
}
}
namespace mpost {
constexpr int GSTR = 576;
constexpr int XC_OFF = 0, WV_OFF = 128 * GSTR, LDS_BYTES = WV_OFF + 128 * 64;
struct Tensors { bf16* hm; const bf16* om; const bf16* kimg; const float* wv; const float* hng; const float* skip; };

DI void unit(LAS unsigned char* lds, const Tensors& T, int u, int tid_in) {
    const int tid_ = wg_tid_local(tid_in);
    const int tid = tid_;
    const int h = u & 3, c = (u >> 2) & 63, b = u >> 8;
#pragma unroll
    for (int k = 0; k < 2; ++k) {
        const int id = tid + 512 * k, pb = id & 7, g = id >> 3, ks = pb >> 1, hi_ = pb & 1;
        const char* src = (const char*)T.kimg + ((size_t)((b * 4 + h) * 64 + c) * 64 + (g >> 3) * 4 + ks) * 1024 + (4 * (g & 7) + 32 * hi_) * 16;
        const v4u r0 = *(const v4u*)(src), r1 = *(const v4u*)(src + 16), r2 = *(const v4u*)(src + 32), r3 = *(const v4u*)(src + 48);
        const unsigned a0[4] = {r0.x, r0.y, r0.z, r0.w}, a1[4] = {r1.x, r1.y, r1.z, r1.w}, a2[4] = {r2.x, r2.y, r2.z, r2.w}, a3[4] = {r3.x, r3.y, r3.z, r3.w};
#pragma unroll
        for (int m = 0; m < 4; ++m) {
            const int tok = 16 * ks + 8 * (m >> 1) + 4 * hi_ + 2 * (m & 1);
            v2u e0, e1;
            e0.x = (a0[m] & 0xffffu) | (a1[m] << 16); e0.y = (a2[m] & 0xffffu) | (a3[m] << 16);
            e1.x = (a0[m] >> 16) | (a1[m] & 0xffff0000u); e1.y = (a2[m] >> 16) | (a3[m] & 0xffff0000u);
            *(LAS v2u*)(lds + XC_OFF + g * GSTR + tok * 8) = e0;
            *(LAS v2u*)(lds + XC_OFF + g * GSTR + (tok + 1) * 8) = e1;
        }
    }
    *(LAS f32x4*)(lds + WV_OFF + tid * 16) = *(const f32x4*)(T.wv + (size_t)(128 * h) * 16 + tid * 4);
    __syncthreads();
    const int t5 = tid >> 4, seg = tid & 15;
#pragma unroll 1
    for (int pass = 0; pass < 2; ++pass) {
        const int t = t5 + 32 * pass;
        const size_t rowu = ((size_t)b * SEQ + 64 * c + 32 * pass) * 2048 + 512 * h;
        char* hmb = (char*)(T.hm + rowu); const char* omb = (const char*)(T.om + rowu);
        const char* gnb = (const char*)(T.hng + 512 * h); const char* skb = (const char*)(T.skip + 512 * h);
        const unsigned voff = (unsigned)(t5 * 4096 + seg * 8), soff = (unsigned)(seg * 16);
        float uv[32];
        float sum = 0.f;
#pragma unroll
        for (int k = 0; k < 8; ++k) {
            const int gi = seg + 16 * k;
            const v2u hx = *(const v2u*)(hmb + voff + k * 128);
            const v2u og = *(const v2u*)(omb + voff + k * 128);
            const float hv[4] = {bflo(hx.x), bfhi(hx.x), bflo(hx.y), bfhi(hx.y)};
            const float ov[4] = {bflo(og.x), bfhi(og.x), bflo(og.y), bfhi(og.y)};
            const LAS f32x4* wp = (const LAS f32x4*)(lds + WV_OFF + gi * 64);
            const f32x4 w0 = wp[0], w1 = wp[1], w2 = wp[2], w3 = wp[3];
#pragma unroll
            for (int o = 0; o < 4; ++o) {
                const float v = hv[0] * w0[o] + hv[1] * w1[o] + hv[2] * w2[o] + hv[3] * w3[o];
                const float x = v * ov[o];
                uv[4 * k + o] = x; sum += x;
            }
            if (k & 1) __builtin_amdgcn_sched_barrier(0);
        }
        sum += __shfl_xor(sum, 1); sum += __shfl_xor(sum, 2); sum += __shfl_xor(sum, 4); sum += __shfl_xor(sum, 8);
        const float mean = sum * (1.0f / 512.0f);
        float sq = 0.f;
#pragma unroll
        for (int i = 0; i < 32; ++i) { const float d = uv[i] - mean; sq += d * d; }
        sq += __shfl_xor(sq, 1); sq += __shfl_xor(sq, 2); sq += __shfl_xor(sq, 4); sq += __shfl_xor(sq, 8);
        const float rstd = 1.0f / sqrtf(sq * (1.0f / 512.0f) + EPS);
#pragma unroll
        for (int k = 0; k < 8; ++k) {
            const int gi = seg + 16 * k;
            const f32x4 gn = *(const f32x4*)(gnb + soff + k * 256), sk = *(const f32x4*)(skb + soff + k * 256);
            const v2u xc = *(const LAS v2u*)(lds + XC_OFF + gi * GSTR + t * 8);
            const float xv[4] = {bflo(xc.x), bfhi(xc.x), bflo(xc.y), bfhi(xc.y)};
            float r[4];
#pragma unroll
            for (int o = 0; o < 4; ++o) r[o] = (uv[4 * k + o] - mean) * rstd * gn[o] + sk[o] * xv[o];
            v2u wv; wv.x = pk2(r[0], r[1]); wv.y = pk2(r[2], r[3]);
            *(v2u*)(hmb + voff + k * 128) = wv;
        }
    }
    __syncthreads();
}
DI void phase(LAS unsigned char* lds, const Tensors& T, int G, int blk, int wv) {
    for (int u = blk; u < BATCH * NCHUNK * MH; u += G) unit(lds, T, u, wv);
}
}

DI void transpose_item(const float* W, int K, int N, bf16* WT, const float* kscale, LAS float* scr, int item, int lane) {
    const int nblk = N / 32, kb = item / nblk, nb = item % nblk, k0 = 64 * kb, n0 = 32 * nb;
#pragma unroll 8
    for (int i = 0; i < 32; ++i) { const int kk = 2 * i + (lane >> 5); float v = W[(size_t)(k0 + kk) * N + n0 + (lane & 31)]; if (kscale) v *= kscale[k0 + kk]; scr[kk * 33 + (lane & 31)] = v; }
    asm volatile("s_waitcnt lgkmcnt(0)" ::: "memory");
    const int cc = lane & 7;
#pragma unroll
    for (int j = 0; j < 4; ++j) { const int n = (lane >> 3) + 8 * j; const LAS float* s = scr + (8 * cc) * 33 + n;
        v4u o; o.x = pk2(s[0 * 33], s[1 * 33]); o.y = pk2(s[2 * 33], s[3 * 33]); o.z = pk2(s[4 * 33], s[5 * 33]); o.w = pk2(s[6 * 33], s[7 * 33]);
        *(v4u*)(WT + (size_t)(n0 + n) * K + k0 + 8 * cc) = o; }
    asm volatile("s_waitcnt lgkmcnt(0)" ::: "memory");
}
DI void rms_row_to_bf16(const float* xrow, bf16* orow, int lane) {
    const f32x4* xr = (const f32x4*)xrow + lane;
    f32x4 v[4]; float s = 0.f;
#pragma unroll
    for (int j = 0; j < 4; ++j) { v[j] = xr[64 * j]; s += (v[j][0] * v[j][0] + v[j][1] * v[j][1]) + (v[j][2] * v[j][2] + v[j][3] * v[j][3]); }
    const float r = 1.0f / sqrtf(wave_sum(s) * (1.0f / 1024.0f) + EPS);
    v2u* o8 = (v2u*)orow + lane;
#pragma unroll
    for (int j = 0; j < 4; ++j) { v2u w; w.x = pk2(v[j][0] * r, v[j][1] * r); w.y = pk2(v[j][2] * r, v[j][3] * r); o8[64 * j] = w; }
}
DI void rms_row_inplace(float* row, const float* g, int lane) {
    f32x4* xr = (f32x4*)row + lane; const f32x4* gr = (const f32x4*)g + lane;
    f32x4 v[4]; float s = 0.f;
#pragma unroll
    for (int j = 0; j < 4; ++j) { v[j] = xr[64 * j]; s += (v[j][0] * v[j][0] + v[j][1] * v[j][1]) + (v[j][2] * v[j][2] + v[j][3] * v[j][3]); }
    const float r = 1.0f / sqrtf(wave_sum(s) * (1.0f / 1024.0f) + EPS);
#pragma unroll
    for (int j = 0; j < 4; ++j) xr[64 * j] = v[j] * r * gr[64 * j];
}
constexpr int N_PHASES = 15;
constexpr int LDS_TOTAL = 163840, XB_LDS_OFF = 163840 - 16;
static_assert(pg8::STAGE_BYTES <= XB_LDS_OFF && att::LDS_BYTES <= XB_LDS_OFF && mpre::LDS_BYTES <= XB_LDS_OFF && mscan::LDS_BYTES <= XB_LDS_OFF && mpost::LDS_BYTES <= XB_LDS_OFF, "LDS map vs barrier words");
static_assert(pg8::STAGE_BYTES <= LDS_TOTAL && att::LDS_BYTES <= LDS_TOTAL && mpre::LDS_BYTES <= LDS_TOTAL && mscan::LDS_BYTES <= LDS_TOTAL && mpost::LDS_BYTES <= LDS_TOTAL, "LDS map");

struct Args { const float* in[18]; float* out; unsigned char* ws; int ph_lo, ph_hi; };

DI void prologue(const Args& a, LAS unsigned char* lds, int G, int blk, int wvi) {
    const int tid = wg_tid_local(wvi), lane = tid & 63, wave = __builtin_amdgcn_readfirstlane(tid >> 6);
    unsigned char* ws = a.ws;
    LAS float* scr = (LAS float*)(lds + wave * 16384);
    const int gw = blk * NWAVES + wave, NGW = G * NWAVES;
    constexpr int I_IN = (DM / 64) * (NIN / 32), I_PA = (AW / 64) * (DM / 32), I_PB = (MW / 64) * (DM / 32), I_OUT = (DM / 64) * (DM / 32);
    constexpr int NITEMS = I_IN + I_PA + I_PB + I_OUT;
    for (int it = gw; it < NITEMS; it += NGW) {
        int r = it;
        if (r < I_IN) { transpose_item(a.in[2], DM, NIN, (bf16*)(ws + WS_WIN), a.in[1], scr, r, lane); continue; } r -= I_IN;
        if (r < I_PA) { transpose_item(a.in[13], AW, DM, (bf16*)(ws + WS_WPA), nullptr, scr, r, lane); continue; } r -= I_PA;
        if (r < I_PB) { transpose_item(a.in[14], MW, DM, (bf16*)(ws + WS_WPB), nullptr, scr, r, lane); continue; } r -= I_PB;
        transpose_item(a.in[15], DM, DM, (bf16*)(ws + WS_WOUT), nullptr, scr, r, lane);
    }
    for (int m = gw; m < MTOK; m += NGW) rms_row_to_bf16(a.in[0] + (size_t)m * DM, (bf16*)(ws + WS_XN) + (size_t)m * DM, lane);
    float* tab = (float*)(ws + WS_TAB);
    const float* wq = a.in[6]; const float* wk = a.in[7]; const float* wv = a.in[8]; const float* wif = a.in[9]; const float* rb = a.in[16];
    const int gt = blk * NTHR + tid, NGT = G * NTHR;
    for (int i = gt; i < 2048 * 8; i += NGT) {
        const int c = i >> 3, j = i & 7, g = c >> 2, ii = c & 3;
        float sc = 0.f, sm = 0.f;
#pragma unroll
        for (int o = 0; o < 4; ++o) {
            sc += wq[g * 16 + ii * 4 + o] * wif[(size_t)(4 * g + o) * 8 + j] + wk[g * 16 + ii * 4 + o] * wif[(size_t)(2048 + 4 * g + o) * 8 + j];
            sm += wv[g * 16 + ii * 4 + o] * wif[(size_t)(4096 + 4 * g + o) * 8 + j];
        }
        ((bf16*)(tab + TAB_WC))[j * 2048 + c] = (bf16)(pk2(sc, 0.f) & 0xffffu); ((bf16*)(tab + TAB_WM))[j * 2048 + c] = (bf16)(pk2(sm, 0.f) & 0xffffu);
    }
    for (int i = gt; i < 512 * 16; i += NGT) {
        const int g = i >> 4, ii = (i >> 2) & 3, i2 = i & 3;
        float s = 0.f;
#pragma unroll
        for (int o = 0; o < 4; ++o) s += wq[g * 16 + ii * 4 + o] * wk[g * 16 + i2 * 4 + o];
        tab[TAB_G + i] = s * 0.04419417382415922f;
    }
    for (int i = gt; i < 3 * 16 * 132; i += NGT) {
        const int d = i % 132, ph = i / 132, p = ph >> 4, hh = ph & 15;
        tab[TAB_BIAS + i] = rb[BUCKET[p][d] * 16 + hh] * LOG2E;
    }
}

#define XB_TMO      128
#define XB_XCNT(j)  (256  + 64 * (j))
#define XB_XSUB(j)  (1280 + 64 * (j))
#define XB_XGEN(j)  (2304 + 64 * (j))
#define XB_TOP      3328
#define XB_TOPGEN   3392
#define XCD_BAR_WORDS 3456
#define XB_SPIN_CAP (1u << 18)
DI unsigned xb_ld(unsigned* p)              { return __hip_atomic_load(p, __ATOMIC_RELAXED, __HIP_MEMORY_SCOPE_AGENT); }
DI unsigned xb_add(unsigned* p, unsigned v) { return __hip_atomic_fetch_add(p, v, __ATOMIC_RELAXED, __HIP_MEMORY_SCOPE_AGENT); }
DI unsigned xb_xcc_id() { return (unsigned)__builtin_amdgcn_s_getreg((3 << 11) | 20) & 0xFu; }
#define XB_SPIN(cond, bar) do { unsigned _sp = 0; while (cond) { __builtin_amdgcn_s_sleep(1); \
    if ((++_sp & 255u) == 0u) { if (xb_ld(&(bar)[XB_TMO])) break; if (_sp > XB_SPIN_CAP) { atomicAdd(&(bar)[XB_TMO], 1u); break; } } } } while (0)
struct XcdBarrier { unsigned* bar; unsigned x; volatile LAS unsigned* st; };
DI XcdBarrier xcd_barrier_post(unsigned* bar, volatile LAS unsigned* st, int tid) {
    XcdBarrier b; b.bar = bar; b.x = xb_xcc_id(); b.st = st;
    if (tid == 0) (void)xb_add(&bar[XB_XCNT(b.x)], 1u);
    return b;
}
DI void xcd_barrier_complete(unsigned* bar, unsigned x, unsigned& nloc, unsigned& nx) {
    const unsigned G = gridDim.x * gridDim.y * gridDim.z;
    unsigned sum, cnt, mine, sp = 0u;
    for (;;) {
        sum = 0u; cnt = 0u; mine = 0u;
#pragma unroll
        for (unsigned j = 0; j < 16; ++j) { const unsigned c = xb_ld(&bar[XB_XCNT(j)]); sum += c; cnt += (c > 0u) ? 1u : 0u; mine = (j == x) ? c : mine; }
        if (sum == G) break;
        __builtin_amdgcn_s_sleep(1);
        if ((++sp & 255u) == 0u) { if (xb_ld(&bar[XB_TMO])) break; if (sp > XB_SPIN_CAP) { atomicAdd(&bar[XB_TMO], 1u); break; } }
    }
    nloc = mine > 0u ? mine : 1u; nx = cnt > 0u ? cnt : 1u;
}
DI void xcd_barrier(const XcdBarrier& b, int tid) {
    asm volatile("s_waitcnt vmcnt(0)" ::: "memory");
    __syncthreads();
    if (tid == 0) {
        unsigned* bar = b.bar;
        __builtin_amdgcn_s_waitcnt(0);
        unsigned nloc = b.st[0], nx = b.st[1];
        if (nloc == 0u) { xcd_barrier_complete(bar, b.x, nloc, nx); b.st[0] = nloc; b.st[1] = nx; }
        const unsigned old = xb_add(&bar[XB_XSUB(b.x)], 1u);
        const unsigned gen = old / nloc;
        if (old + 1u == (gen + 1u) * nloc) {
            __builtin_amdgcn_fence(__ATOMIC_RELEASE, "agent");
            asm volatile("s_waitcnt vmcnt(0)" ::: "memory");
            const unsigned og = xb_add(&bar[XB_TOP], 1u);
            const unsigned tg = og / nx;
            if (og + 1u == (tg + 1u) * nx) xb_add(&bar[XB_TOPGEN], 1u);
            else XB_SPIN(xb_ld(&bar[XB_TOPGEN]) == tg, bar);
            __builtin_amdgcn_fence(__ATOMIC_ACQUIRE, "agent");
            xb_add(&bar[XB_XGEN(b.x)], 1u);
            asm volatile("s_waitcnt vmcnt(0)" ::: "memory");
        } else {
            XB_SPIN(xb_ld(&bar[XB_XGEN(b.x)]) == gen, bar);
            __builtin_amdgcn_fence(__ATOMIC_ACQUIRE, "agent");
            asm volatile("s_waitcnt vmcnt(0)" ::: "memory");
        }
    }
    __syncthreads();
}

DI void grid_sync_(int tid) {
    asm volatile("s_waitcnt vmcnt(0) lgkmcnt(0)" ::: "memory");
    __builtin_amdgcn_fence(__ATOMIC_RELEASE, "workgroup");
    __builtin_amdgcn_s_barrier();
    if (tid == 0) {
        __builtin_amdgcn_fence(__ATOMIC_ACQUIRE, "workgroup");
        __builtin_amdgcn_fence(__ATOMIC_RELEASE, "agent");
        const __attribute__((address_space(4))) char* ia = (const __attribute__((address_space(4))) char*)__builtin_amdgcn_implicitarg_ptr();
        const unsigned long long p = *(const __attribute__((address_space(4))) unsigned long long*)(ia + 88);
        unsigned* bar = (unsigned*)(p + 32);
        const unsigned nwg = *(const unsigned*)(p + 40);
        const unsigned old = __hip_atomic_fetch_add(bar, 1u, __ATOMIC_RELAXED, __HIP_MEMORY_SCOPE_AGENT);
        if ((old & 0xffffu) == nwg - 1u) (void)__hip_atomic_fetch_add(bar, 65536u - nwg, __ATOMIC_RELAXED, __HIP_MEMORY_SCOPE_AGENT);
        const unsigned gen = old & 0xffff0000u;
        while ((__hip_atomic_load(bar, __ATOMIC_RELAXED, __HIP_MEMORY_SCOPE_AGENT) & 0xffff0000u) == gen) __builtin_amdgcn_s_sleep(1);
        __builtin_amdgcn_fence(__ATOMIC_ACQUIRE, "agent");
        __builtin_amdgcn_fence(__ATOMIC_RELEASE, "workgroup");
    }
    __builtin_amdgcn_s_barrier();
    __builtin_amdgcn_fence(__ATOMIC_ACQUIRE, "workgroup");
}

__global__ void __launch_bounds__(NTHR) mk_fwd(Args a) {
    extern __shared__ __attribute__((aligned(16))) unsigned char lds_raw[];
    LAS unsigned char* lds = (LAS unsigned char*)lds_raw;
    const int G = gridDim.x, blk = blockIdx.x;
    const int wv = __builtin_amdgcn_readfirstlane(threadIdx.x >> 6);
    volatile LAS unsigned* bst = (volatile LAS unsigned*)(lds + XB_LDS_OFF);
    if (wg_tid_local(wv) < 4) bst[wg_tid_local(wv)] = 0u;
    __syncthreads();
    (void)xcd_barrier_post((unsigned*)(a.ws + WS_CTL) + 1024, bst, wg_tid_local(wv));
#define XBAR() do { XcdBarrier xb_; xb_.bar = (unsigned*)(a.ws + WS_CTL) + 1024; xb_.x = xb_xcc_id(); xb_.st = (volatile LAS unsigned*)(lds + XB_LDS_OFF); xcd_barrier(xb_, wg_tid_local(wv)); } while (0)
    unsigned char* ws = a.ws;
    const int lo = a.ph_lo, hi = a.ph_hi;
    bf16* XN = (bf16*)(ws + WS_XN); bf16* WIN = (bf16*)(ws + WS_WIN);
#ifndef PH_MASK
#define PH_MASK 0x7fff
#endif
#define IN(k) (((PH_MASK >> (k)) & 1) && lo <= (k) && (k) < hi)
#ifndef REP_MASK
#define REP_MASK 0
#endif
#define REPEAT(k, body) do { body; if ((REP_MASK >> (k)) & 1) { XBAR(); body; } } while (0)
#define SEAM(k) do { if (IN(k) && IN((k) + 1)) { if (lo < 0) grid_sync_(wg_tid_local(wv)); XBAR(); } } while (0)
#define GEMM_PHASE(EPI, E, Aop, Bop, NN, KK) do { pg8::Gemm g{(const pg8::bf16_t*)(Aop), (const pg8::bf16_t*)(Bop), MTOK, (NN), (KK)}; pg8::StaticOrder S; S.init(MTOK, (NN), G, blk); \
        pg8::gemm_phase<EPI, pg8::StaticOrder, true, true>(lds, g, S, E, wg_tid_local(wv)); } while (0)

    if (IN(0)) { REPEAT(0, prologue(a, lds, G, blk, wv)); } SEAM(0);
    if (IN(1)) {
        pg8::EpiXM E{(bf16*)(ws + WS_R0), (bf16*)(ws + WS_HALO)};
        REPEAT(1, GEMM_PHASE(pg8::EpiXM, E, XN, WIN + (size_t)C_XM * DM, MW, DM));
    } SEAM(1);
    if (IN(2)) {
        const float* tab = (const float*)(ws + WS_TAB);
        mpre::Tensors T{(const bf16*)(ws + WS_R0), (const bf16*)(ws + WS_HALO), (bf16*)(ws + WS_R1), (bf16*)a.out, (bf16*)(ws + WS_R2), (float*)(ws + WS_GP), (bf16*)(ws + WS_S), a.in[4], a.in[5], (const bf16*)(tab + TAB_WC), (const bf16*)(tab + TAB_WM), tab + TAB_G};
        REPEAT(2, mpre::phase(lds, T, G, blk, wv));
    } SEAM(2);
    if (IN(3)) {
        mscan::Tensors T{(const bf16*)(ws + WS_R2), (const bf16*)(ws + WS_R1), (const bf16*)a.out, (const bf16*)(ws + WS_S), (const float*)(ws + WS_GP), a.in[10], (float*)(ws + WS_SCAL), (bf16*)(ws + WS_R0)};
        REPEAT(3, mscan::phase(lds, T, G, blk, wv));
    } SEAM(3);
    if (IN(4)) {
        pg8::EpiSig E{(bf16*)(ws + WS_R2), MW, nullptr};
        REPEAT(4, GEMM_PHASE(pg8::EpiSig, E, XN, WIN + (size_t)C_OM * DM, MW, DM));
    } SEAM(4);
    if (IN(5)) {
        mpost::Tensors T{(bf16*)(ws + WS_R0), (const bf16*)(ws + WS_R2), (const bf16*)(ws + WS_R1), a.in[8], a.in[11], a.in[12]};
        mpost::phase(lds, T, G, blk, wv);
    } SEAM(5);
    if (IN(6)) {
        pg8::EpiZM E{(bf16*)(ws + WS_R0)};
        GEMM_PHASE(pg8::EpiZM, E, XN, WIN + (size_t)C_ZM * DM, MW, DM);
    } SEAM(6);
    if (IN(7)) {
        pg8::EpiQKV E{(bf16*)(ws + WS_QA), (size_t)(WS_KA - WS_QA) / 2};
        REPEAT(7, GEMM_PHASE(pg8::EpiQKV, E, XN, WIN + (size_t)C_QA * DM, 3 * AW, DM));
    } SEAM(7);
    if (IN(8)) {
        att::Tensors T{(const bf16*)(ws + WS_QA), (const bf16*)(ws + WS_KA), (const bf16*)(ws + WS_VA), (bf16*)(ws + WS_O1), (bf16*)a.out, (float*)(ws + WS_ST), (const float*)(ws + WS_TAB) + TAB_BIAS};
        REPEAT(8, att::phase(lds, T, G, blk, wv));
    } SEAM(8);
    if (IN(9)) {
        pg8::EpiZA E{(const bf16*)(ws + WS_O1), (const bf16*)a.out, (const bf16*)a.out + (size_t)MTOK * AW, (const float*)(ws + WS_ST), (bf16*)(ws + WS_A1)};
        REPEAT(9, GEMM_PHASE(pg8::EpiZA, E, XN, WIN + (size_t)C_ZA * DM, AW, DM));
    } SEAM(9);
    if (IN(10)) {
        pg8::EpiSig E{(bf16*)(ws + WS_G), 2 * DM, a.in[3]};
        REPEAT(10, GEMM_PHASE(pg8::EpiSig, E, XN, WIN + (size_t)C_G * DM, 2 * DM, DM));
    } SEAM(10);
    if (IN(11)) {
        pg8::EpiYA E{(bf16*)(ws + WS_G)};
        GEMM_PHASE(pg8::EpiYA, E, ws + WS_A1, ws + WS_WPA, DM, AW);
    } SEAM(11);
    if (IN(12)) {
        pg8::EpiYM E{(const bf16*)(ws + WS_G), (bf16*)(ws + WS_MRG)};
        REPEAT(12, GEMM_PHASE(pg8::EpiYM, E, ws + WS_R0, ws + WS_WPB, DM, MW));
    } SEAM(12);
    if (IN(13)) {
        pg8::EpiOut E{a.in[0], a.out};
        REPEAT(13, GEMM_PHASE(pg8::EpiOut, E, ws + WS_MRG, ws + WS_WOUT, DM, DM));
    } SEAM(13);
#ifdef EXTRA_SYNCS
    if (IN(13) && IN(14)) { for (int i = 0; i < EXTRA_SYNCS; ++i) XBAR(); }
#endif
    if (IN(14)) {
        const int lane = wg_tid_local(wv) & 63, wave = wv;
        for (int m = blk * NWAVES + wave; m < MTOK; m += G * NWAVES) rms_row_inplace(a.out + (size_t)m * DM, a.in[17], lane);
    }
#undef IN
#undef SEAM
#undef GEMM_PHASE
}

#ifndef MK_ONE_LAUNCH
#define MK_ONE_LAUNCH 0
#endif
extern "C" void kernel_launch(void* const* d_in, const int* in_sizes, int n_in, void* d_out, int out_size, void* d_ws, size_t ws_size, hipStream_t stream) {
    static int grid = 0;
    if (grid == 0) {
        if (n_in != 18 || in_sizes[0] != MTOK * DM || out_size != MTOK * DM || ws_size < WS_END) { fprintf(stderr, "kernel_launch: unexpected shapes (n_in %d, ws %zu)\n", n_in, ws_size); grid = -1; return; }
        int dev = 0, cus = 0, per_cu = 0;
        (void)hipGetDevice(&dev); (void)hipDeviceGetAttribute(&cus, hipDeviceAttributeMultiprocessorCount, dev);
        if (hipFuncSetAttribute((const void*)mk_fwd, hipFuncAttributeMaxDynamicSharedMemorySize, LDS_TOTAL) != hipSuccess) { fprintf(stderr, "kernel_launch: hipFuncSetAttribute failed\n"); grid = -1; return; }
        if (hipOccupancyMaxActiveBlocksPerMultiprocessor(&per_cu, (const void*)mk_fwd, NTHR, LDS_TOTAL) != hipSuccess || per_cu < 1) { fprintf(stderr, "kernel_launch: occupancy query says %d\n", per_cu); per_cu = 1; }
        (void)hipGetLastError();
        grid = cus * (per_cu > 1 ? 1 : per_cu);
    }
    if (grid < 0) return;
    if (hipMemsetAsync((char*)d_ws + WS_CTL, 0, 65536, stream) != hipSuccess) { fprintf(stderr, "kernel_launch: hipMemsetAsync failed\n"); return; }
    Args a{};
    for (int i = 0; i < 18; ++i) a.in[i] = (const float*)d_in[i];
    a.out = (float*)d_out; a.ws = (unsigned char*)d_ws;
#if MK_ONE_LAUNCH
    a.ph_lo = 0; a.ph_hi = N_PHASES;
    void* args[] = {&a};
    hipError_t e = hipLaunchCooperativeKernel((const void*)mk_fwd, dim3(grid), dim3(NTHR), args, LDS_TOTAL, stream);
    if (e != hipSuccess) fprintf(stderr, "cooperative launch failed: %s (grid %d)\n", hipGetErrorString(e), grid);
#else
    for (int p = 0; p < N_PHASES; ++p) {
        a.ph_lo = p; a.ph_hi = p + 1;
        hipLaunchKernelGGL(mk_fwd, dim3(grid), dim3(NTHR), LDS_TOTAL, stream, a);
    }
#endif
}
```

```cpp
#define MK_ONE_LAUNCH 1
#include <hip/hip_runtime.h>
#include <hip/hip_cooperative_groups.h>
#include <cstdio>
#include <cstdint>
namespace cg = cooperative_groups;
#define LAS __attribute__((address_space(3)))
#define GAS __attribute__((address_space(1)))
typedef unsigned short bf16;
typedef unsigned v4u __attribute__((ext_vector_type(4)));
typedef unsigned v2u __attribute__((ext_vector_type(2)));
typedef float f32x4 __attribute__((ext_vector_type(4)));
typedef float f32x16 __attribute__((ext_vector_type(16)));
typedef short bf16x8 __attribute__((ext_vector_type(8)));
typedef short s16x4 __attribute__((ext_vector_type(4)));
typedef float f32x2_t __attribute__((ext_vector_type(2)));
typedef __bf16 bf16x2_t __attribute__((ext_vector_type(2)));

constexpr int NWAVES = 8, NTHR = 512;
constexpr int BATCH = 8, SEQ = 4096, DM = 1024, MTOK = BATCH * SEQ;
constexpr int AH = 16, AHD = 64, AW = 1024;
constexpr int MH = 4, MHD = 512, MW = 2048;
constexpr int NIN = 12288;
constexpr int C_QA = 0, C_KA = 1024, C_VA = 2048, C_ZA = 3072, C_XM = 4096, C_ZM = 6144, C_OM = 8192, C_G = 10240;
constexpr int CHUNK = 64, NCHUNK = SEQ / CHUNK;
constexpr float EPS = 1e-6f;
constexpr float LOG2E = 1.4426950408889634f;
constexpr float QSCALE = 0.125f * 1.4426950408889634f;

constexpr size_t MiB = 1u << 20;
constexpr size_t WS_CTL = 0;
constexpr size_t WS_WIN = 1 * MiB;
constexpr size_t WS_WPA = 25 * MiB;
constexpr size_t WS_WPB = 27 * MiB;
constexpr size_t WS_WOUT = 31 * MiB;
constexpr size_t WS_TAB = 33 * MiB;
constexpr size_t WS_GP = 34 * MiB;
constexpr size_t WS_SCAL = 38 * MiB;
constexpr size_t WS_HALO = 40 * MiB;
constexpr size_t WS_ST = 34 * MiB;
constexpr size_t WS_XN = 46 * MiB;
constexpr size_t WS_R0 = 110 * MiB;
constexpr size_t WS_R1 = 238 * MiB;
constexpr size_t WS_R2 = 366 * MiB;
constexpr size_t WS_S = 494 * MiB;
constexpr size_t WS_END = 512 * MiB;
constexpr size_t WS_QA = 238 * MiB, WS_KA = 302 * MiB, WS_VA = 366 * MiB;
constexpr size_t WS_O1 = 430 * MiB;
constexpr size_t WS_A1 = 238 * MiB;
constexpr size_t WS_G = 302 * MiB;
constexpr size_t WS_MRG = 430 * MiB;
constexpr int TAB_WC = 0;
constexpr int TAB_WM = 2048 * 8;
constexpr int TAB_G = 2 * 2048 * 8;
constexpr int TAB_BIAS = TAB_G + 512 * 16;
constexpr int TAB_END = TAB_BIAS + 3 * 16 * 132;

__device__ const unsigned char BUCKET[3][132] = {
 {0,1,2,3,4,5,6,7,8,9,10,11,12,13,14,15,16,16,16,16,16,16,17,17,17,17,17,17,17,17,18,18,18,18,18,18,18,18,18,18,19,19,19,19,19,19,19,19,19,19,19,19,19,19,20,20,20,20,20,20,20,20,20,20,20,20,20,20,20,20,20,20,20,21,21,21,21,21,21,21,21,21,21,21,21,21,21,21,21,21,21,21,21,21,21,21,21,21,21,22,22,22,22,22,22,22,22,22,22,22,22,22,22,22,22,22,22,22,22,22,22,22,22,22,22,22,22,22,22,0,0,0},
 {0,4,8,12,16,16,17,17,18,18,19,19,19,19,20,20,20,20,20,21,21,21,21,21,21,22,22,22,22,22,22,22,22,22,23,23,23,23,23,23,23,23,23,23,23,23,24,24,24,24,24,24,24,24,24,24,24,24,24,24,24,24,25,25,25,25,25,25,25,25,25,25,25,25,25,25,25,25,25,25,25,25,25,26,26,26,26,26,26,26,26,26,26,26,26,26,26,26,26,26,26,26,26,26,26,26,26,26,26,26,26,26,26,27,27,27,27,27,27,27,27,27,27,27,27,27,27,27,27,0,0,0},
 {0,16,18,19,20,21,21,22,22,23,23,23,24,24,24,24,25,25,25,25,25,26,26,26,26,26,26,26,26,27,27,27,27,27,27,27,27,27,27,28,28,28,28,28,28,28,28,28,28,28,28,28,29,29,29,29,29,29,29,29,29,29,29,29,29,29,29,29,29,29,30,30,30,30,30,30,30,30,30,30,30,30,30,30,30,30,30,30,30,30,30,30,30,30,30,31,31,31,31,31,31,31,31,31,31,31,31,31,31,31,31,31,31,31,31,31,31,31,31,31,31,31,31,31,31,31,31,31,31,0,0,0}};

#define DI __device__ __forceinline__
DI unsigned pk2(float lo, float hi) { f32x2_t v = {lo, hi}; bf16x2_t b = __builtin_convertvector(v, bf16x2_t); return __builtin_bit_cast(unsigned, b); }
DI float bflo(unsigned u) { return __uint_as_float(u << 16); }
DI float bfhi(unsigned u) { return __uint_as_float(u & 0xffff0000u); }
DI float sigmoidf_(float x) { return 1.0f / (1.0f + __expf(-x)); }
DI float siluf_(float x) { return x / (1.0f + __expf(-x)); }
DI float wave_sum(float v) {
#pragma unroll
    for (int o = 1; o < 64; o <<= 1) v += __shfl_xor(v, o);
    return v;
}
DI int wg_tid(int wv) { return wv * 64 + (int)__builtin_amdgcn_mbcnt_hi(~0u, __builtin_amdgcn_mbcnt_lo(~0u, 0u)); }
DI int wg_tid_local(int wv) { int z; asm volatile("v_mov_b32 %0, 0" : "=v"(z)); return wv * 64 + (int)__builtin_amdgcn_mbcnt_hi(~0u, __builtin_amdgcn_mbcnt_lo(~0u, (unsigned)z)); }
DI float dot2bf(unsigned a, unsigned b, float acc) { return __builtin_amdgcn_fdot2_f32_bf16(__builtin_bit_cast(bf16x2_t, a), __builtin_bit_cast(bf16x2_t, b), acc, false); }
DI float bperm(float v, int srclane) { return __int_as_float(__builtin_amdgcn_ds_bpermute(srclane << 2, __float_as_int(v))); }
DI int crow(int r, int hi) { return (r & 3) + 8 * (r >> 2) + 4 * hi; }
#define MFMA32(a, b, c) __builtin_amdgcn_mfma_f32_32x32x16_bf16((a), (b), (c), 0, 0, 0)
DI s16x4 tr_read(const LAS unsigned char* p) { return __builtin_bit_cast(s16x4, __builtin_amdgcn_ds_read_tr16_b64_v4i16((LAS s16x4*)p)); }
DI bf16x8 cat8(s16x4 lo, s16x4 hi) { return __builtin_shufflevector(lo, hi, 0, 1, 2, 3, 4, 5, 6, 7); }
DI bf16x8 pack8(float a0, float a1, float a2, float a3, float a4, float a5, float a6, float a7) {
    v4u p; p.x = pk2(a0, a1); p.y = pk2(a2, a3); p.z = pk2(a4, a5); p.w = pk2(a6, a7); return __builtin_bit_cast(bf16x8, p);
}
namespace pg8 {
#define PG8_LAS __attribute__((address_space(3)))
typedef unsigned short bf16_t;
typedef short bf16x8 __attribute__((ext_vector_type(8)));
typedef float f32x4 __attribute__((ext_vector_type(4)));
typedef unsigned u32x4 __attribute__((ext_vector_type(4)));
constexpr int BM = 256, BK = 64, HALF = 128, HTB = HALF * BK * 2  , STAGE_BYTES = 8 * HTB, NXCD = 8, WGM = 8;

__host__ __device__ __forceinline__ int lds_byte(int r, int c) { const int st = (r >> 4) * 2 + (c >> 5), rr = r & 15, cc = c & 31, ob = rr * 64 + cc * 2; return st * 1024 + (ob ^ (((ob >> 9) & 1) << 5)); }
__host__ __device__ __forceinline__ void stage_rc(int b, int& R, int& C) { const int st = b / 1024, sb = b % 1024, swz = sb ^ (((sb >> 9) & 1) << 5); R = (st >> 1) * 16 + swz / 64; C = (st & 1) * 32 + (swz % 64) / 2; }
__host__ __device__ __forceinline__ int perm32(int rho) { const int n = rho >> 4, i = rho & 15; return 8 * (i >> 2) + 4 * n + (i & 3); }

struct Unit { int pm, pn; };
struct Gemm { const bf16_t* A; const bf16_t* Bt; int M, N, K; };

struct StaticOrder {
    int nM, nN, nwg, G, c;
    __host__ __device__ void init(int M, int N, int G_, int c_) { nM = M / BM; nN = N / BM; nwg = nM * nN; G = G_; c = c_; }
    __host__ __device__ bool next(int i, Unit& u) const {
        const long L = (long)i * G + c; if (L >= nwg) return false;
        int wgid = (int)L; { const int q = nwg / NXCD, r = nwg % NXCD, xcd = wgid % NXCD, off = wgid / NXCD; wgid = (xcd < r ? xcd * (q + 1) : r * (q + 1) + (xcd - r) * q) + off; }
        const int nig = WGM * nN, gid = wgid / nig, fm = gid * WGM, gsz = (nM - fm) < WGM ? (nM - fm) : WGM;
        u.pm = fm + ((wgid % nig) % gsz); u.pn = (wgid % nig) / gsz; return true;
    }
    __device__ __forceinline__ void a_ready(const Unit&) const {}
    __device__ __forceinline__ void done(const Unit&) const {}
};

}
namespace pg8 {
#define EPI_OPERATOR \
    static constexpr bool PERM = true, AFTER_DRAIN = false; \
    __device__ __forceinline__ void operator()(const f32x4 (&acc)[2][2][4][2], const Unit& u, int wr, int wc, int fr, int fq) const { \
        const int row0 = u.pm * BM + wr * 64 + fr, col0 = u.pn * BM + wc * 32 + 8 * fq; \
        _Pragma("unroll") for (int ai = 0; ai < 2; ++ai) \
        _Pragma("unroll") for (int m = 0; m < 4; ++m) \
        _Pragma("unroll") for (int bj = 0; bj < 2; ++bj) store8(row0 + ai * HALF + m * 16, col0 + bj * HALF, acc[ai][bj][m][0], acc[ai][bj][m][1]); \
    }
DI ::v4u pack_bf16x8(f32x4 v0, f32x4 v1) { ::v4u w; w.x = ::pk2(v0[0], v0[1]); w.y = ::pk2(v0[2], v0[3]); w.z = ::pk2(v1[0], v1[1]); w.w = ::pk2(v1[2], v1[3]); return w; }
DI void unpack_bf16x8(::v4u w, f32x4& v0, f32x4& v1) { v0 = (f32x4){::bflo(w.x), ::bfhi(w.x), ::bflo(w.y), ::bfhi(w.y)}; v1 = (f32x4){::bflo(w.z), ::bfhi(w.z), ::bflo(w.w), ::bfhi(w.w)}; }

struct EpiXM {
    bf16_t* xm; bf16_t* halo;
    DI void store8(int row, int col, f32x4 v0, f32x4 v1) const {
        const ::v4u w = pack_bf16x8(v0, v1);
        *(::v4u*)(xm + (size_t)row * 2048 + col) = w;
        const int r = row & 63;
        if (r >= 61) *(::v4u*)(halo + ((size_t)(row >> 6) * 3 + (r - 61)) * 2048 + col) = w;
    }
    EPI_OPERATOR
};
struct EpiSig {
    bf16_t* out; int ldc; const float* bias;
    DI void store8(int row, int col, f32x4 v0, f32x4 v1) const {
        if (bias) { v0 += *(const f32x4*)(bias + col); v1 += *(const f32x4*)(bias + col + 4); }
#pragma unroll
        for (int i = 0; i < 4; ++i) { v0[i] = ::sigmoidf_(v0[i]); v1[i] = ::sigmoidf_(v1[i]); }
        *(::v4u*)(out + (size_t)row * ldc + col) = pack_bf16x8(v0, v1);
    }
    EPI_OPERATOR
};
struct EpiZM {
    bf16_t* buf;
    DI void store8(int row, int col, f32x4 v0, f32x4 v1) const {
        ::v4u* p = (::v4u*)(buf + (size_t)row * 2048 + col);
        f32x4 h0, h1; unpack_bf16x8(*p, h0, h1);
#pragma unroll
        for (int i = 0; i < 4; ++i) { h0[i] *= ::siluf_(v0[i]); h1[i] *= ::siluf_(v1[i]); }
        *p = pack_bf16x8(h0, h1);
    }
    EPI_OPERATOR
};
struct EpiQKV {
    bf16_t* q; size_t stride;
    DI void store8(int row, int col, f32x4 v0, f32x4 v1) const {
        const int t = col >> 10, c = col & 1023;
        bf16_t* base = q + (size_t)t * stride;
        if (t == 0) { v0 *= ::QSCALE; v1 *= ::QSCALE; }
        *(::v4u*)(base + (size_t)row * 1024 + c) = pack_bf16x8(v0, v1);
    }
    EPI_OPERATOR
};
struct EpiZA {
    const bf16_t* o0; const bf16_t* o1; const bf16_t* o2; const float* st; bf16_t* a1;
    DI void store8(int row, int col, f32x4 v0, f32x4 v1) const {
        const int head = col >> 6;
        const ::f32x2_t s0 = *(const ::f32x2_t*)(st + ((size_t)(0 * ::MTOK + row) * 16 + head) * 2);
        const ::f32x2_t s1 = *(const ::f32x2_t*)(st + ((size_t)(1 * ::MTOK + row) * 16 + head) * 2);
        const ::f32x2_t s2 = *(const ::f32x2_t*)(st + ((size_t)(2 * ::MTOK + row) * 16 + head) * 2);
        const float mx = fmaxf(s0.x, fmaxf(s1.x, s2.x));
        float w0 = __builtin_amdgcn_exp2f(s0.x - mx) * s0.y, w1 = __builtin_amdgcn_exp2f(s1.x - mx) * s1.y, w2 = __builtin_amdgcn_exp2f(s2.x - mx) * s2.y;
        const float inv = 1.0f / (w0 + w1 + w2); w0 *= inv; w1 *= inv; w2 *= inv;
        const size_t off = (size_t)row * 1024 + col;
        f32x4 a0, a1v, b0, b1, c0, c1;
        unpack_bf16x8(*(const ::v4u*)(o0 + off), a0, a1v); unpack_bf16x8(*(const ::v4u*)(o1 + off), b0, b1); unpack_bf16x8(*(const ::v4u*)(o2 + off), c0, c1);
        f32x4 r0 = a0 * w0 + b0 * w1 + c0 * w2, r1 = a1v * w0 + b1 * w1 + c1 * w2;
#pragma unroll
        for (int i = 0; i < 4; ++i) { r0[i] *= ::siluf_(v0[i]); r1[i] *= ::siluf_(v1[i]); }
        *(::v4u*)(a1 + off) = pack_bf16x8(r0, r1);
    }
    EPI_OPERATOR
};
struct EpiYA {
    bf16_t* g;
    DI void store8(int row, int col, f32x4 v0, f32x4 v1) const {
        ::v4u* p = (::v4u*)(g + (size_t)row * 2048 + col);
        f32x4 h0, h1; unpack_bf16x8(*p, h0, h1);
        *p = pack_bf16x8(h0 * v0, h1 * v1);
    }
    EPI_OPERATOR
};
struct EpiYM {
    const bf16_t* g; bf16_t* mrg;
    DI void store8(int row, int col, f32x4 v0, f32x4 v1) const {
        f32x4 t0, t1, g0, g1;
        unpack_bf16x8(*(const ::v4u*)(g + (size_t)row * 2048 + col), t0, t1);
        unpack_bf16x8(*(const ::v4u*)(g + (size_t)row * 2048 + 1024 + col), g0, g1);
        *(::v4u*)(mrg + (size_t)row * 1024 + col) = pack_bf16x8(t0 + g0 * v0, t1 + g1 * v1);
    }
    EPI_OPERATOR
};
struct EpiOut {
    const float* x; float* out;
    DI void store8(int row, int col, f32x4 v0, f32x4 v1) const {
        const size_t off = (size_t)row * 1024 + col;
        *(f32x4*)(out + off) = *(const f32x4*)(x + off) + v0;
        *(f32x4*)(out + off + 4) = *(const f32x4*)(x + off + 4) + v1;
    }
    EPI_OPERATOR
};
}
namespace pg8 {
template <class Epi, class Sched, bool ALIGN_EPI = false, bool SP2 = false>
__device__ __forceinline__ void gemm_phase(PG8_LAS unsigned char* lds, const Gemm g, const Sched& S, const Epi& E, const int tid_in) {
    const int tid = tid_in, wid = __builtin_amdgcn_readfirstlane(tid >> 6), lane = tid & 63, wr = wid >> 2, wc = wid & 3, fr = lane & 15, fq = lane >> 4;
    const int K = g.K, nt = K / BK;
    unsigned voffA[2], voffB[2];
#pragma unroll
    for (int i = 0; i < 2; ++i) { int R, C; stage_rc(tid * 16 + i * 8192, R, C); const int Rb = Epi::PERM ? ((R & ~31) + perm32(R & 31)) : R;
        voffA[i] = (unsigned)(R * K + C) * 2u; voffB[i] = (unsigned)(Rb * K + C) * 2u; }
    const size_t kstep = (size_t)(BK * 2);
    const size_t hstep = (size_t)HALF * K * 2;
    const size_t tstep = 2 * hstep;
    const unsigned ldsw = (unsigned)wid * 1024u;
    const int aoff = lds_byte(wr * 64 + fr, fq * 8), boff = lds_byte(wc * 32 + fr, fq * 8);
#define PG8_SA(b, h) (((b) * 2 + (h)) * HTB)
#define PG8_SB(b, h) ((4 + (b) * 2 + (h)) * HTB)
#define PG8_STAGE(bufoff, gbase, voff) do { _Pragma("unroll") for (int _i = 0; _i < 2; ++_i) \
        __builtin_amdgcn_global_load_lds((const unsigned*)((const char*)(gbase) + (voff)[_i]), (PG8_LAS unsigned*)(lds + (bufoff) + ldsw + _i * 8192), 16, 0, 0); } while (0)
#define PG8_LDA(dst, b, h) do { _Pragma("unroll") for (int m = 0; m < 4; ++m) _Pragma("unroll") for (int k = 0; k < 2; ++k) dst[m][k] = *(const PG8_LAS bf16x8*)(lds + PG8_SA(b, h) + aoff + m * 2048 + k * 1024); } while (0)
#define PG8_LDB(dst, b, h) do { _Pragma("unroll") for (int n = 0; n < 2; ++n) _Pragma("unroll") for (int k = 0; k < 2; ++k) dst[n][k] = *(const PG8_LAS bf16x8*)(lds + PG8_SB(b, h) + boff + n * 2048 + k * 1024); } while (0)
#define PG8_MMA(ai, bj, At, Bt) do { __builtin_amdgcn_s_setprio(1); _Pragma("unroll") for (int m = 0; m < 4; ++m) _Pragma("unroll") for (int n = 0; n < 2; ++n) _Pragma("unroll") for (int k = 0; k < 2; ++k) \
        acc[ai][bj][m][n] = __builtin_amdgcn_mfma_f32_16x16x32_bf16(Bt[n][k], At[m][k], acc[ai][bj][m][n], 0, 0, 0); __builtin_amdgcn_s_setprio(0); } while (0)
#define PG8_WAIT_V(n) asm volatile("s_waitcnt vmcnt(" #n ")" ::: "memory")
#define PG8_WAIT_L(n) asm volatile("s_waitcnt lgkmcnt(" #n ")" ::: "memory")
#define PG8_BAR __builtin_amdgcn_s_barrier()
#define PG8_SCHED __builtin_amdgcn_sched_barrier(0)
    Unit cur, nxt; int ui = 0;
    if (!S.next(0, cur)) return;
    f32x4 acc[2][2][4][2];
#pragma unroll
    for (int a = 0; a < 2; ++a)
#pragma unroll
        for (int b = 0; b < 2; ++b)
#pragma unroll
            for (int m = 0; m < 4; ++m)
#pragma unroll
                for (int n = 0; n < 2; ++n) acc[a][b][m][n] = (f32x4){0.f, 0.f, 0.f, 0.f};
    bf16x8 At[4][2], B0[2][2], B1[2][2];
    const char* cA = (const char*)g.A + (size_t)cur.pm * tstep; const char* cB = (const char*)g.Bt + (size_t)cur.pn * tstep;
    S.a_ready(cur);
    if constexpr (SP2) {
        PG8_STAGE(PG8_SB(0, 0), cB, voffB); PG8_STAGE(PG8_SB(0, 1), cB + hstep, voffB); PG8_STAGE(PG8_SA(0, 0), cA, voffA); PG8_STAGE(PG8_SA(0, 1), cA + hstep, voffA);
        if (wr == 1) PG8_BAR;
        PG8_WAIT_V(2); PG8_BAR;
        PG8_STAGE(PG8_SB(1, 0), cB + kstep, voffB); PG8_STAGE(PG8_SA(1, 0), cA + kstep, voffA); PG8_STAGE(PG8_SB(1, 1), cB + hstep + kstep, voffB);
        PG8_WAIT_V(6); PG8_BAR;
    } else {
        PG8_STAGE(PG8_SB(0, 0), cB, voffB); PG8_STAGE(PG8_SA(0, 0), cA, voffA); PG8_STAGE(PG8_SB(0, 1), cB + hstep, voffB); PG8_STAGE(PG8_SA(0, 1), cA + hstep, voffA);
        if (wr == 1) PG8_BAR;
        PG8_WAIT_V(4); PG8_BAR;
        PG8_STAGE(PG8_SB(1, 0), cB + kstep, voffB); PG8_STAGE(PG8_SA(1, 0), cA + kstep, voffA); PG8_STAGE(PG8_SB(1, 1), cB + hstep + kstep, voffB);
        PG8_WAIT_V(6); PG8_BAR;
    }
    for (;;) {
        const bool has_next = S.next(ui + 1, nxt);
        const char* nA = has_next ? (const char*)g.A + (size_t)nxt.pm * tstep : cA; const char* nB = has_next ? (const char*)g.Bt + (size_t)nxt.pn * tstep : cB;
        for (int t = 0; t < nt; t += 2) {
            const bool last = (t == nt - 2);
            const char* a1 = cA + (size_t)(t + 1) * kstep;
            const char* a2 = last ? nA : cA + (size_t)(t + 2) * kstep; const char* b2 = last ? nB : cB + (size_t)(t + 2) * kstep;
            const char* a3 = a2 + kstep; const char* b3 = b2 + kstep;
            if (last && has_next) S.a_ready(nxt);
            if constexpr (SP2) {
            PG8_LDB(B0, 0, 0); PG8_LDB(B1, 0, 1); PG8_SCHED; PG8_LDA(At, 0, 0); PG8_STAGE(PG8_SA(1, 1), a1 + hstep, voffA);
            PG8_WAIT_V(8); PG8_WAIT_L(0); PG8_BAR; PG8_MMA(0, 0, At, B0); PG8_MMA(0, 1, At, B1); PG8_BAR; PG8_SCHED;
            PG8_LDA(At, 0, 1); PG8_STAGE(PG8_SB(0, 0), b2, voffB); PG8_STAGE(PG8_SB(0, 1), b2 + hstep, voffB); PG8_STAGE(PG8_SA(0, 0), a2, voffA);
            PG8_WAIT_V(8); PG8_WAIT_L(0); PG8_BAR; PG8_MMA(1, 0, At, B0); PG8_MMA(1, 1, At, B1); PG8_BAR; PG8_SCHED;
            PG8_LDB(B0, 1, 0); PG8_LDB(B1, 1, 1); PG8_SCHED; PG8_LDA(At, 1, 0); PG8_STAGE(PG8_SA(0, 1), a2 + hstep, voffA);
            PG8_WAIT_V(8); PG8_WAIT_L(0); PG8_BAR; PG8_MMA(0, 0, At, B0); PG8_MMA(0, 1, At, B1); PG8_BAR; PG8_SCHED;
            PG8_LDA(At, 1, 1); PG8_STAGE(PG8_SB(1, 0), b3, voffB); PG8_STAGE(PG8_SB(1, 1), b3 + hstep, voffB); PG8_STAGE(PG8_SA(1, 0), a3, voffA);
            PG8_WAIT_V(8); PG8_WAIT_L(0); PG8_BAR; PG8_MMA(1, 0, At, B0); PG8_MMA(1, 1, At, B1); PG8_BAR; PG8_SCHED;
            } else {
            PG8_LDB(B0, 0, 0); PG8_SCHED; PG8_LDA(At, 0, 0); PG8_STAGE(PG8_SA(1, 1), a1 + hstep, voffA);
            PG8_WAIT_L(8); PG8_BAR; PG8_WAIT_L(0); PG8_MMA(0, 0, At, B0); PG8_BAR; PG8_SCHED;
            PG8_LDB(B1, 0, 1); PG8_STAGE(PG8_SB(0, 0), b2, voffB);
            PG8_BAR; PG8_WAIT_L(0); PG8_MMA(0, 1, At, B1); PG8_BAR;
            PG8_LDA(At, 0, 1); PG8_STAGE(PG8_SA(0, 0), a2, voffA);
            PG8_BAR; PG8_WAIT_L(0); PG8_MMA(1, 0, At, B0); PG8_BAR; PG8_SCHED;
            PG8_STAGE(PG8_SB(0, 1), b2 + hstep, voffB);
            PG8_WAIT_V(6); PG8_BAR; PG8_MMA(1, 1, At, B1); PG8_BAR;
            PG8_LDB(B0, 1, 0); PG8_SCHED; PG8_LDA(At, 1, 0); PG8_STAGE(PG8_SA(0, 1), a2 + hstep, voffA);
            PG8_WAIT_L(8); PG8_BAR; PG8_WAIT_L(0); PG8_MMA(0, 0, At, B0); PG8_BAR; PG8_SCHED;
            PG8_LDB(B1, 1, 1); PG8_STAGE(PG8_SB(1, 0), b3, voffB);
            PG8_BAR; PG8_WAIT_L(0); PG8_MMA(0, 1, At, B1); PG8_BAR;
            PG8_LDA(At, 1, 1); PG8_STAGE(PG8_SA(1, 0), a3, voffA);
            PG8_BAR; PG8_WAIT_L(0); PG8_MMA(1, 0, At, B0); PG8_BAR; PG8_SCHED;
            PG8_STAGE(PG8_SB(1, 1), b3 + hstep, voffB);
            PG8_WAIT_V(6); PG8_BAR; PG8_MMA(1, 1, At, B1); PG8_BAR;
            }
        }
        if constexpr (ALIGN_EPI) { if (wr == 0) PG8_BAR; }
        if constexpr (!Epi::AFTER_DRAIN) { E(acc, cur, wr, wc, fr, fq); S.done(cur); }
        if (!has_next) break;
#pragma unroll
        for (int a = 0; a < 2; ++a)
#pragma unroll
            for (int b = 0; b < 2; ++b)
#pragma unroll
                for (int m = 0; m < 4; ++m)
#pragma unroll
                    for (int n = 0; n < 2; ++n) acc[a][b][m][n] = (f32x4){0.f, 0.f, 0.f, 0.f};
        cur = nxt; cA = nA; cB = nB; ++ui;
        if constexpr (ALIGN_EPI) { if (wr == 1) PG8_BAR; }
    }
    PG8_WAIT_V(0);
    if constexpr (!ALIGN_EPI) { if (wr == 0) PG8_BAR; }
    PG8_BAR;
    if constexpr (Epi::AFTER_DRAIN) { E.fused(acc, cur, wr, wc, fr, fq, lds, wid, lane); S.done(cur); }
#undef PG8_SA
#undef PG8_SB
#undef PG8_STAGE
#undef PG8_LDA
#undef PG8_LDB
#undef PG8_MMA
#undef PG8_WAIT_V
#undef PG8_WAIT_L
#undef PG8_BAR
#undef PG8_SCHED
}
}
namespace att {
constexpr int KP = 144;
constexpr int K_OFF = 0, V_OFF = 384 * KP, B_OFF = 2 * 384 * KP, LDS_BYTES = B_OFF + 132 * 4;
struct Tensors { const bf16* Q; const bf16* K; const bf16* V; bf16* Oa; bf16* Ob; float* st; const float* biasL2; };

DI void unit(LAS unsigned char* lds, const Tensors& T, int u, int tid_in) {
    const int tid_ = wg_tid_local(tid_in);
    const int tid = tid_, lane = tid & 63, l31 = lane & 31, hi = lane >> 5, w = __builtin_amdgcn_readfirstlane(tid >> 6);
    const int bh = u / 48, rem = u % 48, p = rem >> 4, w16 = rem & 15;
    const int b = bh >> 4, h = bh & 15;
    const int dsh = 2 * p, nqb = 16 >> dsh, r = w16 / nqb, qblk = w16 % nqb;
    const size_t rowb = (size_t)b * SEQ;
    {
#pragma unroll
        for (int k = 0; k < 6; ++k) {
            const int id = tid + 512 * k, j = id >> 3, pc = id & 7;
            int pos = 256 * qblk - 128 + j; pos = pos < 0 ? 0 : pos;
            const size_t off = (rowb + r + ((size_t)pos << dsh)) * 1024 + h * 64 + pc * 8;
            const v4u kv = *(const v4u*)(T.K + off); const v4u vv = *(const v4u*)(T.V + off);
            *(LAS v4u*)(lds + K_OFF + j * KP + pc * 16) = kv;
            *(LAS v4u*)(lds + V_OFF + j * KP + pc * 16) = vv;
        }
        if (tid < 132) ((LAS float*)(lds + B_OFF))[tid] = T.biasL2[(p * 16 + h) * 132 + tid];
    }
    const int qpos = 256 * qblk + 32 * w + l31;
    const size_t qrow = rowb + r + ((size_t)qpos << dsh);
    bf16x8 qf[4];
#pragma unroll
    for (int d0 = 0; d0 < 4; ++d0) qf[d0] = *(const bf16x8*)(T.Q + qrow * 1024 + h * 64 + d0 * 16 + hi * 8);
    __syncthreads();
    f32x16 st[5];
#pragma unroll
    for (int kt = 0; kt < 5; ++kt) {
        f32x16 a = {};
#pragma unroll
        for (int d0 = 0; d0 < 4; ++d0) {
            const bf16x8 kf = *(const LAS bf16x8*)(lds + K_OFF + (32 * w + 32 * kt + l31) * KP + (16 * d0 + 8 * hi) * 2);
            a = MFMA32(kf, qf[d0], a);
        }
        st[kt] = a;
    }
    const LAS float* bl = (const LAS float*)(lds + B_OFF);
    float mx = -1e30f;
#pragma unroll
    for (int kt = 0; kt < 5; ++kt)
#pragma unroll
        for (int rr = 0; rr < 16; ++rr) {
            const int kl = crow(rr, hi);
            const int delta = 128 + l31 - 32 * kt - kl;
            const int pk = 256 * qblk - 128 + 32 * w + 32 * kt + kl;
            const bool valid = (delta >= 0) && (delta <= 128) && (pk >= 0);
            const int dc = delta < 0 ? 0 : (delta > 128 ? 128 : delta);
            const float s = valid ? st[kt][rr] + bl[dc] : -1e30f;
            st[kt][rr] = s; mx = fmaxf(mx, s);
        }
    mx = fmaxf(mx, __shfl_xor(mx, 32));
    float lsum = 0.f;
#pragma unroll
    for (int kt = 0; kt < 5; ++kt)
#pragma unroll
        for (int rr = 0; rr < 16; ++rr) { const float e = __builtin_amdgcn_exp2f(st[kt][rr] - mx); st[kt][rr] = e; lsum += e; }
    lsum += __shfl_xor(lsum, 32);
    f32x16 o[2]; o[0] = (f32x16){}; o[1] = (f32x16){};
    const int i16 = lane & 15, q4 = i16 >> 2, p4 = i16 & 3, gidx = (lane >> 4) & 1;
#pragma unroll
    for (int kt = 0; kt < 5; ++kt)
#pragma unroll
        for (int s2 = 0; s2 < 2; ++s2) {
            const bf16x8 pb = pack8(st[kt][8 * s2 + 0], st[kt][8 * s2 + 1], st[kt][8 * s2 + 2], st[kt][8 * s2 + 3], st[kt][8 * s2 + 4], st[kt][8 * s2 + 5], st[kt][8 * s2 + 6], st[kt][8 * s2 + 7]);
            const int jrow = 32 * w + 32 * kt + 16 * s2 + 4 * hi + q4;
#pragma unroll
            for (int dt = 0; dt < 2; ++dt) {
                const LAS unsigned char* a0 = lds + V_OFF + jrow * KP + (32 * dt + 16 * gidx + 4 * p4) * 2;
                const bf16x8 va = cat8(tr_read(a0), tr_read(a0 + 8 * KP));
                o[dt] = MFMA32(va, pb, o[dt]);
            }
        }
    const float inv = 1.0f / lsum;
    bf16* orow = (p == 0 ? T.Oa : T.Ob + (size_t)(p - 1) * MTOK * AW) + qrow * 1024 + h * 64;
#pragma unroll
    for (int dt = 0; dt < 2; ++dt)
#pragma unroll
        for (int g4 = 0; g4 < 4; ++g4) {
            v2u wv; wv.x = pk2(o[dt][4 * g4] * inv, o[dt][4 * g4 + 1] * inv); wv.y = pk2(o[dt][4 * g4 + 2] * inv, o[dt][4 * g4 + 3] * inv);
            *(v2u*)(orow + 32 * dt + 8 * g4 + 4 * hi) = wv;
        }
    if (hi == 0) { f32x2_t sv = {mx, lsum}; *(f32x2_t*)(T.st + ((size_t)p * MTOK + qrow) * 32 + h * 2) = sv; }
    __syncthreads();
}
DI void phase(LAS unsigned char* lds, const Tensors& T, int G, int blk, int wv) {
    for (int u = blk; u < BATCH * AH * 48; u += G) unit(lds, T, u, wv);
}
}
namespace mpre {
constexpr int TP = 144;
constexpr int XC_OFF = 0, XM_OFF = 256 * TP, QT_OFF = 2 * 256 * TP, RED_OFF = 3 * 256 * TP, GRED_OFF = RED_OFF + 4 * 4096, LDS_BYTES = GRED_OFF + 4 * 64 * 8 * 4;
struct Tensors { const bf16* xm; const bf16* halo; bf16* kimg; bf16* vimg; bf16* qimg; float* gp; bf16* S; const float* convw; const float* convb; const bf16* WcT; const bf16* WmT; const float* G; };

DI void unit(LAS unsigned char* lds, const Tensors& T, int u, int tid_in) {
    const int tid_ = wg_tid_local(tid_in);
    const int tid = tid_, lane = tid & 63, l31 = lane & 31, hi = lane >> 5, w = __builtin_amdgcn_readfirstlane(tid >> 6);
    const int h = u & 3, c = (u >> 2) & 63, b = u >> 8;
    const int g6 = lane, tp = w;
    const size_t tok0 = (size_t)b * SEQ + 64 * c;
    const int ti = w & 1, si = (w >> 1) & 1, kh = w >> 2;
    f32x16 sacc = {};
    f32x16 gacc = {};
    const int kq = w >> 1;
    const int i16 = lane & 15, q4 = i16 >> 2, p4 = i16 & 3, gidx = (lane >> 4) & 1;
#pragma unroll 1
    for (int hh = 0; hh < 2; ++hh) {
        const int gg = 128 * h + 64 * hh + g6, ch = 4 * gg;
        v2u xr[11];
#pragma unroll
        for (int k = 0; k < 11; ++k) {
            const int tl = 8 * tp - 3 + k;
            if (tl >= 0) xr[k] = *(const v2u*)(T.xm + (tok0 + tl) * 2048 + ch);
            else if (c > 0) xr[k] = *(const v2u*)(T.halo + ((size_t)(b * 64 + c - 1) * 3 + (3 + tl)) * 2048 + ch);
            else xr[k] = (v2u){0u, 0u};
        }
        float xmv[11][4];
#pragma unroll
        for (int k = 0; k < 11; ++k) { xmv[k][0] = bflo(xr[k].x); xmv[k][1] = bfhi(xr[k].x); xmv[k][2] = bflo(xr[k].y); xmv[k][3] = bfhi(xr[k].y); }
        float cw[4][4], cb[4], Gm[4][4];
        {
            const f32x4 b4 = *(const f32x4*)(T.convb + ch); cb[0] = b4[0]; cb[1] = b4[1]; cb[2] = b4[2]; cb[3] = b4[3];
#pragma unroll
            for (int tap = 0; tap < 4; ++tap) { const f32x4 w4 = *(const f32x4*)(T.convw + tap * 2048 + ch); cw[tap][0] = w4[0]; cw[tap][1] = w4[1]; cw[tap][2] = w4[2]; cw[tap][3] = w4[3]; }
#pragma unroll
            for (int i = 0; i < 4; ++i) { const f32x4 g4 = *(const f32x4*)(T.G + gg * 16 + i * 4); Gm[i][0] = g4[0]; Gm[i][1] = g4[1]; Gm[i][2] = g4[2]; Gm[i][3] = g4[3]; }
        }
        __syncthreads();
        unsigned xcp[4][4], xmp[4][4], qtp[4][4];
        float prev_xc[4], prev_q[4];
#pragma unroll
        for (int tl = 0; tl < 8; ++tl) {
            float xc[4], qt[4];
#pragma unroll
            for (int i = 0; i < 4; ++i) {
                float a = cb[i];
#pragma unroll
                for (int tap = 0; tap < 4; ++tap) a += cw[tap][i] * xmv[tl + tap][i];
                xc[i] = siluf_(a);
            }
#pragma unroll
            for (int i2 = 0; i2 < 4; ++i2) qt[i2] = xc[0] * Gm[0][i2] + xc[1] * Gm[1][i2] + xc[2] * Gm[2][i2] + xc[3] * Gm[3][i2];
            if (tl & 1) {
#pragma unroll
                for (int i = 0; i < 4; ++i) { xcp[i][tl >> 1] = pk2(prev_xc[i], xc[i]); qtp[i][tl >> 1] = pk2(prev_q[i], qt[i]); xmp[i][tl >> 1] = pk2(xmv[tl + 2][i], xmv[tl + 3][i]); }
            } else {
#pragma unroll
                for (int i = 0; i < 4; ++i) { prev_xc[i] = xc[i]; prev_q[i] = qt[i]; }
            }
        }
#pragma unroll
        for (int i = 0; i < 4; ++i) {
            const int off = (4 * g6 + i) * TP + 16 * tp;
            *(LAS v4u*)(lds + XC_OFF + off) = (v4u){xcp[i][0], xcp[i][1], xcp[i][2], xcp[i][3]};
            *(LAS v4u*)(lds + XM_OFF + off) = (v4u){xmp[i][0], xmp[i][1], xmp[i][2], xmp[i][3]};
            *(LAS v4u*)(lds + QT_OFF + off) = (v4u){qtp[i][0], qtp[i][1], qtp[i][2], qtp[i][3]};
        }
        __syncthreads();
        {
            const size_t ibase = ((size_t)((b * 4 + h) * 64 + c) * 64 + 32 * hh) * 1024;
#pragma unroll
            for (int k = 0; k < 4; ++k) {
                const int id = tid + 512 * k, f = id >> 6, L = id & 63;
                const int row = 32 * (f >> 2) + (L & 31), colb = (16 * (f & 3) + 4 * (L >> 5)) * 2;
                const v2u k0 = *(const LAS v2u*)(lds + XC_OFF + row * TP + colb), k1 = *(const LAS v2u*)(lds + XC_OFF + row * TP + colb + 16);
                const v2u v0 = *(const LAS v2u*)(lds + XM_OFF + row * TP + colb), v1 = *(const LAS v2u*)(lds + XM_OFF + row * TP + colb + 16);
                *(v4u*)((char*)T.kimg + ibase + (size_t)id * 16) = (v4u){k0.x, k0.y, k1.x, k1.y};
                *(v4u*)((char*)T.vimg + ibase + (size_t)id * 16) = (v4u){v0.x, v0.y, v1.x, v1.y};
            }
#pragma unroll
            for (int k = 0; k < 4; ++k) {
                const int f = 4 * w + k, tt = f & 1, cb0 = 16 * (f >> 1) + 4 * hi + q4;
                const LAS unsigned char* pq = lds + QT_OFF + cb0 * TP + (32 * tt + 16 * gidx + 4 * p4) * 2;
                const s16x4 lo = tr_read(pq), hi4 = tr_read(pq + 8 * TP);
                *(bf16x8*)((char*)T.qimg + ibase + (size_t)f * 1024 + lane * 16) = cat8(lo, hi4);
            }
        }
#pragma unroll
        for (int ks = 0; ks < 8; ++ks) {
            const int crow0 = 128 * kh + 16 * ks + 8 * hi + q4;
            const LAS unsigned char* pa = lds + XC_OFF + crow0 * TP + (32 * si + 16 * gidx + 4 * p4) * 2;
            const LAS unsigned char* pb = lds + QT_OFF + crow0 * TP + (32 * ti + 16 * gidx + 4 * p4) * 2;
            const bf16x8 af = cat8(tr_read(pa), tr_read(pa + 4 * TP));
            const bf16x8 bfr = cat8(tr_read(pb), tr_read(pb + 4 * TP));
            sacc = MFMA32(af, bfr, sacc);
        }
#pragma unroll
        for (int ks = 0; ks < 4; ++ks) {
            const int crow1 = 64 * kq + 16 * ks + 8 * hi + q4;
            const LAS unsigned char* pc_ = lds + XC_OFF + crow1 * TP + (32 * ti + 16 * gidx + 4 * p4) * 2;
            const LAS unsigned char* pm_ = lds + XM_OFF + crow1 * TP + (32 * ti + 16 * gidx + 4 * p4) * 2;
            const bf16x8 ac = cat8(tr_read(pc_), tr_read(pc_ + 4 * TP));
            const bf16x8 am = cat8(tr_read(pm_), tr_read(pm_ + 4 * TP));
            const int c0 = 512 * h + 256 * hh + 64 * kq + 16 * ks + 8 * hi;
            const bf16x8 bc = *(const bf16x8*)(T.WcT + (l31 & 7) * 2048 + c0);
            const bf16x8 bm = *(const bf16x8*)(T.WmT + (l31 & 7) * 2048 + c0);
            gacc = MFMA32(ac, bc, gacc);
            gacc = MFMA32(am, bm, gacc);
        }
    }
    if (l31 < 8) {
#pragma unroll
        for (int r = 0; r < 16; ++r) ((LAS float*)(lds + GRED_OFF))[(kq * 64 + 32 * ti + crow(r, hi)) * 8 + l31] = gacc[r];
    }
    __syncthreads();
    if (kh == 1) {
#pragma unroll
        for (int g4 = 0; g4 < 4; ++g4) *(LAS f32x4*)(lds + RED_OFF + ((w & 3) * 4 + g4) * 1024 + lane * 16) = (f32x4){sacc[4 * g4], sacc[4 * g4 + 1], sacc[4 * g4 + 2], sacc[4 * g4 + 3]};
    }
    __syncthreads();
    { const LAS float* gr = (const LAS float*)(lds + GRED_OFF);
      T.gp[((size_t)h * MTOK + tok0) * 8 + tid] = gr[tid] + gr[512 + tid] + gr[1024 + tid] + gr[1536 + tid]; }
    if (kh == 0) {
        float tot[16];
#pragma unroll
        for (int g4 = 0; g4 < 4; ++g4) {
            const f32x4 o = *(const LAS f32x4*)(lds + RED_OFF + ((w & 3) * 4 + g4) * 1024 + lane * 16);
            tot[4 * g4] = sacc[4 * g4] + o[0]; tot[4 * g4 + 1] = sacc[4 * g4 + 1] + o[1]; tot[4 * g4 + 2] = sacc[4 * g4 + 2] + o[2]; tot[4 * g4 + 3] = sacc[4 * g4 + 3] + o[3];
        }
        char* sp = (char*)T.S + (size_t)((b * 4 + h) * 64 + c) * 8192;
#pragma unroll
        for (int kk = 0; kk < 2; ++kk)
            *(bf16x8*)(sp + ((2 * si + kk) * 2 + ti) * 1024 + lane * 16) = pack8(tot[8 * kk], tot[8 * kk + 1], tot[8 * kk + 2], tot[8 * kk + 3], tot[8 * kk + 4], tot[8 * kk + 5], tot[8 * kk + 6], tot[8 * kk + 7]);
    }
    __syncthreads();
}
DI void phase(LAS unsigned char* lds, const Tensors& T, int G, int blk, int wv) {
    for (int u = blk; u < BATCH * NCHUNK * MH; u += G) unit(lds, T, u, wv);
}
}
namespace mscan {
constexpr int P_OFF = 0;
constexpr int V_OFF = 131072;
constexpr int DEN_OFF = V_OFF + 16384;
constexpr int NS_OFF = DEN_OFF + 4096;
constexpr int NSB_OFF = NS_OFF + 2048;
constexpr int TMP_OFF = NSB_OFF + 1024, SCW_OFF = TMP_OFF + 128, LDS_BYTES = SCW_OFF + 8 * 640;
static_assert(LDS_BYTES <= 163840 - 16, "scan LDS");
struct Tensors { const bf16* q; const bf16* k; const bf16* v; const bf16* S; const float* gp; const float* bif; float* scal; bf16* hm; };

DI float logsigmoid_(float x) { return fminf(x, 0.f) - log1pf(__expf(-fabsf(x))); }
DI void unpack8(bf16x8 f, float (&o)[8]) {
    const v4u u = __builtin_bit_cast(v4u, f);
    o[0] = bflo(u.x); o[1] = bfhi(u.x); o[2] = bflo(u.y); o[3] = bfhi(u.y); o[4] = bflo(u.z); o[5] = bfhi(u.z); o[6] = bflo(u.w); o[7] = bfhi(u.w);
}

DI void unit(LAS unsigned char* lds, const Tensors& T, int bh, int es, int tid_in) {
    const int tid_ = wg_tid_local(tid_in);
    const int tid = tid_, lane = tid & 63, l31 = lane & 31, hi = lane >> 5, wid = __builtin_amdgcn_readfirstlane(tid >> 6);
    const int b = bh >> 2, h = bh & 3;
    LAS float* sTmp = (LAS float*)(lds + TMP_OFF);
    float* scal = T.scal + (size_t)bh * 3 * SEQ;
    {
        float li[8], cs[8];
        const float bi = T.bif[h], bf_ = T.bif[4 + h];
        float run = 0.f;
        const float* gpb = T.gp + (size_t)b * SEQ * 8 + h;
        const unsigned toff = (unsigned)tid * 64u;
#pragma unroll
        for (int k = 0; k < 8; ++k) { li[k] = bi; cs[k] = bf_; }
#pragma unroll
        for (int hh = 0; hh < 4; ++hh) {
            const float* p = gpb + (size_t)hh * MTOK * 8;
#pragma unroll
            for (int k = 0; k < 8; ++k) { li[k] += p[toff + k * 8]; cs[k] += p[toff + k * 8 + 4]; }
        }
#pragma unroll
        for (int k = 0; k < 8; ++k) { run += logsigmoid_(cs[k]); cs[k] = run; }
        float inc = run;
#pragma unroll
        for (int o = 1; o < 64; o <<= 1) { const float t = bperm(inc, lane >= o ? lane - o : lane); if (lane >= o) inc += t; }
        if (lane == 63) sTmp[wid] = inc;
        __syncthreads();
        float base = inc - run;
        for (int w2 = 0; w2 < wid; ++w2) base += sTmp[w2];
        __syncthreads();
        float av[8], mloc = -3.0e38f, cm[8];
#pragma unroll
        for (int k = 0; k < 8; ++k) { cs[k] += base; av[k] = li[k] - cs[k]; mloc = fmaxf(mloc, av[k]); cm[k] = mloc; }
        float minc = mloc;
#pragma unroll
        for (int o = 1; o < 64; o <<= 1) { const float t = bperm(minc, lane >= o ? lane - o : lane); if (lane >= o) minc = fmaxf(minc, t); }
        if (lane == 63) sTmp[wid] = minc;
        __syncthreads();
        float mbase = bperm(minc, lane > 0 ? lane - 1 : 0); if (lane == 0) mbase = -3.0e38f;
        for (int w2 = 0; w2 < wid; ++w2) mbase = fmaxf(mbase, sTmp[w2]);
#pragma unroll
        for (int k = 0; k < 8; ++k) {
            const float Mt = fmaxf(mbase, cm[k]);
            scal[0 * SEQ + 8 * tid + k] = av[k]; scal[1 * SEQ + 8 * tid + k] = Mt; scal[2 * SEQ + 8 * tid + k] = __expf(-(cs[k] + Mt));
        }
        ((LAS float*)(lds + NS_OFF))[tid] = 0.f; ((LAS unsigned short*)(lds + NSB_OFF))[tid] = 0;
        __threadfence();
        __syncthreads();
    }
    f32x16 cst[2][2];
#pragma unroll
    for (int id = 0; id < 2; ++id)
#pragma unroll
        for (int ie = 0; ie < 2; ++ie) cst[id][ie] = (f32x16){};
    const char* qb = (const char*)T.q + (size_t)bh * NCHUNK * 65536 + (size_t)wid * 8192;
    const char* kb = (const char*)T.k + (size_t)bh * NCHUNK * 65536 + (size_t)wid * 8192;
    const char* vb = (const char*)T.v + (size_t)bh * NCHUNK * 65536 + (size_t)es * 8192 + (size_t)wid * 1024;
    const char* sb = (const char*)T.S + (size_t)bh * NCHUNK * 8192 + (size_t)(wid & 3) * 2048;
    const unsigned loff = (unsigned)lane * 16u;
    const float* sa = scal; const float* sm = scal + SEQ; const float* sthr = scal + 2 * SEQ;
    bf16* hg = T.hm + (size_t)b * SEQ * 2048 + 512 * h + 64 * es;
    int zv = 0; asm volatile("" : "+v"(zv));
    float Mc = sm[zv];
    LAS float* sca = (LAS float*)(lds + SCW_OFF) + wid * 160;
    LAS float* nsw = (LAS float*)(lds + NS_OFF) + 64 * wid; LAS unsigned short* nsb = (LAS unsigned short*)(lds + NSB_OFF) + 64 * wid;
    bf16x8 fb[16]; bf16x8 sf[2]; bf16x8 vnext;
    float a_l, m_l, thr_l;
#pragma unroll
    for (int g = 0; g < 8; ++g) fb[g] = *(const bf16x8*)(qb + g * 1024 + loff);
#pragma unroll
    for (int g = 0; g < 8; ++g) fb[8 + g] = *(const bf16x8*)(kb + ((g & 1) * 4 + (g >> 1)) * 1024 + loff);
    sf[0] = *(const bf16x8*)(sb + loff); sf[1] = *(const bf16x8*)(sb + 1024 + loff);
    *(LAS bf16x8*)(lds + V_OFF + wid * 1024 + lane * 16) = *(const bf16x8*)(vb + loff);
    a_l = sa[lane]; m_l = sm[lane]; thr_l = sthr[lane];
    __syncthreads();
#pragma unroll 1
    for (int c = 0; c < NCHUNK; ++c) {
        const int cur = c & 1;
        LAS float* denp = (LAS float*)(lds + DEN_OFF) + cur * 512;
        LAS unsigned char* pbuf = lds + P_OFF + cur * 65536;
        const LAS unsigned char* vcur = lds + V_OFF + cur * 8192; LAS unsigned char* vnxt = lds + V_OFF + (cur ^ 1) * 8192;
        const int cn = (c + 1 < NCHUNK) ? c + 1 : c;
        const char* qn_ = qb + (size_t)cn * 65536; const char* kn_ = kb + (size_t)cn * 65536; const char* sn_ = sb + (size_t)cn * 8192;
        vnext = *(const bf16x8*)(vb + (size_t)cn * 65536 + loff);
        const float Mc2 = bperm(m_l, 63 + zv);
        const float Mt0 = bperm(m_l, l31), Mt1 = bperm(m_l, 32 + l31);
        const float thr0 = bperm(thr_l, l31), thr1 = bperm(thr_l, 32 + l31);
        { const float cwl = __expf(a_l - Mc2); sca[lane] = a_l; sca[64 + lane] = cwl; ((LAS unsigned short*)(sca + 128))[lane] = (unsigned short)(pk2(cwl, 0.f) & 0xffffu); }
        a_l = sa[64 * cn + lane]; m_l = sm[64 * cn + lane]; thr_l = sthr[64 * cn + lane];
        const int ksw = wid & 3, iew = wid >> 2;
        bf16x8 pf[2]; float psum[2];
        {
            const f32x4 aown0 = *(const LAS f32x4*)(sca + 16 * ksw + 4 * hi), aown1 = *(const LAS f32x4*)(sca + 16 * ksw + 8 + 4 * hi);
            const float aw[8] = {aown0[0], aown0[1], aown0[2], aown0[3], aown1[0], aown1[1], aown1[2], aown1[3]};
#pragma unroll
            for (int tt = 0; tt < 2; ++tt) {
                const int t = 32 * tt + l31; const float Mt = tt ? Mt1 : Mt0;
                float sv[8]; unpack8(sf[tt], sv);
                float pw[8]; float ps = 0.f;
#pragma unroll
                for (int j = 0; j < 8; ++j) { const int s = 16 * ksw + 8 * (j >> 2) + 4 * hi + (j & 3); pw[j] = (s <= t) ? sv[j] * __expf(aw[j] - Mt) : 0.f; ps += pw[j]; }
                pf[tt] = pack8(pw[0], pw[1], pw[2], pw[3], pw[4], pw[5], pw[6], pw[7]);
                psum[tt] = ps;
            }
            sf[0] = *(const bf16x8*)(sn_ + loff); sf[1] = *(const bf16x8*)(sn_ + 1024 + loff);
        }
        const float rs0 = __expf(Mc - Mt0), rs1 = __expf(Mc - Mt1);
#pragma unroll
        for (int ie = 0; ie < 2; ++ie) {
            f32x16 ao[2]; ao[0] = (f32x16){}; ao[1] = (f32x16){};
            float qn[2] = {0.f, 0.f};
#pragma unroll
            for (int id = 0; id < 2; ++id)
#pragma unroll
                for (int s = 0; s < 2; ++s) {
                    const int g0 = (id * 2 + s) * 2;
                    const bf16x8 cb = pack8(cst[id][ie][8 * s + 0], cst[id][ie][8 * s + 1], cst[id][ie][8 * s + 2], cst[id][ie][8 * s + 3], cst[id][ie][8 * s + 4], cst[id][ie][8 * s + 5], cst[id][ie][8 * s + 6], cst[id][ie][8 * s + 7]);
                    ao[0] = MFMA32(cb, fb[g0], ao[0]);
                    ao[1] = MFMA32(cb, fb[g0 + 1], ao[1]);
                    if (ie == 0) {
                        const v2u n0 = *(const LAS v2u*)(nsb + 32 * id + 16 * s + 4 * hi), n1 = *(const LAS v2u*)(nsb + 32 * id + 16 * s + 8 + 4 * hi);
#pragma unroll
                        for (int tt = 0; tt < 2; ++tt) {
                            const v4u qv = __builtin_bit_cast(v4u, fb[g0 + tt]);
                            float q_ = qn[tt];
                            q_ = dot2bf(qv.x, n0.x, q_); q_ = dot2bf(qv.y, n0.y, q_); q_ = dot2bf(qv.z, n1.x, q_); q_ = dot2bf(qv.w, n1.y, q_);
                            qn[tt] = q_;
                        }
                    } else {
                        fb[g0] = *(const bf16x8*)(qn_ + g0 * 1024 + loff);
                        fb[g0 + 1] = *(const bf16x8*)(qn_ + (g0 + 1) * 1024 + loff);
                    }
                    __builtin_amdgcn_sched_barrier(0);
                }
            if (ie == 0) {
                float d0 = rs0 * qn[0] + (wid < 4 ? psum[0] : 0.f), d1 = rs1 * qn[1] + (wid < 4 ? psum[1] : 0.f);
                d0 += bperm(d0, lane ^ 32); d1 += bperm(d1, lane ^ 32);
                if (hi == 0) { denp[wid * 64 + l31] = d0; denp[wid * 64 + 32 + l31] = d1; }
            }
#pragma unroll
            for (int r = 0; r < 16; ++r) { ao[0][r] *= rs0; ao[1][r] *= rs1; }
            if (ie == iew) {
                const bf16x8 vown = *(const LAS bf16x8*)(vcur + (iew * 4 + ksw) * 1024 + lane * 16);
                ao[0] = MFMA32(vown, pf[0], ao[0]); ao[1] = MFMA32(vown, pf[1], ao[1]);
            }
#pragma unroll
            for (int tt = 0; tt < 2; ++tt)
#pragma unroll
                for (int g4 = 0; g4 < 4; ++g4) {
                    v2u pw_; pw_.x = pk2(ao[tt][4 * g4], ao[tt][4 * g4 + 1]); pw_.y = pk2(ao[tt][4 * g4 + 2], ao[tt][4 * g4 + 3]);
                    *(LAS v2u*)(pbuf + ((((wid * 2 + ie) * 2 + tt) * 4 + g4) * 512) + lane * 8) = pw_;
                }
        }
        const float decay = __expf(Mc - Mc2);
#pragma unroll
        for (int id = 0; id < 2; ++id)
#pragma unroll
            for (int ie = 0; ie < 2; ++ie)
#pragma unroll
                for (int r = 0; r < 16; ++r) cst[id][ie][r] *= decay;
        float nacc[2] = {0.f, 0.f};
#pragma unroll
        for (int ks = 0; ks < 4; ++ks) {
            const f32x4 c0 = *(const LAS f32x4*)(sca + 64 + 16 * ks + 4 * hi), c1 = *(const LAS f32x4*)(sca + 64 + 16 * ks + 8 + 4 * hi);
            const float cw[8] = {c0[0], c0[1], c0[2], c0[3], c1[0], c1[1], c1[2], c1[3]};
            const v2u cwb0 = *(const LAS v2u*)((const LAS unsigned short*)(sca + 128) + 16 * ks + 4 * hi), cwb1 = *(const LAS v2u*)((const LAS unsigned short*)(sca + 128) + 16 * ks + 8 + 4 * hi);
            bf16x8 vw[2];
#pragma unroll
            for (int ie = 0; ie < 2; ++ie) {
                float vv[8]; unpack8(*(const LAS bf16x8*)(vcur + (ie * 4 + ks) * 1024 + lane * 16), vv);
                vw[ie] = pack8(vv[0] * cw[0], vv[1] * cw[1], vv[2] * cw[2], vv[3] * cw[3], vv[4] * cw[4], vv[5] * cw[5], vv[6] * cw[6], vv[7] * cw[7]);
            }
#pragma unroll
            for (int id = 0; id < 2; ++id) {
                const int g = 8 + ks * 2 + id;
                cst[id][0] = MFMA32(fb[g], vw[0], cst[id][0]);
                cst[id][1] = MFMA32(fb[g], vw[1], cst[id][1]);
                {
                    const v4u kv = __builtin_bit_cast(v4u, fb[g]);
                    float na = nacc[id];
                    na = dot2bf(kv.x, cwb0.x, na); na = dot2bf(kv.y, cwb0.y, na); na = dot2bf(kv.z, cwb1.x, na); na = dot2bf(kv.w, cwb1.y, na);
                    nacc[id] = na;
                }
                fb[g] = *(const bf16x8*)(kn_ + (id * 4 + ks) * 1024 + loff);
            }
            __builtin_amdgcn_sched_barrier(0);
        }
#pragma unroll
        for (int id = 0; id < 2; ++id) {
            float v = nacc[id]; v += bperm(v, lane ^ 32);
            if (hi == 0) { const float nv = decay * nsw[32 * id + l31] + v; nsw[32 * id + l31] = nv; nsb[32 * id + l31] = (unsigned short)(pk2(nv, 0.f) & 0xffffu); }
        }
        *(LAS bf16x8*)(vnxt + wid * 1024 + lane * 16) = vnext;
        __syncthreads();
#pragma unroll
        for (int tt = 0; tt < 2; ++tt) {
            float nm[4] = {0.f, 0.f, 0.f, 0.f};
#pragma unroll
            for (int src = 0; src < 8; ++src) {
                const v2u pv = *(const LAS v2u*)(pbuf + ((((src * 2 + iew) * 2 + tt) * 4 + ksw) * 512) + lane * 8);
                nm[0] += bflo(pv.x); nm[1] += bfhi(pv.x); nm[2] += bflo(pv.y); nm[3] += bfhi(pv.y);
            }
            const int t = 32 * tt + l31;
            float den = 0.f;
#pragma unroll
            for (int src = 0; src < 8; ++src) den += denp[src * 64 + t];
            const float dn = fmaxf(fabsf(den), tt ? thr1 : thr0);
            const float inv = 1.0f / dn;
            v2u wv; wv.x = pk2(nm[0] * inv, nm[1] * inv); wv.y = pk2(nm[2] * inv, nm[3] * inv);
            *(v2u*)(hg + (size_t)(64 * c + t) * 2048 + 32 * iew + 8 * ksw + 4 * hi) = wv;
        }
        Mc = Mc2;
    }
    __syncthreads();
}
DI void phase(LAS unsigned char* lds, const Tensors& T, int G, int blk, int wv) {
#pragma unroll 1
    for (int u = blk; u < 256; u += G) {
        const int xcd = u & 7, j = u >> 3;
        unit(lds, T, xcd * 4 + (j >> 3), j & 7, wv);
    }
}
}
namespace mpost {
constexpr int GSTR = 576;
constexpr int XC_OFF = 0, WV_OFF = 128 * GSTR, LDS_BYTES = WV_OFF + 128 * 64;
struct Tensors { bf16* hm; const bf16* om; const bf16* kimg; const float* wv; const float* hng; const float* skip; };

DI void unit(LAS unsigned char* lds, const Tensors& T, int u, int tid_in) {
    const int tid_ = wg_tid_local(tid_in);
    const int tid = tid_;
    const int h = u & 3, c = (u >> 2) & 63, b = u >> 8;
#pragma unroll
    for (int k = 0; k < 2; ++k) {
        const int id = tid + 512 * k, pb = id & 7, g = id >> 3, ks = pb >> 1, hi_ = pb & 1;
        const char* src = (const char*)T.kimg + ((size_t)((b * 4 + h) * 64 + c) * 64 + (g >> 3) * 4 + ks) * 1024 + (4 * (g & 7) + 32 * hi_) * 16;
        const v4u r0 = *(const v4u*)(src), r1 = *(const v4u*)(src + 16), r2 = *(const v4u*)(src + 32), r3 = *(const v4u*)(src + 48);
        const unsigned a0[4] = {r0.x, r0.y, r0.z, r0.w}, a1[4] = {r1.x, r1.y, r1.z, r1.w}, a2[4] = {r2.x, r2.y, r2.z, r2.w}, a3[4] = {r3.x, r3.y, r3.z, r3.w};
#pragma unroll
        for (int m = 0; m < 4; ++m) {
            const int tok = 16 * ks + 8 * (m >> 1) + 4 * hi_ + 2 * (m & 1);
            v2u e0, e1;
            e0.x = (a0[m] & 0xffffu) | (a1[m] << 16); e0.y = (a2[m] & 0xffffu) | (a3[m] << 16);
            e1.x = (a0[m] >> 16) | (a1[m] & 0xffff0000u); e1.y = (a2[m] >> 16) | (a3[m] & 0xffff0000u);
            *(LAS v2u*)(lds + XC_OFF + g * GSTR + tok * 8) = e0;
            *(LAS v2u*)(lds + XC_OFF + g * GSTR + (tok + 1) * 8) = e1;
        }
    }
    *(LAS f32x4*)(lds + WV_OFF + tid * 16) = *(const f32x4*)(T.wv + (size_t)(128 * h) * 16 + tid * 4);
    __syncthreads();
    const int t5 = tid >> 4, seg = tid & 15;
#pragma unroll 1
    for (int pass = 0; pass < 2; ++pass) {
        const int t = t5 + 32 * pass;
        const size_t rowu = ((size_t)b * SEQ + 64 * c + 32 * pass) * 2048 + 512 * h;
        char* hmb = (char*)(T.hm + rowu); const char* omb = (const char*)(T.om + rowu);
        const char* gnb = (const char*)(T.hng + 512 * h); const char* skb = (const char*)(T.skip + 512 * h);
        const unsigned voff = (unsigned)(t5 * 4096 + seg * 8), soff = (unsigned)(seg * 16);
        float uv[32];
        float sum = 0.f;
#pragma unroll
        for (int k = 0; k < 8; ++k) {
            const int gi = seg + 16 * k;
            const v2u hx = *(const v2u*)(hmb + voff + k * 128);
            const v2u og = *(const v2u*)(omb + voff + k * 128);
            const float hv[4] = {bflo(hx.x), bfhi(hx.x), bflo(hx.y), bfhi(hx.y)};
            const float ov[4] = {bflo(og.x), bfhi(og.x), bflo(og.y), bfhi(og.y)};
            const LAS f32x4* wp = (const LAS f32x4*)(lds + WV_OFF + gi * 64);
            const f32x4 w0 = wp[0], w1 = wp[1], w2 = wp[2], w3 = wp[3];
#pragma unroll
            for (int o = 0; o < 4; ++o) {
                const float v = hv[0] * w0[o] + hv[1] * w1[o] + hv[2] * w2[o] + hv[3] * w3[o];
                const float x = v * ov[o];
                uv[4 * k + o] = x; sum += x;
            }
            if (k & 1) __builtin_amdgcn_sched_barrier(0);
        }
        sum += __shfl_xor(sum, 1); sum += __shfl_xor(sum, 2); sum += __shfl_xor(sum, 4); sum += __shfl_xor(sum, 8);
        const float mean = sum * (1.0f / 512.0f);
        float sq = 0.f;
#pragma unroll
        for (int i = 0; i < 32; ++i) { const float d = uv[i] - mean; sq += d * d; }
        sq += __shfl_xor(sq, 1); sq += __shfl_xor(sq, 2); sq += __shfl_xor(sq, 4); sq += __shfl_xor(sq, 8);
        const float rstd = 1.0f / sqrtf(sq * (1.0f / 512.0f) + EPS);
#pragma unroll
        for (int k = 0; k < 8; ++k) {
            const int gi = seg + 16 * k;
            const f32x4 gn = *(const f32x4*)(gnb + soff + k * 256), sk = *(const f32x4*)(skb + soff + k * 256);
            const v2u xc = *(const LAS v2u*)(lds + XC_OFF + gi * GSTR + t * 8);
            const float xv[4] = {bflo(xc.x), bfhi(xc.x), bflo(xc.y), bfhi(xc.y)};
            float r[4];
#pragma unroll
            for (int o = 0; o < 4; ++o) r[o] = (uv[4 * k + o] - mean) * rstd * gn[o] + sk[o] * xv[o];
            v2u wv; wv.x = pk2(r[0], r[1]); wv.y = pk2(r[2], r[3]);
            *(v2u*)(hmb + voff + k * 128) = wv;
        }
    }
    __syncthreads();
}
DI void phase(LAS unsigned char* lds, const Tensors& T, int G, int blk, int wv) {
    for (int u = blk; u < BATCH * NCHUNK * MH; u += G) unit(lds, T, u, wv);
}
}

DI void transpose_item(const float* W, int K, int N, bf16* WT, const float* kscale, LAS float* scr, int item, int lane) {
    const int nblk = N / 32, kb = item / nblk, nb = item % nblk, k0 = 64 * kb, n0 = 32 * nb;
#pragma unroll 8
    for (int i = 0; i < 32; ++i) { const int kk = 2 * i + (lane >> 5); float v = W[(size_t)(k0 + kk) * N + n0 + (lane & 31)]; if (kscale) v *= kscale[k0 + kk]; scr[kk * 33 + (lane & 31)] = v; }
    asm volatile("s_waitcnt lgkmcnt(0)" ::: "memory");
    const int cc = lane & 7;
#pragma unroll
    for (int j = 0; j < 4; ++j) { const int n = (lane >> 3) + 8 * j; const LAS float* s = scr + (8 * cc) * 33 + n;
        v4u o; o.x = pk2(s[0 * 33], s[1 * 33]); o.y = pk2(s[2 * 33], s[3 * 33]); o.z = pk2(s[4 * 33], s[5 * 33]); o.w = pk2(s[6 * 33], s[7 * 33]);
        *(v4u*)(WT + (size_t)(n0 + n) * K + k0 + 8 * cc) = o; }
    asm volatile("s_waitcnt lgkmcnt(0)" ::: "memory");
}
DI void rms_row_to_bf16(const float* xrow, bf16* orow, int lane) {
    const f32x4* xr = (const f32x4*)xrow + lane;
    f32x4 v[4]; float s = 0.f;
#pragma unroll
    for (int j = 0; j < 4; ++j) { v[j] = xr[64 * j]; s += (v[j][0] * v[j][0] + v[j][1] * v[j][1]) + (v[j][2] * v[j][2] + v[j][3] * v[j][3]); }
    const float r = 1.0f / sqrtf(wave_sum(s) * (1.0f / 1024.0f) + EPS);
    v2u* o8 = (v2u*)orow + lane;
#pragma unroll
    for (int j = 0; j < 4; ++j) { v2u w; w.x = pk2(v[j][0] * r, v[j][1] * r); w.y = pk2(v[j][2] * r, v[j][3] * r); o8[64 * j] = w; }
}
DI void rms_row_inplace(float* row, const float* g, int lane) {
    f32x4* xr = (f32x4*)row + lane; const f32x4* gr = (const f32x4*)g + lane;
    f32x4 v[4]; float s = 0.f;
#pragma unroll
    for (int j = 0; j < 4; ++j) { v[j] = xr[64 * j]; s += (v[j][0] * v[j][0] + v[j][1] * v[j][1]) + (v[j][2] * v[j][2] + v[j][3] * v[j][3]); }
    const float r = 1.0f / sqrtf(wave_sum(s) * (1.0f / 1024.0f) + EPS);
#pragma unroll
    for (int j = 0; j < 4; ++j) xr[64 * j] = v[j] * r * gr[64 * j];
}
constexpr int N_PHASES = 15;
constexpr int LDS_TOTAL = 163840, XB_LDS_OFF = 163840 - 16;
static_assert(pg8::STAGE_BYTES <= XB_LDS_OFF && att::LDS_BYTES <= XB_LDS_OFF && mpre::LDS_BYTES <= XB_LDS_OFF && mscan::LDS_BYTES <= XB_LDS_OFF && mpost::LDS_BYTES <= XB_LDS_OFF, "LDS map vs barrier words");
static_assert(pg8::STAGE_BYTES <= LDS_TOTAL && att::LDS_BYTES <= LDS_TOTAL && mpre::LDS_BYTES <= LDS_TOTAL && mscan::LDS_BYTES <= LDS_TOTAL && mpost::LDS_BYTES <= LDS_TOTAL, "LDS map");

struct Args { const float* in[18]; float* out; unsigned char* ws; int ph_lo, ph_hi; };

DI void prologue(const Args& a, LAS unsigned char* lds, int G, int blk, int wvi) {
    const int tid = wg_tid_local(wvi), lane = tid & 63, wave = __builtin_amdgcn_readfirstlane(tid >> 6);
    unsigned char* ws = a.ws;
    LAS float* scr = (LAS float*)(lds + wave * 16384);
    const int gw = blk * NWAVES + wave, NGW = G * NWAVES;
    constexpr int I_IN = (DM / 64) * (NIN / 32), I_PA = (AW / 64) * (DM / 32), I_PB = (MW / 64) * (DM / 32), I_OUT = (DM / 64) * (DM / 32);
    constexpr int NITEMS = I_IN + I_PA + I_PB + I_OUT;
    for (int it = gw; it < NITEMS; it += NGW) {
        int r = it;
        if (r < I_IN) { transpose_item(a.in[2], DM, NIN, (bf16*)(ws + WS_WIN), a.in[1], scr, r, lane); continue; } r -= I_IN;
        if (r < I_PA) { transpose_item(a.in[13], AW, DM, (bf16*)(ws + WS_WPA), nullptr, scr, r, lane); continue; } r -= I_PA;
        if (r < I_PB) { transpose_item(a.in[14], MW, DM, (bf16*)(ws + WS_WPB), nullptr, scr, r, lane); continue; } r -= I_PB;
        transpose_item(a.in[15], DM, DM, (bf16*)(ws + WS_WOUT), nullptr, scr, r, lane);
    }
    for (int m = gw; m < MTOK; m += NGW) rms_row_to_bf16(a.in[0] + (size_t)m * DM, (bf16*)(ws + WS_XN) + (size_t)m * DM, lane);
    float* tab = (float*)(ws + WS_TAB);
    const float* wq = a.in[6]; const float* wk = a.in[7]; const float* wv = a.in[8]; const float* wif = a.in[9]; const float* rb = a.in[16];
    const int gt = blk * NTHR + tid, NGT = G * NTHR;
    for (int i = gt; i < 2048 * 8; i += NGT) {
        const int c = i >> 3, j = i & 7, g = c >> 2, ii = c & 3;
        float sc = 0.f, sm = 0.f;
#pragma unroll
        for (int o = 0; o < 4; ++o) {
            sc += wq[g * 16 + ii * 4 + o] * wif[(size_t)(4 * g + o) * 8 + j] + wk[g * 16 + ii * 4 + o] * wif[(size_t)(2048 + 4 * g + o) * 8 + j];
            sm += wv[g * 16 + ii * 4 + o] * wif[(size_t)(4096 + 4 * g + o) * 8 + j];
        }
        ((bf16*)(tab + TAB_WC))[j * 2048 + c] = (bf16)(pk2(sc, 0.f) & 0xffffu); ((bf16*)(tab + TAB_WM))[j * 2048 + c] = (bf16)(pk2(sm, 0.f) & 0xffffu);
    }
    for (int i = gt; i < 512 * 16; i += NGT) {
        const int g = i >> 4, ii = (i >> 2) & 3, i2 = i & 3;
        float s = 0.f;
#pragma unroll
        for (int o = 0; o < 4; ++o) s += wq[g * 16 + ii * 4 + o] * wk[g * 16 + i2 * 4 + o];
        tab[TAB_G + i] = s * 0.04419417382415922f;
    }
    for (int i = gt; i < 3 * 16 * 132; i += NGT) {
        const int d = i % 132, ph = i / 132, p = ph >> 4, hh = ph & 15;
        tab[TAB_BIAS + i] = rb[BUCKET[p][d] * 16 + hh] * LOG2E;
    }
}

#define XB_TMO      128
#define XB_XCNT(j)  (256  + 64 * (j))
#define XB_XSUB(j)  (1280 + 64 * (j))
#define XB_XGEN(j)  (2304 + 64 * (j))
#define XB_TOP      3328
#define XB_TOPGEN   3392
#define XCD_BAR_WORDS 3456
#define XB_SPIN_CAP (1u << 18)
DI unsigned xb_ld(unsigned* p)              { return __hip_atomic_load(p, __ATOMIC_RELAXED, __HIP_MEMORY_SCOPE_AGENT); }
DI unsigned xb_add(unsigned* p, unsigned v) { return __hip_atomic_fetch_add(p, v, __ATOMIC_RELAXED, __HIP_MEMORY_SCOPE_AGENT); }
DI unsigned xb_xcc_id() { return (unsigned)__builtin_amdgcn_s_getreg((3 << 11) | 20) & 0xFu; }
#define XB_SPIN(cond, bar) do { unsigned _sp = 0; while (cond) { __builtin_amdgcn_s_sleep(1); \
    if ((++_sp & 255u) == 0u) { if (xb_ld(&(bar)[XB_TMO])) break; if (_sp > XB_SPIN_CAP) { atomicAdd(&(bar)[XB_TMO], 1u); break; } } } } while (0)
struct XcdBarrier { unsigned* bar; unsigned x; volatile LAS unsigned* st; };
DI XcdBarrier xcd_barrier_post(unsigned* bar, volatile LAS unsigned* st, int tid) {
    XcdBarrier b; b.bar = bar; b.x = xb_xcc_id(); b.st = st;
    if (tid == 0) (void)xb_add(&bar[XB_XCNT(b.x)], 1u);
    return b;
}
DI void xcd_barrier_complete(unsigned* bar, unsigned x, unsigned& nloc, unsigned& nx) {
    const unsigned G = gridDim.x * gridDim.y * gridDim.z;
    unsigned sum, cnt, mine, sp = 0u;
    for (;;) {
        sum = 0u; cnt = 0u; mine = 0u;
#pragma unroll
        for (unsigned j = 0; j < 16; ++j) { const unsigned c = xb_ld(&bar[XB_XCNT(j)]); sum += c; cnt += (c > 0u) ? 1u : 0u; mine = (j == x) ? c : mine; }
        if (sum == G) break;
        __builtin_amdgcn_s_sleep(1);
        if ((++sp & 255u) == 0u) { if (xb_ld(&bar[XB_TMO])) break; if (sp > XB_SPIN_CAP) { atomicAdd(&bar[XB_TMO], 1u); break; } }
    }
    nloc = mine > 0u ? mine : 1u; nx = cnt > 0u ? cnt : 1u;
}
DI void xcd_barrier(const XcdBarrier& b, int tid) {
    asm volatile("s_waitcnt vmcnt(0)" ::: "memory");
    __syncthreads();
    if (tid == 0) {
        unsigned* bar = b.bar;
        __builtin_amdgcn_s_waitcnt(0);
        unsigned nloc = b.st[0], nx = b.st[1];
        if (nloc == 0u) { xcd_barrier_complete(bar, b.x, nloc, nx); b.st[0] = nloc; b.st[1] = nx; }
        const unsigned old = xb_add(&bar[XB_XSUB(b.x)], 1u);
        const unsigned gen = old / nloc;
        if (old + 1u == (gen + 1u) * nloc) {
            __builtin_amdgcn_fence(__ATOMIC_RELEASE, "agent");
            asm volatile("s_waitcnt vmcnt(0)" ::: "memory");
            const unsigned og = xb_add(&bar[XB_TOP], 1u);
            const unsigned tg = og / nx;
            if (og + 1u == (tg + 1u) * nx) xb_add(&bar[XB_TOPGEN], 1u);
            else XB_SPIN(xb_ld(&bar[XB_TOPGEN]) == tg, bar);
            __builtin_amdgcn_fence(__ATOMIC_ACQUIRE, "agent");
            xb_add(&bar[XB_XGEN(b.x)], 1u);
            asm volatile("s_waitcnt vmcnt(0)" ::: "memory");
        } else {
            XB_SPIN(xb_ld(&bar[XB_XGEN(b.x)]) == gen, bar);
            __builtin_amdgcn_fence(__ATOMIC_ACQUIRE, "agent");
            asm volatile("s_waitcnt vmcnt(0)" ::: "memory");
        }
    }
    __syncthreads();
}

DI void grid_sync_(int tid) {
    asm volatile("s_waitcnt vmcnt(0) lgkmcnt(0)" ::: "memory");
    __builtin_amdgcn_fence(__ATOMIC_RELEASE, "workgroup");
    __builtin_amdgcn_s_barrier();
    if (tid == 0) {
        __builtin_amdgcn_fence(__ATOMIC_ACQUIRE, "workgroup");
        __builtin_amdgcn_fence(__ATOMIC_RELEASE, "agent");
        const __attribute__((address_space(4))) char* ia = (const __attribute__((address_space(4))) char*)__builtin_amdgcn_implicitarg_ptr();
        const unsigned long long p = *(const __attribute__((address_space(4))) unsigned long long*)(ia + 88);
        unsigned* bar = (unsigned*)(p + 32);
        const unsigned nwg = *(const unsigned*)(p + 40);
        const unsigned old = __hip_atomic_fetch_add(bar, 1u, __ATOMIC_RELAXED, __HIP_MEMORY_SCOPE_AGENT);
        if ((old & 0xffffu) == nwg - 1u) (void)__hip_atomic_fetch_add(bar, 65536u - nwg, __ATOMIC_RELAXED, __HIP_MEMORY_SCOPE_AGENT);
        const unsigned gen = old & 0xffff0000u;
        while ((__hip_atomic_load(bar, __ATOMIC_RELAXED, __HIP_MEMORY_SCOPE_AGENT) & 0xffff0000u) == gen) __builtin_amdgcn_s_sleep(1);
        __builtin_amdgcn_fence(__ATOMIC_ACQUIRE, "agent");
        __builtin_amdgcn_fence(__ATOMIC_RELEASE, "workgroup");
    }
    __builtin_amdgcn_s_barrier();
    __builtin_amdgcn_fence(__ATOMIC_ACQUIRE, "workgroup");
}

__global__ void __launch_bounds__(NTHR) mk_fwd(Args a) {
    extern __shared__ __attribute__((aligned(16))) unsigned char lds_raw[];
    LAS unsigned char* lds = (LAS unsigned char*)lds_raw;
    const int G = gridDim.x, blk = blockIdx.x;
    const int wv = __builtin_amdgcn_readfirstlane(threadIdx.x >> 6);
    volatile LAS unsigned* bst = (volatile LAS unsigned*)(lds + XB_LDS_OFF);
    if (wg_tid_local(wv) < 4) bst[wg_tid_local(wv)] = 0u;
    __syncthreads();
    (void)xcd_barrier_post((unsigned*)(a.ws + WS_CTL) + 1024, bst, wg_tid_local(wv));
#define XBAR() do { XcdBarrier xb_; xb_.bar = (unsigned*)(a.ws + WS_CTL) + 1024; xb_.x = xb_xcc_id(); xb_.st = (volatile LAS unsigned*)(lds + XB_LDS_OFF); xcd_barrier(xb_, wg_tid_local(wv)); } while (0)
    unsigned char* ws = a.ws;
    const int lo = a.ph_lo, hi = a.ph_hi;
    bf16* XN = (bf16*)(ws + WS_XN); bf16* WIN = (bf16*)(ws + WS_WIN);
#ifndef PH_MASK
#define PH_MASK 0x7fff
#endif
#define IN(k) (((PH_MASK >> (k)) & 1) && lo <= (k) && (k) < hi)
#ifndef REP_MASK
#define REP_MASK 0
#endif
#define REPEAT(k, body) do { body; if ((REP_MASK >> (k)) & 1) { XBAR(); body; } } while (0)
#define SEAM(k) do { if (IN(k) && IN((k) + 1)) { if (lo < 0) grid_sync_(wg_tid_local(wv)); XBAR(); } } while (0)
#define GEMM_PHASE(EPI, E, Aop, Bop, NN, KK) do { pg8::Gemm g{(const pg8::bf16_t*)(Aop), (const pg8::bf16_t*)(Bop), MTOK, (NN), (KK)}; pg8::StaticOrder S; S.init(MTOK, (NN), G, blk); \
        pg8::gemm_phase<EPI, pg8::StaticOrder, true, true>(lds, g, S, E, wg_tid_local(wv)); } while (0)

    if (IN(0)) { REPEAT(0, prologue(a, lds, G, blk, wv)); } SEAM(0);
    if (IN(1)) {
        pg8::EpiXM E{(bf16*)(ws + WS_R0), (bf16*)(ws + WS_HALO)};
        REPEAT(1, GEMM_PHASE(pg8::EpiXM, E, XN, WIN + (size_t)C_XM * DM, MW, DM));
    } SEAM(1);
    if (IN(2)) {
        const float* tab = (const float*)(ws + WS_TAB);
        mpre::Tensors T{(const bf16*)(ws + WS_R0), (const bf16*)(ws + WS_HALO), (bf16*)(ws + WS_R1), (bf16*)a.out, (bf16*)(ws + WS_R2), (float*)(ws + WS_GP), (bf16*)(ws + WS_S), a.in[4], a.in[5], (const bf16*)(tab + TAB_WC), (const bf16*)(tab + TAB_WM), tab + TAB_G};
        REPEAT(2, mpre::phase(lds, T, G, blk, wv));
    } SEAM(2);
    if (IN(3)) {
        mscan::Tensors T{(const bf16*)(ws + WS_R2), (const bf16*)(ws + WS_R1), (const bf16*)a.out, (const bf16*)(ws + WS_S), (const float*)(ws + WS_GP), a.in[10], (float*)(ws + WS_SCAL), (bf16*)(ws + WS_R0)};
        REPEAT(3, mscan::phase(lds, T, G, blk, wv));
    } SEAM(3);
    if (IN(4)) {
        pg8::EpiSig E{(bf16*)(ws + WS_R2), MW, nullptr};
        REPEAT(4, GEMM_PHASE(pg8::EpiSig, E, XN, WIN + (size_t)C_OM * DM, MW, DM));
    } SEAM(4);
    if (IN(5)) {
        mpost::Tensors T{(bf16*)(ws + WS_R0), (const bf16*)(ws + WS_R2), (const bf16*)(ws + WS_R1), a.in[8], a.in[11], a.in[12]};
        mpost::phase(lds, T, G, blk, wv);
    } SEAM(5);
    if (IN(6)) {
        pg8::EpiZM E{(bf16*)(ws + WS_R0)};
        GEMM_PHASE(pg8::EpiZM, E, XN, WIN + (size_t)C_ZM * DM, MW, DM);
    } SEAM(6);
    if (IN(7)) {
        pg8::EpiQKV E{(bf16*)(ws + WS_QA), (size_t)(WS_KA - WS_QA) / 2};
        REPEAT(7, GEMM_PHASE(pg8::EpiQKV, E, XN, WIN + (size_t)C_QA * DM, 3 * AW, DM));
    } SEAM(7);
    if (IN(8)) {
        att::Tensors T{(const bf16*)(ws + WS_QA), (const bf16*)(ws + WS_KA), (const bf16*)(ws + WS_VA), (bf16*)(ws + WS_O1), (bf16*)a.out, (float*)(ws + WS_ST), (const float*)(ws + WS_TAB) + TAB_BIAS};
        REPEAT(8, att::phase(lds, T, G, blk, wv));
    } SEAM(8);
    if (IN(9)) {
        pg8::EpiZA E{(const bf16*)(ws + WS_O1), (const bf16*)a.out, (const bf16*)a.out + (size_t)MTOK * AW, (const float*)(ws + WS_ST), (bf16*)(ws + WS_A1)};
        REPEAT(9, GEMM_PHASE(pg8::EpiZA, E, XN, WIN + (size_t)C_ZA * DM, AW, DM));
    } SEAM(9);
    if (IN(10)) {
        pg8::EpiSig E{(bf16*)(ws + WS_G), 2 * DM, a.in[3]};
        REPEAT(10, GEMM_PHASE(pg8::EpiSig, E, XN, WIN + (size_t)C_G * DM, 2 * DM, DM));
    } SEAM(10);
    if (IN(11)) {
        pg8::EpiYA E{(bf16*)(ws + WS_G)};
        GEMM_PHASE(pg8::EpiYA, E, ws + WS_A1, ws + WS_WPA, DM, AW);
    } SEAM(11);
    if (IN(12)) {
        pg8::EpiYM E{(const bf16*)(ws + WS_G), (bf16*)(ws + WS_MRG)};
        REPEAT(12, GEMM_PHASE(pg8::EpiYM, E, ws + WS_R0, ws + WS_WPB, DM, MW));
    } SEAM(12);
    if (IN(13)) {
        pg8::EpiOut E{a.in[0], a.out};
        REPEAT(13, GEMM_PHASE(pg8::EpiOut, E, ws + WS_MRG, ws + WS_WOUT, DM, DM));
    } SEAM(13);
#ifdef EXTRA_SYNCS
    if (IN(13) && IN(14)) { for (int i = 0; i < EXTRA_SYNCS; ++i) XBAR(); }
#endif
    if (IN(14)) {
        const int lane = wg_tid_local(wv) & 63, wave = wv;
        for (int m = blk * NWAVES + wave; m < MTOK; m += G * NWAVES) rms_row_inplace(a.out + (size_t)m * DM, a.in[17], lane);
    }
#undef IN
#undef SEAM
#undef GEMM_PHASE
}

#ifndef MK_ONE_LAUNCH
#define MK_ONE_LAUNCH 0
#endif
extern "C" void kernel_launch(void* const* d_in, const int* in_sizes, int n_in, void* d_out, int out_size, void* d_ws, size_t ws_size, hipStream_t stream) {
    static int grid = 0;
    if (grid == 0) {
        if (n_in != 18 || in_sizes[0] != MTOK * DM || out_size != MTOK * DM || ws_size < WS_END) { fprintf(stderr, "kernel_launch: unexpected shapes (n_in %d, ws %zu)\n", n_in, ws_size); grid = -1; return; }
        int dev = 0, cus = 0, per_cu = 0;
        (void)hipGetDevice(&dev); (void)hipDeviceGetAttribute(&cus, hipDeviceAttributeMultiprocessorCount, dev);
        if (hipFuncSetAttribute((const void*)mk_fwd, hipFuncAttributeMaxDynamicSharedMemorySize, LDS_TOTAL) != hipSuccess) { fprintf(stderr, "kernel_launch: hipFuncSetAttribute failed\n"); grid = -1; return; }
        if (hipOccupancyMaxActiveBlocksPerMultiprocessor(&per_cu, (const void*)mk_fwd, NTHR, LDS_TOTAL) != hipSuccess || per_cu < 1) { fprintf(stderr, "kernel_launch: occupancy query says %d\n", per_cu); per_cu = 1; }
        (void)hipGetLastError();
        grid = cus * (per_cu > 1 ? 1 : per_cu);
    }
    if (grid < 0) return;
    if (hipMemsetAsync((char*)d_ws + WS_CTL, 0, 65536, stream) != hipSuccess) { fprintf(stderr, "kernel_launch: hipMemsetAsync failed\n"); return; }
    Args a{};
    for (int i = 0; i < 18; ++i) a.in[i] = (const float*)d_in[i];
    a.out = (float*)d_out; a.ws = (unsigned char*)d_ws;
#if MK_ONE_LAUNCH
    a.ph_lo = 0; a.ph_hi = N_PHASES;
    void* args[] = {&a};
    hipError_t e = hipLaunchCooperativeKernel((const void*)mk_fwd, dim3(grid), dim3(NTHR), args, LDS_TOTAL, stream);
    if (e != hipSuccess) fprintf(stderr, "cooperative launch failed: %s (grid %d)\n", hipGetErrorString(e), grid);
#else
    for (int p = 0; p < N_PHASES; ++p) {
        a.ph_lo = p; a.ph_hi = p + 1;
        hipLaunchKernelGGL(mk_fwd, dim3(grid), dim3(NTHR), LDS_TOTAL, stream, a);
    }
#endif
}
```

```cpp
#define MK_ONE_LAUNCH 1
#include <hip/hip_runtime.h>
#include <hip/hip_cooperative_groups.h>
#include <cstdio>
#include <cstdint>
namespace cg = cooperative_groups;
#define LAS __attribute__((address_space(3)))
#define GAS __attribute__((address_space(1)))
typedef unsigned short bf16;
typedef unsigned v4u __attribute__((ext_vector_type(4)));
typedef unsigned v2u __attribute__((ext_vector_type(2)));
typedef float f32x4 __attribute__((ext_vector_type(4)));
typedef float f32x16 __attribute__((ext_vector_type(16)));
typedef short bf16x8 __attribute__((ext_vector_type(8)));
typedef short s16x4 __attribute__((ext_vector_type(4)));
typedef float f32x2_t __attribute__((ext_vector_type(2)));
typedef __bf16 bf16x2_t __attribute__((ext_vector_type(2)));

constexpr int NWAVES = 8, NTHR = 512;
constexpr int BATCH = 8, SEQ = 4096, DM = 1024, MTOK = BATCH * SEQ;
constexpr int AH = 16, AHD = 64, AW = 1024;
constexpr int MH = 4, MHD = 512, MW = 2048;
constexpr int NIN = 12288;
constexpr int C_QA = 0, C_KA = 1024, C_VA = 2048, C_ZA = 3072, C_XM = 4096, C_ZM = 6144, C_OM = 8192, C_G = 10240;
constexpr int CHUNK = 64, NCHUNK = SEQ / CHUNK;
constexpr float EPS = 1e-6f;
constexpr float LOG2E = 1.4426950408889634f;
constexpr float QSCALE = 0.125f * 1.4426950408889634f;

constexpr size_t MiB = 1u << 20;
constexpr size_t WS_CTL = 0;
constexpr size_t WS_WIN = 1 * MiB;
constexpr size_t WS_WPA = 25 * MiB;
constexpr size_t WS_WPB = 27 * MiB;
constexpr size_t WS_WOUT = 31 * MiB;
constexpr size_t WS_TAB = 33 * MiB;
constexpr size_t WS_GP = 34 * MiB;
constexpr size_t WS_SCAL = 38 * MiB;
constexpr size_t WS_HALO = 40 * MiB;
constexpr size_t WS_ST = 34 * MiB;
constexpr size_t WS_XN = 46 * MiB;
constexpr size_t WS_R0 = 110 * MiB;
constexpr size_t WS_R1 = 238 * MiB;
constexpr size_t WS_R2 = 366 * MiB;
constexpr size_t WS_S = 494 * MiB;
constexpr size_t WS_END = 512 * MiB;
constexpr size_t WS_QA = 238 * MiB, WS_KA = 302 * MiB, WS_VA = 366 * MiB;
constexpr size_t WS_O1 = 430 * MiB;
constexpr size_t WS_A1 = 238 * MiB;
constexpr size_t WS_G = 302 * MiB;
constexpr size_t WS_MRG = 430 * MiB;
constexpr int TAB_WC = 0;
constexpr int TAB_WM = 2048 * 8;
constexpr int TAB_G = 2 * 2048 * 8;
constexpr int TAB_BIAS = TAB_G + 512 * 16;
constexpr int TAB_END = TAB_BIAS + 3 * 16 * 132;

__device__ const unsigned char BUCKET[3][132] = {
 {0,1,2,3,4,5,6,7,8,9,10,11,12,13,14,15,16,16,16,16,16,16,17,17,17,17,17,17,17,17,18,18,18,18,18,18,18,18,18,18,19,19,19,19,19,19,19,19,19,19,19,19,19,19,20,20,20,20,20,20,20,20,20,20,20,20,20,20,20,20,20,20,20,21,21,21,21,21,21,21,21,21,21,21,21,21,21,21,21,21,21,21,21,21,21,21,21,21,21,22,22,22,22,22,22,22,22,22,22,22,22,22,22,22,22,22,22,22,22,22,22,22,22,22,22,22,22,22,22,0,0,0},
 {0,4,8,12,16,16,17,17,18,18,19,19,19,19,20,20,20,20,20,21,21,21,21,21,21,22,22,22,22,22,22,22,22,22,23,23,23,23,23,23,23,23,23,23,23,23,24,24,24,24,24,24,24,24,24,24,24,24,24,24,24,24,25,25,25,25,25,25,25,25,25,25,25,25,25,25,25,25,25,25,25,25,25,26,26,26,26,26,26,26,26,26,26,26,26,26,26,26,26,26,26,26,26,26,26,26,26,26,26,26,26,26,26,27,27,27,27,27,27,27,27,27,27,27,27,27,27,27,27,0,0,0},
 {0,16,18,19,20,21,21,22,22,23,23,23,24,24,24,24,25,25,25,25,25,26,26,26,26,26,26,26,26,27,27,27,27,27,27,27,27,27,27,28,28,28,28,28,28,28,28,28,28,28,28,28,29,29,29,29,29,29,29,29,29,29,29,29,29,29,29,29,29,29,30,30,30,30,30,30,30,30,30,30,30,30,30,30,30,30,30,30,30,30,30,30,30,30,30,31,31,31,31,31,31,31,31,31,31,31,31,31,31,31,31,31,31,31,31,31,31,31,31,31,31,31,31,31,31,31,31,31,31,0,0,0}};

#define DI __device__ __forceinline__
DI unsigned pk2(float lo, float hi) { f32x2_t v = {lo, hi}; bf16x2_t b = __builtin_convertvector(v, bf16x2_t); return __builtin_bit_cast(unsigned, b); }
DI float bflo(unsigned u) { return __uint_as_float(u << 16); }
DI float bfhi(unsigned u) { return __uint_as_float(u & 0xffff0000u); }
DI float sigmoidf_(float x) { return 1.0f / (1.0f + __expf(-x)); }
DI float siluf_(float x) { return x / (1.0f + __expf(-x)); }
DI float wave_sum(float v) {
#pragma unroll
    for (int o = 1; o < 64; o <<= 1) v += __shfl_xor(v, o);
    return v;
}
DI int wg_tid(int wv) { return wv * 64 + (int)__builtin_amdgcn_mbcnt_hi(~0u, __builtin_amdgcn_mbcnt_lo(~0u, 0u)); }
DI int wg_tid_local(int wv) { int z; asm volatile("v_mov_b32 %0, 0" : "=v"(z)); return wv * 64 + (int)__builtin_amdgcn_mbcnt_hi(~0u, __builtin_amdgcn_mbcnt_lo(~0u, (unsigned)z)); }
DI float dot2bf(unsigned a, unsigned b, float acc) { return __builtin_amdgcn_fdot2_f32_bf16(__builtin_bit_cast(bf16x2_t, a), __builtin_bit_cast(bf16x2_t, b), acc, false); }
DI float bperm(float v, int srclane) { return __int_as_float(__builtin_amdgcn_ds_bpermute(srclane << 2, __float_as_int(v))); }
DI int crow(int r, int hi) { return (r & 3) + 8 * (r >> 2) + 4 * hi; }
#define MFMA32(a, b, c) __builtin_amdgcn_mfma_f32_32x32x16_bf16((a), (b), (c), 0, 0, 0)
DI s16x4 tr_read(const LAS unsigned char* p) { return __builtin_bit_cast(s16x4, __builtin_amdgcn_ds_read_tr16_b64_v4i16((LAS s16x4*)p)); }
DI bf16x8 cat8(s16x4 lo, s16x4 hi) { return __builtin_shufflevector(lo, hi, 0, 1, 2, 3, 4, 5, 6, 7); }
DI bf16x8 pack8(float a0, float a1, float a2, float a3, float a4, float a5, float a6, float a7) {
    v4u p; p.x = pk2(a0, a1); p.y = pk2(a2, a3); p.z = pk2(a4, a5); p.w = pk2(a6, a7); return __builtin_bit_cast(bf16x8, p);
}
namespace pg8 {
#define PG8_LAS __attribute__((address_space(3)))
typedef unsigned short bf16_t;
typedef short bf16x8 __attribute__((ext_vector_type(8)));
typedef float f32x4 __attribute__((ext_vector_type(4)));
typedef unsigned u32x4 __attribute__((ext_vector_type(4)));
constexpr int BM = 256, BK = 64, HALF = 128, HTB = HALF * BK * 2  , STAGE_BYTES = 8 * HTB, NXCD = 8, WGM = 8;

__host__ __device__ __forceinline__ int lds_byte(int r, int c) { const int st = (r >> 4) * 2 + (c >> 5), rr = r & 15, cc = c & 31, ob = rr * 64 + cc * 2; return st * 1024 + (ob ^ (((ob >> 9) & 1) << 5)); }
__host__ __device__ __forceinline__ void stage_rc(int b, int& R, int& C) { const int st = b / 1024, sb = b % 1024, swz = sb ^ (((sb >> 9) & 1) << 5); R = (st >> 1) * 16 + swz / 64; C = (st & 1) * 32 + (swz % 64) / 2; }
__host__ __device__ __forceinline__ int perm32(int rho) { const int n = rho >> 4, i = rho & 15; return 8 * (i >> 2) + 4 * n + (i & 3); }

struct Unit { int pm, pn; };
struct Gemm { const bf16_t* A; const bf16_t* Bt; int M, N, K; };

struct StaticOrder {
    int nM, nN, nwg, G, c;
    __host__ __device__ void init(int M, int N, int G_, int c_) { nM = M / BM; nN = N / BM; nwg = nM * nN; G = G_; c = c_; }
    __host__ __device__ bool next(int i, Unit& u) const {
        const long L = (long)i * G + c; if (L >= nwg) return false;
        int wgid = (int)L; { const int q = nwg / NXCD, r = nwg % NXCD, xcd = wgid % NXCD, off = wgid / NXCD; wgid = (xcd < r ? xcd * (q + 1) : r * (q + 1) + (xcd - r) * q) + off; }
        const int nig = WGM * nN, gid = wgid / nig, fm = gid * WGM, gsz = (nM - fm) < WGM ? (nM - fm) : WGM;
        u.pm = fm + ((wgid % nig) % gsz); u.pn = (wgid % nig) / gsz; return true;
    }
    __device__ __forceinline__ void a_ready(const Unit&) const {}
    __device__ __forceinline__ void done(const Unit&) const {}
};

}
namespace pg8 {
#define EPI_OPERATOR \
    static constexpr bool PERM = true, AFTER_DRAIN = false; \
    __device__ __forceinline__ void operator()(const f32x4 (&acc)[2][2][4][2], const Unit& u, int wr, int wc, int fr, int fq) const { \
        const int row0 = u.pm * BM + wr * 64 + fr, col0 = u.pn * BM + wc * 32 + 8 * fq; \
        _Pragma("unroll") for (int ai = 0; ai < 2; ++ai) \
        _Pragma("unroll") for (int m = 0; m < 4; ++m) \
        _Pragma("unroll") for (int bj = 0; bj < 2; ++bj) store8(row0 + ai * HALF + m * 16, col0 + bj * HALF, acc[ai][bj][m][0], acc[ai][bj][m][1]); \
    }
DI ::v4u pack_bf16x8(f32x4 v0, f32x4 v1) { ::v4u w; w.x = ::pk2(v0[0], v0[1]); w.y = ::pk2(v0[2], v0[3]); w.z = ::pk2(v1[0], v1[1]); w.w = ::pk2(v1[2], v1[3]); return w; }
DI void unpack_bf16x8(::v4u w, f32x4& v0, f32x4& v1) { v0 = (f32x4){::bflo(w.x), ::bfhi(w.x), ::bflo(w.y), ::bfhi(w.y)}; v1 = (f32x4){::bflo(w.z), ::bfhi(w.z), ::bflo(w.w), ::bfhi(w.w)}; }

struct EpiXM {
    bf16_t* xm; bf16_t* halo;
    DI void store8(int row, int col, f32x4 v0, f32x4 v1) const {
        const ::v4u w = pack_bf16x8(v0, v1);
        *(::v4u*)(xm + (size_t)row * 2048 + col) = w;
        const int r = row & 63;
        if (r >= 61) *(::v4u*)(halo + ((size_t)(row >> 6) * 3 + (r - 61)) * 2048 + col) = w;
    }
    EPI_OPERATOR
};
struct EpiSig {
    bf16_t* out; int ldc; const float* bias;
    DI void store8(int row, int col, f32x4 v0, f32x4 v1) const {
        if (bias) { v0 += *(const f32x4*)(bias + col); v1 += *(const f32x4*)(bias + col + 4); }
#pragma unroll
        for (int i = 0; i < 4; ++i) { v0[i] = ::sigmoidf_(v0[i]); v1[i] = ::sigmoidf_(v1[i]); }
        *(::v4u*)(out + (size_t)row * ldc + col) = pack_bf16x8(v0, v1);
    }
    EPI_OPERATOR
};
struct EpiZM {
    bf16_t* buf;
    DI void store8(int row, int col, f32x4 v0, f32x4 v1) const {
        ::v4u* p = (::v4u*)(buf + (size_t)row * 2048 + col);
        f32x4 h0, h1; unpack_bf16x8(*p, h0, h1);
#pragma unroll
        for (int i = 0; i < 4; ++i) { h0[i] *= ::siluf_(v0[i]); h1[i] *= ::siluf_(v1[i]); }
        *p = pack_bf16x8(h0, h1);
    }
    EPI_OPERATOR
};
struct EpiQKV {
    bf16_t* q; size_t stride;
    DI void store8(int row, int col, f32x4 v0, f32x4 v1) const {
        const int t = col >> 10, c = col & 1023;
        bf16_t* base = q + (size_t)t * stride;
        if (t == 0) { v0 *= ::QSCALE; v1 *= ::QSCALE; }
        *(::v4u*)(base + (size_t)row * 1024 + c) = pack_bf16x8(v0, v1);
    }
    EPI_OPERATOR
};
struct EpiZA {
    const bf16_t* o0; const bf16_t* o1; const bf16_t* o2; const float* st; bf16_t* a1;
    DI void store8(int row, int col, f32x4 v0, f32x4 v1) const {
        const int head = col >> 6;
        const ::f32x2_t s0 = *(const ::f32x2_t*)(st + ((size_t)(0 * ::MTOK + row) * 16 + head) * 2);
        const ::f32x2_t s1 = *(const ::f32x2_t*)(st + ((size_t)(1 * ::MTOK + row) * 16 + head) * 2);
        const ::f32x2_t s2 = *(const ::f32x2_t*)(st + ((size_t)(2 * ::MTOK + row) * 16 + head) * 2);
        const float mx = fmaxf(s0.x, fmaxf(s1.x, s2.x));
        float w0 = __builtin_amdgcn_exp2f(s0.x - mx) * s0.y, w1 = __builtin_amdgcn_exp2f(s1.x - mx) * s1.y, w2 = __builtin_amdgcn_exp2f(s2.x - mx) * s2.y;
        const float inv = 1.0f / (w0 + w1 + w2); w0 *= inv; w1 *= inv; w2 *= inv;
        const size_t off = (size_t)row * 1024 + col;
        f32x4 a0, a1v, b0, b1, c0, c1;
        unpack_bf16x8(*(const ::v4u*)(o0 + off), a0, a1v); unpack_bf16x8(*(const ::v4u*)(o1 + off), b0, b1); unpack_bf16x8(*(const ::v4u*)(o2 + off), c0, c1);
        f32x4 r0 = a0 * w0 + b0 * w1 + c0 * w2, r1 = a1v * w0 + b1 * w1 + c1 * w2;
#pragma unroll
        for (int i = 0; i < 4; ++i) { r0[i] *= ::siluf_(v0[i]); r1[i] *= ::siluf_(v1[i]); }
        *(::v4u*)(a1 + off) = pack_bf16x8(r0, r1);
    }
    EPI_OPERATOR
};
struct EpiYA {
    bf16_t* g;
    DI void store8(int row, int col, f32x4 v0, f32x4 v1) const {
        ::v4u* p = (::v4u*)(g + (size_t)row * 2048 + col);
        f32x4 h0, h1; unpack_bf16x8(*p, h0, h1);
        *p = pack_bf16x8(h0 * v0, h1 * v1);
    }
    EPI_OPERATOR
};
struct EpiYM {
    const bf16_t* g; bf16_t* mrg;
    DI void store8(int row, int col, f32x4 v0, f32x4 v1) const {
        f32x4 t0, t1, g0, g1;
        unpack_bf16x8(*(const ::v4u*)(g + (size_t)row * 2048 + col), t0, t1);
        unpack_bf16x8(*(const ::v4u*)(g + (size_t)row * 2048 + 1024 + col), g0, g1);
        *(::v4u*)(mrg + (size_t)row * 1024 + col) = pack_bf16x8(t0 + g0 * v0, t1 + g1 * v1);
    }
    EPI_OPERATOR
};
struct EpiOut {
    const float* x; float* out;
    DI void store8(int row, int col, f32x4 v0, f32x4 v1) const {
        const size_t off = (size_t)row * 1024 + col;
        *(f32x4*)(out + off) = *(const f32x4*)(x + off) + v0;
        *(f32x4*)(out + off + 4) = *(const f32x4*)(x + off + 4) + v1;
    }
    EPI_OPERATOR
};
}
namespace pg8 {
template <class Epi, class Sched, bool ALIGN_EPI = false, bool SP2 = false>
__device__ __forceinline__ void gemm_phase(PG8_LAS unsigned char* lds, const Gemm g, const Sched& S, const Epi& E, const int tid_in) {
    const int tid = tid_in, wid = __builtin_amdgcn_readfirstlane(tid >> 6), lane = tid & 63, wr = wid >> 2, wc = wid & 3, fr = lane & 15, fq = lane >> 4;
    const int K = g.K, nt = K / BK;
    unsigned voffA[2], voffB[2];
#pragma unroll
    for (int i = 0; i < 2; ++i) { int R, C; stage_rc(tid * 16 + i * 8192, R, C); const int Rb = Epi::PERM ? ((R & ~31) + perm32(R & 31)) : R;
        voffA[i] = (unsigned)(R * K + C) * 2u; voffB[i] = (unsigned)(Rb * K + C) * 2u; }
    const size_t kstep = (size_t)(BK * 2);
    const size_t hstep = (size_t)HALF * K * 2;
    const size_t tstep = 2 * hstep;
    const unsigned ldsw = (unsigned)wid * 1024u;
    const int aoff = lds_byte(wr * 64 + fr, fq * 8), boff = lds_byte(wc * 32 + fr, fq * 8);
#define PG8_SA(b, h) (((b) * 2 + (h)) * HTB)
#define PG8_SB(b, h) ((4 + (b) * 2 + (h)) * HTB)
#define PG8_STAGE(bufoff, gbase, voff) do { _Pragma("unroll") for (int _i = 0; _i < 2; ++_i) \
        __builtin_amdgcn_global_load_lds((const unsigned*)((const char*)(gbase) + (voff)[_i]), (PG8_LAS unsigned*)(lds + (bufoff) + ldsw + _i * 8192), 16, 0, 0); } while (0)
#define PG8_LDA(dst, b, h) do { _Pragma("unroll") for (int m = 0; m < 4; ++m) _Pragma("unroll") for (int k = 0; k < 2; ++k) dst[m][k] = *(const PG8_LAS bf16x8*)(lds + PG8_SA(b, h) + aoff + m * 2048 + k * 1024); } while (0)
#define PG8_LDB(dst, b, h) do { _Pragma("unroll") for (int n = 0; n < 2; ++n) _Pragma("unroll") for (int k = 0; k < 2; ++k) dst[n][k] = *(const PG8_LAS bf16x8*)(lds + PG8_SB(b, h) + boff + n * 2048 + k * 1024); } while (0)
#define PG8_MMA(ai, bj, At, Bt) do { __builtin_amdgcn_s_setprio(1); _Pragma("unroll") for (int m = 0; m < 4; ++m) _Pragma("unroll") for (int n = 0; n < 2; ++n) _Pragma("unroll") for (int k = 0; k < 2; ++k) \
        acc[ai][bj][m][n] = __builtin_amdgcn_mfma_f32_16x16x32_bf16(Bt[n][k], At[m][k], acc[ai][bj][m][n], 0, 0, 0); __builtin_amdgcn_s_setprio(0); } while (0)
#define PG8_WAIT_V(n) asm volatile("s_waitcnt vmcnt(" #n ")" ::: "memory")
#define PG8_WAIT_L(n) asm volatile("s_waitcnt lgkmcnt(" #n ")" ::: "memory")
#define PG8_BAR __builtin_amdgcn_s_barrier()
#define PG8_SCHED __builtin_amdgcn_sched_barrier(0)
    Unit cur, nxt; int ui = 0;
    if (!S.next(0, cur)) return;
    f32x4 acc[2][2][4][2];
#pragma unroll
    for (int a = 0; a < 2; ++a)
#pragma unroll
        for (int b = 0; b < 2; ++b)
#pragma unroll
            for (int m = 0; m < 4; ++m)
#pragma unroll
                for (int n = 0; n < 2; ++n) acc[a][b][m][n] = (f32x4){0.f, 0.f, 0.f, 0.f};
    bf16x8 At[4][2], B0[2][2], B1[2][2];
    const char* cA = (const char*)g.A + (size_t)cur.pm * tstep; const char* cB = (const char*)g.Bt + (size_t)cur.pn * tstep;
    S.a_ready(cur);
    if constexpr (SP2) {
        PG8_STAGE(PG8_SB(0, 0), cB, voffB); PG8_STAGE(PG8_SB(0, 1), cB + hstep, voffB); PG8_STAGE(PG8_SA(0, 0), cA, voffA); PG8_STAGE(PG8_SA(0, 1), cA + hstep, voffA);
        if (wr == 1) PG8_BAR;
        PG8_WAIT_V(2); PG8_BAR;
        PG8_STAGE(PG8_SB(1, 0), cB + kstep, voffB); PG8_STAGE(PG8_SA(1, 0), cA + kstep, voffA); PG8_STAGE(PG8_SB(1, 1), cB + hstep + kstep, voffB);
        PG8_WAIT_V(6); PG8_BAR;
    } else {
        PG8_STAGE(PG8_SB(0, 0), cB, voffB); PG8_STAGE(PG8_SA(0, 0), cA, voffA); PG8_STAGE(PG8_SB(0, 1), cB + hstep, voffB); PG8_STAGE(PG8_SA(0, 1), cA + hstep, voffA);
        if (wr == 1) PG8_BAR;
        PG8_WAIT_V(4); PG8_BAR;
        PG8_STAGE(PG8_SB(1, 0), cB + kstep, voffB); PG8_STAGE(PG8_SA(1, 0), cA + kstep, voffA); PG8_STAGE(PG8_SB(1, 1), cB + hstep + kstep, voffB);
        PG8_WAIT_V(6); PG8_BAR;
    }
    for (;;) {
        const bool has_next = S.next(ui + 1, nxt);
        const char* nA = has_next ? (const char*)g.A + (size_t)nxt.pm * tstep : cA; const char* nB = has_next ? (const char*)g.Bt + (size_t)nxt.pn * tstep : cB;
        for (int t = 0; t < nt; t += 2) {
            const bool last = (t == nt - 2);
            const char* a1 = cA + (size_t)(t + 1) * kstep;
            const char* a2 = last ? nA : cA + (size_t)(t + 2) * kstep; const char* b2 = last ? nB : cB + (size_t)(t + 2) * kstep;
            const char* a3 = a2 + kstep; const char* b3 = b2 + kstep;
            if (last && has_next) S.a_ready(nxt);
            if constexpr (SP2) {
            PG8_LDB(B0, 0, 0); PG8_LDB(B1, 0, 1); PG8_SCHED; PG8_LDA(At, 0, 0); PG8_STAGE(PG8_SA(1, 1), a1 + hstep, voffA);
            PG8_WAIT_V(8); PG8_WAIT_L(0); PG8_BAR; PG8_MMA(0, 0, At, B0); PG8_MMA(0, 1, At, B1); PG8_BAR; PG8_SCHED;
            PG8_LDA(At, 0, 1); PG8_STAGE(PG8_SB(0, 0), b2, voffB); PG8_STAGE(PG8_SB(0, 1), b2 + hstep, voffB); PG8_STAGE(PG8_SA(0, 0), a2, voffA);
            PG8_WAIT_V(8); PG8_WAIT_L(0); PG8_BAR; PG8_MMA(1, 0, At, B0); PG8_MMA(1, 1, At, B1); PG8_BAR; PG8_SCHED;
            PG8_LDB(B0, 1, 0); PG8_LDB(B1, 1, 1); PG8_SCHED; PG8_LDA(At, 1, 0); PG8_STAGE(PG8_SA(0, 1), a2 + hstep, voffA);
            PG8_WAIT_V(8); PG8_WAIT_L(0); PG8_BAR; PG8_MMA(0, 0, At, B0); PG8_MMA(0, 1, At, B1); PG8_BAR; PG8_SCHED;
            PG8_LDA(At, 1, 1); PG8_STAGE(PG8_SB(1, 0), b3, voffB); PG8_STAGE(PG8_SB(1, 1), b3 + hstep, voffB); PG8_STAGE(PG8_SA(1, 0), a3, voffA);
            PG8_WAIT_V(8); PG8_WAIT_L(0); PG8_BAR; PG8_MMA(1, 0, At, B0); PG8_MMA(1, 1, At, B1); PG8_BAR; PG8_SCHED;
            } else {
            PG8_LDB(B0, 0, 0); PG8_SCHED; PG8_LDA(At, 0, 0); PG8_STAGE(PG8_SA(1, 1), a1 + hstep, voffA);
            PG8_WAIT_L(8); PG8_BAR; PG8_WAIT_L(0); PG8_MMA(0, 0, At, B0); PG8_BAR; PG8_SCHED;
            PG8_LDB(B1, 0, 1); PG8_STAGE(PG8_SB(0, 0), b2, voffB);
            PG8_BAR; PG8_WAIT_L(0); PG8_MMA(0, 1, At, B1); PG8_BAR;
            PG8_LDA(At, 0, 1); PG8_STAGE(PG8_SA(0, 0), a2, voffA);
            PG8_BAR; PG8_WAIT_L(0); PG8_MMA(1, 0, At, B0); PG8_BAR; PG8_SCHED;
            PG8_STAGE(PG8_SB(0, 1), b2 + hstep, voffB);
            PG8_WAIT_V(6); PG8_BAR; PG8_MMA(1, 1, At, B1); PG8_BAR;
            PG8_LDB(B0, 1, 0); PG8_SCHED; PG8_LDA(At, 1, 0); PG8_STAGE(PG8_SA(0, 1), a2 + hstep, voffA);
            PG8_WAIT_L(8); PG8_BAR; PG8_WAIT_L(0); PG8_MMA(0, 0, At, B0); PG8_BAR; PG8_SCHED;
            PG8_LDB(B1, 1, 1); PG8_STAGE(PG8_SB(1, 0), b3, voffB);
            PG8_BAR; PG8_WAIT_L(0); PG8_MMA(0, 1, At, B1); PG8_BAR;
            PG8_LDA(At, 1, 1); PG8_STAGE(PG8_SA(1, 0), a3, voffA);
            PG8_BAR; PG8_WAIT_L(0); PG8_MMA(1, 0, At, B0); PG8_BAR; PG8_SCHED;
            PG8_STAGE(PG8_SB(1, 1), b3 + hstep, voffB);
            PG8_WAIT_V(6); PG8_BAR; PG8_MMA(1, 1, At, B1); PG8_BAR;
            }
        }
        if constexpr (ALIGN_EPI) { if (wr == 0) PG8_BAR; }
        if constexpr (!Epi::AFTER_DRAIN) { E(acc, cur, wr, wc, fr, fq); S.done(cur); }
        if (!has_next) break;
#pragma unroll
        for (int a = 0; a < 2; ++a)
#pragma unroll
            for (int b = 0; b < 2; ++b)
#pragma unroll
                for (int m = 0; m < 4; ++m)
#pragma unroll
                    for (int n = 0; n < 2; ++n) acc[a][b][m][n] = (f32x4){0.f, 0.f, 0.f, 0.f};
        cur = nxt; cA = nA; cB = nB; ++ui;
        if constexpr (ALIGN_EPI) { if (wr == 1) PG8_BAR; }
    }
    PG8_WAIT_V(0);
    if constexpr (!ALIGN_EPI) { if (wr == 0) PG8_BAR; }
    PG8_BAR;
    if constexpr (Epi::AFTER_DRAIN) { E.fused(acc, cur, wr, wc, fr, fq, lds, wid, lane); S.done(cur); }
#undef PG8_SA
#undef PG8_SB
#undef PG8_STAGE
#undef PG8_LDA
#undef PG8_LDB
#undef PG8_MMA
#undef PG8_WAIT_V
#undef PG8_WAIT_L
#undef PG8_BAR
#undef PG8_SCHED
}
}
namespace att {
constexpr int KP = 144;
constexpr int K_OFF = 0, V_OFF = 384 * KP, B_OFF = 2 * 384 * KP, LDS_BYTES = B_OFF + 132 * 4;
struct Tensors { const bf16* Q; const bf16* K; const bf16* V; bf16* Oa; bf16* Ob; float* st; const float* biasL2; };

DI void unit(LAS unsigned char* lds, const Tensors& T, int u, int tid_in) {
    const int tid_ = wg_tid_local(tid_in);
    const int tid = tid_, lane = tid & 63, l31 = lane & 31, hi = lane >> 5, w = __builtin_amdgcn_readfirstlane(tid >> 6);
    const int bh = u / 48, rem = u % 48, p = rem >> 4, w16 = rem & 15;
    const int b = bh >> 4, h = bh & 15;
    const int dsh = 2 * p, nqb = 16 >> dsh, r = w16 / nqb, qblk = w16 % nqb;
    const size_t rowb = (size_t)b * SEQ;
    {
#pragma unroll
        for (int k = 0; k < 6; ++k) {
            const int id = tid + 512 * k, j = id >> 3, pc = id & 7;
            int pos = 256 * qblk - 128 + j; pos = pos < 0 ? 0 : pos;
            const size_t off = (rowb + r + ((size_t)pos << dsh)) * 1024 + h * 64 + pc * 8;
            const v4u kv = *(const v4u*)(T.K + off); const v4u vv = *(const v4u*)(T.V + off);
            *(LAS v4u*)(lds + K_OFF + j * KP + pc * 16) = kv;
            *(LAS v4u*)(lds + V_OFF + j * KP + pc * 16) = vv;
        }
        if (tid < 132) ((LAS float*)(lds + B_OFF))[tid] = T.biasL2[(p * 16 + h) * 132 + tid];
    }
    const int qpos = 256 * qblk + 32 * w + l31;
    const size_t qrow = rowb + r + ((size_t)qpos << dsh);
    bf16x8 qf[4];
#pragma unroll
    for (int d0 = 0; d0 < 4; ++d0) qf[d0] = *(const bf16x8*)(T.Q + qrow * 1024 + h * 64 + d0 * 16 + hi * 8);
    __syncthreads();
    f32x16 st[5];
#pragma unroll
    for (int kt = 0; kt < 5; ++kt) {
        f32x16 a = {};
#pragma unroll
        for (int d0 = 0; d0 < 4; ++d0) {
            const bf16x8 kf = *(const LAS bf16x8*)(lds + K_OFF + (32 * w + 32 * kt + l31) * KP + (16 * d0 + 8 * hi) * 2);
            a = MFMA32(kf, qf[d0], a);
        }
        st[kt] = a;
    }
    const LAS float* bl = (const LAS float*)(lds + B_OFF);
    float mx = -1e30f;
#pragma unroll
    for (int kt = 0; kt < 5; ++kt)
#pragma unroll
        for (int rr = 0; rr < 16; ++rr) {
            const int kl = crow(rr, hi);
            const int delta = 128 + l31 - 32 * kt - kl;
            const int pk = 256 * qblk - 128 + 32 * w + 32 * kt + kl;
            const bool valid = (delta >= 0) && (delta <= 128) && (pk >= 0);
            const int dc = delta < 0 ? 0 : (delta > 128 ? 128 : delta);
            const float s = valid ? st[kt][rr] + bl[dc] : -1e30f;
            st[kt][rr] = s; mx = fmaxf(mx, s);
        }
    mx = fmaxf(mx, __shfl_xor(mx, 32));
    float lsum = 0.f;
#pragma unroll
    for (int kt = 0; kt < 5; ++kt)
#pragma unroll
        for (int rr = 0; rr < 16; ++rr) { const float e = __builtin_amdgcn_exp2f(st[kt][rr] - mx); st[kt][rr] = e; lsum += e; }
    lsum += __shfl_xor(lsum, 32);
    f32x16 o[2]; o[0] = (f32x16){}; o[1] = (f32x16){};
    const int i16 = lane & 15, q4 = i16 >> 2, p4 = i16 & 3, gidx = (lane >> 4) & 1;
#pragma unroll
    for (int kt = 0; kt < 5; ++kt)
#pragma unroll
        for (int s2 = 0; s2 < 2; ++s2) {
            const bf16x8 pb = pack8(st[kt][8 * s2 + 0], st[kt][8 * s2 + 1], st[kt][8 * s2 + 2], st[kt][8 * s2 + 3], st[kt][8 * s2 + 4], st[kt][8 * s2 + 5], st[kt][8 * s2 + 6], st[kt][8 * s2 + 7]);
            const int jrow = 32 * w + 32 * kt + 16 * s2 + 4 * hi + q4;
#pragma unroll
            for (int dt = 0; dt < 2; ++dt) {
                const LAS unsigned char* a0 = lds + V_OFF + jrow * KP + (32 * dt + 16 * gidx + 4 * p4) * 2;
                const bf16x8 va = cat8(tr_read(a0), tr_read(a0 + 8 * KP));
                o[dt] = MFMA32(va, pb, o[dt]);
            }
        }
    const float inv = 1.0f / lsum;
    bf16* orow = (p == 0 ? T.Oa : T.Ob + (size_t)(p - 1) * MTOK * AW) + qrow * 1024 + h * 64;
#pragma unroll
    for (int dt = 0; dt < 2; ++dt)
#pragma unroll
        for (int g4 = 0; g4 < 4; ++g4) {
            v2u wv; wv.x = pk2(o[dt][4 * g4] * inv, o[dt][4 * g4 + 1] * inv); wv.y = pk2(o[dt][4 * g4 + 2] * inv, o[dt][4 * g4 + 3] * inv);
            *(v2u*)(orow + 32 * dt + 8 * g4 + 4 * hi) = wv;
        }
    if (hi == 0) { f32x2_t sv = {mx, lsum}; *(f32x2_t*)(T.st + ((size_t)p * MTOK + qrow) * 32 + h * 2) = sv; }
    __syncthreads();
}
DI void phase(LAS unsigned char* lds, const Tensors& T, int G, int blk, int wv) {
    for (int u = blk; u < BATCH * AH * 48; u += G) unit(lds, T, u, wv);
}
}
namespace mpre {
constexpr int TP = 144;
constexpr int XC_OFF = 0, XM_OFF = 256 * TP, QT_OFF = 2 * 256 * TP, RED_OFF = 3 * 256 * TP, GRED_OFF = RED_OFF + 4 * 4096, LDS_BYTES = GRED_OFF + 4 * 64 * 8 * 4;
struct Tensors { const bf16* xm; const bf16* halo; bf16* kimg; bf16* vimg; bf16* qimg; float* gp; bf16* S; const float* convw; const float* convb; const bf16* WcT; const bf16* WmT; const float* G; };

DI void unit(LAS unsigned char* lds, const Tensors& T, int u, int tid_in) {
    const int tid_ = wg_tid_local(tid_in);
    const int tid = tid_, lane = tid & 63, l31 = lane & 31, hi = lane >> 5, w = __builtin_amdgcn_readfirstlane(tid >> 6);
    const int h = u & 3, c = (u >> 2) & 63, b = u >> 8;
    const int g6 = lane, tp = w;
    const size_t tok0 = (size_t)b * SEQ + 64 * c;
    const int ti = w & 1, si = (w >> 1) & 1, kh = w >> 2;
    f32x16 sacc = {};
    f32x16 gacc = {};
    const int kq = w >> 1;
    const int i16 = lane & 15, q4 = i16 >> 2, p4 = i16 & 3, gidx = (lane >> 4) & 1;
#pragma unroll 1
    for (int hh = 0; hh < 2; ++hh) {
        const int gg = 128 * h + 64 * hh + g6, ch = 4 * gg;
        v2u xr[11];
#pragma unroll
        for (int k = 0; k < 11; ++k) {
            const int tl = 8 * tp - 3 + k;
            if (tl >= 0) xr[k] = *(const v2u*)(T.xm + (tok0 + tl) * 2048 + ch);
            else if (c > 0) xr[k] = *(const v2u*)(T.halo + ((size_t)(b * 64 + c - 1) * 3 + (3 + tl)) * 2048 + ch);
            else xr[k] = (v2u){0u, 0u};
        }
        float xmv[11][4];
#pragma unroll
        for (int k = 0; k < 11; ++k) { xmv[k][0] = bflo(xr[k].x); xmv[k][1] = bfhi(xr[k].x); xmv[k][2] = bflo(xr[k].y); xmv[k][3] = bfhi(xr[k].y); }
        float cw[4][4], cb[4], Gm[4][4];
        {
            const f32x4 b4 = *(const f32x4*)(T.convb + ch); cb[0] = b4[0]; cb[1] = b4[1]; cb[2] = b4[2]; cb[3] = b4[3];
#pragma unroll
            for (int tap = 0; tap < 4; ++tap) { const f32x4 w4 = *(const f32x4*)(T.convw + tap * 2048 + ch); cw[tap][0] = w4[0]; cw[tap][1] = w4[1]; cw[tap][2] = w4[2]; cw[tap][3] = w4[3]; }
#pragma unroll
            for (int i = 0; i < 4; ++i) { const f32x4 g4 = *(const f32x4*)(T.G + gg * 16 + i * 4); Gm[i][0] = g4[0]; Gm[i][1] = g4[1]; Gm[i][2] = g4[2]; Gm[i][3] = g4[3]; }
        }
        __syncthreads();
        unsigned xcp[4][4], xmp[4][4], qtp[4][4];
        float prev_xc[4], prev_q[4];
#pragma unroll
        for (int tl = 0; tl < 8; ++tl) {
            float xc[4], qt[4];
#pragma unroll
            for (int i = 0; i < 4; ++i) {
                float a = cb[i];
#pragma unroll
                for (int tap = 0; tap < 4; ++tap) a += cw[tap][i] * xmv[tl + tap][i];
                xc[i] = siluf_(a);
            }
#pragma unroll
            for (int i2 = 0; i2 < 4; ++i2) qt[i2] = xc[0] * Gm[0][i2] + xc[1] * Gm[1][i2] + xc[2] * Gm[2][i2] + xc[3] * Gm[3][i2];
            if (tl & 1) {
#pragma unroll
                for (int i = 0; i < 4; ++i) { xcp[i][tl >> 1] = pk2(prev_xc[i], xc[i]); qtp[i][tl >> 1] = pk2(prev_q[i], qt[i]); xmp[i][tl >> 1] = pk2(xmv[tl + 2][i], xmv[tl + 3][i]); }
            } else {
#pragma unroll
                for (int i = 0; i < 4; ++i) { prev_xc[i] = xc[i]; prev_q[i] = qt[i]; }
            }
        }
#pragma unroll
        for (int i = 0; i < 4; ++i) {
            const int off = (4 * g6 + i) * TP + 16 * tp;
            *(LAS v4u*)(lds + XC_OFF + off) = (v4u){xcp[i][0], xcp[i][1], xcp[i][2], xcp[i][3]};
            *(LAS v4u*)(lds + XM_OFF + off) = (v4u){xmp[i][0], xmp[i][1], xmp[i][2], xmp[i][3]};
            *(LAS v4u*)(lds + QT_OFF + off) = (v4u){qtp[i][0], qtp[i][1], qtp[i][2], qtp[i][3]};
        }
        __syncthreads();
        {
            const size_t ibase = ((size_t)((b * 4 + h) * 64 + c) * 64 + 32 * hh) * 1024;
#pragma unroll
            for (int k = 0; k < 4; ++k) {
                const int id = tid + 512 * k, f = id >> 6, L = id & 63;
                const int row = 32 * (f >> 2) + (L & 31), colb = (16 * (f & 3) + 4 * (L >> 5)) * 2;
                const v2u k0 = *(const LAS v2u*)(lds + XC_OFF + row * TP + colb), k1 = *(const LAS v2u*)(lds + XC_OFF + row * TP + colb + 16);
                const v2u v0 = *(const LAS v2u*)(lds + XM_OFF + row * TP + colb), v1 = *(const LAS v2u*)(lds + XM_OFF + row * TP + colb + 16);
                *(v4u*)((char*)T.kimg + ibase + (size_t)id * 16) = (v4u){k0.x, k0.y, k1.x, k1.y};
                *(v4u*)((char*)T.vimg + ibase + (size_t)id * 16) = (v4u){v0.x, v0.y, v1.x, v1.y};
            }
#pragma unroll
            for (int k = 0; k < 4; ++k) {
                const int f = 4 * w + k, tt = f & 1, cb0 = 16 * (f >> 1) + 4 * hi + q4;
                const LAS unsigned char* pq = lds + QT_OFF + cb0 * TP + (32 * tt + 16 * gidx + 4 * p4) * 2;
                const s16x4 lo = tr_read(pq), hi4 = tr_read(pq + 8 * TP);
                *(bf16x8*)((char*)T.qimg + ibase + (size_t)f * 1024 + lane * 16) = cat8(lo, hi4);
            }
        }
#pragma unroll
        for (int ks = 0; ks < 8; ++ks) {
            const int crow0 = 128 * kh + 16 * ks + 8 * hi + q4;
            const LAS unsigned char* pa = lds + XC_OFF + crow0 * TP + (32 * si + 16 * gidx + 4 * p4) * 2;
            const LAS unsigned char* pb = lds + QT_OFF + crow0 * TP + (32 * ti + 16 * gidx + 4 * p4) * 2;
            const bf16x8 af = cat8(tr_read(pa), tr_read(pa + 4 * TP));
            const bf16x8 bfr = cat8(tr_read(pb), tr_read(pb + 4 * TP));
            sacc = MFMA32(af, bfr, sacc);
        }
#pragma unroll
        for (int ks = 0; ks < 4; ++ks) {
            const int crow1 = 64 * kq + 16 * ks + 8 * hi + q4;
            const LAS unsigned char* pc_ = lds + XC_OFF + crow1 * TP + (32 * ti + 16 * gidx + 4 * p4) * 2;
            const LAS unsigned char* pm_ = lds + XM_OFF + crow1 * TP + (32 * ti + 16 * gidx + 4 * p4) * 2;
            const bf16x8 ac = cat8(tr_read(pc_), tr_read(pc_ + 4 * TP));
            const bf16x8 am = cat8(tr_read(pm_), tr_read(pm_ + 4 * TP));
            const int c0 = 512 * h + 256 * hh + 64 * kq + 16 * ks + 8 * hi;
            const bf16x8 bc = *(const bf16x8*)(T.WcT + (l31 & 7) * 2048 + c0);
            const bf16x8 bm = *(const bf16x8*)(T.WmT + (l31 & 7) * 2048 + c0);
            gacc = MFMA32(ac, bc, gacc);
            gacc = MFMA32(am, bm, gacc);
        }
    }
    if (l31 < 8) {
#pragma unroll
        for (int r = 0; r < 16; ++r) ((LAS float*)(lds + GRED_OFF))[(kq * 64 + 32 * ti + crow(r, hi)) * 8 + l31] = gacc[r];
    }
    __syncthreads();
    if (kh == 1) {
#pragma unroll
        for (int g4 = 0; g4 < 4; ++g4) *(LAS f32x4*)(lds + RED_OFF + ((w & 3) * 4 + g4) * 1024 + lane * 16) = (f32x4){sacc[4 * g4], sacc[4 * g4 + 1], sacc[4 * g4 + 2], sacc[4 * g4 + 3]};
    }
    __syncthreads();
    { const LAS float* gr = (const LAS float*)(lds + GRED_OFF);
      T.gp[((size_t)h * 8 + (tid & 7)) * MTOK + tok0 + (tid >> 3)] = gr[tid] + gr[512 + tid] + gr[1024 + tid] + gr[1536 + tid]; }
    if (kh == 0) {
        float tot[16];
#pragma unroll
        for (int g4 = 0; g4 < 4; ++g4) {
            const f32x4 o = *(const LAS f32x4*)(lds + RED_OFF + ((w & 3) * 4 + g4) * 1024 + lane * 16);
            tot[4 * g4] = sacc[4 * g4] + o[0]; tot[4 * g4 + 1] = sacc[4 * g4 + 1] + o[1]; tot[4 * g4 + 2] = sacc[4 * g4 + 2] + o[2]; tot[4 * g4 + 3] = sacc[4 * g4 + 3] + o[3];
        }
        char* sp = (char*)T.S + (size_t)((b * 4 + h) * 64 + c) * 8192;
#pragma unroll
        for (int kk = 0; kk < 2; ++kk)
            *(bf16x8*)(sp + ((2 * si + kk) * 2 + ti) * 1024 + lane * 16) = pack8(tot[8 * kk], tot[8 * kk + 1], tot[8 * kk + 2], tot[8 * kk + 3], tot[8 * kk + 4], tot[8 * kk + 5], tot[8 * kk + 6], tot[8 * kk + 7]);
    }
    __syncthreads();
}
DI void phase(LAS unsigned char* lds, const Tensors& T, int G, int blk, int wv) {
    for (int u = blk; u < BATCH * NCHUNK * MH; u += G) unit(lds, T, u, wv);
}
}
namespace mscan {
constexpr int P_OFF = 0;
constexpr int V_OFF = 131072;
constexpr int DEN_OFF = V_OFF + 16384;
constexpr int NS_OFF = DEN_OFF + 4096;
constexpr int NSB_OFF = NS_OFF + 2048;
constexpr int TMP_OFF = NSB_OFF + 1024, SCW_OFF = TMP_OFF + 128, LDS_BYTES = SCW_OFF + 8 * 896;
static_assert(LDS_BYTES <= 163840 - 16, "scan LDS");
struct Tensors { const bf16* q; const bf16* k; const bf16* v; const bf16* S; const float* gp; const float* bif; float* scal; bf16* hm; };

DI float logsigmoid_(float x) { return fminf(x, 0.f) - log1pf(__expf(-fabsf(x))); }
DI void unpack8(bf16x8 f, float (&o)[8]) {
    const v4u u = __builtin_bit_cast(v4u, f);
    o[0] = bflo(u.x); o[1] = bfhi(u.x); o[2] = bflo(u.y); o[3] = bfhi(u.y); o[4] = bflo(u.z); o[5] = bfhi(u.z); o[6] = bflo(u.w); o[7] = bfhi(u.w);
}

template <int VAR> DI void unit(LAS unsigned char* lds, const Tensors& T, int bh, int es, int tid_in) {
    const int tid_ = wg_tid_local(tid_in);
    const int tid = tid_, lane = tid & 63, l31 = lane & 31, hi = lane >> 5, wid = __builtin_amdgcn_readfirstlane(tid >> 6);
    const int b = bh >> 2, h = bh & 3;
    LAS float* sTmp = (LAS float*)(lds + TMP_OFF);
    float* scal = T.scal + (size_t)bh * 3 * SEQ;
    {
        float li[8], cs[8];
        const float bi = T.bif[h], bf_ = T.bif[4 + h];
        float run = 0.f;
        const float* gpb = T.gp + (size_t)b * SEQ;
        const unsigned toff = (unsigned)tid * 8u;
#pragma unroll
        for (int k = 0; k < 8; ++k) { li[k] = bi; cs[k] = bf_; }
#pragma unroll
        for (int hh = 0; hh < 4; ++hh) {
            const float* pi = gpb + ((size_t)hh * 8 + h) * MTOK; const float* pf_ = gpb + ((size_t)hh * 8 + 4 + h) * MTOK;
            const f32x4 i0 = *(const f32x4*)(pi + toff), i1 = *(const f32x4*)(pi + toff + 4), f0 = *(const f32x4*)(pf_ + toff), f1 = *(const f32x4*)(pf_ + toff + 4);
#pragma unroll
            for (int k = 0; k < 4; ++k) { li[k] += i0[k]; li[4 + k] += i1[k]; cs[k] += f0[k]; cs[4 + k] += f1[k]; }
        }
#pragma unroll
        for (int k = 0; k < 8; ++k) { run += logsigmoid_(cs[k]); cs[k] = run; }
        float inc = run;
#pragma unroll
        for (int o = 1; o < 64; o <<= 1) { const float t = bperm(inc, lane >= o ? lane - o : lane); if (lane >= o) inc += t; }
        if (lane == 63) sTmp[wid] = inc;
        __syncthreads();
        float base = inc - run;
        for (int w2 = 0; w2 < wid; ++w2) base += sTmp[w2];
        __syncthreads();
        float av[8], mloc = -3.0e38f, cm[8];
#pragma unroll
        for (int k = 0; k < 8; ++k) { cs[k] += base; av[k] = li[k] - cs[k]; mloc = fmaxf(mloc, av[k]); cm[k] = mloc; }
        float minc = mloc;
#pragma unroll
        for (int o = 1; o < 64; o <<= 1) { const float t = bperm(minc, lane >= o ? lane - o : lane); if (lane >= o) minc = fmaxf(minc, t); }
        if (lane == 63) sTmp[wid] = minc;
        __syncthreads();
        float mbase = bperm(minc, lane > 0 ? lane - 1 : 0); if (lane == 0) mbase = -3.0e38f;
        for (int w2 = 0; w2 < wid; ++w2) mbase = fmaxf(mbase, sTmp[w2]);
#pragma unroll
        for (int k = 0; k < 8; ++k) {
            const float Mt = fmaxf(mbase, cm[k]);
            scal[0 * SEQ + 8 * tid + k] = av[k]; scal[1 * SEQ + 8 * tid + k] = Mt; scal[2 * SEQ + 8 * tid + k] = __expf(-(cs[k] + Mt));
        }
        ((LAS float*)(lds + NS_OFF))[tid] = 0.f; ((LAS unsigned short*)(lds + NSB_OFF))[tid] = 0;
        __threadfence();
        __syncthreads();
    }
#define MFMAV(a_, b_, c_) (VAR == 3 ? (c_) : MFMA32((a_), (b_), (c_)))
    f32x16 cst[2][2];
#pragma unroll
    for (int id = 0; id < 2; ++id)
#pragma unroll
        for (int ie = 0; ie < 2; ++ie) cst[id][ie] = (f32x16){};
    const char* qb = (const char*)T.q + (size_t)bh * NCHUNK * 65536 + (size_t)wid * 8192;
    const char* kb = (const char*)T.k + (size_t)bh * NCHUNK * 65536 + (size_t)wid * 8192;
    const char* vb = (const char*)T.v + (size_t)bh * NCHUNK * 65536 + (size_t)es * 8192 + (size_t)wid * 1024;
    const char* sb = (const char*)T.S + (size_t)bh * NCHUNK * 8192 + (size_t)(wid & 3) * 2048;
    const unsigned loff = (unsigned)lane * 16u;
    const float* sa = scal; const float* sm = scal + SEQ; const float* sthr = scal + 2 * SEQ;
    bf16* hg = T.hm + (size_t)b * SEQ * 2048 + 512 * h + 64 * es;
    int zv = 0; asm volatile("" : "+v"(zv));
    float Mc = sm[zv];
    LAS float* sca = (LAS float*)(lds + SCW_OFF) + wid * 224;
    LAS float* nsw = (LAS float*)(lds + NS_OFF) + 64 * wid; LAS unsigned short* nsb = (LAS unsigned short*)(lds + NSB_OFF) + 64 * wid;
    bf16x8 fb[16]; bf16x8 sf[2]; bf16x8 vnext;
    float a_l, m_l, thr_l;
#pragma unroll
    for (int g = 0; g < 8; ++g) fb[g] = *(const bf16x8*)(qb + g * 1024 + loff);
#pragma unroll
    for (int g = 0; g < 8; ++g) fb[8 + g] = *(const bf16x8*)(kb + ((g & 1) * 4 + (g >> 1)) * 1024 + loff);
    sf[0] = *(const bf16x8*)(sb + loff); sf[1] = *(const bf16x8*)(sb + 1024 + loff);
    vnext = *(const bf16x8*)(vb + loff);
    a_l = sa[lane]; m_l = sm[lane]; thr_l = sthr[lane];
    const int ksw = wid & 3, iew = wid >> 2;
#define STAGE_VW(dst_) do { const float mend_ = bperm(m_l, 63 + zv); sca[160 + lane] = __expf(a_l - mend_); \
        const f32x4 w0_ = *(const LAS f32x4*)(sca + 160 + 16 * ksw + 4 * hi), w1_ = *(const LAS f32x4*)(sca + 160 + 16 * ksw + 8 + 4 * hi); \
        float vv_[8]; unpack8(vnext, vv_); \
        *(LAS bf16x8*)((dst_) + wid * 1024 + lane * 16) = pack8(vv_[0] * w0_[0], vv_[1] * w0_[1], vv_[2] * w0_[2], vv_[3] * w0_[3], vv_[4] * w1_[0], vv_[5] * w1_[1], vv_[6] * w1_[2], vv_[7] * w1_[3]); } while (0)
    STAGE_VW(lds + V_OFF);
    bf16x8 vown = vnext;
    asm volatile("" :: "v"(a_l), "v"(m_l), "v"(thr_l), "v"(sf[0]), "v"(sf[1]));
#pragma unroll
    for (int g = 0; g < 16; ++g) asm volatile("" :: "v"(fb[g]));
    __syncthreads();
#pragma unroll 1
    for (int c = 0; c < NCHUNK; ++c) {
        const int cur = c & 1;
        LAS float* denp = (LAS float*)(lds + DEN_OFF) + cur * 512;
        LAS unsigned char* pbuf = lds + P_OFF + cur * 65536;
        const LAS unsigned char* vcur = lds + V_OFF + cur * 8192; LAS unsigned char* vnxt = lds + V_OFF + (cur ^ 1) * 8192;
        const int cn = (c + 1 < NCHUNK) ? c + 1 : c;
        const char* qn_ = qb + (size_t)cn * 65536; const char* kn_ = kb + (size_t)cn * 65536; const char* sn_ = sb + (size_t)cn * 8192;
        vnext = *(const bf16x8*)(vb + (size_t)cn * 65536 + loff);
        const float Mc2 = bperm(m_l, 63 + zv);
        const float Mt0 = bperm(m_l, l31), Mt1 = bperm(m_l, 32 + l31);
        const float thr0 = bperm(thr_l, l31), thr1 = bperm(thr_l, 32 + l31);
        { const float cwl = __expf(a_l - Mc2); sca[lane] = a_l; sca[64 + lane] = cwl; ((LAS unsigned short*)(sca + 128))[lane] = (unsigned short)(pk2(cwl, 0.f) & 0xffffu); }
        a_l = sa[64 * cn + lane]; m_l = sm[64 * cn + lane]; thr_l = sthr[64 * cn + lane];
        bf16x8 pf[2]; float psum[2];
        {
            const f32x4 aown0 = *(const LAS f32x4*)(sca + 16 * ksw + 4 * hi), aown1 = *(const LAS f32x4*)(sca + 16 * ksw + 8 + 4 * hi);
            const float aw[8] = {aown0[0], aown0[1], aown0[2], aown0[3], aown1[0], aown1[1], aown1[2], aown1[3]};
#pragma unroll
            for (int tt = 0; tt < 2; ++tt) {
                const int t = 32 * tt + l31; const float Mt = tt ? Mt1 : Mt0;
                float sv[8]; unpack8(sf[tt], sv);
                float pw[8]; float ps = 0.f;
#pragma unroll
                for (int j = 0; j < 8; ++j) { const int s = 16 * ksw + 8 * (j >> 2) + 4 * hi + (j & 3); pw[j] = (s <= t) ? sv[j] * __expf(aw[j] - Mt) : 0.f; ps += pw[j]; }
                pf[tt] = pack8(pw[0], pw[1], pw[2], pw[3], pw[4], pw[5], pw[6], pw[7]);
                psum[tt] = ps;
            }
            sf[0] = *(const bf16x8*)(sn_ + loff); sf[1] = *(const bf16x8*)(sn_ + 1024 + loff);
        }
        const float rs0 = __expf(Mc - Mt0), rs1 = __expf(Mc - Mt1);
#pragma unroll
        for (int ie = 0; ie < 2; ++ie) {
            f32x16 ao[2]; ao[0] = (f32x16){}; ao[1] = (f32x16){};
            float qn[2] = {0.f, 0.f};
#pragma unroll
            for (int id = 0; id < 2; ++id)
#pragma unroll
                for (int s = 0; s < 2; ++s) {
                    const int g0 = (id * 2 + s) * 2;
                    const bf16x8 cb = pack8(cst[id][ie][8 * s + 0], cst[id][ie][8 * s + 1], cst[id][ie][8 * s + 2], cst[id][ie][8 * s + 3], cst[id][ie][8 * s + 4], cst[id][ie][8 * s + 5], cst[id][ie][8 * s + 6], cst[id][ie][8 * s + 7]);
                    ao[0] = MFMAV(cb, fb[g0], ao[0]);
                    ao[1] = MFMAV(cb, fb[g0 + 1], ao[1]);
                    if (ie == 0) {
                        const v2u n0 = *(const LAS v2u*)(nsb + 32 * id + 16 * s + 4 * hi), n1 = *(const LAS v2u*)(nsb + 32 * id + 16 * s + 8 + 4 * hi);
#pragma unroll
                        for (int tt = 0; tt < 2; ++tt) {
                            const v4u qv = __builtin_bit_cast(v4u, fb[g0 + tt]);
                            float q_ = qn[tt];
                            q_ = dot2bf(qv.x, n0.x, q_); q_ = dot2bf(qv.y, n0.y, q_); q_ = dot2bf(qv.z, n1.x, q_); q_ = dot2bf(qv.w, n1.y, q_);
                            asm volatile("" : "+v"(q_));
                            qn[tt] = q_;
                        }
                    } else {
                        __builtin_amdgcn_sched_barrier(0);
                        if (VAR != 2) { fb[g0] = *(const bf16x8*)(qn_ + g0 * 1024 + loff);
                        fb[g0 + 1] = *(const bf16x8*)(qn_ + (g0 + 1) * 1024 + loff); }
                    }
                    __builtin_amdgcn_sched_barrier(0);
                }
            if (ie == 0) {
                float d0 = rs0 * qn[0] + (wid < 4 ? psum[0] : 0.f), d1 = rs1 * qn[1] + (wid < 4 ? psum[1] : 0.f);
                d0 += bperm(d0, lane ^ 32); d1 += bperm(d1, lane ^ 32);
                if (hi == 0) { denp[wid * 64 + l31] = d0; denp[wid * 64 + 32 + l31] = d1; }
            }
#pragma unroll
            for (int r = 0; r < 16; ++r) { ao[0][r] *= rs0; ao[1][r] *= rs1; }
            if (ie == iew) {
                ao[0] = MFMAV(vown, pf[0], ao[0]); ao[1] = MFMAV(vown, pf[1], ao[1]);
            }
#pragma unroll
            for (int tt = 0; tt < 2; ++tt)
#pragma unroll
                for (int g4 = 0; g4 < 4; ++g4) {
                    v2u pw_; pw_.x = pk2(ao[tt][4 * g4], ao[tt][4 * g4 + 1]); pw_.y = pk2(ao[tt][4 * g4 + 2], ao[tt][4 * g4 + 3]);
                    *(LAS v2u*)(pbuf + ((((wid * 2 + ie) * 2 + tt) * 4 + g4) * 512) + lane * 8) = pw_;
                }
        }
        const float decay = __expf(Mc - Mc2);
#pragma unroll
        for (int id = 0; id < 2; ++id)
#pragma unroll
            for (int ie = 0; ie < 2; ++ie)
#pragma unroll
                for (int r = 0; r < 16; ++r) cst[id][ie][r] *= decay;
        float nacc[2] = {0.f, 0.f};
#pragma unroll
        for (int ks = 0; ks < 4; ++ks) {
            const v2u cwb0 = *(const LAS v2u*)((const LAS unsigned short*)(sca + 128) + 16 * ks + 4 * hi), cwb1 = *(const LAS v2u*)((const LAS unsigned short*)(sca + 128) + 16 * ks + 8 + 4 * hi);
            bf16x8 vw[2];
            vw[0] = *(const LAS bf16x8*)(vcur + (0 * 4 + ks) * 1024 + lane * 16); vw[1] = *(const LAS bf16x8*)(vcur + (1 * 4 + ks) * 1024 + lane * 16);
#pragma unroll
            for (int id = 0; id < 2; ++id) {
                const int g = 8 + ks * 2 + id;
                cst[id][0] = MFMAV(fb[g], vw[0], cst[id][0]);
                cst[id][1] = MFMAV(fb[g], vw[1], cst[id][1]);
                {
                    const v4u kv = __builtin_bit_cast(v4u, fb[g]);
                    float na = nacc[id];
                    na = dot2bf(kv.x, cwb0.x, na); na = dot2bf(kv.y, cwb0.y, na); na = dot2bf(kv.z, cwb1.x, na); na = dot2bf(kv.w, cwb1.y, na);
                    asm volatile("" : "+v"(na));
                    nacc[id] = na;
                }
                __builtin_amdgcn_sched_barrier(0);
                if (VAR != 2) fb[g] = *(const bf16x8*)(kn_ + (id * 4 + ks) * 1024 + loff);
            }
            __builtin_amdgcn_sched_barrier(0);
        }
#pragma unroll
        for (int id = 0; id < 2; ++id) {
            float v = nacc[id]; v += bperm(v, lane ^ 32);
            if (hi == 0) { const float nv = decay * nsw[32 * id + l31] + v; nsw[32 * id + l31] = nv; nsb[32 * id + l31] = (unsigned short)(pk2(nv, 0.f) & 0xffffu); }
        }
        STAGE_VW(vnxt);
        vown = vnext;
        if (VAR != 4) __syncthreads();
#pragma unroll
        for (int tt = 0; tt < 2; ++tt) {
            float nm[4] = {0.f, 0.f, 0.f, 0.f};
#pragma unroll
            for (int src = 0; src < 8; ++src) {
                const v2u pv = *(const LAS v2u*)(pbuf + ((((src * 2 + iew) * 2 + tt) * 4 + ksw) * 512) + lane * 8);
                nm[0] += bflo(pv.x); nm[1] += bfhi(pv.x); nm[2] += bflo(pv.y); nm[3] += bfhi(pv.y);
            }
            const int t = 32 * tt + l31;
            float den = 0.f;
#pragma unroll
            for (int src = 0; src < 8; ++src) den += denp[src * 64 + t];
            const float dn = fmaxf(fabsf(den), tt ? thr1 : thr0);
            const float inv = 1.0f / dn;
            v2u wv; wv.x = pk2(nm[0] * inv, nm[1] * inv); wv.y = pk2(nm[2] * inv, nm[3] * inv);
            if (VAR == 0 || (VAR != 0 && wv.x == 0x12345678u && wv.y == 0x9abcdef0u)) *(v2u*)(hg + (size_t)(64 * c + t) * 2048 + 32 * iew + 8 * ksw + 4 * hi) = wv;
        }
        Mc = Mc2;
    }
    __syncthreads();
}
#undef MFMAV
#undef STAGE_VW
template <int VAR> DI void phase(LAS unsigned char* lds, const Tensors& T, int G, int blk, int wv) {
#pragma unroll 1
    for (int u = blk; u < 256; u += G) {
        const int xcd = u & 7, j = u >> 3;
        unit<VAR>(lds, T, xcd * 4 + (j >> 3), j & 7, wv);
    }
}
}
namespace mpost {
constexpr int GSTR = 576;
constexpr int XC_OFF = 0, WV_OFF = 128 * GSTR, LDS_BYTES = WV_OFF + 128 * 64;
struct Tensors { bf16* hm; const bf16* om; const bf16* kimg; const float* wv; const float* hng; const float* skip; };

DI void unit(LAS unsigned char* lds, const Tensors& T, int u, int tid_in) {
    const int tid_ = wg_tid_local(tid_in);
    const int tid = tid_;
    const int h = u & 3, c = (u >> 2) & 63, b = u >> 8;
#pragma unroll
    for (int k = 0; k < 2; ++k) {
        const int id = tid + 512 * k, pb = id & 7, g = id >> 3, ks = pb >> 1, hi_ = pb & 1;
        const char* src = (const char*)T.kimg + ((size_t)((b * 4 + h) * 64 + c) * 64 + (g >> 3) * 4 + ks) * 1024 + (4 * (g & 7) + 32 * hi_) * 16;
        const v4u r0 = *(const v4u*)(src), r1 = *(const v4u*)(src + 16), r2 = *(const v4u*)(src + 32), r3 = *(const v4u*)(src + 48);
        const unsigned a0[4] = {r0.x, r0.y, r0.z, r0.w}, a1[4] = {r1.x, r1.y, r1.z, r1.w}, a2[4] = {r2.x, r2.y, r2.z, r2.w}, a3[4] = {r3.x, r3.y, r3.z, r3.w};
#pragma unroll
        for (int m = 0; m < 4; ++m) {
            const int tok = 16 * ks + 8 * (m >> 1) + 4 * hi_ + 2 * (m & 1);
            v2u e0, e1;
            e0.x = (a0[m] & 0xffffu) | (a1[m] << 16); e0.y = (a2[m] & 0xffffu) | (a3[m] << 16);
            e1.x = (a0[m] >> 16) | (a1[m] & 0xffff0000u); e1.y = (a2[m] >> 16) | (a3[m] & 0xffff0000u);
            *(LAS v2u*)(lds + XC_OFF + g * GSTR + tok * 8) = e0;
            *(LAS v2u*)(lds + XC_OFF + g * GSTR + (tok + 1) * 8) = e1;
        }
    }
    *(LAS f32x4*)(lds + WV_OFF + tid * 16) = *(const f32x4*)(T.wv + (size_t)(128 * h) * 16 + tid * 4);
    __syncthreads();
    const int t5 = tid >> 4, seg = tid & 15;
#pragma unroll 1
    for (int pass = 0; pass < 2; ++pass) {
        const int t = t5 + 32 * pass;
        const size_t rowu = ((size_t)b * SEQ + 64 * c + 32 * pass) * 2048 + 512 * h;
        char* hmb = (char*)(T.hm + rowu); const char* omb = (const char*)(T.om + rowu);
        const char* gnb = (const char*)(T.hng + 512 * h); const char* skb = (const char*)(T.skip + 512 * h);
        const unsigned voff = (unsigned)(t5 * 4096 + seg * 8), soff = (unsigned)(seg * 16);
        float uv[32];
        float sum = 0.f;
#pragma unroll
        for (int k = 0; k < 8; ++k) {
            const int gi = seg + 16 * k;
            const v2u hx = *(const v2u*)(hmb + voff + k * 128);
            const v2u og = *(const v2u*)(omb + voff + k * 128);
            const float hv[4] = {bflo(hx.x), bfhi(hx.x), bflo(hx.y), bfhi(hx.y)};
            const float ov[4] = {bflo(og.x), bfhi(og.x), bflo(og.y), bfhi(og.y)};
            const LAS f32x4* wp = (const LAS f32x4*)(lds + WV_OFF + gi * 64);
            const f32x4 w0 = wp[0], w1 = wp[1], w2 = wp[2], w3 = wp[3];
#pragma unroll
            for (int o = 0; o < 4; ++o) {
                const float v = hv[0] * w0[o] + hv[1] * w1[o] + hv[2] * w2[o] + hv[3] * w3[o];
                const float x = v * ov[o];
                uv[4 * k + o] = x; sum += x;
            }
            if (k & 1) __builtin_amdgcn_sched_barrier(0);
        }
        sum += __shfl_xor(sum, 1); sum += __shfl_xor(sum, 2); sum += __shfl_xor(sum, 4); sum += __shfl_xor(sum, 8);
        const float mean = sum * (1.0f / 512.0f);
        float sq = 0.f;
#pragma unroll
        for (int i = 0; i < 32; ++i) { const float d = uv[i] - mean; sq += d * d; }
        sq += __shfl_xor(sq, 1); sq += __shfl_xor(sq, 2); sq += __shfl_xor(sq, 4); sq += __shfl_xor(sq, 8);
        const float rstd = 1.0f / sqrtf(sq * (1.0f / 512.0f) + EPS);
#pragma unroll
        for (int k = 0; k < 8; ++k) {
            const int gi = seg + 16 * k;
            const f32x4 gn = *(const f32x4*)(gnb + soff + k * 256), sk = *(const f32x4*)(skb + soff + k * 256);
            const v2u xc = *(const LAS v2u*)(lds + XC_OFF + gi * GSTR + t * 8);
            const float xv[4] = {bflo(xc.x), bfhi(xc.x), bflo(xc.y), bfhi(xc.y)};
            float r[4];
#pragma unroll
            for (int o = 0; o < 4; ++o) r[o] = (uv[4 * k + o] - mean) * rstd * gn[o] + sk[o] * xv[o];
            v2u wv; wv.x = pk2(r[0], r[1]); wv.y = pk2(r[2], r[3]);
            *(v2u*)(hmb + voff + k * 128) = wv;
        }
    }
    __syncthreads();
}
DI void phase(LAS unsigned char* lds, const Tensors& T, int G, int blk, int wv) {
    for (int u = blk; u < BATCH * NCHUNK * MH; u += G) unit(lds, T, u, wv);
}
}

DI void transpose_item(const float* W, int K, int N, bf16* WT, const float* kscale, LAS float* scr, int item, int lane) {
    const int nblk = N / 32, kb = item / nblk, nb = item % nblk, k0 = 64 * kb, n0 = 32 * nb;
#pragma unroll 8
    for (int i = 0; i < 32; ++i) { const int kk = 2 * i + (lane >> 5); float v = W[(size_t)(k0 + kk) * N + n0 + (lane & 31)]; if (kscale) v *= kscale[k0 + kk]; scr[kk * 33 + (lane & 31)] = v; }
    asm volatile("s_waitcnt lgkmcnt(0)" ::: "memory");
    const int cc = lane & 7;
#pragma unroll
    for (int j = 0; j < 4; ++j) { const int n = (lane >> 3) + 8 * j; const LAS float* s = scr + (8 * cc) * 33 + n;
        v4u o; o.x = pk2(s[0 * 33], s[1 * 33]); o.y = pk2(s[2 * 33], s[3 * 33]); o.z = pk2(s[4 * 33], s[5 * 33]); o.w = pk2(s[6 * 33], s[7 * 33]);
        *(v4u*)(WT + (size_t)(n0 + n) * K + k0 + 8 * cc) = o; }
    asm volatile("s_waitcnt lgkmcnt(0)" ::: "memory");
}
DI void rms_row_to_bf16(const float* xrow, bf16* orow, int lane) {
    const f32x4* xr = (const f32x4*)xrow + lane;
    f32x4 v[4]; float s = 0.f;
#pragma unroll
    for (int j = 0; j < 4; ++j) { v[j] = xr[64 * j]; s += (v[j][0] * v[j][0] + v[j][1] * v[j][1]) + (v[j][2] * v[j][2] + v[j][3] * v[j][3]); }
    const float r = 1.0f / sqrtf(wave_sum(s) * (1.0f / 1024.0f) + EPS);
    v2u* o8 = (v2u*)orow + lane;
#pragma unroll
    for (int j = 0; j < 4; ++j) { v2u w; w.x = pk2(v[j][0] * r, v[j][1] * r); w.y = pk2(v[j][2] * r, v[j][3] * r); o8[64 * j] = w; }
}
DI void rms_row_inplace(float* row, const float* g, int lane) {
    f32x4* xr = (f32x4*)row + lane; const f32x4* gr = (const f32x4*)g + lane;
    f32x4 v[4]; float s = 0.f;
#pragma unroll
    for (int j = 0; j < 4; ++j) { v[j] = xr[64 * j]; s += (v[j][0] * v[j][0] + v[j][1] * v[j][1]) + (v[j][2] * v[j][2] + v[j][3] * v[j][3]); }
    const float r = 1.0f / sqrtf(wave_sum(s) * (1.0f / 1024.0f) + EPS);
#pragma unroll
    for (int j = 0; j < 4; ++j) xr[64 * j] = v[j] * r * gr[64 * j];
}
constexpr int N_PHASES = 15;
constexpr int LDS_TOTAL = 163840, XB_LDS_OFF = 163840 - 16;
static_assert(pg8::STAGE_BYTES <= XB_LDS_OFF && att::LDS_BYTES <= XB_LDS_OFF && mpre::LDS_BYTES <= XB_LDS_OFF && mscan::LDS_BYTES <= XB_LDS_OFF && mpost::LDS_BYTES <= XB_LDS_OFF, "LDS map vs barrier words");
static_assert(pg8::STAGE_BYTES <= LDS_TOTAL && att::LDS_BYTES <= LDS_TOTAL && mpre::LDS_BYTES <= LDS_TOTAL && mscan::LDS_BYTES <= LDS_TOTAL && mpost::LDS_BYTES <= LDS_TOTAL, "LDS map");

struct Args { const float* in[18]; float* out; unsigned char* ws; int ph_lo, ph_hi; };

DI void prologue(const Args& a, LAS unsigned char* lds, int G, int blk, int wvi) {
    const int tid = wg_tid_local(wvi), lane = tid & 63, wave = __builtin_amdgcn_readfirstlane(tid >> 6);
    unsigned char* ws = a.ws;
    LAS float* scr = (LAS float*)(lds + wave * 16384);
    const int gw = blk * NWAVES + wave, NGW = G * NWAVES;
    constexpr int I_IN = (DM / 64) * (NIN / 32), I_PA = (AW / 64) * (DM / 32), I_PB = (MW / 64) * (DM / 32), I_OUT = (DM / 64) * (DM / 32);
    constexpr int NITEMS = I_IN + I_PA + I_PB + I_OUT;
    for (int it = gw; it < NITEMS; it += NGW) {
        int r = it;
        if (r < I_IN) { transpose_item(a.in[2], DM, NIN, (bf16*)(ws + WS_WIN), a.in[1], scr, r, lane); continue; } r -= I_IN;
        if (r < I_PA) { transpose_item(a.in[13], AW, DM, (bf16*)(ws + WS_WPA), nullptr, scr, r, lane); continue; } r -= I_PA;
        if (r < I_PB) { transpose_item(a.in[14], MW, DM, (bf16*)(ws + WS_WPB), nullptr, scr, r, lane); continue; } r -= I_PB;
        transpose_item(a.in[15], DM, DM, (bf16*)(ws + WS_WOUT), nullptr, scr, r, lane);
    }
    for (int m = gw; m < MTOK; m += NGW) rms_row_to_bf16(a.in[0] + (size_t)m * DM, (bf16*)(ws + WS_XN) + (size_t)m * DM, lane);
    float* tab = (float*)(ws + WS_TAB);
    const float* wq = a.in[6]; const float* wk = a.in[7]; const float* wv = a.in[8]; const float* wif = a.in[9]; const float* rb = a.in[16];
    const int gt = blk * NTHR + tid, NGT = G * NTHR;
    for (int i = gt; i < 2048 * 8; i += NGT) {
        const int c = i >> 3, j = i & 7, g = c >> 2, ii = c & 3;
        float sc = 0.f, sm = 0.f;
#pragma unroll
        for (int o = 0; o < 4; ++o) {
            sc += wq[g * 16 + ii * 4 + o] * wif[(size_t)(4 * g + o) * 8 + j] + wk[g * 16 + ii * 4 + o] * wif[(size_t)(2048 + 4 * g + o) * 8 + j];
            sm += wv[g * 16 + ii * 4 + o] * wif[(size_t)(4096 + 4 * g + o) * 8 + j];
        }
        ((bf16*)(tab + TAB_WC))[j * 2048 + c] = (bf16)(pk2(sc, 0.f) & 0xffffu); ((bf16*)(tab + TAB_WM))[j * 2048 + c] = (bf16)(pk2(sm, 0.f) & 0xffffu);
    }
    for (int i = gt; i < 512 * 16; i += NGT) {
        const int g = i >> 4, ii = (i >> 2) & 3, i2 = i & 3;
        float s = 0.f;
#pragma unroll
        for (int o = 0; o < 4; ++o) s += wq[g * 16 + ii * 4 + o] * wk[g * 16 + i2 * 4 + o];
        tab[TAB_G + i] = s * 0.04419417382415922f;
    }
    for (int i = gt; i < 3 * 16 * 132; i += NGT) {
        const int d = i % 132, ph = i / 132, p = ph >> 4, hh = ph & 15;
        tab[TAB_BIAS + i] = rb[BUCKET[p][d] * 16 + hh] * LOG2E;
    }
}

#define XB_TMO      128
#define XB_XCNT(j)  (256  + 64 * (j))
#define XB_XSUB(j)  (1280 + 64 * (j))
#define XB_XGEN(j)  (2304 + 64 * (j))
#define XB_TOP      3328
#define XB_TOPGEN   3392
#define XCD_BAR_WORDS 3456
#define XB_SPIN_CAP (1u << 18)
DI unsigned xb_ld(unsigned* p)              { return __hip_atomic_load(p, __ATOMIC_RELAXED, __HIP_MEMORY_SCOPE_AGENT); }
DI unsigned xb_add(unsigned* p, unsigned v) { return __hip_atomic_fetch_add(p, v, __ATOMIC_RELAXED, __HIP_MEMORY_SCOPE_AGENT); }
DI unsigned xb_xcc_id() { return (unsigned)__builtin_amdgcn_s_getreg((3 << 11) | 20) & 0xFu; }
#define XB_SPIN(cond, bar) do { unsigned _sp = 0; while (cond) { __builtin_amdgcn_s_sleep(1); \
    if ((++_sp & 255u) == 0u) { if (xb_ld(&(bar)[XB_TMO])) break; if (_sp > XB_SPIN_CAP) { atomicAdd(&(bar)[XB_TMO], 1u); break; } } } } while (0)
struct XcdBarrier { unsigned* bar; unsigned x; volatile LAS unsigned* st; };
DI XcdBarrier xcd_barrier_post(unsigned* bar, volatile LAS unsigned* st, int tid) {
    XcdBarrier b; b.bar = bar; b.x = xb_xcc_id(); b.st = st;
    if (tid == 0) (void)xb_add(&bar[XB_XCNT(b.x)], 1u);
    return b;
}
DI void xcd_barrier_complete(unsigned* bar, unsigned x, unsigned& nloc, unsigned& nx) {
    const unsigned G = gridDim.x * gridDim.y * gridDim.z;
    unsigned sum, cnt, mine, sp = 0u;
    for (;;) {
        sum = 0u; cnt = 0u; mine = 0u;
#pragma unroll
        for (unsigned j = 0; j < 16; ++j) { const unsigned c = xb_ld(&bar[XB_XCNT(j)]); sum += c; cnt += (c > 0u) ? 1u : 0u; mine = (j == x) ? c : mine; }
        if (sum == G) break;
        __builtin_amdgcn_s_sleep(1);
        if ((++sp & 255u) == 0u) { if (xb_ld(&bar[XB_TMO])) break; if (sp > XB_SPIN_CAP) { atomicAdd(&bar[XB_TMO], 1u); break; } }
    }
    nloc = mine > 0u ? mine : 1u; nx = cnt > 0u ? cnt : 1u;
}
DI void xcd_barrier(const XcdBarrier& b, int tid) {
    asm volatile("s_waitcnt vmcnt(0)" ::: "memory");
    __syncthreads();
    if (tid == 0) {
        unsigned* bar = b.bar;
        __builtin_amdgcn_s_waitcnt(0);
        unsigned nloc = b.st[0], nx = b.st[1];
        if (nloc == 0u) { xcd_barrier_complete(bar, b.x, nloc, nx); b.st[0] = nloc; b.st[1] = nx; }
        const unsigned old = xb_add(&bar[XB_XSUB(b.x)], 1u);
        const unsigned gen = old / nloc;
        if (old + 1u == (gen + 1u) * nloc) {
            __builtin_amdgcn_fence(__ATOMIC_RELEASE, "agent");
            asm volatile("s_waitcnt vmcnt(0)" ::: "memory");
            const unsigned og = xb_add(&bar[XB_TOP], 1u);
            const unsigned tg = og / nx;
            if (og + 1u == (tg + 1u) * nx) xb_add(&bar[XB_TOPGEN], 1u);
            else XB_SPIN(xb_ld(&bar[XB_TOPGEN]) == tg, bar);
            __builtin_amdgcn_fence(__ATOMIC_ACQUIRE, "agent");
            xb_add(&bar[XB_XGEN(b.x)], 1u);
            asm volatile("s_waitcnt vmcnt(0)" ::: "memory");
        } else {
            XB_SPIN(xb_ld(&bar[XB_XGEN(b.x)]) == gen, bar);
            __builtin_amdgcn_fence(__ATOMIC_ACQUIRE, "agent");
            asm volatile("s_waitcnt vmcnt(0)" ::: "memory");
        }
    }
    __syncthreads();
}

DI void grid_sync_(int tid) {
    asm volatile("s_waitcnt vmcnt(0) lgkmcnt(0)" ::: "memory");
    __builtin_amdgcn_fence(__ATOMIC_RELEASE, "workgroup");
    __builtin_amdgcn_s_barrier();
    if (tid == 0) {
        __builtin_amdgcn_fence(__ATOMIC_ACQUIRE, "workgroup");
        __builtin_amdgcn_fence(__ATOMIC_RELEASE, "agent");
        const __attribute__((address_space(4))) char* ia = (const __attribute__((address_space(4))) char*)__builtin_amdgcn_implicitarg_ptr();
        const unsigned long long p = *(const __attribute__((address_space(4))) unsigned long long*)(ia + 88);
        unsigned* bar = (unsigned*)(p + 32);
        const unsigned nwg = *(const unsigned*)(p + 40);
        const unsigned old = __hip_atomic_fetch_add(bar, 1u, __ATOMIC_RELAXED, __HIP_MEMORY_SCOPE_AGENT);
        if ((old & 0xffffu) == nwg - 1u) (void)__hip_atomic_fetch_add(bar, 65536u - nwg, __ATOMIC_RELAXED, __HIP_MEMORY_SCOPE_AGENT);
        const unsigned gen = old & 0xffff0000u;
        while ((__hip_atomic_load(bar, __ATOMIC_RELAXED, __HIP_MEMORY_SCOPE_AGENT) & 0xffff0000u) == gen) __builtin_amdgcn_s_sleep(1);
        __builtin_amdgcn_fence(__ATOMIC_ACQUIRE, "agent");
        __builtin_amdgcn_fence(__ATOMIC_RELEASE, "workgroup");
    }
    __builtin_amdgcn_s_barrier();
    __builtin_amdgcn_fence(__ATOMIC_ACQUIRE, "workgroup");
}

__global__ void __launch_bounds__(NTHR) mk_fwd(Args a) {
    extern __shared__ __attribute__((aligned(16))) unsigned char lds_raw[];
    LAS unsigned char* lds = (LAS unsigned char*)lds_raw;
    const int G = gridDim.x, blk = blockIdx.x;
    const int wv = __builtin_amdgcn_readfirstlane(threadIdx.x >> 6);
    volatile LAS unsigned* bst = (volatile LAS unsigned*)(lds + XB_LDS_OFF);
    if (wg_tid_local(wv) < 4) bst[wg_tid_local(wv)] = 0u;
    __syncthreads();
    (void)xcd_barrier_post((unsigned*)(a.ws + WS_CTL) + 1024, bst, wg_tid_local(wv));
#define XBAR() do { XcdBarrier xb_; xb_.bar = (unsigned*)(a.ws + WS_CTL) + 1024; xb_.x = xb_xcc_id(); xb_.st = (volatile LAS unsigned*)(lds + XB_LDS_OFF); xcd_barrier(xb_, wg_tid_local(wv)); } while (0)
    unsigned char* ws = a.ws;
    const int lo = a.ph_lo, hi = a.ph_hi;
    bf16* XN = (bf16*)(ws + WS_XN); bf16* WIN = (bf16*)(ws + WS_WIN);
#ifndef PH_MASK
#define PH_MASK 0x7fff
#endif
#define IN(k) (((PH_MASK >> (k)) & 1) && lo <= (k) && (k) < hi)
#ifndef REP_MASK
#define REP_MASK 0
#endif
#define REPEAT(k, body) do { body; if ((REP_MASK >> (k)) & 1) { XBAR(); body; } } while (0)
#define SEAM(k) do { if (IN(k) && IN((k) + 1)) { if (lo < 0) grid_sync_(wg_tid_local(wv)); XBAR(); } } while (0)
#define GEMM_PHASE(EPI, E, Aop, Bop, NN, KK) do { pg8::Gemm g{(const pg8::bf16_t*)(Aop), (const pg8::bf16_t*)(Bop), MTOK, (NN), (KK)}; pg8::StaticOrder S; S.init(MTOK, (NN), G, blk); \
        pg8::gemm_phase<EPI, pg8::StaticOrder, true, true>(lds, g, S, E, wg_tid_local(wv)); } while (0)

    if (IN(0)) { REPEAT(0, prologue(a, lds, G, blk, wv)); } SEAM(0);
    if (IN(1)) {
        pg8::EpiXM E{(bf16*)(ws + WS_R0), (bf16*)(ws + WS_HALO)};
        REPEAT(1, GEMM_PHASE(pg8::EpiXM, E, XN, WIN + (size_t)C_XM * DM, MW, DM));
    } SEAM(1);
    if (IN(2)) {
        const float* tab = (const float*)(ws + WS_TAB);
        mpre::Tensors T{(const bf16*)(ws + WS_R0), (const bf16*)(ws + WS_HALO), (bf16*)(ws + WS_R1), (bf16*)a.out, (bf16*)(ws + WS_R2), (float*)(ws + WS_GP), (bf16*)(ws + WS_S), a.in[4], a.in[5], (const bf16*)(tab + TAB_WC), (const bf16*)(tab + TAB_WM), tab + TAB_G};
        REPEAT(2, mpre::phase(lds, T, G, blk, wv));
    } SEAM(2);
    if (IN(3)) {
        mscan::Tensors T{(const bf16*)(ws + WS_R2), (const bf16*)(ws + WS_R1), (const bf16*)a.out, (const bf16*)(ws + WS_S), (const float*)(ws + WS_GP), a.in[10], (float*)(ws + WS_SCAL), (bf16*)(ws + WS_R0)};
        mscan::phase<0>(lds, T, G, blk, wv);
#ifdef SCAN_PROBE
        XBAR(); mscan::phase<SCAN_PROBE>(lds, T, G, blk, wv);
#endif
    } SEAM(3);
    if (IN(4)) {
        pg8::EpiSig E{(bf16*)(ws + WS_R2), MW, nullptr};
        REPEAT(4, GEMM_PHASE(pg8::EpiSig, E, XN, WIN + (size_t)C_OM * DM, MW, DM));
    } SEAM(4);
    if (IN(5)) {
        mpost::Tensors T{(bf16*)(ws + WS_R0), (const bf16*)(ws + WS_R2), (const bf16*)(ws + WS_R1), a.in[8], a.in[11], a.in[12]};
        mpost::phase(lds, T, G, blk, wv);
    } SEAM(5);
    if (IN(6)) {
        pg8::EpiZM E{(bf16*)(ws + WS_R0)};
        GEMM_PHASE(pg8::EpiZM, E, XN, WIN + (size_t)C_ZM * DM, MW, DM);
    } SEAM(6);
    if (IN(7)) {
        pg8::EpiQKV E{(bf16*)(ws + WS_QA), (size_t)(WS_KA - WS_QA) / 2};
        REPEAT(7, GEMM_PHASE(pg8::EpiQKV, E, XN, WIN + (size_t)C_QA * DM, 3 * AW, DM));
    } SEAM(7);
    if (IN(8)) {
        att::Tensors T{(const bf16*)(ws + WS_QA), (const bf16*)(ws + WS_KA), (const bf16*)(ws + WS_VA), (bf16*)(ws + WS_O1), (bf16*)a.out, (float*)(ws + WS_ST), (const float*)(ws + WS_TAB) + TAB_BIAS};
        REPEAT(8, att::phase(lds, T, G, blk, wv));
    } SEAM(8);
    if (IN(9)) {
        pg8::EpiZA E{(const bf16*)(ws + WS_O1), (const bf16*)a.out, (const bf16*)a.out + (size_t)MTOK * AW, (const float*)(ws + WS_ST), (bf16*)(ws + WS_A1)};
        REPEAT(9, GEMM_PHASE(pg8::EpiZA, E, XN, WIN + (size_t)C_ZA * DM, AW, DM));
    } SEAM(9);
    if (IN(10)) {
        pg8::EpiSig E{(bf16*)(ws + WS_G), 2 * DM, a.in[3]};
        REPEAT(10, GEMM_PHASE(pg8::EpiSig, E, XN, WIN + (size_t)C_G * DM, 2 * DM, DM));
    } SEAM(10);
    if (IN(11)) {
        pg8::EpiYA E{(bf16*)(ws + WS_G)};
        GEMM_PHASE(pg8::EpiYA, E, ws + WS_A1, ws + WS_WPA, DM, AW);
    } SEAM(11);
    if (IN(12)) {
        pg8::EpiYM E{(const bf16*)(ws + WS_G), (bf16*)(ws + WS_MRG)};
        REPEAT(12, GEMM_PHASE(pg8::EpiYM, E, ws + WS_R0, ws + WS_WPB, DM, MW));
    } SEAM(12);
    if (IN(13)) {
        pg8::EpiOut E{a.in[0], a.out};
        REPEAT(13, GEMM_PHASE(pg8::EpiOut, E, ws + WS_MRG, ws + WS_WOUT, DM, DM));
    } SEAM(13);
#ifdef EXTRA_SYNCS
    if (IN(13) && IN(14)) { for (int i = 0; i < EXTRA_SYNCS; ++i) XBAR(); }
#endif
    if (IN(14)) {
        const int lane = wg_tid_local(wv) & 63, wave = wv;
        for (int m = blk * NWAVES + wave; m < MTOK; m += G * NWAVES) rms_row_inplace(a.out + (size_t)m * DM, a.in[17], lane);
    }
#undef IN
#undef SEAM
#undef GEMM_PHASE
}

#ifndef MK_ONE_LAUNCH
#define MK_ONE_LAUNCH 0
#endif
extern "C" void kernel_launch(void* const* d_in, const int* in_sizes, int n_in, void* d_out, int out_size, void* d_ws, size_t ws_size, hipStream_t stream) {
    static int grid = 0;
    if (grid == 0) {
        if (n_in != 18 || in_sizes[0] != MTOK * DM || out_size != MTOK * DM || ws_size < WS_END) { fprintf(stderr, "kernel_launch: unexpected shapes (n_in %d, ws %zu)\n", n_in, ws_size); grid = -1; return; }
        int dev = 0, cus = 0, per_cu = 0;
        (void)hipGetDevice(&dev); (void)hipDeviceGetAttribute(&cus, hipDeviceAttributeMultiprocessorCount, dev);
        if (hipFuncSetAttribute((const void*)mk_fwd, hipFuncAttributeMaxDynamicSharedMemorySize, LDS_TOTAL) != hipSuccess) { fprintf(stderr, "kernel_launch: hipFuncSetAttribute failed\n"); grid = -1; return; }
        if (hipOccupancyMaxActiveBlocksPerMultiprocessor(&per_cu, (const void*)mk_fwd, NTHR, LDS_TOTAL) != hipSuccess || per_cu < 1) { fprintf(stderr, "kernel_launch: occupancy query says %d\n", per_cu); per_cu = 1; }
        (void)hipGetLastError();
        grid = cus * (per_cu > 1 ? 1 : per_cu);
    }
    if (grid < 0) return;
    if (hipMemsetAsync((char*)d_ws + WS_CTL, 0, 65536, stream) != hipSuccess) { fprintf(stderr, "kernel_launch: hipMemsetAsync failed\n"); return; }
    Args a{};
    for (int i = 0; i < 18; ++i) a.in[i] = (const float*)d_in[i];
    a.out = (float*)d_out; a.ws = (unsigned char*)d_ws;
#if MK_ONE_LAUNCH
    a.ph_lo = 0; a.ph_hi = N_PHASES;
    void* args[] = {&a};
    hipError_t e = hipLaunchCooperativeKernel((const void*)mk_fwd, dim3(grid), dim3(NTHR), args, LDS_TOTAL, stream);
    if (e != hipSuccess) fprintf(stderr, "cooperative launch failed: %s (grid %d)\n", hipGetErrorString(e), grid);
#else
    for (int p = 0; p < N_PHASES; ++p) {
        a.ph_lo = p; a.ph_hi = p + 1;
        hipLaunchKernelGGL(mk_fwd, dim3(grid), dim3(NTHR), LDS_TOTAL, stream, a);
    }
#endif
}
```

```cpp
#define MK_ONE_LAUNCH 1
#include <hip/hip_runtime.h>
#include <hip/hip_cooperative_groups.h>
#include <cstdio>
#include <cstdint>
namespace cg = cooperative_groups;
#define LAS __attribute__((address_space(3)))
#define GAS __attribute__((address_space(1)))
typedef unsigned short bf16;
typedef unsigned v4u __attribute__((ext_vector_type(4)));
typedef unsigned v2u __attribute__((ext_vector_type(2)));
typedef float f32x4 __attribute__((ext_vector_type(4)));
typedef float f32x16 __attribute__((ext_vector_type(16)));
typedef short bf16x8 __attribute__((ext_vector_type(8)));
typedef short s16x4 __attribute__((ext_vector_type(4)));
typedef float f32x2_t __attribute__((ext_vector_type(2)));
typedef __bf16 bf16x2_t __attribute__((ext_vector_type(2)));

constexpr int NWAVES = 8, NTHR = 512;
constexpr int BATCH = 8, SEQ = 4096, DM = 1024, MTOK = BATCH * SEQ;
constexpr int AH = 16, AHD = 64, AW = 1024;
constexpr int MH = 4, MHD = 512, MW = 2048;
constexpr int NIN = 12288;
constexpr int C_QA = 0, C_KA = 1024, C_VA = 2048, C_ZA = 3072, C_XM = 4096, C_ZM = 6144, C_OM = 8192, C_G = 10240;
constexpr int CHUNK = 64, NCHUNK = SEQ / CHUNK;
constexpr float EPS = 1e-6f;
constexpr float LOG2E = 1.4426950408889634f;
constexpr float QSCALE = 0.125f * 1.4426950408889634f;

constexpr size_t MiB = 1u << 20;
constexpr size_t WS_CTL = 0;
constexpr size_t WS_WIN = 1 * MiB;
constexpr size_t WS_WPA = 25 * MiB;
constexpr size_t WS_WPB = 27 * MiB;
constexpr size_t WS_WOUT = 31 * MiB;
constexpr size_t WS_TAB = 33 * MiB;
constexpr size_t WS_GP = 34 * MiB;
constexpr size_t WS_SCAL = 38 * MiB;
constexpr size_t WS_HALO = 40 * MiB;
constexpr size_t WS_ST = 34 * MiB;
constexpr size_t WS_XN = 46 * MiB;
constexpr size_t WS_R0 = 110 * MiB;
constexpr size_t WS_R1 = 238 * MiB;
constexpr size_t WS_R2 = 366 * MiB;
constexpr size_t WS_S = 494 * MiB;
constexpr size_t WS_END = 512 * MiB;
constexpr size_t WS_QA = 238 * MiB, WS_KA = 302 * MiB, WS_VA = 366 * MiB;
constexpr size_t WS_O1 = 430 * MiB;
constexpr size_t WS_A1 = 238 * MiB;
constexpr size_t WS_G = 302 * MiB;
constexpr size_t WS_MRG = 430 * MiB;
constexpr int TAB_WC = 0;
constexpr int TAB_WM = 2048 * 8;
constexpr int TAB_G = 2 * 2048 * 8;
constexpr int TAB_BIAS = TAB_G + 512 * 16;
constexpr int TAB_END = TAB_BIAS + 3 * 16 * 132;

__device__ const unsigned char BUCKET[3][132] = {
 {0,1,2,3,4,5,6,7,8,9,10,11,12,13,14,15,16,16,16,16,16,16,17,17,17,17,17,17,17,17,18,18,18,18,18,18,18,18,18,18,19,19,19,19,19,19,19,19,19,19,19,19,19,19,20,20,20,20,20,20,20,20,20,20,20,20,20,20,20,20,20,20,20,21,21,21,21,21,21,21,21,21,21,21,21,21,21,21,21,21,21,21,21,21,21,21,21,21,21,22,22,22,22,22,22,22,22,22,22,22,22,22,22,22,22,22,22,22,22,22,22,22,22,22,22,22,22,22,22,0,0,0},
 {0,4,8,12,16,16,17,17,18,18,19,19,19,19,20,20,20,20,20,21,21,21,21,21,21,22,22,22,22,22,22,22,22,22,23,23,23,23,23,23,23,23,23,23,23,23,24,24,24,24,24,24,24,24,24,24,24,24,24,24,24,24,25,25,25,25,25,25,25,25,25,25,25,25,25,25,25,25,25,25,25,25,25,26,26,26,26,26,26,26,26,26,26,26,26,26,26,26,26,26,26,26,26,26,26,26,26,26,26,26,26,26,26,27,27,27,27,27,27,27,27,27,27,27,27,27,27,27,27,0,0,0},
 {0,16,18,19,20,21,21,22,22,23,23,23,24,24,24,24,25,25,25,25,25,26,26,26,26,26,26,26,26,27,27,27,27,27,27,27,27,27,27,28,28,28,28,28,28,28,28,28,28,28,28,28,29,29,29,29,29,29,29,29,29,29,29,29,29,29,29,29,29,29,30,30,30,30,30,30,30,30,30,30,30,30,30,30,30,30,30,30,30,30,30,30,30,30,30,31,31,31,31,31,31,31,31,31,31,31,31,31,31,31,31,31,31,31,31,31,31,31,31,31,31,31,31,31,31,31,31,31,31,0,0,0}};

#define DI __device__ __forceinline__
DI unsigned pk2(float lo, float hi) { f32x2_t v = {lo, hi}; bf16x2_t b = __builtin_convertvector(v, bf16x2_t); return __builtin_bit_cast(unsigned, b); }
DI float bflo(unsigned u) { return __uint_as_float(u << 16); }
DI float bfhi(unsigned u) { return __uint_as_float(u & 0xffff0000u); }
DI float sigmoidf_(float x) { return 1.0f / (1.0f + __expf(-x)); }
DI float siluf_(float x) { return x / (1.0f + __expf(-x)); }
DI float wave_sum(float v) {
#pragma unroll
    for (int o = 1; o < 64; o <<= 1) v += __shfl_xor(v, o);
    return v;
}
DI int wg_tid(int wv) { return wv * 64 + (int)__builtin_amdgcn_mbcnt_hi(~0u, __builtin_amdgcn_mbcnt_lo(~0u, 0u)); }
DI int wg_tid_local(int wv) { int z; asm volatile("v_mov_b32 %0, 0" : "=v"(z)); return wv * 64 + (int)__builtin_amdgcn_mbcnt_hi(~0u, __builtin_amdgcn_mbcnt_lo(~0u, (unsigned)z)); }
DI float dot2bf(unsigned a, unsigned b, float acc) { return __builtin_amdgcn_fdot2_f32_bf16(__builtin_bit_cast(bf16x2_t, a), __builtin_bit_cast(bf16x2_t, b), acc, false); }
DI float bperm(float v, int srclane) { return __int_as_float(__builtin_amdgcn_ds_bpermute(srclane << 2, __float_as_int(v))); }
DI int crow(int r, int hi) { return (r & 3) + 8 * (r >> 2) + 4 * hi; }
#define MFMA32(a, b, c) __builtin_amdgcn_mfma_f32_32x32x16_bf16((a), (b), (c), 0, 0, 0)
DI s16x4 tr_read(const LAS unsigned char* p) { return __builtin_bit_cast(s16x4, __builtin_amdgcn_ds_read_tr16_b64_v4i16((LAS s16x4*)p)); }
DI bf16x8 cat8(s16x4 lo, s16x4 hi) { return __builtin_shufflevector(lo, hi, 0, 1, 2, 3, 4, 5, 6, 7); }
DI bf16x8 pack8(float a0, float a1, float a2, float a3, float a4, float a5, float a6, float a7) {
    v4u p; p.x = pk2(a0, a1); p.y = pk2(a2, a3); p.z = pk2(a4, a5); p.w = pk2(a6, a7); return __builtin_bit_cast(bf16x8, p);
}
namespace pg8 {
#define PG8_LAS __attribute__((address_space(3)))
typedef unsigned short bf16_t;
typedef short bf16x8 __attribute__((ext_vector_type(8)));
typedef float f32x4 __attribute__((ext_vector_type(4)));
typedef unsigned u32x4 __attribute__((ext_vector_type(4)));
constexpr int BM = 256, BK = 64, HALF = 128, HTB = HALF * BK * 2  , STAGE_BYTES = 8 * HTB, NXCD = 8, WGM = 8;

__host__ __device__ __forceinline__ int lds_byte(int r, int c) { const int st = (r >> 4) * 2 + (c >> 5), rr = r & 15, cc = c & 31, ob = rr * 64 + cc * 2; return st * 1024 + (ob ^ (((ob >> 9) & 1) << 5)); }
__host__ __device__ __forceinline__ void stage_rc(int b, int& R, int& C) { const int st = b / 1024, sb = b % 1024, swz = sb ^ (((sb >> 9) & 1) << 5); R = (st >> 1) * 16 + swz / 64; C = (st & 1) * 32 + (swz % 64) / 2; }
__host__ __device__ __forceinline__ int perm32(int rho) { const int n = rho >> 4, i = rho & 15; return 8 * (i >> 2) + 4 * n + (i & 3); }

struct Unit { int pm, pn; };
struct Gemm { const bf16_t* A; const bf16_t* Bt; int M, N, K; };

struct StaticOrder {
    int nM, nN, nwg, G, c;
    __host__ __device__ void init(int M, int N, int G_, int c_) { nM = M / BM; nN = N / BM; nwg = nM * nN; G = G_; c = c_; }
    __host__ __device__ bool next(int i, Unit& u) const {
        const long L = (long)i * G + c; if (L >= nwg) return false;
        int wgid = (int)L; { const int q = nwg / NXCD, r = nwg % NXCD, xcd = wgid % NXCD, off = wgid / NXCD; wgid = (xcd < r ? xcd * (q + 1) : r * (q + 1) + (xcd - r) * q) + off; }
        const int nig = WGM * nN, gid = wgid / nig, fm = gid * WGM, gsz = (nM - fm) < WGM ? (nM - fm) : WGM;
        u.pm = fm + ((wgid % nig) % gsz); u.pn = (wgid % nig) / gsz; return true;
    }
    __device__ __forceinline__ void a_ready(const Unit&) const {}
    __device__ __forceinline__ void done(const Unit&) const {}
};

}
namespace pg8 {
#define EPI_OPERATOR \
    static constexpr bool PERM = true, AFTER_DRAIN = false; \
    __device__ __forceinline__ void operator()(const f32x4 (&acc)[2][2][4][2], const Unit& u, int wr, int wc, int fr, int fq) const { \
        const int row0 = u.pm * BM + wr * 64 + fr, col0 = u.pn * BM + wc * 32 + 8 * fq; \
        _Pragma("unroll") for (int ai = 0; ai < 2; ++ai) \
        _Pragma("unroll") for (int m = 0; m < 4; ++m) \
        _Pragma("unroll") for (int bj = 0; bj < 2; ++bj) store8(row0 + ai * HALF + m * 16, col0 + bj * HALF, acc[ai][bj][m][0], acc[ai][bj][m][1]); \
    }
DI ::v4u pack_bf16x8(f32x4 v0, f32x4 v1) { ::v4u w; w.x = ::pk2(v0[0], v0[1]); w.y = ::pk2(v0[2], v0[3]); w.z = ::pk2(v1[0], v1[1]); w.w = ::pk2(v1[2], v1[3]); return w; }
DI void unpack_bf16x8(::v4u w, f32x4& v0, f32x4& v1) { v0 = (f32x4){::bflo(w.x), ::bfhi(w.x), ::bflo(w.y), ::bfhi(w.y)}; v1 = (f32x4){::bflo(w.z), ::bfhi(w.z), ::bflo(w.w), ::bfhi(w.w)}; }

struct EpiXM {
    bf16_t* xm; bf16_t* halo;
    DI void store8(int row, int col, f32x4 v0, f32x4 v1) const {
        const ::v4u w = pack_bf16x8(v0, v1);
        *(::v4u*)(xm + (size_t)row * 2048 + col) = w;
        const int r = row & 63;
        if (r >= 61) *(::v4u*)(halo + ((size_t)(row >> 6) * 3 + (r - 61)) * 2048 + col) = w;
    }
    EPI_OPERATOR
};
struct EpiSig {
    bf16_t* out; int ldc; const float* bias;
    DI void store8(int row, int col, f32x4 v0, f32x4 v1) const {
        if (bias) { v0 += *(const f32x4*)(bias + col); v1 += *(const f32x4*)(bias + col + 4); }
#pragma unroll
        for (int i = 0; i < 4; ++i) { v0[i] = ::sigmoidf_(v0[i]); v1[i] = ::sigmoidf_(v1[i]); }
        *(::v4u*)(out + (size_t)row * ldc + col) = pack_bf16x8(v0, v1);
    }
    EPI_OPERATOR
};
struct EpiZM {
    bf16_t* buf;
    DI void store8(int row, int col, f32x4 v0, f32x4 v1) const {
        ::v4u* p = (::v4u*)(buf + (size_t)row * 2048 + col);
        f32x4 h0, h1; unpack_bf16x8(*p, h0, h1);
#pragma unroll
        for (int i = 0; i < 4; ++i) { h0[i] *= ::siluf_(v0[i]); h1[i] *= ::siluf_(v1[i]); }
        *p = pack_bf16x8(h0, h1);
    }
    EPI_OPERATOR
};
struct EpiQKV {
    bf16_t* q; size_t stride;
    DI void store8(int row, int col, f32x4 v0, f32x4 v1) const {
        const int t = col >> 10, c = col & 1023;
        bf16_t* base = q + (size_t)t * stride;
        if (t == 0) { v0 *= ::QSCALE; v1 *= ::QSCALE; }
        *(::v4u*)(base + (size_t)row * 1024 + c) = pack_bf16x8(v0, v1);
    }
    EPI_OPERATOR
};
struct EpiZA {
    const bf16_t* o0; const bf16_t* o1; const bf16_t* o2; const float* st; bf16_t* a1;
    DI void store8(int row, int col, f32x4 v0, f32x4 v1) const {
        const int head = col >> 6;
        const ::f32x2_t s0 = *(const ::f32x2_t*)(st + ((size_t)(0 * ::MTOK + row) * 16 + head) * 2);
        const ::f32x2_t s1 = *(const ::f32x2_t*)(st + ((size_t)(1 * ::MTOK + row) * 16 + head) * 2);
        const ::f32x2_t s2 = *(const ::f32x2_t*)(st + ((size_t)(2 * ::MTOK + row) * 16 + head) * 2);
        const float mx = fmaxf(s0.x, fmaxf(s1.x, s2.x));
        float w0 = __builtin_amdgcn_exp2f(s0.x - mx) * s0.y, w1 = __builtin_amdgcn_exp2f(s1.x - mx) * s1.y, w2 = __builtin_amdgcn_exp2f(s2.x - mx) * s2.y;
        const float inv = 1.0f / (w0 + w1 + w2); w0 *= inv; w1 *= inv; w2 *= inv;
        const size_t off = (size_t)row * 1024 + col;
        f32x4 a0, a1v, b0, b1, c0, c1;
        unpack_bf16x8(*(const ::v4u*)(o0 + off), a0, a1v); unpack_bf16x8(*(const ::v4u*)(o1 + off), b0, b1); unpack_bf16x8(*(const ::v4u*)(o2 + off), c0, c1);
        f32x4 r0 = a0 * w0 + b0 * w1 + c0 * w2, r1 = a1v * w0 + b1 * w1 + c1 * w2;
#pragma unroll
        for (int i = 0; i < 4; ++i) { r0[i] *= ::siluf_(v0[i]); r1[i] *= ::siluf_(v1[i]); }
        *(::v4u*)(a1 + off) = pack_bf16x8(r0, r1);
    }
    EPI_OPERATOR
};
struct EpiYA {
    bf16_t* g;
    DI void store8(int row, int col, f32x4 v0, f32x4 v1) const {
        ::v4u* p = (::v4u*)(g + (size_t)row * 2048 + col);
        f32x4 h0, h1; unpack_bf16x8(*p, h0, h1);
        *p = pack_bf16x8(h0 * v0, h1 * v1);
    }
    EPI_OPERATOR
};
struct EpiYM {
    const bf16_t* g; bf16_t* mrg;
    DI void store8(int row, int col, f32x4 v0, f32x4 v1) const {
        f32x4 t0, t1, g0, g1;
        unpack_bf16x8(*(const ::v4u*)(g + (size_t)row * 2048 + col), t0, t1);
        unpack_bf16x8(*(const ::v4u*)(g + (size_t)row * 2048 + 1024 + col), g0, g1);
        *(::v4u*)(mrg + (size_t)row * 1024 + col) = pack_bf16x8(t0 + g0 * v0, t1 + g1 * v1);
    }
    EPI_OPERATOR
};
struct EpiOut {
    const float* x; float* out;
    DI void store8(int row, int col, f32x4 v0, f32x4 v1) const {
        const size_t off = (size_t)row * 1024 + col;
        *(f32x4*)(out + off) = *(const f32x4*)(x + off) + v0;
        *(f32x4*)(out + off + 4) = *(const f32x4*)(x + off + 4) + v1;
    }
    EPI_OPERATOR
};
}
namespace pg8 {
template <class Epi, class Sched, bool ALIGN_EPI = false, bool SP2 = false>
__device__ __forceinline__ void gemm_phase(PG8_LAS unsigned char* lds, const Gemm g, const Sched& S, const Epi& E, const int tid_in) {
    const int tid = tid_in, wid = __builtin_amdgcn_readfirstlane(tid >> 6), lane = tid & 63, wr = wid >> 2, wc = wid & 3, fr = lane & 15, fq = lane >> 4;
    const int K = g.K, nt = K / BK;
    unsigned voffA[2], voffB[2];
#pragma unroll
    for (int i = 0; i < 2; ++i) { int R, C; stage_rc(tid * 16 + i * 8192, R, C); const int Rb = Epi::PERM ? ((R & ~31) + perm32(R & 31)) : R;
        voffA[i] = (unsigned)(R * K + C) * 2u; voffB[i] = (unsigned)(Rb * K + C) * 2u; }
    const size_t kstep = (size_t)(BK * 2);
    const size_t hstep = (size_t)HALF * K * 2;
    const size_t tstep = 2 * hstep;
    const unsigned ldsw = (unsigned)wid * 1024u;
    const int aoff = lds_byte(wr * 64 + fr, fq * 8), boff = lds_byte(wc * 32 + fr, fq * 8);
#define PG8_SA(b, h) (((b) * 2 + (h)) * HTB)
#define PG8_SB(b, h) ((4 + (b) * 2 + (h)) * HTB)
#define PG8_STAGE(bufoff, gbase, voff) do { _Pragma("unroll") for (int _i = 0; _i < 2; ++_i) \
        __builtin_amdgcn_global_load_lds((const unsigned*)((const char*)(gbase) + (voff)[_i]), (PG8_LAS unsigned*)(lds + (bufoff) + ldsw + _i * 8192), 16, 0, 0); } while (0)
#define PG8_LDA(dst, b, h) do { _Pragma("unroll") for (int m = 0; m < 4; ++m) _Pragma("unroll") for (int k = 0; k < 2; ++k) dst[m][k] = *(const PG8_LAS bf16x8*)(lds + PG8_SA(b, h) + aoff + m * 2048 + k * 1024); } while (0)
#define PG8_LDB(dst, b, h) do { _Pragma("unroll") for (int n = 0; n < 2; ++n) _Pragma("unroll") for (int k = 0; k < 2; ++k) dst[n][k] = *(const PG8_LAS bf16x8*)(lds + PG8_SB(b, h) + boff + n * 2048 + k * 1024); } while (0)
#define PG8_MMA(ai, bj, At, Bt) do { __builtin_amdgcn_s_setprio(1); _Pragma("unroll") for (int m = 0; m < 4; ++m) _Pragma("unroll") for (int n = 0; n < 2; ++n) _Pragma("unroll") for (int k = 0; k < 2; ++k) \
        acc[ai][bj][m][n] = __builtin_amdgcn_mfma_f32_16x16x32_bf16(Bt[n][k], At[m][k], acc[ai][bj][m][n], 0, 0, 0); __builtin_amdgcn_s_setprio(0); } while (0)
#define PG8_WAIT_V(n) asm volatile("s_waitcnt vmcnt(" #n ")" ::: "memory")
#define PG8_WAIT_L(n) asm volatile("s_waitcnt lgkmcnt(" #n ")" ::: "memory")
#define PG8_BAR __builtin_amdgcn_s_barrier()
#define PG8_SCHED __builtin_amdgcn_sched_barrier(0)
    Unit cur, nxt; int ui = 0;
    if (!S.next(0, cur)) return;
    f32x4 acc[2][2][4][2];
#pragma unroll
    for (int a = 0; a < 2; ++a)
#pragma unroll
        for (int b = 0; b < 2; ++b)
#pragma unroll
            for (int m = 0; m < 4; ++m)
#pragma unroll
                for (int n = 0; n < 2; ++n) acc[a][b][m][n] = (f32x4){0.f, 0.f, 0.f, 0.f};
    bf16x8 At[4][2], B0[2][2], B1[2][2];
    const char* cA = (const char*)g.A + (size_t)cur.pm * tstep; const char* cB = (const char*)g.Bt + (size_t)cur.pn * tstep;
    S.a_ready(cur);
    if constexpr (SP2) {
        PG8_STAGE(PG8_SB(0, 0), cB, voffB); PG8_STAGE(PG8_SB(0, 1), cB + hstep, voffB); PG8_STAGE(PG8_SA(0, 0), cA, voffA); PG8_STAGE(PG8_SA(0, 1), cA + hstep, voffA);
        if (wr == 1) PG8_BAR;
        PG8_WAIT_V(2); PG8_BAR;
        PG8_STAGE(PG8_SB(1, 0), cB + kstep, voffB); PG8_STAGE(PG8_SA(1, 0), cA + kstep, voffA); PG8_STAGE(PG8_SB(1, 1), cB + hstep + kstep, voffB);
        PG8_WAIT_V(6); PG8_BAR;
    } else {
        PG8_STAGE(PG8_SB(0, 0), cB, voffB); PG8_STAGE(PG8_SA(0, 0), cA, voffA); PG8_STAGE(PG8_SB(0, 1), cB + hstep, voffB); PG8_STAGE(PG8_SA(0, 1), cA + hstep, voffA);
        if (wr == 1) PG8_BAR;
        PG8_WAIT_V(4); PG8_BAR;
        PG8_STAGE(PG8_SB(1, 0), cB + kstep, voffB); PG8_STAGE(PG8_SA(1, 0), cA + kstep, voffA); PG8_STAGE(PG8_SB(1, 1), cB + hstep + kstep, voffB);
        PG8_WAIT_V(6); PG8_BAR;
    }
    for (;;) {
        const bool has_next = S.next(ui + 1, nxt);
        const char* nA = has_next ? (const char*)g.A + (size_t)nxt.pm * tstep : cA; const char* nB = has_next ? (const char*)g.Bt + (size_t)nxt.pn * tstep : cB;
        for (int t = 0; t < nt; t += 2) {
            const bool last = (t == nt - 2);
            const char* a1 = cA + (size_t)(t + 1) * kstep;
            const char* a2 = last ? nA : cA + (size_t)(t + 2) * kstep; const char* b2 = last ? nB : cB + (size_t)(t + 2) * kstep;
            const char* a3 = a2 + kstep; const char* b3 = b2 + kstep;
            if (last && has_next) S.a_ready(nxt);
            if constexpr (SP2) {
            PG8_LDB(B0, 0, 0); PG8_LDB(B1, 0, 1); PG8_SCHED; PG8_LDA(At, 0, 0); PG8_STAGE(PG8_SA(1, 1), a1 + hstep, voffA);
            PG8_WAIT_V(8); PG8_WAIT_L(0); PG8_BAR; PG8_MMA(0, 0, At, B0); PG8_MMA(0, 1, At, B1); PG8_BAR; PG8_SCHED;
            PG8_LDA(At, 0, 1); PG8_STAGE(PG8_SB(0, 0), b2, voffB); PG8_STAGE(PG8_SB(0, 1), b2 + hstep, voffB); PG8_STAGE(PG8_SA(0, 0), a2, voffA);
            PG8_WAIT_V(8); PG8_WAIT_L(0); PG8_BAR; PG8_MMA(1, 0, At, B0); PG8_MMA(1, 1, At, B1); PG8_BAR; PG8_SCHED;
            PG8_LDB(B0, 1, 0); PG8_LDB(B1, 1, 1); PG8_SCHED; PG8_LDA(At, 1, 0); PG8_STAGE(PG8_SA(0, 1), a2 + hstep, voffA);
            PG8_WAIT_V(8); PG8_WAIT_L(0); PG8_BAR; PG8_MMA(0, 0, At, B0); PG8_MMA(0, 1, At, B1); PG8_BAR; PG8_SCHED;
            PG8_LDA(At, 1, 1); PG8_STAGE(PG8_SB(1, 0), b3, voffB); PG8_STAGE(PG8_SB(1, 1), b3 + hstep, voffB); PG8_STAGE(PG8_SA(1, 0), a3, voffA);
            PG8_WAIT_V(8); PG8_WAIT_L(0); PG8_BAR; PG8_MMA(1, 0, At, B0); PG8_MMA(1, 1, At, B1); PG8_BAR; PG8_SCHED;
            } else {
            PG8_LDB(B0, 0, 0); PG8_SCHED; PG8_LDA(At, 0, 0); PG8_STAGE(PG8_SA(1, 1), a1 + hstep, voffA);
            PG8_WAIT_L(8); PG8_BAR; PG8_WAIT_L(0); PG8_MMA(0, 0, At, B0); PG8_BAR; PG8_SCHED;
            PG8_LDB(B1, 0, 1); PG8_STAGE(PG8_SB(0, 0), b2, voffB);
            PG8_BAR; PG8_WAIT_L(0); PG8_MMA(0, 1, At, B1); PG8_BAR;
            PG8_LDA(At, 0, 1); PG8_STAGE(PG8_SA(0, 0), a2, voffA);
            PG8_BAR; PG8_WAIT_L(0); PG8_MMA(1, 0, At, B0); PG8_BAR; PG8_SCHED;
            PG8_STAGE(PG8_SB(0, 1), b2 + hstep, voffB);
            PG8_WAIT_V(6); PG8_BAR; PG8_MMA(1, 1, At, B1); PG8_BAR;
            PG8_LDB(B0, 1, 0); PG8_SCHED; PG8_LDA(At, 1, 0); PG8_STAGE(PG8_SA(0, 1), a2 + hstep, voffA);
            PG8_WAIT_L(8); PG8_BAR; PG8_WAIT_L(0); PG8_MMA(0, 0, At, B0); PG8_BAR; PG8_SCHED;
            PG8_LDB(B1, 1, 1); PG8_STAGE(PG8_SB(1, 0), b3, voffB);
            PG8_BAR; PG8_WAIT_L(0); PG8_MMA(0, 1, At, B1); PG8_BAR;
            PG8_LDA(At, 1, 1); PG8_STAGE(PG8_SA(1, 0), a3, voffA);
            PG8_BAR; PG8_WAIT_L(0); PG8_MMA(1, 0, At, B0); PG8_BAR; PG8_SCHED;
            PG8_STAGE(PG8_SB(1, 1), b3 + hstep, voffB);
            PG8_WAIT_V(6); PG8_BAR; PG8_MMA(1, 1, At, B1); PG8_BAR;
            }
        }
        if constexpr (ALIGN_EPI) { if (wr == 0) PG8_BAR; }
        if constexpr (!Epi::AFTER_DRAIN) { E(acc, cur, wr, wc, fr, fq); S.done(cur); }
        if (!has_next) break;
#pragma unroll
        for (int a = 0; a < 2; ++a)
#pragma unroll
            for (int b = 0; b < 2; ++b)
#pragma unroll
                for (int m = 0; m < 4; ++m)
#pragma unroll
                    for (int n = 0; n < 2; ++n) acc[a][b][m][n] = (f32x4){0.f, 0.f, 0.f, 0.f};
        cur = nxt; cA = nA; cB = nB; ++ui;
        if constexpr (ALIGN_EPI) { if (wr == 1) PG8_BAR; }
    }
    PG8_WAIT_V(0);
    if constexpr (!ALIGN_EPI) { if (wr == 0) PG8_BAR; }
    PG8_BAR;
    if constexpr (Epi::AFTER_DRAIN) { E.fused(acc, cur, wr, wc, fr, fq, lds, wid, lane); S.done(cur); }
#undef PG8_SA
#undef PG8_SB
#undef PG8_STAGE
#undef PG8_LDA
#undef PG8_LDB
#undef PG8_MMA
#undef PG8_WAIT_V
#undef PG8_WAIT_L
#undef PG8_BAR
#undef PG8_SCHED
}
}
namespace att {
constexpr int KP = 144;
constexpr int K_OFF = 0, V_OFF = 384 * KP, B_OFF = 2 * 384 * KP, LDS_BYTES = B_OFF + 132 * 4;
struct Tensors { const bf16* Q; const bf16* K; const bf16* V; bf16* Oa; bf16* Ob; float* st; const float* biasL2; };

struct UnitId { int b, h, p, dsh, r, qblk; };
DI UnitId decode(int u) { UnitId d; const int bh = u / 48, rem = u % 48; d.p = rem >> 4; const int w16 = rem & 15; d.b = bh >> 4; d.h = bh & 15; d.dsh = 2 * d.p; const int nqb = 16 >> d.dsh; d.r = w16 / nqb; d.qblk = w16 % nqb; return d; }

DI void phase(LAS unsigned char* lds, const Tensors& T, int G, int blk, int wv) {
    const int tid_ = wg_tid_local(wv);
    const int tid = tid_, lane = tid & 63, l31 = lane & 31, hi = lane >> 5, w = __builtin_amdgcn_readfirstlane(tid >> 6);
    const int NU = BATCH * AH * 48;
    const int i16 = lane & 15, q4 = i16 >> 2, p4 = i16 & 3, gidx = (lane >> 4) & 1;
    v4u kreg[6], vreg[6]; bf16x8 qf[4]; float breg = 0.f;
    auto fetch = [&](int u) {
        const UnitId d = decode(u);
        const size_t rowb = (size_t)d.b * SEQ;
#pragma unroll
        for (int k = 0; k < 6; ++k) {
            const int id = tid + 512 * k, j = id >> 3, pc = id & 7;
            int pos = 256 * d.qblk - 128 + j; pos = pos < 0 ? 0 : pos;
            const size_t off = (rowb + d.r + ((size_t)pos << d.dsh)) * 1024 + d.h * 64 + pc * 8;
            kreg[k] = *(const v4u*)(T.K + off); vreg[k] = *(const v4u*)(T.V + off);
        }
        const int qpos = 256 * d.qblk + 32 * w + l31;
        const size_t qrow = rowb + d.r + ((size_t)qpos << d.dsh);
#pragma unroll
        for (int d0 = 0; d0 < 4; ++d0) qf[d0] = *(const bf16x8*)(T.Q + qrow * 1024 + d.h * 64 + d0 * 16 + hi * 8);
        if (tid < 132) breg = T.biasL2[(d.p * 16 + d.h) * 132 + tid];
    };
    int u = blk;
    if (u < NU) fetch(u);
#pragma unroll 1
    for (; u < NU; u += G) {
        const UnitId d = decode(u);
        const size_t rowb = (size_t)d.b * SEQ;
        const int qpos = 256 * d.qblk + 32 * w + l31;
        const size_t qrow = rowb + d.r + ((size_t)qpos << d.dsh);
#pragma unroll
        for (int k = 0; k < 6; ++k) {
            const int id = tid + 512 * k, j = id >> 3, pc = id & 7;
            *(LAS v4u*)(lds + K_OFF + j * KP + pc * 16) = kreg[k];
            *(LAS v4u*)(lds + V_OFF + j * KP + pc * 16) = vreg[k];
        }
        if (tid < 132) ((LAS float*)(lds + B_OFF))[tid] = breg;
        bf16x8 qc[4];
#pragma unroll
        for (int d0 = 0; d0 < 4; ++d0) qc[d0] = qf[d0];
        __syncthreads();
        fetch(u + G < NU ? u + G : u);
        f32x16 st[5];
#pragma unroll
        for (int kt = 0; kt < 5; ++kt) {
            f32x16 a = {};
#pragma unroll
            for (int d0 = 0; d0 < 4; ++d0) {
                const bf16x8 kf = *(const LAS bf16x8*)(lds + K_OFF + (32 * w + 32 * kt + l31) * KP + (16 * d0 + 8 * hi) * 2);
                a = MFMA32(kf, qc[d0], a);
            }
            st[kt] = a;
        }
        const LAS float* bl = (const LAS float*)(lds + B_OFF);
        float mx = -1e30f;
#pragma unroll
        for (int kt = 0; kt < 5; ++kt) {
            float bv[16];
#pragma unroll
            for (int rr = 0; rr < 16; ++rr) {
                const int delta = 128 + l31 - 32 * kt - crow(rr, hi);
                bv[rr] = bl[delta < 0 ? 0 : (delta > 128 ? 128 : delta)];
            }
            asm volatile("" : "+v"(bv[0]), "+v"(bv[1]), "+v"(bv[2]), "+v"(bv[3]), "+v"(bv[4]), "+v"(bv[5]), "+v"(bv[6]), "+v"(bv[7]), "+v"(bv[8]), "+v"(bv[9]), "+v"(bv[10]), "+v"(bv[11]), "+v"(bv[12]), "+v"(bv[13]), "+v"(bv[14]), "+v"(bv[15]));
#pragma unroll
            for (int rr = 0; rr < 16; ++rr) {
                const int kl = crow(rr, hi);
                const int delta = 128 + l31 - 32 * kt - kl;
                const int pk = 256 * d.qblk - 128 + 32 * w + 32 * kt + kl;
                const bool valid = (delta >= 0) && (delta <= 128) && (pk >= 0);
                const float s_ = valid ? st[kt][rr] + bv[rr] : -1e30f;
                st[kt][rr] = s_; mx = fmaxf(mx, s_);
            }
        }
        mx = fmaxf(mx, bperm(mx, lane ^ 32));
        float lsum = 0.f;
#pragma unroll
        for (int kt = 0; kt < 5; ++kt)
#pragma unroll
            for (int rr = 0; rr < 16; ++rr) { const float e = __builtin_amdgcn_exp2f(st[kt][rr] - mx); st[kt][rr] = e; lsum += e; }
        lsum += bperm(lsum, lane ^ 32);
        f32x16 o[2]; o[0] = (f32x16){}; o[1] = (f32x16){};
#pragma unroll
        for (int kt = 0; kt < 5; ++kt)
#pragma unroll
            for (int s2 = 0; s2 < 2; ++s2) {
                const bf16x8 pb = pack8(st[kt][8 * s2 + 0], st[kt][8 * s2 + 1], st[kt][8 * s2 + 2], st[kt][8 * s2 + 3], st[kt][8 * s2 + 4], st[kt][8 * s2 + 5], st[kt][8 * s2 + 6], st[kt][8 * s2 + 7]);
                const int jrow = 32 * w + 32 * kt + 16 * s2 + 4 * hi + q4;
#pragma unroll
                for (int dt = 0; dt < 2; ++dt) {
                    const LAS unsigned char* a0 = lds + V_OFF + jrow * KP + (32 * dt + 16 * gidx + 4 * p4) * 2;
                    const bf16x8 va = cat8(tr_read(a0), tr_read(a0 + 8 * KP));
                    o[dt] = MFMA32(va, pb, o[dt]);
                }
            }
        const float inv = 1.0f / lsum;
        bf16* orow = (d.p == 0 ? T.Oa : T.Ob + (size_t)(d.p - 1) * MTOK * AW) + qrow * 1024 + d.h * 64;
#pragma unroll
        for (int dt = 0; dt < 2; ++dt)
#pragma unroll
            for (int g4 = 0; g4 < 4; ++g4) {
                v2u wv_; wv_.x = pk2(o[dt][4 * g4] * inv, o[dt][4 * g4 + 1] * inv); wv_.y = pk2(o[dt][4 * g4 + 2] * inv, o[dt][4 * g4 + 3] * inv);
                *(v2u*)(orow + 32 * dt + 8 * g4 + 4 * hi) = wv_;
            }
        if (hi == 0) { f32x2_t sv = {mx, lsum}; *(f32x2_t*)(T.st + ((size_t)d.p * MTOK + qrow) * 32 + d.h * 2) = sv; }
        __syncthreads();
    }
}
}
namespace mpre {
constexpr int TP = 144;
constexpr int XC_OFF = 0, XM_OFF = 256 * TP, QT_OFF = 2 * 256 * TP, RED_OFF = 3 * 256 * TP, GRED_OFF = RED_OFF + 4 * 4096, LDS_BYTES = GRED_OFF + 4 * 64 * 8 * 4;
struct Tensors { const bf16* xm; const bf16* halo; bf16* kimg; bf16* vimg; bf16* qimg; float* gp; bf16* S; const float* convw; const float* convb; const bf16* WcT; const bf16* WmT; const float* G; };

DI void unit(LAS unsigned char* lds, const Tensors& T, int u, int tid_in) {
    const int tid_ = wg_tid_local(tid_in);
    const int tid = tid_, lane = tid & 63, l31 = lane & 31, hi = lane >> 5, w = __builtin_amdgcn_readfirstlane(tid >> 6);
    const int h = u & 3, c = (u >> 2) & 63, b = u >> 8;
    const int g6 = lane, tp = w;
    const size_t tok0 = (size_t)b * SEQ + 64 * c;
    const int ti = w & 1, si = (w >> 1) & 1, kh = w >> 2;
    f32x16 sacc = {};
    f32x16 gacc = {};
    const int kq = w >> 1;
    const int i16 = lane & 15, q4 = i16 >> 2, p4 = i16 & 3, gidx = (lane >> 4) & 1;
#pragma unroll 1
    for (int hh = 0; hh < 2; ++hh) {
        const int gg = 128 * h + 64 * hh + g6, ch = 4 * gg;
        v2u xr[11];
#pragma unroll
        for (int k = 0; k < 11; ++k) {
            const int tl = 8 * tp - 3 + k;
            if (tl >= 0) xr[k] = *(const v2u*)(T.xm + (tok0 + tl) * 2048 + ch);
            else if (c > 0) xr[k] = *(const v2u*)(T.halo + ((size_t)(b * 64 + c - 1) * 3 + (3 + tl)) * 2048 + ch);
            else xr[k] = (v2u){0u, 0u};
        }
        float xmv[11][4];
#pragma unroll
        for (int k = 0; k < 11; ++k) { xmv[k][0] = bflo(xr[k].x); xmv[k][1] = bfhi(xr[k].x); xmv[k][2] = bflo(xr[k].y); xmv[k][3] = bfhi(xr[k].y); }
        float cw[4][4], cb[4], Gm[4][4];
        {
            const f32x4 b4 = *(const f32x4*)(T.convb + ch); cb[0] = b4[0]; cb[1] = b4[1]; cb[2] = b4[2]; cb[3] = b4[3];
#pragma unroll
            for (int tap = 0; tap < 4; ++tap) { const f32x4 w4 = *(const f32x4*)(T.convw + tap * 2048 + ch); cw[tap][0] = w4[0]; cw[tap][1] = w4[1]; cw[tap][2] = w4[2]; cw[tap][3] = w4[3]; }
#pragma unroll
            for (int i = 0; i < 4; ++i) { const f32x4 g4 = *(const f32x4*)(T.G + gg * 16 + i * 4); Gm[i][0] = g4[0]; Gm[i][1] = g4[1]; Gm[i][2] = g4[2]; Gm[i][3] = g4[3]; }
        }
        __syncthreads();
        unsigned xcp[4][4], xmp[4][4], qtp[4][4];
        float prev_xc[4], prev_q[4];
#pragma unroll
        for (int tl = 0; tl < 8; ++tl) {
            float xc[4], qt[4];
#pragma unroll
            for (int i = 0; i < 4; ++i) {
                float a = cb[i];
#pragma unroll
                for (int tap = 0; tap < 4; ++tap) a += cw[tap][i] * xmv[tl + tap][i];
                xc[i] = siluf_(a);
            }
#pragma unroll
            for (int i2 = 0; i2 < 4; ++i2) qt[i2] = xc[0] * Gm[0][i2] + xc[1] * Gm[1][i2] + xc[2] * Gm[2][i2] + xc[3] * Gm[3][i2];
            if (tl & 1) {
#pragma unroll
                for (int i = 0; i < 4; ++i) { xcp[i][tl >> 1] = pk2(prev_xc[i], xc[i]); qtp[i][tl >> 1] = pk2(prev_q[i], qt[i]); xmp[i][tl >> 1] = pk2(xmv[tl + 2][i], xmv[tl + 3][i]); }
            } else {
#pragma unroll
                for (int i = 0; i < 4; ++i) { prev_xc[i] = xc[i]; prev_q[i] = qt[i]; }
            }
        }
#pragma unroll
        for (int i = 0; i < 4; ++i) {
            const int off = (4 * g6 + i) * TP + 16 * tp;
            *(LAS v4u*)(lds + XC_OFF + off) = (v4u){xcp[i][0], xcp[i][1], xcp[i][2], xcp[i][3]};
            *(LAS v4u*)(lds + XM_OFF + off) = (v4u){xmp[i][0], xmp[i][1], xmp[i][2], xmp[i][3]};
            *(LAS v4u*)(lds + QT_OFF + off) = (v4u){qtp[i][0], qtp[i][1], qtp[i][2], qtp[i][3]};
        }
        __syncthreads();
        {
            const size_t ibase = ((size_t)((b * 4 + h) * 64 + c) * 64 + 32 * hh) * 1024;
#pragma unroll
            for (int k = 0; k < 4; ++k) {
                const int id = tid + 512 * k, f = id >> 6, L = id & 63;
                const int row = 32 * (f >> 2) + (L & 31), colb = (16 * (f & 3) + 4 * (L >> 5)) * 2;
                const v2u k0 = *(const LAS v2u*)(lds + XC_OFF + row * TP + colb), k1 = *(const LAS v2u*)(lds + XC_OFF + row * TP + colb + 16);
                const v2u v0 = *(const LAS v2u*)(lds + XM_OFF + row * TP + colb), v1 = *(const LAS v2u*)(lds + XM_OFF + row * TP + colb + 16);
                *(v4u*)((char*)T.kimg + ibase + (size_t)id * 16) = (v4u){k0.x, k0.y, k1.x, k1.y};
                *(v4u*)((char*)T.vimg + ibase + (size_t)id * 16) = (v4u){v0.x, v0.y, v1.x, v1.y};
            }
#pragma unroll
            for (int k = 0; k < 4; ++k) {
                const int f = 4 * w + k, tt = f & 1, cb0 = 16 * (f >> 1) + 4 * hi + q4;
                const LAS unsigned char* pq = lds + QT_OFF + cb0 * TP + (32 * tt + 16 * gidx + 4 * p4) * 2;
                const s16x4 lo = tr_read(pq), hi4 = tr_read(pq + 8 * TP);
                *(bf16x8*)((char*)T.qimg + ibase + (size_t)f * 1024 + lane * 16) = cat8(lo, hi4);
            }
        }
#pragma unroll
        for (int ks = 0; ks < 8; ++ks) {
            const int crow0 = 128 * kh + 16 * ks + 8 * hi + q4;
            const LAS unsigned char* pa = lds + XC_OFF + crow0 * TP + (32 * si + 16 * gidx + 4 * p4) * 2;
            const LAS unsigned char* pb = lds + QT_OFF + crow0 * TP + (32 * ti + 16 * gidx + 4 * p4) * 2;
            const bf16x8 af = cat8(tr_read(pa), tr_read(pa + 4 * TP));
            const bf16x8 bfr = cat8(tr_read(pb), tr_read(pb + 4 * TP));
            sacc = MFMA32(af, bfr, sacc);
        }
#pragma unroll
        for (int ks = 0; ks < 4; ++ks) {
            const int crow1 = 64 * kq + 16 * ks + 8 * hi + q4;
            const LAS unsigned char* pc_ = lds + XC_OFF + crow1 * TP + (32 * ti + 16 * gidx + 4 * p4) * 2;
            const LAS unsigned char* pm_ = lds + XM_OFF + crow1 * TP + (32 * ti + 16 * gidx + 4 * p4) * 2;
            const bf16x8 ac = cat8(tr_read(pc_), tr_read(pc_ + 4 * TP));
            const bf16x8 am = cat8(tr_read(pm_), tr_read(pm_ + 4 * TP));
            const int c0 = 512 * h + 256 * hh + 64 * kq + 16 * ks + 8 * hi;
            const bf16x8 bc = *(const bf16x8*)(T.WcT + (l31 & 7) * 2048 + c0);
            const bf16x8 bm = *(const bf16x8*)(T.WmT + (l31 & 7) * 2048 + c0);
            gacc = MFMA32(ac, bc, gacc);
            gacc = MFMA32(am, bm, gacc);
        }
    }
    if (l31 < 8) {
#pragma unroll
        for (int r = 0; r < 16; ++r) ((LAS float*)(lds + GRED_OFF))[(kq * 64 + 32 * ti + crow(r, hi)) * 8 + l31] = gacc[r];
    }
    __syncthreads();
    if (kh == 1) {
#pragma unroll
        for (int g4 = 0; g4 < 4; ++g4) *(LAS f32x4*)(lds + RED_OFF + ((w & 3) * 4 + g4) * 1024 + lane * 16) = (f32x4){sacc[4 * g4], sacc[4 * g4 + 1], sacc[4 * g4 + 2], sacc[4 * g4 + 3]};
    }
    __syncthreads();
    { const LAS float* gr = (const LAS float*)(lds + GRED_OFF);
      T.gp[((size_t)h * 8 + (tid & 7)) * MTOK + tok0 + (tid >> 3)] = gr[tid] + gr[512 + tid] + gr[1024 + tid] + gr[1536 + tid]; }
    if (kh == 0) {
        float tot[16];
#pragma unroll
        for (int g4 = 0; g4 < 4; ++g4) {
            const f32x4 o = *(const LAS f32x4*)(lds + RED_OFF + ((w & 3) * 4 + g4) * 1024 + lane * 16);
            tot[4 * g4] = sacc[4 * g4] + o[0]; tot[4 * g4 + 1] = sacc[4 * g4 + 1] + o[1]; tot[4 * g4 + 2] = sacc[4 * g4 + 2] + o[2]; tot[4 * g4 + 3] = sacc[4 * g4 + 3] + o[3];
        }
        char* sp = (char*)T.S + (size_t)((b * 4 + h) * 64 + c) * 8192;
#pragma unroll
        for (int kk = 0; kk < 2; ++kk)
            *(bf16x8*)(sp + ((2 * si + kk) * 2 + ti) * 1024 + lane * 16) = pack8(tot[8 * kk], tot[8 * kk + 1], tot[8 * kk + 2], tot[8 * kk + 3], tot[8 * kk + 4], tot[8 * kk + 5], tot[8 * kk + 6], tot[8 * kk + 7]);
    }
    __syncthreads();
}
DI void phase(LAS unsigned char* lds, const Tensors& T, int G, int blk, int wv) {
    for (int u = blk; u < BATCH * NCHUNK * MH; u += G) unit(lds, T, u, wv);
}
}
namespace mscan {
constexpr int P_OFF = 0;
constexpr int V_OFF = 131072;
constexpr int DEN_OFF = V_OFF + 16384;
constexpr int NS_OFF = DEN_OFF + 4096;
constexpr int NSB_OFF = NS_OFF + 2048;
constexpr int TMP_OFF = NSB_OFF + 1024, SCW_OFF = TMP_OFF + 128, LDS_BYTES = SCW_OFF + 8 * 896;
static_assert(LDS_BYTES <= 163840 - 16, "scan LDS");
struct Tensors { const bf16* q; const bf16* k; const bf16* v; const bf16* S; const float* gp; const float* bif; float* scal; bf16* hm; };

DI float logsigmoid_(float x) { return fminf(x, 0.f) - log1pf(__expf(-fabsf(x))); }
DI void unpack8(bf16x8 f, float (&o)[8]) {
    const v4u u = __builtin_bit_cast(v4u, f);
    o[0] = bflo(u.x); o[1] = bfhi(u.x); o[2] = bflo(u.y); o[3] = bfhi(u.y); o[4] = bflo(u.z); o[5] = bfhi(u.z); o[6] = bflo(u.w); o[7] = bfhi(u.w);
}

template <int VAR> DI void unit(LAS unsigned char* lds, const Tensors& T, int bh, int es, int tid_in) {
    const int tid_ = wg_tid_local(tid_in);
    const int tid = tid_, lane = tid & 63, l31 = lane & 31, hi = lane >> 5, wid = __builtin_amdgcn_readfirstlane(tid >> 6);
    const int b = bh >> 2, h = bh & 3;
    LAS float* sTmp = (LAS float*)(lds + TMP_OFF);
    float* scal = T.scal + (size_t)bh * 3 * SEQ;
    {
        float li[8], cs[8];
        const float bi = T.bif[h], bf_ = T.bif[4 + h];
        float run = 0.f;
        const float* gpb = T.gp + (size_t)b * SEQ;
        const unsigned toff = (unsigned)tid * 8u;
#pragma unroll
        for (int k = 0; k < 8; ++k) { li[k] = bi; cs[k] = bf_; }
#pragma unroll
        for (int hh = 0; hh < 4; ++hh) {
            const float* pi = gpb + ((size_t)hh * 8 + h) * MTOK; const float* pf_ = gpb + ((size_t)hh * 8 + 4 + h) * MTOK;
            const f32x4 i0 = *(const f32x4*)(pi + toff), i1 = *(const f32x4*)(pi + toff + 4), f0 = *(const f32x4*)(pf_ + toff), f1 = *(const f32x4*)(pf_ + toff + 4);
#pragma unroll
            for (int k = 0; k < 4; ++k) { li[k] += i0[k]; li[4 + k] += i1[k]; cs[k] += f0[k]; cs[4 + k] += f1[k]; }
        }
#pragma unroll
        for (int k = 0; k < 8; ++k) { run += logsigmoid_(cs[k]); cs[k] = run; }
        float inc = run;
#pragma unroll
        for (int o = 1; o < 64; o <<= 1) { const float t = bperm(inc, lane >= o ? lane - o : lane); if (lane >= o) inc += t; }
        if (lane == 63) sTmp[wid] = inc;
        __syncthreads();
        float base = inc - run;
        for (int w2 = 0; w2 < wid; ++w2) base += sTmp[w2];
        __syncthreads();
        float av[8], mloc = -3.0e38f, cm[8];
#pragma unroll
        for (int k = 0; k < 8; ++k) { cs[k] += base; av[k] = li[k] - cs[k]; mloc = fmaxf(mloc, av[k]); cm[k] = mloc; }
        float minc = mloc;
#pragma unroll
        for (int o = 1; o < 64; o <<= 1) { const float t = bperm(minc, lane >= o ? lane - o : lane); if (lane >= o) minc = fmaxf(minc, t); }
        if (lane == 63) sTmp[wid] = minc;
        __syncthreads();
        float mbase = bperm(minc, lane > 0 ? lane - 1 : 0); if (lane == 0) mbase = -3.0e38f;
        for (int w2 = 0; w2 < wid; ++w2) mbase = fmaxf(mbase, sTmp[w2]);
#pragma unroll
        for (int k = 0; k < 8; ++k) {
            const float Mt = fmaxf(mbase, cm[k]);
            scal[0 * SEQ + 8 * tid + k] = av[k]; scal[1 * SEQ + 8 * tid + k] = Mt; scal[2 * SEQ + 8 * tid + k] = __expf(-(cs[k] + Mt));
        }
        ((LAS float*)(lds + NS_OFF))[tid] = 0.f; ((LAS unsigned short*)(lds + NSB_OFF))[tid] = 0;
        __threadfence();
        __syncthreads();
    }
#define MFMAV(a_, b_, c_) (VAR == 3 ? (c_) : MFMA32((a_), (b_), (c_)))
    f32x16 cst[2][2];
#pragma unroll
    for (int id = 0; id < 2; ++id)
#pragma unroll
        for (int ie = 0; ie < 2; ++ie) cst[id][ie] = (f32x16){};
    const char* qb = (const char*)T.q + (size_t)bh * NCHUNK * 65536 + (size_t)wid * 8192;
    const char* kb = (const char*)T.k + (size_t)bh * NCHUNK * 65536 + (size_t)wid * 8192;
    const char* vb = (const char*)T.v + (size_t)bh * NCHUNK * 65536 + (size_t)es * 8192 + (size_t)wid * 1024;
    const char* sb = (const char*)T.S + (size_t)bh * NCHUNK * 8192 + (size_t)(wid & 3) * 2048;
    const unsigned loff = (unsigned)lane * 16u;
    const float* sa = scal; const float* sm = scal + SEQ; const float* sthr = scal + 2 * SEQ;
    bf16* hg = T.hm + (size_t)b * SEQ * 2048 + 512 * h + 64 * es;
    int zv = 0; asm volatile("" : "+v"(zv));
    float Mc = sm[zv];
    LAS float* sca = (LAS float*)(lds + SCW_OFF) + wid * 224;
    LAS float* nsw = (LAS float*)(lds + NS_OFF) + 64 * wid; LAS unsigned short* nsb = (LAS unsigned short*)(lds + NSB_OFF) + 64 * wid;
    bf16x8 fb[16]; bf16x8 sf[2]; bf16x8 vnext;
    float a_l, m_l, thr_l;
#pragma unroll
    for (int g = 0; g < 8; ++g) fb[g] = *(const bf16x8*)(qb + g * 1024 + loff);
#pragma unroll
    for (int g = 0; g < 8; ++g) fb[8 + g] = *(const bf16x8*)(kb + ((g & 1) * 4 + (g >> 1)) * 1024 + loff);
    sf[0] = *(const bf16x8*)(sb + loff); sf[1] = *(const bf16x8*)(sb + 1024 + loff);
    vnext = *(const bf16x8*)(vb + loff);
    a_l = sa[lane]; m_l = sm[lane]; thr_l = sthr[lane];
    const int ksw = wid & 3, iew = wid >> 2;
#define STAGE_VW(dst_) do { const float mend_ = bperm(m_l, 63 + zv); sca[160 + lane] = __expf(a_l - mend_); \
        const f32x4 w0_ = *(const LAS f32x4*)(sca + 160 + 16 * ksw + 4 * hi), w1_ = *(const LAS f32x4*)(sca + 160 + 16 * ksw + 8 + 4 * hi); \
        float vv_[8]; unpack8(vnext, vv_); \
        *(LAS bf16x8*)((dst_) + wid * 1024 + lane * 16) = pack8(vv_[0] * w0_[0], vv_[1] * w0_[1], vv_[2] * w0_[2], vv_[3] * w0_[3], vv_[4] * w1_[0], vv_[5] * w1_[1], vv_[6] * w1_[2], vv_[7] * w1_[3]); } while (0)
    STAGE_VW(lds + V_OFF);
    bf16x8 vown = vnext;
    asm volatile("" :: "v"(a_l), "v"(m_l), "v"(thr_l), "v"(sf[0]), "v"(sf[1]));
#pragma unroll
    for (int g = 0; g < 16; ++g) asm volatile("" :: "v"(fb[g]));
    __syncthreads();
#pragma unroll 1
    for (int c = 0; c < NCHUNK; ++c) {
        const int cur = c & 1;
        LAS float* denp = (LAS float*)(lds + DEN_OFF) + cur * 512;
        LAS unsigned char* pbuf = lds + P_OFF + cur * 65536;
        const LAS unsigned char* vcur = lds + V_OFF + cur * 8192; LAS unsigned char* vnxt = lds + V_OFF + (cur ^ 1) * 8192;
        const int cn = (c + 1 < NCHUNK) ? c + 1 : c;
        const char* qn_ = qb + (size_t)cn * 65536; const char* kn_ = kb + (size_t)cn * 65536; const char* sn_ = sb + (size_t)cn * 8192;
        vnext = *(const bf16x8*)(vb + (size_t)cn * 65536 + loff);
        const float Mc2 = bperm(m_l, 63 + zv);
        const float Mt0 = bperm(m_l, l31), Mt1 = bperm(m_l, 32 + l31);
        const float thr0 = bperm(thr_l, l31), thr1 = bperm(thr_l, 32 + l31);
        { const float cwl = __expf(a_l - Mc2); sca[lane] = a_l; sca[64 + lane] = cwl; ((LAS unsigned short*)(sca + 128))[lane] = (unsigned short)(pk2(cwl, 0.f) & 0xffffu); }
        a_l = sa[64 * cn + lane]; m_l = sm[64 * cn + lane]; thr_l = sthr[64 * cn + lane];
        bf16x8 pf[2]; float psum[2];
        {
            const f32x4 aown0 = *(const LAS f32x4*)(sca + 16 * ksw + 4 * hi), aown1 = *(const LAS f32x4*)(sca + 16 * ksw + 8 + 4 * hi);
            const float aw[8] = {aown0[0], aown0[1], aown0[2], aown0[3], aown1[0], aown1[1], aown1[2], aown1[3]};
#pragma unroll
            for (int tt = 0; tt < 2; ++tt) {
                const int t = 32 * tt + l31; const float Mt = tt ? Mt1 : Mt0;
                float sv[8]; unpack8(sf[tt], sv);
                float pw[8]; float ps = 0.f;
#pragma unroll
                for (int j = 0; j < 8; ++j) { const int s = 16 * ksw + 8 * (j >> 2) + 4 * hi + (j & 3); pw[j] = (s <= t) ? sv[j] * __expf(aw[j] - Mt) : 0.f; ps += pw[j]; }
                pf[tt] = pack8(pw[0], pw[1], pw[2], pw[3], pw[4], pw[5], pw[6], pw[7]);
                psum[tt] = ps;
            }
            sf[0] = *(const bf16x8*)(sn_ + loff); sf[1] = *(const bf16x8*)(sn_ + 1024 + loff);
        }
        const float rs0 = __expf(Mc - Mt0), rs1 = __expf(Mc - Mt1);
#pragma unroll
        for (int ie = 0; ie < 2; ++ie) {
            f32x16 ao[2]; ao[0] = (f32x16){}; ao[1] = (f32x16){};
            float qn[2] = {0.f, 0.f};
#pragma unroll
            for (int id = 0; id < 2; ++id)
#pragma unroll
                for (int s = 0; s < 2; ++s) {
                    const int g0 = (id * 2 + s) * 2;
                    const bf16x8 cb = pack8(cst[id][ie][8 * s + 0], cst[id][ie][8 * s + 1], cst[id][ie][8 * s + 2], cst[id][ie][8 * s + 3], cst[id][ie][8 * s + 4], cst[id][ie][8 * s + 5], cst[id][ie][8 * s + 6], cst[id][ie][8 * s + 7]);
                    ao[0] = MFMAV(cb, fb[g0], ao[0]);
                    ao[1] = MFMAV(cb, fb[g0 + 1], ao[1]);
                    if (ie == 0) {
                        const v2u n0 = *(const LAS v2u*)(nsb + 32 * id + 16 * s + 4 * hi), n1 = *(const LAS v2u*)(nsb + 32 * id + 16 * s + 8 + 4 * hi);
#pragma unroll
                        for (int tt = 0; tt < 2; ++tt) {
                            const v4u qv = __builtin_bit_cast(v4u, fb[g0 + tt]);
                            float q_ = qn[tt];
                            q_ = dot2bf(qv.x, n0.x, q_); q_ = dot2bf(qv.y, n0.y, q_); q_ = dot2bf(qv.z, n1.x, q_); q_ = dot2bf(qv.w, n1.y, q_);
                            asm volatile("" : "+v"(q_));
                            qn[tt] = q_;
                        }
                    } else {
                        __builtin_amdgcn_sched_barrier(0);
                        if (VAR != 2) { fb[g0] = *(const bf16x8*)(qn_ + g0 * 1024 + loff);
                        fb[g0 + 1] = *(const bf16x8*)(qn_ + (g0 + 1) * 1024 + loff); }
                    }
                    __builtin_amdgcn_sched_barrier(0);
                }
            if (ie == 0) {
                float d0 = rs0 * qn[0] + (wid < 4 ? psum[0] : 0.f), d1 = rs1 * qn[1] + (wid < 4 ? psum[1] : 0.f);
                d0 += bperm(d0, lane ^ 32); d1 += bperm(d1, lane ^ 32);
                if (hi == 0) { denp[wid * 64 + l31] = d0; denp[wid * 64 + 32 + l31] = d1; }
            }
#pragma unroll
            for (int r = 0; r < 16; ++r) { ao[0][r] *= rs0; ao[1][r] *= rs1; }
            if (ie == iew) {
                ao[0] = MFMAV(vown, pf[0], ao[0]); ao[1] = MFMAV(vown, pf[1], ao[1]);
            }
#pragma unroll
            for (int tt = 0; tt < 2; ++tt)
#pragma unroll
                for (int g4 = 0; g4 < 4; ++g4) {
                    v2u pw_; pw_.x = pk2(ao[tt][4 * g4], ao[tt][4 * g4 + 1]); pw_.y = pk2(ao[tt][4 * g4 + 2], ao[tt][4 * g4 + 3]);
                    *(LAS v2u*)(pbuf + ((((wid * 2 + ie) * 2 + tt) * 4 + g4) * 512) + lane * 8) = pw_;
                }
        }
        const float decay = __expf(Mc - Mc2);
#pragma unroll
        for (int id = 0; id < 2; ++id)
#pragma unroll
            for (int ie = 0; ie < 2; ++ie)
#pragma unroll
                for (int r = 0; r < 16; ++r) cst[id][ie][r] *= decay;
        float nacc[2] = {0.f, 0.f};
#pragma unroll
        for (int ks = 0; ks < 4; ++ks) {
            const v2u cwb0 = *(const LAS v2u*)((const LAS unsigned short*)(sca + 128) + 16 * ks + 4 * hi), cwb1 = *(const LAS v2u*)((const LAS unsigned short*)(sca + 128) + 16 * ks + 8 + 4 * hi);
            bf16x8 vw[2];
            vw[0] = *(const LAS bf16x8*)(vcur + (0 * 4 + ks) * 1024 + lane * 16); vw[1] = *(const LAS bf16x8*)(vcur + (1 * 4 + ks) * 1024 + lane * 16);
#pragma unroll
            for (int id = 0; id < 2; ++id) {
                const int g = 8 + ks * 2 + id;
                cst[id][0] = MFMAV(fb[g], vw[0], cst[id][0]);
                cst[id][1] = MFMAV(fb[g], vw[1], cst[id][1]);
                {
                    const v4u kv = __builtin_bit_cast(v4u, fb[g]);
                    float na = nacc[id];
                    na = dot2bf(kv.x, cwb0.x, na); na = dot2bf(kv.y, cwb0.y, na); na = dot2bf(kv.z, cwb1.x, na); na = dot2bf(kv.w, cwb1.y, na);
                    asm volatile("" : "+v"(na));
                    nacc[id] = na;
                }
                __builtin_amdgcn_sched_barrier(0);
                if (VAR != 2) fb[g] = *(const bf16x8*)(kn_ + (id * 4 + ks) * 1024 + loff);
            }
            __builtin_amdgcn_sched_barrier(0);
        }
#pragma unroll
        for (int id = 0; id < 2; ++id) {
            float v = nacc[id]; v += bperm(v, lane ^ 32);
            if (hi == 0) { const float nv = decay * nsw[32 * id + l31] + v; nsw[32 * id + l31] = nv; nsb[32 * id + l31] = (unsigned short)(pk2(nv, 0.f) & 0xffffu); }
        }
        STAGE_VW(vnxt);
        vown = vnext;
        if (VAR != 4) __syncthreads();
#pragma unroll
        for (int tt = 0; tt < 2; ++tt) {
            float nm[4] = {0.f, 0.f, 0.f, 0.f};
#pragma unroll
            for (int src = 0; src < 8; ++src) {
                const v2u pv = *(const LAS v2u*)(pbuf + ((((src * 2 + iew) * 2 + tt) * 4 + ksw) * 512) + lane * 8);
                nm[0] += bflo(pv.x); nm[1] += bfhi(pv.x); nm[2] += bflo(pv.y); nm[3] += bfhi(pv.y);
            }
            const int t = 32 * tt + l31;
            float den = 0.f;
#pragma unroll
            for (int src = 0; src < 8; ++src) den += denp[src * 64 + t];
            const float dn = fmaxf(fabsf(den), tt ? thr1 : thr0);
            const float inv = 1.0f / dn;
            v2u wv; wv.x = pk2(nm[0] * inv, nm[1] * inv); wv.y = pk2(nm[2] * inv, nm[3] * inv);
            if (VAR == 0 || (VAR != 0 && wv.x == 0x12345678u && wv.y == 0x9abcdef0u)) *(v2u*)(hg + (size_t)(64 * c + t) * 2048 + 32 * iew + 8 * ksw + 4 * hi) = wv;
        }
        Mc = Mc2;
    }
    __syncthreads();
}
#undef MFMAV
#undef STAGE_VW
template <int VAR> DI void phase(LAS unsigned char* lds, const Tensors& T, int G, int blk, int wv) {
#pragma unroll 1
    for (int u = blk; u < 256; u += G) {
        const int xcd = u & 7, j = u >> 3;
        unit<VAR>(lds, T, xcd * 4 + (j >> 3), j & 7, wv);
    }
}
}
namespace mpost {
constexpr int GSTR = 576;
constexpr int XC_OFF = 0, WV_OFF = 128 * GSTR, LDS_BYTES = WV_OFF + 128 * 64;
struct Tensors { bf16* hm; const bf16* om; const bf16* kimg; const float* wv; const float* hng; const float* skip; };

DI void unit(LAS unsigned char* lds, const Tensors& T, int u, int tid_in) {
    const int tid_ = wg_tid_local(tid_in);
    const int tid = tid_;
    const int h = u & 3, c = (u >> 2) & 63, b = u >> 8;
#pragma unroll
    for (int k = 0; k < 2; ++k) {
        const int id = tid + 512 * k, pb = id & 7, g = id >> 3, ks = pb >> 1, hi_ = pb & 1;
        const char* src = (const char*)T.kimg + ((size_t)((b * 4 + h) * 64 + c) * 64 + (g >> 3) * 4 + ks) * 1024 + (4 * (g & 7) + 32 * hi_) * 16;
        const v4u r0 = *(const v4u*)(src), r1 = *(const v4u*)(src + 16), r2 = *(const v4u*)(src + 32), r3 = *(const v4u*)(src + 48);
        const unsigned a0[4] = {r0.x, r0.y, r0.z, r0.w}, a1[4] = {r1.x, r1.y, r1.z, r1.w}, a2[4] = {r2.x, r2.y, r2.z, r2.w}, a3[4] = {r3.x, r3.y, r3.z, r3.w};
#pragma unroll
        for (int m = 0; m < 4; ++m) {
            const int tok = 16 * ks + 8 * (m >> 1) + 4 * hi_ + 2 * (m & 1);
            v2u e0, e1;
            e0.x = (a0[m] & 0xffffu) | (a1[m] << 16); e0.y = (a2[m] & 0xffffu) | (a3[m] << 16);
            e1.x = (a0[m] >> 16) | (a1[m] & 0xffff0000u); e1.y = (a2[m] >> 16) | (a3[m] & 0xffff0000u);
            *(LAS v2u*)(lds + XC_OFF + g * GSTR + tok * 8) = e0;
            *(LAS v2u*)(lds + XC_OFF + g * GSTR + (tok + 1) * 8) = e1;
        }
    }
    *(LAS f32x4*)(lds + WV_OFF + tid * 16) = *(const f32x4*)(T.wv + (size_t)(128 * h) * 16 + tid * 4);
    __syncthreads();
    const int t5 = tid >> 4, seg = tid & 15;
#pragma unroll 1
    for (int pass = 0; pass < 2; ++pass) {
        const int t = t5 + 32 * pass;
        const size_t rowu = ((size_t)b * SEQ + 64 * c + 32 * pass) * 2048 + 512 * h;
        char* hmb = (char*)(T.hm + rowu); const char* omb = (const char*)(T.om + rowu);
        const char* gnb = (const char*)(T.hng + 512 * h); const char* skb = (const char*)(T.skip + 512 * h);
        const unsigned voff = (unsigned)(t5 * 4096 + seg * 8), soff = (unsigned)(seg * 16);
        float uv[32];
        float sum = 0.f;
#pragma unroll
        for (int k = 0; k < 8; ++k) {
            const int gi = seg + 16 * k;
            const v2u hx = *(const v2u*)(hmb + voff + k * 128);
            const v2u og = *(const v2u*)(omb + voff + k * 128);
            const float hv[4] = {bflo(hx.x), bfhi(hx.x), bflo(hx.y), bfhi(hx.y)};
            const float ov[4] = {bflo(og.x), bfhi(og.x), bflo(og.y), bfhi(og.y)};
            const LAS f32x4* wp = (const LAS f32x4*)(lds + WV_OFF + gi * 64);
            const f32x4 w0 = wp[0], w1 = wp[1], w2 = wp[2], w3 = wp[3];
#pragma unroll
            for (int o = 0; o < 4; ++o) {
                const float v = hv[0] * w0[o] + hv[1] * w1[o] + hv[2] * w2[o] + hv[3] * w3[o];
                const float x = v * ov[o];
                uv[4 * k + o] = x; sum += x;
            }
            if (k & 1) __builtin_amdgcn_sched_barrier(0);
        }
        sum += __shfl_xor(sum, 1); sum += __shfl_xor(sum, 2); sum += __shfl_xor(sum, 4); sum += __shfl_xor(sum, 8);
        const float mean = sum * (1.0f / 512.0f);
        float sq = 0.f;
#pragma unroll
        for (int i = 0; i < 32; ++i) { const float d = uv[i] - mean; sq += d * d; }
        sq += __shfl_xor(sq, 1); sq += __shfl_xor(sq, 2); sq += __shfl_xor(sq, 4); sq += __shfl_xor(sq, 8);
        const float rstd = 1.0f / sqrtf(sq * (1.0f / 512.0f) + EPS);
#pragma unroll
        for (int k = 0; k < 8; ++k) {
            const int gi = seg + 16 * k;
            const f32x4 gn = *(const f32x4*)(gnb + soff + k * 256), sk = *(const f32x4*)(skb + soff + k * 256);
            const v2u xc = *(const LAS v2u*)(lds + XC_OFF + gi * GSTR + t * 8);
            const float xv[4] = {bflo(xc.x), bfhi(xc.x), bflo(xc.y), bfhi(xc.y)};
            float r[4];
#pragma unroll
            for (int o = 0; o < 4; ++o) r[o] = (uv[4 * k + o] - mean) * rstd * gn[o] + sk[o] * xv[o];
            v2u wv; wv.x = pk2(r[0], r[1]); wv.y = pk2(r[2], r[3]);
            *(v2u*)(hmb + voff + k * 128) = wv;
        }
    }
    __syncthreads();
}
DI void phase(LAS unsigned char* lds, const Tensors& T, int G, int blk, int wv) {
    for (int u = blk; u < BATCH * NCHUNK * MH; u += G) unit(lds, T, u, wv);
}
}

DI void transpose_item(const float* W, int K, int N, bf16* WT, const float* kscale, LAS float* scr, int item, int lane) {
    const int nblk = N / 32, kb = item / nblk, nb = item % nblk, k0 = 64 * kb, n0 = 32 * nb;
#pragma unroll 8
    for (int i = 0; i < 32; ++i) { const int kk = 2 * i + (lane >> 5); float v = W[(size_t)(k0 + kk) * N + n0 + (lane & 31)]; if (kscale) v *= kscale[k0 + kk]; scr[kk * 33 + (lane & 31)] = v; }
    asm volatile("s_waitcnt lgkmcnt(0)" ::: "memory");
    const int cc = lane & 7;
#pragma unroll
    for (int j = 0; j < 4; ++j) { const int n = (lane >> 3) + 8 * j; const LAS float* s = scr + (8 * cc) * 33 + n;
        v4u o; o.x = pk2(s[0 * 33], s[1 * 33]); o.y = pk2(s[2 * 33], s[3 * 33]); o.z = pk2(s[4 * 33], s[5 * 33]); o.w = pk2(s[6 * 33], s[7 * 33]);
        *(v4u*)(WT + (size_t)(n0 + n) * K + k0 + 8 * cc) = o; }
    asm volatile("s_waitcnt lgkmcnt(0)" ::: "memory");
}
DI void rms_row_to_bf16(const float* xrow, bf16* orow, int lane) {
    const f32x4* xr = (const f32x4*)xrow + lane;
    f32x4 v[4]; float s = 0.f;
#pragma unroll
    for (int j = 0; j < 4; ++j) { v[j] = xr[64 * j]; s += (v[j][0] * v[j][0] + v[j][1] * v[j][1]) + (v[j][2] * v[j][2] + v[j][3] * v[j][3]); }
    const float r = 1.0f / sqrtf(wave_sum(s) * (1.0f / 1024.0f) + EPS);
    v2u* o8 = (v2u*)orow + lane;
#pragma unroll
    for (int j = 0; j < 4; ++j) { v2u w; w.x = pk2(v[j][0] * r, v[j][1] * r); w.y = pk2(v[j][2] * r, v[j][3] * r); o8[64 * j] = w; }
}
DI void rms_row_inplace(float* row, const float* g, int lane) {
    f32x4* xr = (f32x4*)row + lane; const f32x4* gr = (const f32x4*)g + lane;
    f32x4 v[4]; float s = 0.f;
#pragma unroll
    for (int j = 0; j < 4; ++j) { v[j] = xr[64 * j]; s += (v[j][0] * v[j][0] + v[j][1] * v[j][1]) + (v[j][2] * v[j][2] + v[j][3] * v[j][3]); }
    const float r = 1.0f / sqrtf(wave_sum(s) * (1.0f / 1024.0f) + EPS);
#pragma unroll
    for (int j = 0; j < 4; ++j) xr[64 * j] = v[j] * r * gr[64 * j];
}
constexpr int N_PHASES = 15;
constexpr int LDS_TOTAL = 163840, XB_LDS_OFF = 163840 - 16;
static_assert(pg8::STAGE_BYTES <= XB_LDS_OFF && att::LDS_BYTES <= XB_LDS_OFF && mpre::LDS_BYTES <= XB_LDS_OFF && mscan::LDS_BYTES <= XB_LDS_OFF && mpost::LDS_BYTES <= XB_LDS_OFF, "LDS map vs barrier words");
static_assert(pg8::STAGE_BYTES <= LDS_TOTAL && att::LDS_BYTES <= LDS_TOTAL && mpre::LDS_BYTES <= LDS_TOTAL && mscan::LDS_BYTES <= LDS_TOTAL && mpost::LDS_BYTES <= LDS_TOTAL, "LDS map");

struct Args { const float* in[18]; float* out; unsigned char* ws; int ph_lo, ph_hi; };

DI void prologue(const Args& a, LAS unsigned char* lds, int G, int blk, int wvi) {
    const int tid = wg_tid_local(wvi), lane = tid & 63, wave = __builtin_amdgcn_readfirstlane(tid >> 6);
    unsigned char* ws = a.ws;
    LAS float* scr = (LAS float*)(lds + wave * 16384);
    const int gw = blk * NWAVES + wave, NGW = G * NWAVES;
    constexpr int I_IN = (DM / 64) * (NIN / 32), I_PA = (AW / 64) * (DM / 32), I_PB = (MW / 64) * (DM / 32), I_OUT = (DM / 64) * (DM / 32);
    constexpr int NITEMS = I_IN + I_PA + I_PB + I_OUT;
    for (int it = gw; it < NITEMS; it += NGW) {
        int r = it;
        if (r < I_IN) { transpose_item(a.in[2], DM, NIN, (bf16*)(ws + WS_WIN), a.in[1], scr, r, lane); continue; } r -= I_IN;
        if (r < I_PA) { transpose_item(a.in[13], AW, DM, (bf16*)(ws + WS_WPA), nullptr, scr, r, lane); continue; } r -= I_PA;
        if (r < I_PB) { transpose_item(a.in[14], MW, DM, (bf16*)(ws + WS_WPB), nullptr, scr, r, lane); continue; } r -= I_PB;
        transpose_item(a.in[15], DM, DM, (bf16*)(ws + WS_WOUT), nullptr, scr, r, lane);
    }
    for (int m = gw; m < MTOK; m += NGW) rms_row_to_bf16(a.in[0] + (size_t)m * DM, (bf16*)(ws + WS_XN) + (size_t)m * DM, lane);
    float* tab = (float*)(ws + WS_TAB);
    const float* wq = a.in[6]; const float* wk = a.in[7]; const float* wv = a.in[8]; const float* wif = a.in[9]; const float* rb = a.in[16];
    const int gt = blk * NTHR + tid, NGT = G * NTHR;
    for (int i = gt; i < 2048 * 8; i += NGT) {
        const int c = i >> 3, j = i & 7, g = c >> 2, ii = c & 3;
        float sc = 0.f, sm = 0.f;
#pragma unroll
        for (int o = 0; o < 4; ++o) {
            sc += wq[g * 16 + ii * 4 + o] * wif[(size_t)(4 * g + o) * 8 + j] + wk[g * 16 + ii * 4 + o] * wif[(size_t)(2048 + 4 * g + o) * 8 + j];
            sm += wv[g * 16 + ii * 4 + o] * wif[(size_t)(4096 + 4 * g + o) * 8 + j];
        }
        ((bf16*)(tab + TAB_WC))[j * 2048 + c] = (bf16)(pk2(sc, 0.f) & 0xffffu); ((bf16*)(tab + TAB_WM))[j * 2048 + c] = (bf16)(pk2(sm, 0.f) & 0xffffu);
    }
    for (int i = gt; i < 512 * 16; i += NGT) {
        const int g = i >> 4, ii = (i >> 2) & 3, i2 = i & 3;
        float s = 0.f;
#pragma unroll
        for (int o = 0; o < 4; ++o) s += wq[g * 16 + ii * 4 + o] * wk[g * 16 + i2 * 4 + o];
        tab[TAB_G + i] = s * 0.04419417382415922f;
    }
    for (int i = gt; i < 3 * 16 * 132; i += NGT) {
        const int d = i % 132, ph = i / 132, p = ph >> 4, hh = ph & 15;
        tab[TAB_BIAS + i] = rb[BUCKET[p][d] * 16 + hh] * LOG2E;
    }
}

#define XB_TMO      128
#define XB_XCNT(j)  (256  + 64 * (j))
#define XB_XSUB(j)  (1280 + 64 * (j))
#define XB_XGEN(j)  (2304 + 64 * (j))
#define XB_TOP      3328
#define XB_TOPGEN   3392
#define XCD_BAR_WORDS 3456
#define XB_SPIN_CAP (1u << 18)
DI unsigned xb_ld(unsigned* p)              { return __hip_atomic_load(p, __ATOMIC_RELAXED, __HIP_MEMORY_SCOPE_AGENT); }
DI unsigned xb_add(unsigned* p, unsigned v) { return __hip_atomic_fetch_add(p, v, __ATOMIC_RELAXED, __HIP_MEMORY_SCOPE_AGENT); }
DI unsigned xb_xcc_id() { return (unsigned)__builtin_amdgcn_s_getreg((3 << 11) | 20) & 0xFu; }
#define XB_SPIN(cond, bar) do { unsigned _sp = 0; while (cond) { __builtin_amdgcn_s_sleep(1); \
    if ((++_sp & 255u) == 0u) { if (xb_ld(&(bar)[XB_TMO])) break; if (_sp > XB_SPIN_CAP) { atomicAdd(&(bar)[XB_TMO], 1u); break; } } } } while (0)
struct XcdBarrier { unsigned* bar; unsigned x; volatile LAS unsigned* st; };
DI XcdBarrier xcd_barrier_post(unsigned* bar, volatile LAS unsigned* st, int tid) {
    XcdBarrier b; b.bar = bar; b.x = xb_xcc_id(); b.st = st;
    if (tid == 0) (void)xb_add(&bar[XB_XCNT(b.x)], 1u);
    return b;
}
DI void xcd_barrier_complete(unsigned* bar, unsigned x, unsigned& nloc, unsigned& nx) {
    const unsigned G = gridDim.x * gridDim.y * gridDim.z;
    unsigned sum, cnt, mine, sp = 0u;
    for (;;) {
        sum = 0u; cnt = 0u; mine = 0u;
#pragma unroll
        for (unsigned j = 0; j < 16; ++j) { const unsigned c = xb_ld(&bar[XB_XCNT(j)]); sum += c; cnt += (c > 0u) ? 1u : 0u; mine = (j == x) ? c : mine; }
        if (sum == G) break;
        __builtin_amdgcn_s_sleep(1);
        if ((++sp & 255u) == 0u) { if (xb_ld(&bar[XB_TMO])) break; if (sp > XB_SPIN_CAP) { atomicAdd(&bar[XB_TMO], 1u); break; } }
    }
    nloc = mine > 0u ? mine : 1u; nx = cnt > 0u ? cnt : 1u;
}
DI void xcd_barrier(const XcdBarrier& b, int tid) {
    asm volatile("s_waitcnt vmcnt(0)" ::: "memory");
    __syncthreads();
    if (tid == 0) {
        unsigned* bar = b.bar;
        __builtin_amdgcn_s_waitcnt(0);
        unsigned nloc = b.st[0], nx = b.st[1];
        if (nloc == 0u) { xcd_barrier_complete(bar, b.x, nloc, nx); b.st[0] = nloc; b.st[1] = nx; }
        const unsigned old = xb_add(&bar[XB_XSUB(b.x)], 1u);
        const unsigned gen = old / nloc;
        if (old + 1u == (gen + 1u) * nloc) {
            __builtin_amdgcn_fence(__ATOMIC_RELEASE, "agent");
            asm volatile("s_waitcnt vmcnt(0)" ::: "memory");
            const unsigned og = xb_add(&bar[XB_TOP], 1u);
            const unsigned tg = og / nx;
            if (og + 1u == (tg + 1u) * nx) xb_add(&bar[XB_TOPGEN], 1u);
            else XB_SPIN(xb_ld(&bar[XB_TOPGEN]) == tg, bar);
            __builtin_amdgcn_fence(__ATOMIC_ACQUIRE, "agent");
            xb_add(&bar[XB_XGEN(b.x)], 1u);
            asm volatile("s_waitcnt vmcnt(0)" ::: "memory");
        } else {
            XB_SPIN(xb_ld(&bar[XB_XGEN(b.x)]) == gen, bar);
            __builtin_amdgcn_fence(__ATOMIC_ACQUIRE, "agent");
            asm volatile("s_waitcnt vmcnt(0)" ::: "memory");
        }
    }
    __syncthreads();
}

DI void grid_sync_(int tid) {
    asm volatile("s_waitcnt vmcnt(0) lgkmcnt(0)" ::: "memory");
    __builtin_amdgcn_fence(__ATOMIC_RELEASE, "workgroup");
    __builtin_amdgcn_s_barrier();
    if (tid == 0) {
        __builtin_amdgcn_fence(__ATOMIC_ACQUIRE, "workgroup");
        __builtin_amdgcn_fence(__ATOMIC_RELEASE, "agent");
        const __attribute__((address_space(4))) char* ia = (const __attribute__((address_space(4))) char*)__builtin_amdgcn_implicitarg_ptr();
        const unsigned long long p = *(const __attribute__((address_space(4))) unsigned long long*)(ia + 88);
        unsigned* bar = (unsigned*)(p + 32);
        const unsigned nwg = *(const unsigned*)(p + 40);
        const unsigned old = __hip_atomic_fetch_add(bar, 1u, __ATOMIC_RELAXED, __HIP_MEMORY_SCOPE_AGENT);
        if ((old & 0xffffu) == nwg - 1u) (void)__hip_atomic_fetch_add(bar, 65536u - nwg, __ATOMIC_RELAXED, __HIP_MEMORY_SCOPE_AGENT);
        const unsigned gen = old & 0xffff0000u;
        while ((__hip_atomic_load(bar, __ATOMIC_RELAXED, __HIP_MEMORY_SCOPE_AGENT) & 0xffff0000u) == gen) __builtin_amdgcn_s_sleep(1);
        __builtin_amdgcn_fence(__ATOMIC_ACQUIRE, "agent");
        __builtin_amdgcn_fence(__ATOMIC_RELEASE, "workgroup");
    }
    __builtin_amdgcn_s_barrier();
    __builtin_amdgcn_fence(__ATOMIC_ACQUIRE, "workgroup");
}

__global__ void __launch_bounds__(NTHR) mk_fwd(Args a) {
    extern __shared__ __attribute__((aligned(16))) unsigned char lds_raw[];
    LAS unsigned char* lds = (LAS unsigned char*)lds_raw;
    const int G = gridDim.x, blk = blockIdx.x;
    const int wv = __builtin_amdgcn_readfirstlane(threadIdx.x >> 6);
    volatile LAS unsigned* bst = (volatile LAS unsigned*)(lds + XB_LDS_OFF);
    if (wg_tid_local(wv) < 4) bst[wg_tid_local(wv)] = 0u;
    __syncthreads();
    (void)xcd_barrier_post((unsigned*)(a.ws + WS_CTL) + 1024, bst, wg_tid_local(wv));
#define XBAR() do { XcdBarrier xb_; xb_.bar = (unsigned*)(a.ws + WS_CTL) + 1024; xb_.x = xb_xcc_id(); xb_.st = (volatile LAS unsigned*)(lds + XB_LDS_OFF); xcd_barrier(xb_, wg_tid_local(wv)); } while (0)
    unsigned char* ws = a.ws;
    const int lo = a.ph_lo, hi = a.ph_hi;
    bf16* XN = (bf16*)(ws + WS_XN); bf16* WIN = (bf16*)(ws + WS_WIN);
#ifndef PH_MASK
#define PH_MASK 0x7fff
#endif
#define IN(k) (((PH_MASK >> (k)) & 1) && lo <= (k) && (k) < hi)
#ifndef REP_MASK
#define REP_MASK 0
#endif
#define REPEAT(k, body) do { body; if ((REP_MASK >> (k)) & 1) { XBAR(); body; } } while (0)
#define SEAM(k) do { if (IN(k) && IN((k) + 1)) { if (lo < 0) grid_sync_(wg_tid_local(wv)); XBAR(); } } while (0)
#define GEMM_PHASE(EPI, E, Aop, Bop, NN, KK) do { pg8::Gemm g{(const pg8::bf16_t*)(Aop), (const pg8::bf16_t*)(Bop), MTOK, (NN), (KK)}; pg8::StaticOrder S; S.init(MTOK, (NN), G, blk); \
        pg8::gemm_phase<EPI, pg8::StaticOrder, true, true>(lds, g, S, E, wg_tid_local(wv)); } while (0)

    if (IN(0)) { REPEAT(0, prologue(a, lds, G, blk, wv)); } SEAM(0);
    if (IN(1)) {
        pg8::EpiXM E{(bf16*)(ws + WS_R0), (bf16*)(ws + WS_HALO)};
        REPEAT(1, GEMM_PHASE(pg8::EpiXM, E, XN, WIN + (size_t)C_XM * DM, MW, DM));
    } SEAM(1);
    if (IN(2)) {
        const float* tab = (const float*)(ws + WS_TAB);
        mpre::Tensors T{(const bf16*)(ws + WS_R0), (const bf16*)(ws + WS_HALO), (bf16*)(ws + WS_R1), (bf16*)a.out, (bf16*)(ws + WS_R2), (float*)(ws + WS_GP), (bf16*)(ws + WS_S), a.in[4], a.in[5], (const bf16*)(tab + TAB_WC), (const bf16*)(tab + TAB_WM), tab + TAB_G};
        REPEAT(2, mpre::phase(lds, T, G, blk, wv));
    } SEAM(2);
    if (IN(3)) {
        mscan::Tensors T{(const bf16*)(ws + WS_R2), (const bf16*)(ws + WS_R1), (const bf16*)a.out, (const bf16*)(ws + WS_S), (const float*)(ws + WS_GP), a.in[10], (float*)(ws + WS_SCAL), (bf16*)(ws + WS_R0)};
        mscan::phase<0>(lds, T, G, blk, wv);
#ifdef SCAN_PROBE
        XBAR(); mscan::phase<SCAN_PROBE>(lds, T, G, blk, wv);
#endif
    } SEAM(3);
    if (IN(4)) {
        pg8::EpiSig E{(bf16*)(ws + WS_R2), MW, nullptr};
        REPEAT(4, GEMM_PHASE(pg8::EpiSig, E, XN, WIN + (size_t)C_OM * DM, MW, DM));
    } SEAM(4);
    if (IN(5)) {
        mpost::Tensors T{(bf16*)(ws + WS_R0), (const bf16*)(ws + WS_R2), (const bf16*)(ws + WS_R1), a.in[8], a.in[11], a.in[12]};
        mpost::phase(lds, T, G, blk, wv);
    } SEAM(5);
    if (IN(6)) {
        pg8::EpiZM E{(bf16*)(ws + WS_R0)};
        GEMM_PHASE(pg8::EpiZM, E, XN, WIN + (size_t)C_ZM * DM, MW, DM);
    } SEAM(6);
    if (IN(7)) {
        pg8::EpiQKV E{(bf16*)(ws + WS_QA), (size_t)(WS_KA - WS_QA) / 2};
        REPEAT(7, GEMM_PHASE(pg8::EpiQKV, E, XN, WIN + (size_t)C_QA * DM, 3 * AW, DM));
    } SEAM(7);
    if (IN(8)) {
        att::Tensors T{(const bf16*)(ws + WS_QA), (const bf16*)(ws + WS_KA), (const bf16*)(ws + WS_VA), (bf16*)(ws + WS_O1), (bf16*)a.out, (float*)(ws + WS_ST), (const float*)(ws + WS_TAB) + TAB_BIAS};
        REPEAT(8, att::phase(lds, T, G, blk, wv));
    } SEAM(8);
    if (IN(9)) {
        pg8::EpiZA E{(const bf16*)(ws + WS_O1), (const bf16*)a.out, (const bf16*)a.out + (size_t)MTOK * AW, (const float*)(ws + WS_ST), (bf16*)(ws + WS_A1)};
        REPEAT(9, GEMM_PHASE(pg8::EpiZA, E, XN, WIN + (size_t)C_ZA * DM, AW, DM));
    } SEAM(9);
    if (IN(10)) {
        pg8::EpiSig E{(bf16*)(ws + WS_G), 2 * DM, a.in[3]};
        REPEAT(10, GEMM_PHASE(pg8::EpiSig, E, XN, WIN + (size_t)C_G * DM, 2 * DM, DM));
    } SEAM(10);
    if (IN(11)) {
        pg8::EpiYA E{(bf16*)(ws + WS_G)};
        GEMM_PHASE(pg8::EpiYA, E, ws + WS_A1, ws + WS_WPA, DM, AW);
    } SEAM(11);
    if (IN(12)) {
        pg8::EpiYM E{(const bf16*)(ws + WS_G), (bf16*)(ws + WS_MRG)};
        REPEAT(12, GEMM_PHASE(pg8::EpiYM, E, ws + WS_R0, ws + WS_WPB, DM, MW));
    } SEAM(12);
    if (IN(13)) {
        pg8::EpiOut E{a.in[0], a.out};
        REPEAT(13, GEMM_PHASE(pg8::EpiOut, E, ws + WS_MRG, ws + WS_WOUT, DM, DM));
    } SEAM(13);
#ifdef EXTRA_SYNCS
    if (IN(13) && IN(14)) { for (int i = 0; i < EXTRA_SYNCS; ++i) XBAR(); }
#endif
    if (IN(14)) {
        const int lane = wg_tid_local(wv) & 63, wave = wv;
        for (int m = blk * NWAVES + wave; m < MTOK; m += G * NWAVES) rms_row_inplace(a.out + (size_t)m * DM, a.in[17], lane);
    }
#undef IN
#undef SEAM
#undef GEMM_PHASE
}

#ifndef MK_ONE_LAUNCH
#define MK_ONE_LAUNCH 0
#endif
extern "C" void kernel_launch(void* const* d_in, const int* in_sizes, int n_in, void* d_out, int out_size, void* d_ws, size_t ws_size, hipStream_t stream) {
    static int grid = 0;
    if (grid == 0) {
        if (n_in != 18 || in_sizes[0] != MTOK * DM || out_size != MTOK * DM || ws_size < WS_END) { fprintf(stderr, "kernel_launch: unexpected shapes (n_in %d, ws %zu)\n", n_in, ws_size); grid = -1; return; }
        int dev = 0, cus = 0, per_cu = 0;
        (void)hipGetDevice(&dev); (void)hipDeviceGetAttribute(&cus, hipDeviceAttributeMultiprocessorCount, dev);
        if (hipFuncSetAttribute((const void*)mk_fwd, hipFuncAttributeMaxDynamicSharedMemorySize, LDS_TOTAL) != hipSuccess) { fprintf(stderr, "kernel_launch: hipFuncSetAttribute failed\n"); grid = -1; return; }
        if (hipOccupancyMaxActiveBlocksPerMultiprocessor(&per_cu, (const void*)mk_fwd, NTHR, LDS_TOTAL) != hipSuccess || per_cu < 1) { fprintf(stderr, "kernel_launch: occupancy query says %d\n", per_cu); per_cu = 1; }
        (void)hipGetLastError();
        grid = cus * (per_cu > 1 ? 1 : per_cu);
    }
    if (grid < 0) return;
    if (hipMemsetAsync((char*)d_ws + WS_CTL, 0, 65536, stream) != hipSuccess) { fprintf(stderr, "kernel_launch: hipMemsetAsync failed\n"); return; }
    Args a{};
    for (int i = 0; i < 18; ++i) a.in[i] = (const float*)d_in[i];
    a.out = (float*)d_out; a.ws = (unsigned char*)d_ws;
#if MK_ONE_LAUNCH
    a.ph_lo = 0; a.ph_hi = N_PHASES;
    void* args[] = {&a};
    hipError_t e = hipLaunchCooperativeKernel((const void*)mk_fwd, dim3(grid), dim3(NTHR), args, LDS_TOTAL, stream);
    if (e != hipSuccess) fprintf(stderr, "cooperative launch failed: %s (grid %d)\n", hipGetErrorString(e), grid);
#else
    for (int p = 0; p < N_PHASES; ++p) {
        a.ph_lo = p; a.ph_hi = p + 1;
        hipLaunchKernelGGL(mk_fwd, dim3(grid), dim3(NTHR), LDS_TOTAL, stream, a);
    }
#endif
}
```

```cpp
#define MK_ONE_LAUNCH 1
#include <hip/hip_runtime.h>
#include <hip/hip_cooperative_groups.h>
#include <cstdio>
#include <cstdint>
namespace cg = cooperative_groups;
#define LAS __attribute__((address_space(3)))
#define GAS __attribute__((address_space(1)))
typedef unsigned short bf16;
typedef unsigned v4u __attribute__((ext_vector_type(4)));
typedef unsigned v2u __attribute__((ext_vector_type(2)));
typedef float f32x4 __attribute__((ext_vector_type(4)));
typedef float f32x16 __attribute__((ext_vector_type(16)));
typedef short bf16x8 __attribute__((ext_vector_type(8)));
typedef short s16x4 __attribute__((ext_vector_type(4)));
typedef float f32x2_t __attribute__((ext_vector_type(2)));
typedef __bf16 bf16x2_t __attribute__((ext_vector_type(2)));

constexpr int NWAVES = 8, NTHR = 512;
constexpr int BATCH = 8, SEQ = 4096, DM = 1024, MTOK = BATCH * SEQ;
constexpr int AH = 16, AHD = 64, AW = 1024;
constexpr int MH = 4, MHD = 512, MW = 2048;
constexpr int NIN = 12288;
constexpr int C_QA = 0, C_KA = 1024, C_VA = 2048, C_ZA = 3072, C_XM = 4096, C_ZM = 6144, C_OM = 8192, C_G = 10240;
constexpr int CHUNK = 64, NCHUNK = SEQ / CHUNK;
constexpr float EPS = 1e-6f;
constexpr float LOG2E = 1.4426950408889634f;
constexpr float QSCALE = 0.125f * 1.4426950408889634f;

constexpr size_t MiB = 1u << 20;
constexpr size_t WS_CTL = 0;
constexpr size_t WS_WIN = 1 * MiB;
constexpr size_t WS_WPA = 25 * MiB;
constexpr size_t WS_WPB = 27 * MiB;
constexpr size_t WS_WOUT = 31 * MiB;
constexpr size_t WS_TAB = 33 * MiB;
constexpr size_t WS_GP = 34 * MiB;
constexpr size_t WS_SCAL = 38 * MiB;
constexpr size_t WS_HALO = 40 * MiB;
constexpr size_t WS_ST = 34 * MiB;
constexpr size_t WS_XN = 46 * MiB;
constexpr size_t WS_R0 = 110 * MiB;
constexpr size_t WS_R1 = 238 * MiB;
constexpr size_t WS_R2 = 366 * MiB;
constexpr size_t WS_S = 494 * MiB;
constexpr size_t WS_END = 512 * MiB;
constexpr size_t WS_QA = 238 * MiB, WS_KA = 302 * MiB, WS_VA = 366 * MiB;
constexpr size_t WS_O1 = 430 * MiB;
constexpr size_t WS_A1 = 238 * MiB;
constexpr size_t WS_G = 302 * MiB;
constexpr size_t WS_MRG = 430 * MiB;
constexpr int TAB_WC = 0;
constexpr int TAB_WM = 2048 * 8;
constexpr int TAB_G = 2 * 2048 * 8;
constexpr int TAB_BIAS = TAB_G + 512 * 16;
constexpr int TAB_END = TAB_BIAS + 3 * 16 * 132;

__device__ const unsigned char BUCKET[3][132] = {
 {0,1,2,3,4,5,6,7,8,9,10,11,12,13,14,15,16,16,16,16,16,16,17,17,17,17,17,17,17,17,18,18,18,18,18,18,18,18,18,18,19,19,19,19,19,19,19,19,19,19,19,19,19,19,20,20,20,20,20,20,20,20,20,20,20,20,20,20,20,20,20,20,20,21,21,21,21,21,21,21,21,21,21,21,21,21,21,21,21,21,21,21,21,21,21,21,21,21,21,22,22,22,22,22,22,22,22,22,22,22,22,22,22,22,22,22,22,22,22,22,22,22,22,22,22,22,22,22,22,0,0,0},
 {0,4,8,12,16,16,17,17,18,18,19,19,19,19,20,20,20,20,20,21,21,21,21,21,21,22,22,22,22,22,22,22,22,22,23,23,23,23,23,23,23,23,23,23,23,23,24,24,24,24,24,24,24,24,24,24,24,24,24,24,24,24,25,25,25,25,25,25,25,25,25,25,25,25,25,25,25,25,25,25,25,25,25,26,26,26,26,26,26,26,26,26,26,26,26,26,26,26,26,26,26,26,26,26,26,26,26,26,26,26,26,26,26,27,27,27,27,27,27,27,27,27,27,27,27,27,27,27,27,0,0,0},
 {0,16,18,19,20,21,21,22,22,23,23,23,24,24,24,24,25,25,25,25,25,26,26,26,26,26,26,26,26,27,27,27,27,27,27,27,27,27,27,28,28,28,28,28,28,28,28,28,28,28,28,28,29,29,29,29,29,29,29,29,29,29,29,29,29,29,29,29,29,29,30,30,30,30,30,30,30,30,30,30,30,30,30,30,30,30,30,30,30,30,30,30,30,30,30,31,31,31,31,31,31,31,31,31,31,31,31,31,31,31,31,31,31,31,31,31,31,31,31,31,31,31,31,31,31,31,31,31,31,0,0,0}};

#define DI __device__ __forceinline__
DI unsigned pk2(float lo, float hi) { f32x2_t v = {lo, hi}; bf16x2_t b = __builtin_convertvector(v, bf16x2_t); return __builtin_bit_cast(unsigned, b); }
DI float bflo(unsigned u) { return __uint_as_float(u << 16); }
DI float bfhi(unsigned u) { return __uint_as_float(u & 0xffff0000u); }
DI float sigmoidf_(float x) { return 1.0f / (1.0f + __expf(-x)); }
DI float siluf_(float x) { return x / (1.0f + __expf(-x)); }
DI float wave_sum(float v) {
#pragma unroll
    for (int o = 1; o < 64; o <<= 1) v += __shfl_xor(v, o);
    return v;
}
DI int wg_tid(int wv) { return wv * 64 + (int)__builtin_amdgcn_mbcnt_hi(~0u, __builtin_amdgcn_mbcnt_lo(~0u, 0u)); }
DI int wg_tid_local(int wv) { int z; asm volatile("v_mov_b32 %0, 0" : "=v"(z)); return wv * 64 + (int)__builtin_amdgcn_mbcnt_hi(~0u, __builtin_amdgcn_mbcnt_lo(~0u, (unsigned)z)); }
DI float dot2bf(unsigned a, unsigned b, float acc) { return __builtin_amdgcn_fdot2_f32_bf16(__builtin_bit_cast(bf16x2_t, a), __builtin_bit_cast(bf16x2_t, b), acc, false); }
DI float bperm(float v, int srclane) { return __int_as_float(__builtin_amdgcn_ds_bpermute(srclane << 2, __float_as_int(v))); }
DI int crow(int r, int hi) { return (r & 3) + 8 * (r >> 2) + 4 * hi; }
#define MFMA32(a, b, c) __builtin_amdgcn_mfma_f32_32x32x16_bf16((a), (b), (c), 0, 0, 0)
DI s16x4 tr_read(const LAS unsigned char* p) { return __builtin_bit_cast(s16x4, __builtin_amdgcn_ds_read_tr16_b64_v4i16((LAS s16x4*)p)); }
DI bf16x8 cat8(s16x4 lo, s16x4 hi) { return __builtin_shufflevector(lo, hi, 0, 1, 2, 3, 4, 5, 6, 7); }
DI bf16x8 pack8(float a0, float a1, float a2, float a3, float a4, float a5, float a6, float a7) {
    v4u p; p.x = pk2(a0, a1); p.y = pk2(a2, a3); p.z = pk2(a4, a5); p.w = pk2(a6, a7); return __builtin_bit_cast(bf16x8, p);
}
namespace pg8 {
#define PG8_LAS __attribute__((address_space(3)))
typedef unsigned short bf16_t;
typedef short bf16x8 __attribute__((ext_vector_type(8)));
typedef float f32x4 __attribute__((ext_vector_type(4)));
typedef unsigned u32x4 __attribute__((ext_vector_type(4)));
constexpr int BM = 256, BK = 64, HALF = 128, HTB = HALF * BK * 2  , STAGE_BYTES = 8 * HTB, NXCD = 8, WGM = 8;

__host__ __device__ __forceinline__ int lds_byte(int r, int c) { const int st = (r >> 4) * 2 + (c >> 5), rr = r & 15, cc = c & 31, ob = rr * 64 + cc * 2; return st * 1024 + (ob ^ (((ob >> 9) & 1) << 5)); }
__host__ __device__ __forceinline__ void stage_rc(int b, int& R, int& C) { const int st = b / 1024, sb = b % 1024, swz = sb ^ (((sb >> 9) & 1) << 5); R = (st >> 1) * 16 + swz / 64; C = (st & 1) * 32 + (swz % 64) / 2; }
__host__ __device__ __forceinline__ int perm32(int rho) { const int n = rho >> 4, i = rho & 15; return 8 * (i >> 2) + 4 * n + (i & 3); }

struct Unit { int pm, pn; };
struct Gemm { const bf16_t* A; const bf16_t* Bt; int M, N, K; };

struct StaticOrder {
    int nM, nN, nwg, G, c;
    __host__ __device__ void init(int M, int N, int G_, int c_) { nM = M / BM; nN = N / BM; nwg = nM * nN; G = G_; c = c_; }
    __host__ __device__ bool next(int i, Unit& u) const {
        const long L = (long)i * G + c; if (L >= nwg) return false;
        int wgid = (int)L; { const int q = nwg / NXCD, r = nwg % NXCD, xcd = wgid % NXCD, off = wgid / NXCD; wgid = (xcd < r ? xcd * (q + 1) : r * (q + 1) + (xcd - r) * q) + off; }
        const int nig = WGM * nN, gid = wgid / nig, fm = gid * WGM, gsz = (nM - fm) < WGM ? (nM - fm) : WGM;
        u.pm = fm + ((wgid % nig) % gsz); u.pn = (wgid % nig) / gsz; return true;
    }
    __device__ __forceinline__ void a_ready(const Unit&) const {}
    __device__ __forceinline__ void done(const Unit&) const {}
};

}
namespace pg8 {
#define EPI_OPERATOR \
    static constexpr bool PERM = true, AFTER_DRAIN = false; \
    __device__ __forceinline__ void operator()(const f32x4 (&acc)[2][2][4][2], const Unit& u, int wr, int wc, int fr, int fq) const { \
        const int row0 = u.pm * BM + wr * 64 + fr, col0 = u.pn * BM + wc * 32 + 8 * fq; \
        _Pragma("unroll") for (int ai = 0; ai < 2; ++ai) \
        _Pragma("unroll") for (int m = 0; m < 4; ++m) \
        _Pragma("unroll") for (int bj = 0; bj < 2; ++bj) store8(row0 + ai * HALF + m * 16, col0 + bj * HALF, acc[ai][bj][m][0], acc[ai][bj][m][1]); \
    }
DI ::v4u pack_bf16x8(f32x4 v0, f32x4 v1) { ::v4u w; w.x = ::pk2(v0[0], v0[1]); w.y = ::pk2(v0[2], v0[3]); w.z = ::pk2(v1[0], v1[1]); w.w = ::pk2(v1[2], v1[3]); return w; }
DI void unpack_bf16x8(::v4u w, f32x4& v0, f32x4& v1) { v0 = (f32x4){::bflo(w.x), ::bfhi(w.x), ::bflo(w.y), ::bfhi(w.y)}; v1 = (f32x4){::bflo(w.z), ::bfhi(w.z), ::bflo(w.w), ::bfhi(w.w)}; }

struct EpiXM {
    bf16_t* xm; bf16_t* halo;
    DI void store8(int row, int col, f32x4 v0, f32x4 v1) const {
        const ::v4u w = pack_bf16x8(v0, v1);
        *(::v4u*)(xm + (size_t)row * 2048 + col) = w;
        const int r = row & 63;
        if (r >= 61) *(::v4u*)(halo + ((size_t)(row >> 6) * 3 + (r - 61)) * 2048 + col) = w;
    }
    EPI_OPERATOR
};
struct EpiSig {
    bf16_t* out; int ldc; const float* bias;
    DI void store8(int row, int col, f32x4 v0, f32x4 v1) const {
        if (bias) { v0 += *(const f32x4*)(bias + col); v1 += *(const f32x4*)(bias + col + 4); }
#pragma unroll
        for (int i = 0; i < 4; ++i) { v0[i] = ::sigmoidf_(v0[i]); v1[i] = ::sigmoidf_(v1[i]); }
        *(::v4u*)(out + (size_t)row * ldc + col) = pack_bf16x8(v0, v1);
    }
    EPI_OPERATOR
};
struct EpiZM {
    bf16_t* buf;
    DI void store8(int row, int col, f32x4 v0, f32x4 v1) const {
        ::v4u* p = (::v4u*)(buf + (size_t)row * 2048 + col);
        f32x4 h0, h1; unpack_bf16x8(*p, h0, h1);
#pragma unroll
        for (int i = 0; i < 4; ++i) { h0[i] *= ::siluf_(v0[i]); h1[i] *= ::siluf_(v1[i]); }
        *p = pack_bf16x8(h0, h1);
    }
    EPI_OPERATOR
};
struct EpiQKV {
    bf16_t* q; size_t stride;
    DI void store8(int row, int col, f32x4 v0, f32x4 v1) const {
        const int t = col >> 10, c = col & 1023;
        bf16_t* base = q + (size_t)t * stride;
        if (t == 0) { v0 *= ::QSCALE; v1 *= ::QSCALE; }
        *(::v4u*)(base + (size_t)row * 1024 + c) = pack_bf16x8(v0, v1);
    }
    EPI_OPERATOR
};
struct EpiZA {
    const bf16_t* o0; const bf16_t* o1; const bf16_t* o2; const float* st; bf16_t* a1;
    DI void store8(int row, int col, f32x4 v0, f32x4 v1) const {
        const int head = col >> 6;
        const ::f32x2_t s0 = *(const ::f32x2_t*)(st + ((size_t)(0 * ::MTOK + row) * 16 + head) * 2);
        const ::f32x2_t s1 = *(const ::f32x2_t*)(st + ((size_t)(1 * ::MTOK + row) * 16 + head) * 2);
        const ::f32x2_t s2 = *(const ::f32x2_t*)(st + ((size_t)(2 * ::MTOK + row) * 16 + head) * 2);
        const float mx = fmaxf(s0.x, fmaxf(s1.x, s2.x));
        float w0 = __builtin_amdgcn_exp2f(s0.x - mx) * s0.y, w1 = __builtin_amdgcn_exp2f(s1.x - mx) * s1.y, w2 = __builtin_amdgcn_exp2f(s2.x - mx) * s2.y;
        const float inv = 1.0f / (w0 + w1 + w2); w0 *= inv; w1 *= inv; w2 *= inv;
        const size_t off = (size_t)row * 1024 + col;
        f32x4 a0, a1v, b0, b1, c0, c1;
        unpack_bf16x8(*(const ::v4u*)(o0 + off), a0, a1v); unpack_bf16x8(*(const ::v4u*)(o1 + off), b0, b1); unpack_bf16x8(*(const ::v4u*)(o2 + off), c0, c1);
        f32x4 r0 = a0 * w0 + b0 * w1 + c0 * w2, r1 = a1v * w0 + b1 * w1 + c1 * w2;
#pragma unroll
        for (int i = 0; i < 4; ++i) { r0[i] *= ::siluf_(v0[i]); r1[i] *= ::siluf_(v1[i]); }
        *(::v4u*)(a1 + off) = pack_bf16x8(r0, r1);
    }
    EPI_OPERATOR
};
struct EpiYA {
    bf16_t* g;
    DI void store8(int row, int col, f32x4 v0, f32x4 v1) const {
        ::v4u* p = (::v4u*)(g + (size_t)row * 2048 + col);
        f32x4 h0, h1; unpack_bf16x8(*p, h0, h1);
        *p = pack_bf16x8(h0 * v0, h1 * v1);
    }
    EPI_OPERATOR
};
struct EpiYM {
    const bf16_t* g; bf16_t* mrg;
    DI void store8(int row, int col, f32x4 v0, f32x4 v1) const {
        f32x4 t0, t1, g0, g1;
        unpack_bf16x8(*(const ::v4u*)(g + (size_t)row * 2048 + col), t0, t1);
        unpack_bf16x8(*(const ::v4u*)(g + (size_t)row * 2048 + 1024 + col), g0, g1);
        *(::v4u*)(mrg + (size_t)row * 1024 + col) = pack_bf16x8(t0 + g0 * v0, t1 + g1 * v1);
    }
    EPI_OPERATOR
};
struct EpiOut {
    const float* x; float* out;
    DI void store8(int row, int col, f32x4 v0, f32x4 v1) const {
        const size_t off = (size_t)row * 1024 + col;
        *(f32x4*)(out + off) = *(const f32x4*)(x + off) + v0;
        *(f32x4*)(out + off + 4) = *(const f32x4*)(x + off + 4) + v1;
    }
    EPI_OPERATOR
};
}
namespace pg8 {
template <class Epi, class Sched, bool ALIGN_EPI = false, bool SP2 = false>
__device__ __forceinline__ void gemm_phase(PG8_LAS unsigned char* lds, const Gemm g, const Sched& S, const Epi& E, const int tid_in) {
    const int tid = tid_in, wid = __builtin_amdgcn_readfirstlane(tid >> 6), lane = tid & 63, wr = wid >> 2, wc = wid & 3, fr = lane & 15, fq = lane >> 4;
    const int K = g.K, nt = K / BK;
    unsigned voffA[2], voffB[2];
#pragma unroll
    for (int i = 0; i < 2; ++i) { int R, C; stage_rc(tid * 16 + i * 8192, R, C); const int Rb = Epi::PERM ? ((R & ~31) + perm32(R & 31)) : R;
        voffA[i] = (unsigned)(R * K + C) * 2u; voffB[i] = (unsigned)(Rb * K + C) * 2u; }
    const size_t kstep = (size_t)(BK * 2);
    const size_t hstep = (size_t)HALF * K * 2;
    const size_t tstep = 2 * hstep;
    const unsigned ldsw = (unsigned)wid * 1024u;
    const int aoff = lds_byte(wr * 64 + fr, fq * 8), boff = lds_byte(wc * 32 + fr, fq * 8);
#define PG8_SA(b, h) (((b) * 2 + (h)) * HTB)
#define PG8_SB(b, h) ((4 + (b) * 2 + (h)) * HTB)
#define PG8_STAGE(bufoff, gbase, voff) do { _Pragma("unroll") for (int _i = 0; _i < 2; ++_i) \
        __builtin_amdgcn_global_load_lds((const unsigned*)((const char*)(gbase) + (voff)[_i]), (PG8_LAS unsigned*)(lds + (bufoff) + ldsw + _i * 8192), 16, 0, 0); } while (0)
#define PG8_LDA(dst, b, h) do { _Pragma("unroll") for (int m = 0; m < 4; ++m) _Pragma("unroll") for (int k = 0; k < 2; ++k) dst[m][k] = *(const PG8_LAS bf16x8*)(lds + PG8_SA(b, h) + aoff + m * 2048 + k * 1024); } while (0)
#define PG8_LDB(dst, b, h) do { _Pragma("unroll") for (int n = 0; n < 2; ++n) _Pragma("unroll") for (int k = 0; k < 2; ++k) dst[n][k] = *(const PG8_LAS bf16x8*)(lds + PG8_SB(b, h) + boff + n * 2048 + k * 1024); } while (0)
#define PG8_MMA(ai, bj, At, Bt) do { __builtin_amdgcn_s_setprio(1); _Pragma("unroll") for (int m = 0; m < 4; ++m) _Pragma("unroll") for (int n = 0; n < 2; ++n) _Pragma("unroll") for (int k = 0; k < 2; ++k) \
        acc[ai][bj][m][n] = __builtin_amdgcn_mfma_f32_16x16x32_bf16(Bt[n][k], At[m][k], acc[ai][bj][m][n], 0, 0, 0); __builtin_amdgcn_s_setprio(0); } while (0)
#define PG8_WAIT_V(n) asm volatile("s_waitcnt vmcnt(" #n ")" ::: "memory")
#define PG8_WAIT_L(n) asm volatile("s_waitcnt lgkmcnt(" #n ")" ::: "memory")
#define PG8_BAR __builtin_amdgcn_s_barrier()
#define PG8_SCHED __builtin_amdgcn_sched_barrier(0)
    Unit cur, nxt; int ui = 0;
    if (!S.next(0, cur)) return;
    f32x4 acc[2][2][4][2];
#pragma unroll
    for (int a = 0; a < 2; ++a)
#pragma unroll
        for (int b = 0; b < 2; ++b)
#pragma unroll
            for (int m = 0; m < 4; ++m)
#pragma unroll
                for (int n = 0; n < 2; ++n) acc[a][b][m][n] = (f32x4){0.f, 0.f, 0.f, 0.f};
    bf16x8 At[4][2], B0[2][2], B1[2][2];
    const char* cA = (const char*)g.A + (size_t)cur.pm * tstep; const char* cB = (const char*)g.Bt + (size_t)cur.pn * tstep;
    S.a_ready(cur);
    if constexpr (SP2) {
        PG8_STAGE(PG8_SB(0, 0), cB, voffB); PG8_STAGE(PG8_SB(0, 1), cB + hstep, voffB); PG8_STAGE(PG8_SA(0, 0), cA, voffA); PG8_STAGE(PG8_SA(0, 1), cA + hstep, voffA);
        if (wr == 1) PG8_BAR;
        PG8_WAIT_V(2); PG8_BAR;
        PG8_STAGE(PG8_SB(1, 0), cB + kstep, voffB); PG8_STAGE(PG8_SA(1, 0), cA + kstep, voffA); PG8_STAGE(PG8_SB(1, 1), cB + hstep + kstep, voffB);
        PG8_WAIT_V(6); PG8_BAR;
    } else {
        PG8_STAGE(PG8_SB(0, 0), cB, voffB); PG8_STAGE(PG8_SA(0, 0), cA, voffA); PG8_STAGE(PG8_SB(0, 1), cB + hstep, voffB); PG8_STAGE(PG8_SA(0, 1), cA + hstep, voffA);
        if (wr == 1) PG8_BAR;
        PG8_WAIT_V(4); PG8_BAR;
        PG8_STAGE(PG8_SB(1, 0), cB + kstep, voffB); PG8_STAGE(PG8_SA(1, 0), cA + kstep, voffA); PG8_STAGE(PG8_SB(1, 1), cB + hstep + kstep, voffB);
        PG8_WAIT_V(6); PG8_BAR;
    }
    for (;;) {
        const bool has_next = S.next(ui + 1, nxt);
        const char* nA = has_next ? (const char*)g.A + (size_t)nxt.pm * tstep : cA; const char* nB = has_next ? (const char*)g.Bt + (size_t)nxt.pn * tstep : cB;
        for (int t = 0; t < nt; t += 2) {
            const bool last = (t == nt - 2);
            const char* a1 = cA + (size_t)(t + 1) * kstep;
            const char* a2 = last ? nA : cA + (size_t)(t + 2) * kstep; const char* b2 = last ? nB : cB + (size_t)(t + 2) * kstep;
            const char* a3 = a2 + kstep; const char* b3 = b2 + kstep;
            if (last && has_next) S.a_ready(nxt);
            if constexpr (SP2) {
            PG8_LDB(B0, 0, 0); PG8_LDB(B1, 0, 1); PG8_SCHED; PG8_LDA(At, 0, 0); PG8_STAGE(PG8_SA(1, 1), a1 + hstep, voffA);
            PG8_WAIT_V(8); PG8_WAIT_L(0); PG8_BAR; PG8_MMA(0, 0, At, B0); PG8_MMA(0, 1, At, B1); PG8_BAR; PG8_SCHED;
            PG8_LDA(At, 0, 1); PG8_STAGE(PG8_SB(0, 0), b2, voffB); PG8_STAGE(PG8_SB(0, 1), b2 + hstep, voffB); PG8_STAGE(PG8_SA(0, 0), a2, voffA);
            PG8_WAIT_V(8); PG8_WAIT_L(0); PG8_BAR; PG8_MMA(1, 0, At, B0); PG8_MMA(1, 1, At, B1); PG8_BAR; PG8_SCHED;
            PG8_LDB(B0, 1, 0); PG8_LDB(B1, 1, 1); PG8_SCHED; PG8_LDA(At, 1, 0); PG8_STAGE(PG8_SA(0, 1), a2 + hstep, voffA);
            PG8_WAIT_V(8); PG8_WAIT_L(0); PG8_BAR; PG8_MMA(0, 0, At, B0); PG8_MMA(0, 1, At, B1); PG8_BAR; PG8_SCHED;
            PG8_LDA(At, 1, 1); PG8_STAGE(PG8_SB(1, 0), b3, voffB); PG8_STAGE(PG8_SB(1, 1), b3 + hstep, voffB); PG8_STAGE(PG8_SA(1, 0), a3, voffA);
            PG8_WAIT_V(8); PG8_WAIT_L(0); PG8_BAR; PG8_MMA(1, 0, At, B0); PG8_MMA(1, 1, At, B1); PG8_BAR; PG8_SCHED;
            } else {
            PG8_LDB(B0, 0, 0); PG8_SCHED; PG8_LDA(At, 0, 0); PG8_STAGE(PG8_SA(1, 1), a1 + hstep, voffA);
            PG8_WAIT_L(8); PG8_BAR; PG8_WAIT_L(0); PG8_MMA(0, 0, At, B0); PG8_BAR; PG8_SCHED;
            PG8_LDB(B1, 0, 1); PG8_STAGE(PG8_SB(0, 0), b2, voffB);
            PG8_BAR; PG8_WAIT_L(0); PG8_MMA(0, 1, At, B1); PG8_BAR;
            PG8_LDA(At, 0, 1); PG8_STAGE(PG8_SA(0, 0), a2, voffA);
            PG8_BAR; PG8_WAIT_L(0); PG8_MMA(1, 0, At, B0); PG8_BAR; PG8_SCHED;
            PG8_STAGE(PG8_SB(0, 1), b2 + hstep, voffB);
            PG8_WAIT_V(6); PG8_BAR; PG8_MMA(1, 1, At, B1); PG8_BAR;
            PG8_LDB(B0, 1, 0); PG8_SCHED; PG8_LDA(At, 1, 0); PG8_STAGE(PG8_SA(0, 1), a2 + hstep, voffA);
            PG8_WAIT_L(8); PG8_BAR; PG8_WAIT_L(0); PG8_MMA(0, 0, At, B0); PG8_BAR; PG8_SCHED;
            PG8_LDB(B1, 1, 1); PG8_STAGE(PG8_SB(1, 0), b3, voffB);
            PG8_BAR; PG8_WAIT_L(0); PG8_MMA(0, 1, At, B1); PG8_BAR;
            PG8_LDA(At, 1, 1); PG8_STAGE(PG8_SA(1, 0), a3, voffA);
            PG8_BAR; PG8_WAIT_L(0); PG8_MMA(1, 0, At, B0); PG8_BAR; PG8_SCHED;
            PG8_STAGE(PG8_SB(1, 1), b3 + hstep, voffB);
            PG8_WAIT_V(6); PG8_BAR; PG8_MMA(1, 1, At, B1); PG8_BAR;
            }
        }
        if constexpr (ALIGN_EPI) { if (wr == 0) PG8_BAR; }
        if constexpr (!Epi::AFTER_DRAIN) { E(acc, cur, wr, wc, fr, fq); S.done(cur); }
        if (!has_next) break;
#pragma unroll
        for (int a = 0; a < 2; ++a)
#pragma unroll
            for (int b = 0; b < 2; ++b)
#pragma unroll
                for (int m = 0; m < 4; ++m)
#pragma unroll
                    for (int n = 0; n < 2; ++n) acc[a][b][m][n] = (f32x4){0.f, 0.f, 0.f, 0.f};
        cur = nxt; cA = nA; cB = nB; ++ui;
        if constexpr (ALIGN_EPI) { if (wr == 1) PG8_BAR; }
    }
    PG8_WAIT_V(0);
    if constexpr (!ALIGN_EPI) { if (wr == 0) PG8_BAR; }
    PG8_BAR;
    if constexpr (Epi::AFTER_DRAIN) { E.fused(acc, cur, wr, wc, fr, fq, lds, wid, lane); S.done(cur); }
#undef PG8_SA
#undef PG8_SB
#undef PG8_STAGE
#undef PG8_LDA
#undef PG8_LDB
#undef PG8_MMA
#undef PG8_WAIT_V
#undef PG8_WAIT_L
#undef PG8_BAR
#undef PG8_SCHED
}
}
namespace att {
constexpr int KP = 144;
constexpr int K_OFF = 0, V_OFF = 384 * KP, B_OFF = 2 * 384 * KP, LDS_BYTES = B_OFF + 132 * 4;
struct Tensors { const bf16* Q; const bf16* K; const bf16* V; bf16* Oa; bf16* Ob; float* st; const float* biasL2; };

struct UnitId { int b, h, p, dsh, r, qblk; };
DI UnitId decode(int u) { UnitId d; const int bh = u / 48, rem = u % 48; d.p = rem >> 4; const int w16 = rem & 15; d.b = bh >> 4; d.h = bh & 15; d.dsh = 2 * d.p; const int nqb = 16 >> d.dsh; d.r = w16 / nqb; d.qblk = w16 % nqb; return d; }

DI void phase(LAS unsigned char* lds, const Tensors& T, int G, int blk, int wv) {
    const int tid_ = wg_tid_local(wv);
    const int tid = tid_, lane = tid & 63, l31 = lane & 31, hi = lane >> 5, w = __builtin_amdgcn_readfirstlane(tid >> 6);
    const int NU = BATCH * AH * 48;
    const int i16 = lane & 15, q4 = i16 >> 2, p4 = i16 & 3, gidx = (lane >> 4) & 1;
    v4u kreg[6], vreg[6]; bf16x8 qf[4]; float breg = 0.f;
    auto fetch = [&](int u) {
        const UnitId d = decode(u);
        const size_t rowb = (size_t)d.b * SEQ;
#pragma unroll
        for (int k = 0; k < 6; ++k) {
            const int id = tid + 512 * k, j = id >> 3, pc = id & 7;
            int pos = 256 * d.qblk - 128 + j; pos = pos < 0 ? 0 : pos;
            const size_t off = (rowb + d.r + ((size_t)pos << d.dsh)) * 1024 + d.h * 64 + pc * 8;
            kreg[k] = *(const v4u*)(T.K + off); vreg[k] = *(const v4u*)(T.V + off);
        }
        const int qpos = 256 * d.qblk + 32 * w + l31;
        const size_t qrow = rowb + d.r + ((size_t)qpos << d.dsh);
#pragma unroll
        for (int d0 = 0; d0 < 4; ++d0) qf[d0] = *(const bf16x8*)(T.Q + qrow * 1024 + d.h * 64 + d0 * 16 + hi * 8);
        if (tid < 132) breg = T.biasL2[(d.p * 16 + d.h) * 132 + tid];
    };
    int u = blk;
    if (u < NU) fetch(u);
#pragma unroll 1
    for (; u < NU; u += G) {
        const UnitId d = decode(u);
        const size_t rowb = (size_t)d.b * SEQ;
        const int qpos = 256 * d.qblk + 32 * w + l31;
        const size_t qrow = rowb + d.r + ((size_t)qpos << d.dsh);
#pragma unroll
        for (int k = 0; k < 6; ++k) {
            const int id = tid + 512 * k, j = id >> 3, pc = id & 7;
            *(LAS v4u*)(lds + K_OFF + j * KP + pc * 16) = kreg[k];
            *(LAS v4u*)(lds + V_OFF + j * KP + pc * 16) = vreg[k];
        }
        if (tid < 132) ((LAS float*)(lds + B_OFF))[tid] = breg;
        bf16x8 qc[4];
#pragma unroll
        for (int d0 = 0; d0 < 4; ++d0) qc[d0] = qf[d0];
        __syncthreads();
        fetch(u + G < NU ? u + G : u);
        f32x16 st[5];
#pragma unroll
        for (int kt = 0; kt < 5; ++kt) {
            f32x16 a = {};
#pragma unroll
            for (int d0 = 0; d0 < 4; ++d0) {
                const bf16x8 kf = *(const LAS bf16x8*)(lds + K_OFF + (32 * w + 32 * kt + l31) * KP + (16 * d0 + 8 * hi) * 2);
                a = MFMA32(kf, qc[d0], a);
            }
            st[kt] = a;
        }
        const LAS float* bl = (const LAS float*)(lds + B_OFF);
        float mx = -1e30f;
#pragma unroll
        for (int kt = 0; kt < 5; ++kt) {
            float bv[16];
#pragma unroll
            for (int rr = 0; rr < 16; ++rr) {
                const int delta = 128 + l31 - 32 * kt - crow(rr, hi);
                bv[rr] = bl[delta < 0 ? 0 : (delta > 128 ? 128 : delta)];
            }
            asm volatile("" : "+v"(bv[0]), "+v"(bv[1]), "+v"(bv[2]), "+v"(bv[3]), "+v"(bv[4]), "+v"(bv[5]), "+v"(bv[6]), "+v"(bv[7]), "+v"(bv[8]), "+v"(bv[9]), "+v"(bv[10]), "+v"(bv[11]), "+v"(bv[12]), "+v"(bv[13]), "+v"(bv[14]), "+v"(bv[15]));
#pragma unroll
            for (int rr = 0; rr < 16; ++rr) {
                const int kl = crow(rr, hi);
                const int delta = 128 + l31 - 32 * kt - kl;
                const int pk = 256 * d.qblk - 128 + 32 * w + 32 * kt + kl;
                const bool valid = (delta >= 0) && (delta <= 128) && (pk >= 0);
                const float s_ = valid ? st[kt][rr] + bv[rr] : -1e30f;
                st[kt][rr] = s_; mx = fmaxf(mx, s_);
            }
        }
        mx = fmaxf(mx, bperm(mx, lane ^ 32));
        float lsum = 0.f;
#pragma unroll
        for (int kt = 0; kt < 5; ++kt)
#pragma unroll
            for (int rr = 0; rr < 16; ++rr) { const float e = __builtin_amdgcn_exp2f(st[kt][rr] - mx); st[kt][rr] = e; lsum += e; }
        lsum += bperm(lsum, lane ^ 32);
        f32x16 o[2]; o[0] = (f32x16){}; o[1] = (f32x16){};
#pragma unroll
        for (int kt = 0; kt < 5; ++kt)
#pragma unroll
            for (int s2 = 0; s2 < 2; ++s2) {
                const bf16x8 pb = pack8(st[kt][8 * s2 + 0], st[kt][8 * s2 + 1], st[kt][8 * s2 + 2], st[kt][8 * s2 + 3], st[kt][8 * s2 + 4], st[kt][8 * s2 + 5], st[kt][8 * s2 + 6], st[kt][8 * s2 + 7]);
                const int jrow = 32 * w + 32 * kt + 16 * s2 + 4 * hi + q4;
#pragma unroll
                for (int dt = 0; dt < 2; ++dt) {
                    const LAS unsigned char* a0 = lds + V_OFF + jrow * KP + (32 * dt + 16 * gidx + 4 * p4) * 2;
                    const bf16x8 va = cat8(tr_read(a0), tr_read(a0 + 8 * KP));
                    o[dt] = MFMA32(va, pb, o[dt]);
                }
            }
        const float inv = 1.0f / lsum;
        bf16* orow = (d.p == 0 ? T.Oa : T.Ob + (size_t)(d.p - 1) * MTOK * AW) + qrow * 1024 + d.h * 64;
#pragma unroll
        for (int dt = 0; dt < 2; ++dt)
#pragma unroll
            for (int g4 = 0; g4 < 4; ++g4) {
                v2u wv_; wv_.x = pk2(o[dt][4 * g4] * inv, o[dt][4 * g4 + 1] * inv); wv_.y = pk2(o[dt][4 * g4 + 2] * inv, o[dt][4 * g4 + 3] * inv);
                *(v2u*)(orow + 32 * dt + 8 * g4 + 4 * hi) = wv_;
            }
        if (hi == 0) { f32x2_t sv = {mx, lsum}; *(f32x2_t*)(T.st + ((size_t)d.p * MTOK + qrow) * 32 + d.h * 2) = sv; }
        __syncthreads();
    }
}
}
namespace mpre {
constexpr int TP = 144;
constexpr int XC_OFF = 0, XM_OFF = 256 * TP, QT_OFF = 2 * 256 * TP, W_OFF = 3 * 256 * TP;
constexpr int RED_OFF = 0, GRED_OFF = 4 * 4096;
constexpr int WCV_OFF = W_OFF, WCB_OFF = WCV_OFF + 8192, WG_OFF = WCB_OFF + 2048, WGC_OFF = WG_OFF + 8192, WGM_OFF = WGC_OFF + 8192, LDS_BYTES = WGM_OFF + 8192;
struct Tensors { const bf16* xm; const bf16* halo; bf16* kimg; bf16* vimg; bf16* qimg; float* gp; bf16* S; const float* convw; const float* convb; const bf16* WcT; const bf16* WmT; const float* G; };

DI void phase(LAS unsigned char* lds, const Tensors& T, int G, int blk, int wv) {
    const int tid_ = wg_tid_local(wv);
    const int tid = tid_, lane = tid & 63, l31 = lane & 31, hi = lane >> 5, w = __builtin_amdgcn_readfirstlane(tid >> 6);
    const int g6 = lane, tp = w;
    const int ti = w & 1, si = (w >> 1) & 1, kh = w >> 2, kq = w >> 1;
    const int i16 = lane & 15, q4 = i16 >> 2, p4 = i16 & 3, gidx = (lane >> 4) & 1;
    const int NU = BATCH * NCHUNK * MH;
    if (blk >= NU) return;
    const int nitems = 2 * ((NU - blk + G - 1) / G);
    f32x16 sacc = {}, gacc = {};
    int hcache = -1;
    v2u xr[11];
    auto fetch = [&](int it) {
        const int u_ = blk + (it >> 1) * G, hh_ = it & 1, h_ = u_ & 3, c_ = (u_ >> 2) & 63, b_ = u_ >> 8;
        const int ch_ = 4 * (128 * h_ + 64 * hh_ + g6);
        const bf16* xrow = T.xm + ((size_t)b_ * SEQ + 64 * c_) * 2048 + ch_;
        const bf16* hrow = T.halo + ((size_t)(b_ * 64 + (c_ > 0 ? c_ - 1 : 0)) * 3) * 2048 + ch_;
#pragma unroll
        for (int k = 0; k < 11; ++k) {
            const int tl = 8 * tp - 3 + k;
            const bf16* p = tl >= 0 ? xrow + (size_t)tl * 2048 : hrow + (size_t)(3 + tl) * 2048;
            xr[k] = *(const v2u*)p;
        }
    };
    fetch(0);
#pragma unroll
    for (int k = 0; k < 11; ++k) asm volatile("" : "+v"(xr[k].x), "+v"(xr[k].y));
#pragma unroll 1
    for (int it = 0; it < nitems; ++it) {
        const int u = blk + (it >> 1) * G, hh = it & 1;
        const int h = u & 3, c = (u >> 2) & 63, b = u >> 8;
        const size_t tok0 = (size_t)b * SEQ + 64 * c;
        if (hh == 0) { sacc = (f32x16){}; gacc = (f32x16){}; }
        const int gg = 128 * h + 64 * hh + g6, ch = 4 * gg;
        float xmv[11][4];
#pragma unroll
        for (int k = 0; k < 11; ++k) {
            const bool zero = (8 * tp - 3 + k < 0) && (c == 0);
            const unsigned x0 = zero ? 0u : xr[k].x, x1 = zero ? 0u : xr[k].y;
            xmv[k][0] = bflo(x0); xmv[k][1] = bfhi(x0); xmv[k][2] = bflo(x1); xmv[k][3] = bfhi(x1);
        }
        if (h != hcache) {
            __syncthreads();
            for (int i = tid; i < 2048; i += NTHR) ((LAS float*)(lds + WCV_OFF))[i] = T.convw[(i >> 9) * 2048 + 512 * h + (i & 511)];
            ((LAS float*)(lds + WCB_OFF))[tid] = T.convb[512 * h + tid];
            for (int i = tid; i < 2048; i += NTHR) ((LAS float*)(lds + WG_OFF))[i] = T.G[(size_t)(128 * h) * 16 + i];
            for (int i = tid; i < 4096; i += NTHR) { ((LAS bf16*)(lds + WGC_OFF))[i] = T.WcT[(i >> 9) * 2048 + 512 * h + (i & 511)]; ((LAS bf16*)(lds + WGM_OFF))[i] = T.WmT[(i >> 9) * 2048 + 512 * h + (i & 511)]; }
            hcache = h;
            __syncthreads();
        }
        float cw[4][4], cb[4], Gm[4][4];
        {
            const int cl = 256 * hh + 4 * g6;
            const f32x4 b4 = *(const LAS f32x4*)(lds + WCB_OFF + cl * 4); cb[0] = b4[0]; cb[1] = b4[1]; cb[2] = b4[2]; cb[3] = b4[3];
#pragma unroll
            for (int tap = 0; tap < 4; ++tap) { const f32x4 w4 = *(const LAS f32x4*)(lds + WCV_OFF + (tap * 512 + cl) * 4); cw[tap][0] = w4[0]; cw[tap][1] = w4[1]; cw[tap][2] = w4[2]; cw[tap][3] = w4[3]; }
#pragma unroll
            for (int i = 0; i < 4; ++i) { const f32x4 g4 = *(const LAS f32x4*)(lds + WG_OFF + ((64 * hh + g6) * 16 + i * 4) * 4); Gm[i][0] = g4[0]; Gm[i][1] = g4[1]; Gm[i][2] = g4[2]; Gm[i][3] = g4[3]; }
        }
        __syncthreads();
        fetch(it + 1 < nitems ? it + 1 : it);
        unsigned xcp[4][4], xmp[4][4], qtp[4][4];
        float prev_xc[4], prev_q[4];
#pragma unroll
        for (int tl = 0; tl < 8; ++tl) {
            float xc[4], qt[4];
#pragma unroll
            for (int i = 0; i < 4; ++i) {
                float a = cb[i];
#pragma unroll
                for (int tap = 0; tap < 4; ++tap) a += cw[tap][i] * xmv[tl + tap][i];
                xc[i] = siluf_(a);
            }
#pragma unroll
            for (int i2 = 0; i2 < 4; ++i2) qt[i2] = xc[0] * Gm[0][i2] + xc[1] * Gm[1][i2] + xc[2] * Gm[2][i2] + xc[3] * Gm[3][i2];
            if (tl & 1) {
#pragma unroll
                for (int i = 0; i < 4; ++i) { xcp[i][tl >> 1] = pk2(prev_xc[i], xc[i]); qtp[i][tl >> 1] = pk2(prev_q[i], qt[i]); xmp[i][tl >> 1] = pk2(xmv[tl + 2][i], xmv[tl + 3][i]); }
            } else {
#pragma unroll
                for (int i = 0; i < 4; ++i) { prev_xc[i] = xc[i]; prev_q[i] = qt[i]; }
            }
        }
#pragma unroll
        for (int i = 0; i < 4; ++i) {
            const int off = (4 * g6 + i) * TP + 16 * tp;
            *(LAS v4u*)(lds + XC_OFF + off) = (v4u){xcp[i][0], xcp[i][1], xcp[i][2], xcp[i][3]};
            *(LAS v4u*)(lds + XM_OFF + off) = (v4u){xmp[i][0], xmp[i][1], xmp[i][2], xmp[i][3]};
            *(LAS v4u*)(lds + QT_OFF + off) = (v4u){qtp[i][0], qtp[i][1], qtp[i][2], qtp[i][3]};
        }
        __syncthreads();
#pragma unroll
        for (int k = 0; k < 11; ++k) asm volatile("" : "+v"(xr[k].x), "+v"(xr[k].y));
        {
            const size_t ibase = ((size_t)((b * 4 + h) * 64 + c) * 64 + 32 * hh) * 1024;
#pragma unroll
            for (int k = 0; k < 4; ++k) {
                const int id = tid + 512 * k, f = id >> 6, L = id & 63;
                const int row = 32 * (f >> 2) + (L & 31), colb = (16 * (f & 3) + 4 * (L >> 5)) * 2;
                const v2u k0 = *(const LAS v2u*)(lds + XC_OFF + row * TP + colb), k1 = *(const LAS v2u*)(lds + XC_OFF + row * TP + colb + 16);
                const v2u v0 = *(const LAS v2u*)(lds + XM_OFF + row * TP + colb), v1 = *(const LAS v2u*)(lds + XM_OFF + row * TP + colb + 16);
                *(v4u*)((char*)T.kimg + ibase + (size_t)id * 16) = (v4u){k0.x, k0.y, k1.x, k1.y};
                *(v4u*)((char*)T.vimg + ibase + (size_t)id * 16) = (v4u){v0.x, v0.y, v1.x, v1.y};
            }
#pragma unroll
            for (int k = 0; k < 4; ++k) {
                const int f = 4 * w + k, tt = f & 1, cb0 = 16 * (f >> 1) + 4 * hi + q4;
                const LAS unsigned char* pq = lds + QT_OFF + cb0 * TP + (32 * tt + 16 * gidx + 4 * p4) * 2;
                const s16x4 lo = tr_read(pq), hi4 = tr_read(pq + 8 * TP);
                *(bf16x8*)((char*)T.qimg + ibase + (size_t)f * 1024 + lane * 16) = cat8(lo, hi4);
            }
        }
#pragma unroll
        for (int ks = 0; ks < 8; ++ks) {
            const int crow0 = 128 * kh + 16 * ks + 8 * hi + q4;
            const LAS unsigned char* pa = lds + XC_OFF + crow0 * TP + (32 * si + 16 * gidx + 4 * p4) * 2;
            const LAS unsigned char* pb = lds + QT_OFF + crow0 * TP + (32 * ti + 16 * gidx + 4 * p4) * 2;
            const bf16x8 af = cat8(tr_read(pa), tr_read(pa + 4 * TP));
            const bf16x8 bfr = cat8(tr_read(pb), tr_read(pb + 4 * TP));
            sacc = MFMA32(af, bfr, sacc);
        }
#pragma unroll
        for (int ks = 0; ks < 4; ++ks) {
            const int crow1 = 64 * kq + 16 * ks + 8 * hi + q4;
            const LAS unsigned char* pc_ = lds + XC_OFF + crow1 * TP + (32 * ti + 16 * gidx + 4 * p4) * 2;
            const LAS unsigned char* pm_ = lds + XM_OFF + crow1 * TP + (32 * ti + 16 * gidx + 4 * p4) * 2;
            const bf16x8 ac = cat8(tr_read(pc_), tr_read(pc_ + 4 * TP));
            const bf16x8 am = cat8(tr_read(pm_), tr_read(pm_ + 4 * TP));
            const int cg = 256 * hh + 64 * kq + 16 * ks + 8 * hi;
            gacc = MFMA32(ac, *(const LAS bf16x8*)(lds + WGC_OFF + ((l31 & 7) * 512 + cg) * 2), gacc);
            gacc = MFMA32(am, *(const LAS bf16x8*)(lds + WGM_OFF + ((l31 & 7) * 512 + cg) * 2), gacc);
        }
        if (hh == 1) {
        __syncthreads();
        if (l31 < 8) {
#pragma unroll
            for (int r = 0; r < 16; ++r) ((LAS float*)(lds + GRED_OFF))[(kq * 64 + 32 * ti + crow(r, hi)) * 8 + l31] = gacc[r];
        }
        if (kh == 1) {
#pragma unroll
            for (int g4 = 0; g4 < 4; ++g4) *(LAS f32x4*)(lds + RED_OFF + ((w & 3) * 4 + g4) * 1024 + lane * 16) = (f32x4){sacc[4 * g4], sacc[4 * g4 + 1], sacc[4 * g4 + 2], sacc[4 * g4 + 3]};
        }
        __syncthreads();
        { const LAS float* gr = (const LAS float*)(lds + GRED_OFF);
          T.gp[((size_t)h * 8 + (tid & 7)) * MTOK + tok0 + (tid >> 3)] = gr[tid] + gr[512 + tid] + gr[1024 + tid] + gr[1536 + tid]; }
        if (kh == 0) {
            float tot[16];
#pragma unroll
            for (int g4 = 0; g4 < 4; ++g4) {
                const f32x4 o = *(const LAS f32x4*)(lds + RED_OFF + ((w & 3) * 4 + g4) * 1024 + lane * 16);
                tot[4 * g4] = sacc[4 * g4] + o[0]; tot[4 * g4 + 1] = sacc[4 * g4 + 1] + o[1]; tot[4 * g4 + 2] = sacc[4 * g4 + 2] + o[2]; tot[4 * g4 + 3] = sacc[4 * g4 + 3] + o[3];
            }
            char* sp = (char*)T.S + (size_t)((b * 4 + h) * 64 + c) * 8192;
#pragma unroll
            for (int kk = 0; kk < 2; ++kk)
                *(bf16x8*)(sp + ((2 * si + kk) * 2 + ti) * 1024 + lane * 16) = pack8(tot[8 * kk], tot[8 * kk + 1], tot[8 * kk + 2], tot[8 * kk + 3], tot[8 * kk + 4], tot[8 * kk + 5], tot[8 * kk + 6], tot[8 * kk + 7]);
        }
        __syncthreads();
        }
    }
}
}
namespace mscan {
constexpr int P_OFF = 0;
constexpr int V_OFF = 131072;
constexpr int DEN_OFF = V_OFF + 16384;
constexpr int NS_OFF = DEN_OFF + 4096;
constexpr int NSB_OFF = NS_OFF + 2048;
constexpr int TMP_OFF = NSB_OFF + 1024, SCW_OFF = TMP_OFF + 128, LDS_BYTES = SCW_OFF + 8 * 896;
static_assert(LDS_BYTES <= 163840 - 16, "scan LDS");
struct Tensors { const bf16* q; const bf16* k; const bf16* v; const bf16* S; const float* gp; const float* bif; float* scal; bf16* hm; };

DI float logsigmoid_(float x) { return fminf(x, 0.f) - log1pf(__expf(-fabsf(x))); }
DI void unpack8(bf16x8 f, float (&o)[8]) {
    const v4u u = __builtin_bit_cast(v4u, f);
    o[0] = bflo(u.x); o[1] = bfhi(u.x); o[2] = bflo(u.y); o[3] = bfhi(u.y); o[4] = bflo(u.z); o[5] = bfhi(u.z); o[6] = bflo(u.w); o[7] = bfhi(u.w);
}

template <int VAR> DI void unit(LAS unsigned char* lds, const Tensors& T, int bh, int es, int tid_in) {
    const int tid_ = wg_tid_local(tid_in);
    const int tid = tid_, lane = tid & 63, l31 = lane & 31, hi = lane >> 5, wid = __builtin_amdgcn_readfirstlane(tid >> 6);
    const int b = bh >> 2, h = bh & 3;
    LAS float* sTmp = (LAS float*)(lds + TMP_OFF);
    float* scal = T.scal + (size_t)bh * 3 * SEQ;
    {
        float li[8], cs[8];
        const float bi = T.bif[h], bf_ = T.bif[4 + h];
        float run = 0.f;
        const float* gpb = T.gp + (size_t)b * SEQ;
        const unsigned toff = (unsigned)tid * 8u;
#pragma unroll
        for (int k = 0; k < 8; ++k) { li[k] = bi; cs[k] = bf_; }
#pragma unroll
        for (int hh = 0; hh < 4; ++hh) {
            const float* pi = gpb + ((size_t)hh * 8 + h) * MTOK; const float* pf_ = gpb + ((size_t)hh * 8 + 4 + h) * MTOK;
            const f32x4 i0 = *(const f32x4*)(pi + toff), i1 = *(const f32x4*)(pi + toff + 4), f0 = *(const f32x4*)(pf_ + toff), f1 = *(const f32x4*)(pf_ + toff + 4);
#pragma unroll
            for (int k = 0; k < 4; ++k) { li[k] += i0[k]; li[4 + k] += i1[k]; cs[k] += f0[k]; cs[4 + k] += f1[k]; }
        }
#pragma unroll
        for (int k = 0; k < 8; ++k) { run += logsigmoid_(cs[k]); cs[k] = run; }
        float inc = run;
#pragma unroll
        for (int o = 1; o < 64; o <<= 1) { const float t = bperm(inc, lane >= o ? lane - o : lane); if (lane >= o) inc += t; }
        if (lane == 63) sTmp[wid] = inc;
        __syncthreads();
        float base = inc - run;
        for (int w2 = 0; w2 < wid; ++w2) base += sTmp[w2];
        __syncthreads();
        float av[8], mloc = -3.0e38f, cm[8];
#pragma unroll
        for (int k = 0; k < 8; ++k) { cs[k] += base; av[k] = li[k] - cs[k]; mloc = fmaxf(mloc, av[k]); cm[k] = mloc; }
        float minc = mloc;
#pragma unroll
        for (int o = 1; o < 64; o <<= 1) { const float t = bperm(minc, lane >= o ? lane - o : lane); if (lane >= o) minc = fmaxf(minc, t); }
        if (lane == 63) sTmp[wid] = minc;
        __syncthreads();
        float mbase = bperm(minc, lane > 0 ? lane - 1 : 0); if (lane == 0) mbase = -3.0e38f;
        for (int w2 = 0; w2 < wid; ++w2) mbase = fmaxf(mbase, sTmp[w2]);
#pragma unroll
        for (int k = 0; k < 8; ++k) {
            const float Mt = fmaxf(mbase, cm[k]);
            scal[0 * SEQ + 8 * tid + k] = av[k]; scal[1 * SEQ + 8 * tid + k] = Mt; scal[2 * SEQ + 8 * tid + k] = __expf(-(cs[k] + Mt));
        }
        ((LAS float*)(lds + NS_OFF))[tid] = 0.f; ((LAS unsigned short*)(lds + NSB_OFF))[tid] = 0;
        __threadfence();
        __syncthreads();
    }
#define MFMAV(a_, b_, c_) (VAR == 3 ? (c_) : MFMA32((a_), (b_), (c_)))
    f32x16 cst[2][2];
#pragma unroll
    for (int id = 0; id < 2; ++id)
#pragma unroll
        for (int ie = 0; ie < 2; ++ie) cst[id][ie] = (f32x16){};
    const char* qb = (const char*)T.q + (size_t)bh * NCHUNK * 65536 + (size_t)wid * 8192;
    const char* kb = (const char*)T.k + (size_t)bh * NCHUNK * 65536 + (size_t)wid * 8192;
    const char* vb = (const char*)T.v + (size_t)bh * NCHUNK * 65536 + (size_t)es * 8192 + (size_t)wid * 1024;
    const char* sb = (const char*)T.S + (size_t)bh * NCHUNK * 8192 + (size_t)(wid & 3) * 2048;
    const unsigned loff = (unsigned)lane * 16u;
    const float* sa = scal; const float* sm = scal + SEQ; const float* sthr = scal + 2 * SEQ;
    bf16* hg = T.hm + (size_t)b * SEQ * 2048 + 512 * h + 64 * es;
    int zv = 0; asm volatile("" : "+v"(zv));
    float Mc = sm[zv];
    LAS float* sca = (LAS float*)(lds + SCW_OFF) + wid * 224;
    LAS float* nsw = (LAS float*)(lds + NS_OFF) + 64 * wid; LAS unsigned short* nsb = (LAS unsigned short*)(lds + NSB_OFF) + 64 * wid;
    bf16x8 fb[16]; bf16x8 sf[2]; bf16x8 vnext;
    float a_l, m_l, thr_l;
#pragma unroll
    for (int g = 0; g < 8; ++g) fb[g] = *(const bf16x8*)(qb + g * 1024 + loff);
#pragma unroll
    for (int g = 0; g < 8; ++g) fb[8 + g] = *(const bf16x8*)(kb + ((g & 1) * 4 + (g >> 1)) * 1024 + loff);
    sf[0] = *(const bf16x8*)(sb + loff); sf[1] = *(const bf16x8*)(sb + 1024 + loff);
    vnext = *(const bf16x8*)(vb + loff);
    a_l = sa[lane]; m_l = sm[lane]; thr_l = sthr[lane];
    const int ksw = wid & 3, iew = wid >> 2;
#define STAGE_VW(dst_) do { const float mend_ = bperm(m_l, 63 + zv); sca[160 + lane] = __expf(a_l - mend_); \
        const f32x4 w0_ = *(const LAS f32x4*)(sca + 160 + 16 * ksw + 4 * hi), w1_ = *(const LAS f32x4*)(sca + 160 + 16 * ksw + 8 + 4 * hi); \
        float vv_[8]; unpack8(vnext, vv_); \
        *(LAS bf16x8*)((dst_) + wid * 1024 + lane * 16) = pack8(vv_[0] * w0_[0], vv_[1] * w0_[1], vv_[2] * w0_[2], vv_[3] * w0_[3], vv_[4] * w1_[0], vv_[5] * w1_[1], vv_[6] * w1_[2], vv_[7] * w1_[3]); } while (0)
    STAGE_VW(lds + V_OFF);
    bf16x8 vown = vnext;
    asm volatile("" :: "v"(a_l), "v"(m_l), "v"(thr_l), "v"(sf[0]), "v"(sf[1]));
#pragma unroll
    for (int g = 0; g < 16; ++g) asm volatile("" :: "v"(fb[g]));
    __syncthreads();
#pragma unroll 1
    for (int c = 0; c < NCHUNK; ++c) {
        const int cur = c & 1;
        LAS float* denp = (LAS float*)(lds + DEN_OFF) + cur * 512;
        LAS unsigned char* pbuf = lds + P_OFF + cur * 65536;
        const LAS unsigned char* vcur = lds + V_OFF + cur * 8192; LAS unsigned char* vnxt = lds + V_OFF + (cur ^ 1) * 8192;
        const int cn = (c + 1 < NCHUNK) ? c + 1 : c;
        const char* qn_ = qb + (size_t)cn * 65536; const char* kn_ = kb + (size_t)cn * 65536; const char* sn_ = sb + (size_t)cn * 8192;
        vnext = *(const bf16x8*)(vb + (size_t)cn * 65536 + loff);
        const float Mc2 = bperm(m_l, 63 + zv);
        const float Mt0 = bperm(m_l, l31), Mt1 = bperm(m_l, 32 + l31);
        const float thr0 = bperm(thr_l, l31), thr1 = bperm(thr_l, 32 + l31);
        { const float cwl = __expf(a_l - Mc2); sca[lane] = a_l; sca[64 + lane] = cwl; ((LAS unsigned short*)(sca + 128))[lane] = (unsigned short)(pk2(cwl, 0.f) & 0xffffu); }
        a_l = sa[64 * cn + lane]; m_l = sm[64 * cn + lane]; thr_l = sthr[64 * cn + lane];
        bf16x8 pf[2]; float psum[2];
        {
            const f32x4 aown0 = *(const LAS f32x4*)(sca + 16 * ksw + 4 * hi), aown1 = *(const LAS f32x4*)(sca + 16 * ksw + 8 + 4 * hi);
            const float aw[8] = {aown0[0], aown0[1], aown0[2], aown0[3], aown1[0], aown1[1], aown1[2], aown1[3]};
#pragma unroll
            for (int tt = 0; tt < 2; ++tt) {
                const int t = 32 * tt + l31; const float Mt = tt ? Mt1 : Mt0;
                float sv[8]; unpack8(sf[tt], sv);
                float pw[8]; float ps = 0.f;
#pragma unroll
                for (int j = 0; j < 8; ++j) { const int s = 16 * ksw + 8 * (j >> 2) + 4 * hi + (j & 3); pw[j] = (s <= t) ? sv[j] * __expf(aw[j] - Mt) : 0.f; ps += pw[j]; }
                pf[tt] = pack8(pw[0], pw[1], pw[2], pw[3], pw[4], pw[5], pw[6], pw[7]);
                psum[tt] = ps;
            }
            sf[0] = *(const bf16x8*)(sn_ + loff); sf[1] = *(const bf16x8*)(sn_ + 1024 + loff);
        }
        const float rs0 = __expf(Mc - Mt0), rs1 = __expf(Mc - Mt1);
#pragma unroll
        for (int ie = 0; ie < 2; ++ie) {
            f32x16 ao[2]; ao[0] = (f32x16){}; ao[1] = (f32x16){};
            float qn[2] = {0.f, 0.f};
#pragma unroll
            for (int id = 0; id < 2; ++id)
#pragma unroll
                for (int s = 0; s < 2; ++s) {
                    const int g0 = (id * 2 + s) * 2;
                    const bf16x8 cb = pack8(cst[id][ie][8 * s + 0], cst[id][ie][8 * s + 1], cst[id][ie][8 * s + 2], cst[id][ie][8 * s + 3], cst[id][ie][8 * s + 4], cst[id][ie][8 * s + 5], cst[id][ie][8 * s + 6], cst[id][ie][8 * s + 7]);
                    ao[0] = MFMAV(cb, fb[g0], ao[0]);
                    ao[1] = MFMAV(cb, fb[g0 + 1], ao[1]);
                    if (ie == 0) {
                        const v2u n0 = *(const LAS v2u*)(nsb + 32 * id + 16 * s + 4 * hi), n1 = *(const LAS v2u*)(nsb + 32 * id + 16 * s + 8 + 4 * hi);
#pragma unroll
                        for (int tt = 0; tt < 2; ++tt) {
                            const v4u qv = __builtin_bit_cast(v4u, fb[g0 + tt]);
                            float q_ = qn[tt];
                            q_ = dot2bf(qv.x, n0.x, q_); q_ = dot2bf(qv.y, n0.y, q_); q_ = dot2bf(qv.z, n1.x, q_); q_ = dot2bf(qv.w, n1.y, q_);
                            asm volatile("" : "+v"(q_));
                            qn[tt] = q_;
                        }
                    } else {
                        __builtin_amdgcn_sched_barrier(0);
                        if (VAR != 2) { fb[g0] = *(const bf16x8*)(qn_ + g0 * 1024 + loff);
                        fb[g0 + 1] = *(const bf16x8*)(qn_ + (g0 + 1) * 1024 + loff); }
                    }
                    __builtin_amdgcn_sched_barrier(0);
                }
            if (ie == 0) {
                float d0 = rs0 * qn[0] + (wid < 4 ? psum[0] : 0.f), d1 = rs1 * qn[1] + (wid < 4 ? psum[1] : 0.f);
                d0 += bperm(d0, lane ^ 32); d1 += bperm(d1, lane ^ 32);
                if (hi == 0) { denp[wid * 64 + l31] = d0; denp[wid * 64 + 32 + l31] = d1; }
            }
#pragma unroll
            for (int r = 0; r < 16; ++r) { ao[0][r] *= rs0; ao[1][r] *= rs1; }
            if (ie == iew) {
                ao[0] = MFMAV(vown, pf[0], ao[0]); ao[1] = MFMAV(vown, pf[1], ao[1]);
            }
#pragma unroll
            for (int tt = 0; tt < 2; ++tt)
#pragma unroll
                for (int g4 = 0; g4 < 4; ++g4) {
                    v2u pw_; pw_.x = pk2(ao[tt][4 * g4], ao[tt][4 * g4 + 1]); pw_.y = pk2(ao[tt][4 * g4 + 2], ao[tt][4 * g4 + 3]);
                    *(LAS v2u*)(pbuf + ((((wid * 2 + ie) * 2 + tt) * 4 + g4) * 512) + lane * 8) = pw_;
                }
        }
        const float decay = __expf(Mc - Mc2);
#pragma unroll
        for (int id = 0; id < 2; ++id)
#pragma unroll
            for (int ie = 0; ie < 2; ++ie)
#pragma unroll
                for (int r = 0; r < 16; ++r) cst[id][ie][r] *= decay;
        float nacc[2] = {0.f, 0.f};
#pragma unroll
        for (int ks = 0; ks < 4; ++ks) {
            const v2u cwb0 = *(const LAS v2u*)((const LAS unsigned short*)(sca + 128) + 16 * ks + 4 * hi), cwb1 = *(const LAS v2u*)((const LAS unsigned short*)(sca + 128) + 16 * ks + 8 + 4 * hi);
            bf16x8 vw[2];
            vw[0] = *(const LAS bf16x8*)(vcur + (0 * 4 + ks) * 1024 + lane * 16); vw[1] = *(const LAS bf16x8*)(vcur + (1 * 4 + ks) * 1024 + lane * 16);
#pragma unroll
            for (int id = 0; id < 2; ++id) {
                const int g = 8 + ks * 2 + id;
                cst[id][0] = MFMAV(fb[g], vw[0], cst[id][0]);
                cst[id][1] = MFMAV(fb[g], vw[1], cst[id][1]);
                {
                    const v4u kv = __builtin_bit_cast(v4u, fb[g]);
                    float na = nacc[id];
                    na = dot2bf(kv.x, cwb0.x, na); na = dot2bf(kv.y, cwb0.y, na); na = dot2bf(kv.z, cwb1.x, na); na = dot2bf(kv.w, cwb1.y, na);
                    asm volatile("" : "+v"(na));
                    nacc[id] = na;
                }
                __builtin_amdgcn_sched_barrier(0);
                if (VAR != 2) fb[g] = *(const bf16x8*)(kn_ + (id * 4 + ks) * 1024 + loff);
            }
            __builtin_amdgcn_sched_barrier(0);
        }
#pragma unroll
        for (int id = 0; id < 2; ++id) {
            float v = nacc[id]; v += bperm(v, lane ^ 32);
            if (hi == 0) { const float nv = decay * nsw[32 * id + l31] + v; nsw[32 * id + l31] = nv; nsb[32 * id + l31] = (unsigned short)(pk2(nv, 0.f) & 0xffffu); }
        }
        STAGE_VW(vnxt);
        vown = vnext;
        if (VAR != 4) __syncthreads();
#pragma unroll
        for (int tt = 0; tt < 2; ++tt) {
            float nm[4] = {0.f, 0.f, 0.f, 0.f};
#pragma unroll
            for (int src = 0; src < 8; ++src) {
                const v2u pv = *(const LAS v2u*)(pbuf + ((((src * 2 + iew) * 2 + tt) * 4 + ksw) * 512) + lane * 8);
                nm[0] += bflo(pv.x); nm[1] += bfhi(pv.x); nm[2] += bflo(pv.y); nm[3] += bfhi(pv.y);
            }
            const int t = 32 * tt + l31;
            float den = 0.f;
#pragma unroll
            for (int src = 0; src < 8; ++src) den += denp[src * 64 + t];
            const float dn = fmaxf(fabsf(den), tt ? thr1 : thr0);
            const float inv = 1.0f / dn;
            v2u wv; wv.x = pk2(nm[0] * inv, nm[1] * inv); wv.y = pk2(nm[2] * inv, nm[3] * inv);
            if (VAR == 0 || (VAR != 0 && wv.x == 0x12345678u && wv.y == 0x9abcdef0u)) *(v2u*)(hg + (size_t)(64 * c + t) * 2048 + 32 * iew + 8 * ksw + 4 * hi) = wv;
        }
        Mc = Mc2;
    }
    __syncthreads();
}
#undef MFMAV
#undef STAGE_VW
template <int VAR> DI void phase(LAS unsigned char* lds, const Tensors& T, int G, int blk, int wv) {
#pragma unroll 1
    for (int u = blk; u < 256; u += G) {
        const int xcd = u & 7, j = u >> 3;
        unit<VAR>(lds, T, xcd * 4 + (j >> 3), j & 7, wv);
    }
}
}
namespace mpost {
constexpr int GSTR = 576;
constexpr int XC_OFF = 0, WV_OFF = 128 * GSTR, PRM_OFF = WV_OFF + 128 * 64, LDS_BYTES = PRM_OFF + 4096;
struct Tensors { bf16* hm; const bf16* om; const bf16* kimg; const float* wv; const float* hng; const float* skip; };

DI void phase(LAS unsigned char* lds, const Tensors& T, int G, int blk, int wv) {
    const int tid_ = wg_tid_local(wv);
    int tid = tid_, t5 = tid >> 4, seg = tid & 15;
    const int NU = BATCH * NCHUNK * MH;
    if (blk >= NU) return;
    const int nitems = 2 * ((NU - blk + G - 1) / G);
    unsigned voff = (unsigned)(t5 * 4096 + seg * 8);
    v2u hxv[8], ogv[8], res[8]; v4u sr[8];
    auto rowbase = [&](int it) -> size_t { const int u_ = blk + (it >> 1) * G; return ((size_t)(u_ >> 8) * SEQ + 64 * ((u_ >> 2) & 63) + 32 * (it & 1)) * 2048 + 512 * (u_ & 3); };
    auto fetch_ho = [&](int it) {
        const size_t rb = rowbase(it);
        const char* hb = (const char*)(T.hm + rb); const char* ob = (const char*)(T.om + rb);
#pragma unroll
        for (int k = 0; k < 8; ++k) { hxv[k] = *(const v2u*)(hb + voff + k * 128); ogv[k] = *(const v2u*)(ob + voff + k * 128); }
    };
    auto fetch_stage = [&](int un) {
        const int u_ = blk + un * G, h_ = u_ & 3, c_ = (u_ >> 2) & 63, b_ = u_ >> 8;
        const char* base = (const char*)T.kimg + (size_t)((b_ * 4 + h_) * 64 + c_) * 65536;
        const int tq = tid;
#pragma unroll
        for (int k = 0; k < 2; ++k) {
            const int id = tq + 512 * k, pb = id & 7, g = id >> 3, ks = pb >> 1, hi_ = pb & 1;
            const char* src = base + (unsigned)(((g >> 3) * 4 + ks) * 1024 + (4 * (g & 7) + 32 * hi_) * 16);
            sr[4 * k] = *(const v4u*)(src); sr[4 * k + 1] = *(const v4u*)(src + 16); sr[4 * k + 2] = *(const v4u*)(src + 32); sr[4 * k + 3] = *(const v4u*)(src + 48);
        }
    };
    fetch_stage(0); fetch_ho(0);
#pragma unroll
    for (int k = 0; k < 8; ++k) asm volatile("" : "+v"(hxv[k].x), "+v"(hxv[k].y), "+v"(ogv[k].x), "+v"(ogv[k].y), "+v"(sr[k].x), "+v"(sr[k].y), "+v"(sr[k].z), "+v"(sr[k].w));
    int hcache = -1;
#pragma unroll 1
    for (int it = 0; it < nitems; ++it) {
        { int tq = tid_; asm volatile("" : "+v"(tq)); tid = tq; t5 = tq >> 4; seg = tq & 15; voff = (unsigned)(t5 * 4096 + seg * 8); }
        const int u = blk + (it >> 1) * G, pass = it & 1, h = u & 3;
        const int t = t5 + 32 * pass;
        if (pass == 0) {
            if (h != hcache) {
                __syncthreads();
                *(LAS f32x4*)(lds + WV_OFF + tid * 16) = *(const f32x4*)(T.wv + (size_t)(128 * h) * 16 + tid * 4);
                ((LAS float*)(lds + PRM_OFF))[tid] = T.hng[512 * h + tid]; ((LAS float*)(lds + PRM_OFF))[512 + tid] = T.skip[512 * h + tid];
                hcache = h;
            }
#pragma unroll
            for (int k = 0; k < 2; ++k) {
                const int id = tid + 512 * k, pb = id & 7, g = id >> 3, ks = pb >> 1, hi_ = pb & 1;
                const unsigned a0[4] = {sr[4 * k].x, sr[4 * k].y, sr[4 * k].z, sr[4 * k].w}, a1[4] = {sr[4 * k + 1].x, sr[4 * k + 1].y, sr[4 * k + 1].z, sr[4 * k + 1].w};
                const unsigned a2[4] = {sr[4 * k + 2].x, sr[4 * k + 2].y, sr[4 * k + 2].z, sr[4 * k + 2].w}, a3[4] = {sr[4 * k + 3].x, sr[4 * k + 3].y, sr[4 * k + 3].z, sr[4 * k + 3].w};
#pragma unroll
                for (int m = 0; m < 4; ++m) {
                    const int tok = 16 * ks + 8 * (m >> 1) + 4 * hi_ + 2 * (m & 1);
                    v2u e0, e1;
                    e0.x = (a0[m] & 0xffffu) | (a1[m] << 16); e0.y = (a2[m] & 0xffffu) | (a3[m] << 16);
                    e1.x = (a0[m] >> 16) | (a1[m] & 0xffff0000u); e1.y = (a2[m] >> 16) | (a3[m] & 0xffff0000u);
                    *(LAS v2u*)(lds + XC_OFF + g * GSTR + tok * 8) = e0;
                    *(LAS v2u*)(lds + XC_OFF + g * GSTR + (tok + 1) * 8) = e1;
                }
            }
            __syncthreads();
        }
        float uv[32]; float sum = 0.f;
#pragma unroll
        for (int k = 0; k < 8; ++k) {
            const int gi = seg + 16 * k;
            const float hv[4] = {bflo(hxv[k].x), bfhi(hxv[k].x), bflo(hxv[k].y), bfhi(hxv[k].y)};
            const float ov[4] = {bflo(ogv[k].x), bfhi(ogv[k].x), bflo(ogv[k].y), bfhi(ogv[k].y)};
            const LAS f32x4* wp = (const LAS f32x4*)(lds + WV_OFF + gi * 64);
            const f32x4 w0 = wp[0], w1 = wp[1], w2 = wp[2], w3 = wp[3];
#pragma unroll
            for (int o = 0; o < 4; ++o) {
                const float v = hv[0] * w0[o] + hv[1] * w1[o] + hv[2] * w2[o] + hv[3] * w3[o];
                const float x = v * ov[o];
                uv[4 * k + o] = x; sum += x;
            }
            __builtin_amdgcn_sched_barrier(0);
        }
        if (it > 0) {
            char* pb_ = (char*)(T.hm + rowbase(it - 1));
#pragma unroll
            for (int k = 0; k < 8; ++k) *(v2u*)(pb_ + voff + k * 128) = res[k];
        }
        fetch_ho(it + 1 < nitems ? it + 1 : it);
        if (pass == 1) fetch_stage((it >> 1) + 1 < (nitems >> 1) ? (it >> 1) + 1 : (it >> 1));
        sum += bperm(sum, tid ^ 1); sum += bperm(sum, tid ^ 2); sum += bperm(sum, tid ^ 4); sum += bperm(sum, tid ^ 8);
        const float mean = sum * (1.0f / 512.0f);
        float sq = 0.f;
#pragma unroll
        for (int i = 0; i < 32; ++i) { const float d = uv[i] - mean; sq += d * d; }
        sq += bperm(sq, tid ^ 1); sq += bperm(sq, tid ^ 2); sq += bperm(sq, tid ^ 4); sq += bperm(sq, tid ^ 8);
        const float rstd = 1.0f / sqrtf(sq * (1.0f / 512.0f) + EPS);
#pragma unroll
        for (int k = 0; k < 8; ++k) {
            const int gi = seg + 16 * k;
            const f32x4 gn = *(const LAS f32x4*)(lds + PRM_OFF + gi * 16), sk = *(const LAS f32x4*)(lds + PRM_OFF + 2048 + gi * 16);
            const v2u xc = *(const LAS v2u*)(lds + XC_OFF + gi * GSTR + t * 8);
            const float xv[4] = {bflo(xc.x), bfhi(xc.x), bflo(xc.y), bfhi(xc.y)};
            float r[4];
#pragma unroll
            for (int o = 0; o < 4; ++o) r[o] = (uv[4 * k + o] - mean) * rstd * gn[o] + sk[o] * xv[o];
            res[k].x = pk2(r[0], r[1]); res[k].y = pk2(r[2], r[3]);
            if (k & 1) __builtin_amdgcn_sched_barrier(0);
        }
#pragma unroll
        for (int k = 0; k < 8; ++k) asm volatile("" : "+v"(hxv[k].x), "+v"(hxv[k].y), "+v"(ogv[k].x), "+v"(ogv[k].y));
        if (pass == 1) {
#pragma unroll
            for (int k = 0; k < 8; ++k) asm volatile("" : "+v"(sr[k].x), "+v"(sr[k].y), "+v"(sr[k].z), "+v"(sr[k].w));
            __syncthreads();
        }
    }
    {
        char* pb_ = (char*)(T.hm + rowbase(nitems - 1));
#pragma unroll
        for (int k = 0; k < 8; ++k) *(v2u*)(pb_ + voff + k * 128) = res[k];
    }
}
}

DI void transpose_item(const float* W, int K, int N, bf16* WT, const float* kscale, LAS float* scr, int item, int lane) {
    const int nblk = N / 32, kb = item / nblk, nb = item % nblk, k0 = 64 * kb, n0 = 32 * nb;
#pragma unroll 8
    for (int i = 0; i < 32; ++i) { const int kk = 2 * i + (lane >> 5); float v = W[(size_t)(k0 + kk) * N + n0 + (lane & 31)]; if (kscale) v *= kscale[k0 + kk]; scr[kk * 33 + (lane & 31)] = v; }
    asm volatile("s_waitcnt lgkmcnt(0)" ::: "memory");
    const int cc = lane & 7;
#pragma unroll
    for (int j = 0; j < 4; ++j) { const int n = (lane >> 3) + 8 * j; const LAS float* s = scr + (8 * cc) * 33 + n;
        v4u o; o.x = pk2(s[0 * 33], s[1 * 33]); o.y = pk2(s[2 * 33], s[3 * 33]); o.z = pk2(s[4 * 33], s[5 * 33]); o.w = pk2(s[6 * 33], s[7 * 33]);
        *(v4u*)(WT + (size_t)(n0 + n) * K + k0 + 8 * cc) = o; }
    asm volatile("s_waitcnt lgkmcnt(0)" ::: "memory");
}
DI void rms_row_to_bf16(const float* xrow, bf16* orow, int lane) {
    const f32x4* xr = (const f32x4*)xrow + lane;
    f32x4 v[4]; float s = 0.f;
#pragma unroll
    for (int j = 0; j < 4; ++j) { v[j] = xr[64 * j]; s += (v[j][0] * v[j][0] + v[j][1] * v[j][1]) + (v[j][2] * v[j][2] + v[j][3] * v[j][3]); }
    const float r = 1.0f / sqrtf(wave_sum(s) * (1.0f / 1024.0f) + EPS);
    v2u* o8 = (v2u*)orow + lane;
#pragma unroll
    for (int j = 0; j < 4; ++j) { v2u w; w.x = pk2(v[j][0] * r, v[j][1] * r); w.y = pk2(v[j][2] * r, v[j][3] * r); o8[64 * j] = w; }
}
DI void rms_row_inplace(float* row, const float* g, int lane) {
    f32x4* xr = (f32x4*)row + lane; const f32x4* gr = (const f32x4*)g + lane;
    f32x4 v[4]; float s = 0.f;
#pragma unroll
    for (int j = 0; j < 4; ++j) { v[j] = xr[64 * j]; s += (v[j][0] * v[j][0] + v[j][1] * v[j][1]) + (v[j][2] * v[j][2] + v[j][3] * v[j][3]); }
    const float r = 1.0f / sqrtf(wave_sum(s) * (1.0f / 1024.0f) + EPS);
#pragma unroll
    for (int j = 0; j < 4; ++j) xr[64 * j] = v[j] * r * gr[64 * j];
}
constexpr int N_PHASES = 15;
constexpr int LDS_TOTAL = 163840, XB_LDS_OFF = 163840 - 16;
static_assert(pg8::STAGE_BYTES <= XB_LDS_OFF && att::LDS_BYTES <= XB_LDS_OFF && mpre::LDS_BYTES <= XB_LDS_OFF && mscan::LDS_BYTES <= XB_LDS_OFF && mpost::LDS_BYTES <= XB_LDS_OFF, "LDS map vs barrier words");
static_assert(pg8::STAGE_BYTES <= LDS_TOTAL && att::LDS_BYTES <= LDS_TOTAL && mpre::LDS_BYTES <= LDS_TOTAL && mscan::LDS_BYTES <= LDS_TOTAL && mpost::LDS_BYTES <= LDS_TOTAL, "LDS map");

struct Args { const float* in[18]; float* out; unsigned char* ws; int ph_lo, ph_hi; };

DI void prologue(const Args& a, LAS unsigned char* lds, int G, int blk, int wvi) {
    const int tid = wg_tid_local(wvi), lane = tid & 63, wave = __builtin_amdgcn_readfirstlane(tid >> 6);
    unsigned char* ws = a.ws;
    LAS float* scr = (LAS float*)(lds + wave * 16384);
    const int gw = blk * NWAVES + wave, NGW = G * NWAVES;
    constexpr int I_IN = (DM / 64) * (NIN / 32), I_PA = (AW / 64) * (DM / 32), I_PB = (MW / 64) * (DM / 32), I_OUT = (DM / 64) * (DM / 32);
    constexpr int NITEMS = I_IN + I_PA + I_PB + I_OUT;
    for (int it = gw; it < NITEMS; it += NGW) {
        int r = it;
        if (r < I_IN) { transpose_item(a.in[2], DM, NIN, (bf16*)(ws + WS_WIN), a.in[1], scr, r, lane); continue; } r -= I_IN;
        if (r < I_PA) { transpose_item(a.in[13], AW, DM, (bf16*)(ws + WS_WPA), nullptr, scr, r, lane); continue; } r -= I_PA;
        if (r < I_PB) { transpose_item(a.in[14], MW, DM, (bf16*)(ws + WS_WPB), nullptr, scr, r, lane); continue; } r -= I_PB;
        transpose_item(a.in[15], DM, DM, (bf16*)(ws + WS_WOUT), nullptr, scr, r, lane);
    }
    for (int m = gw; m < MTOK; m += NGW) rms_row_to_bf16(a.in[0] + (size_t)m * DM, (bf16*)(ws + WS_XN) + (size_t)m * DM, lane);
    float* tab = (float*)(ws + WS_TAB);
    const float* wq = a.in[6]; const float* wk = a.in[7]; const float* wv = a.in[8]; const float* wif = a.in[9]; const float* rb = a.in[16];
    const int gt = blk * NTHR + tid, NGT = G * NTHR;
    for (int i = gt; i < 2048 * 8; i += NGT) {
        const int c = i >> 3, j = i & 7, g = c >> 2, ii = c & 3;
        float sc = 0.f, sm = 0.f;
#pragma unroll
        for (int o = 0; o < 4; ++o) {
            sc += wq[g * 16 + ii * 4 + o] * wif[(size_t)(4 * g + o) * 8 + j] + wk[g * 16 + ii * 4 + o] * wif[(size_t)(2048 + 4 * g + o) * 8 + j];
            sm += wv[g * 16 + ii * 4 + o] * wif[(size_t)(4096 + 4 * g + o) * 8 + j];
        }
        ((bf16*)(tab + TAB_WC))[j * 2048 + c] = (bf16)(pk2(sc, 0.f) & 0xffffu); ((bf16*)(tab + TAB_WM))[j * 2048 + c] = (bf16)(pk2(sm, 0.f) & 0xffffu);
    }
    for (int i = gt; i < 512 * 16; i += NGT) {
        const int g = i >> 4, ii = (i >> 2) & 3, i2 = i & 3;
        float s = 0.f;
#pragma unroll
        for (int o = 0; o < 4; ++o) s += wq[g * 16 + ii * 4 + o] * wk[g * 16 + i2 * 4 + o];
        tab[TAB_G + i] = s * 0.04419417382415922f;
    }
    for (int i = gt; i < 3 * 16 * 132; i += NGT) {
        const int d = i % 132, ph = i / 132, p = ph >> 4, hh = ph & 15;
        tab[TAB_BIAS + i] = rb[BUCKET[p][d] * 16 + hh] * LOG2E;
    }
}

#define XB_TMO      128
#define XB_XCNT(j)  (256  + 64 * (j))
#define XB_XSUB(j)  (1280 + 64 * (j))
#define XB_XGEN(j)  (2304 + 64 * (j))
#define XB_TOP      3328
#define XB_TOPGEN   3392
#define XCD_BAR_WORDS 3456
#define XB_SPIN_CAP (1u << 18)
DI unsigned xb_ld(unsigned* p)              { return __hip_atomic_load(p, __ATOMIC_RELAXED, __HIP_MEMORY_SCOPE_AGENT); }
DI unsigned xb_add(unsigned* p, unsigned v) { return __hip_atomic_fetch_add(p, v, __ATOMIC_RELAXED, __HIP_MEMORY_SCOPE_AGENT); }
DI unsigned xb_xcc_id() { return (unsigned)__builtin_amdgcn_s_getreg((3 << 11) | 20) & 0xFu; }
#define XB_SPIN(cond, bar) do { unsigned _sp = 0; while (cond) { __builtin_amdgcn_s_sleep(1); \
    if ((++_sp & 255u) == 0u) { if (xb_ld(&(bar)[XB_TMO])) break; if (_sp > XB_SPIN_CAP) { atomicAdd(&(bar)[XB_TMO], 1u); break; } } } } while (0)
struct XcdBarrier { unsigned* bar; unsigned x; volatile LAS unsigned* st; };
DI XcdBarrier xcd_barrier_post(unsigned* bar, volatile LAS unsigned* st, int tid) {
    XcdBarrier b; b.bar = bar; b.x = xb_xcc_id(); b.st = st;
    if (tid == 0) (void)xb_add(&bar[XB_XCNT(b.x)], 1u);
    return b;
}
DI void xcd_barrier_complete(unsigned* bar, unsigned x, unsigned& nloc, unsigned& nx) {
    const unsigned G = gridDim.x * gridDim.y * gridDim.z;
    unsigned sum, cnt, mine, sp = 0u;
    for (;;) {
        sum = 0u; cnt = 0u; mine = 0u;
#pragma unroll
        for (unsigned j = 0; j < 16; ++j) { const unsigned c = xb_ld(&bar[XB_XCNT(j)]); sum += c; cnt += (c > 0u) ? 1u : 0u; mine = (j == x) ? c : mine; }
        if (sum == G) break;
        __builtin_amdgcn_s_sleep(1);
        if ((++sp & 255u) == 0u) { if (xb_ld(&bar[XB_TMO])) break; if (sp > XB_SPIN_CAP) { atomicAdd(&bar[XB_TMO], 1u); break; } }
    }
    nloc = mine > 0u ? mine : 1u; nx = cnt > 0u ? cnt : 1u;
}
DI void xcd_barrier(const XcdBarrier& b, int tid) {
    asm volatile("s_waitcnt vmcnt(0)" ::: "memory");
    __syncthreads();
    if (tid == 0) {
        unsigned* bar = b.bar;
        __builtin_amdgcn_s_waitcnt(0);
        unsigned nloc = b.st[0], nx = b.st[1];
        if (nloc == 0u) { xcd_barrier_complete(bar, b.x, nloc, nx); b.st[0] = nloc; b.st[1] = nx; }
        const unsigned old = xb_add(&bar[XB_XSUB(b.x)], 1u);
        const unsigned gen = old / nloc;
        if (old + 1u == (gen + 1u) * nloc) {
            __builtin_amdgcn_fence(__ATOMIC_RELEASE, "agent");
            asm volatile("s_waitcnt vmcnt(0)" ::: "memory");
            const unsigned og = xb_add(&bar[XB_TOP], 1u);
            const unsigned tg = og / nx;
            if (og + 1u == (tg + 1u) * nx) xb_add(&bar[XB_TOPGEN], 1u);
            else XB_SPIN(xb_ld(&bar[XB_TOPGEN]) == tg, bar);
            __builtin_amdgcn_fence(__ATOMIC_ACQUIRE, "agent");
            xb_add(&bar[XB_XGEN(b.x)], 1u);
            asm volatile("s_waitcnt vmcnt(0)" ::: "memory");
        } else {
            XB_SPIN(xb_ld(&bar[XB_XGEN(b.x)]) == gen, bar);
            __builtin_amdgcn_fence(__ATOMIC_ACQUIRE, "agent");
            asm volatile("s_waitcnt vmcnt(0)" ::: "memory");
        }
    }
    __syncthreads();
}

DI void grid_sync_(int tid) {
    asm volatile("s_waitcnt vmcnt(0) lgkmcnt(0)" ::: "memory");
    __builtin_amdgcn_fence(__ATOMIC_RELEASE, "workgroup");
    __builtin_amdgcn_s_barrier();
    if (tid == 0) {
        __builtin_amdgcn_fence(__ATOMIC_ACQUIRE, "workgroup");
        __builtin_amdgcn_fence(__ATOMIC_RELEASE, "agent");
        const __attribute__((address_space(4))) char* ia = (const __attribute__((address_space(4))) char*)__builtin_amdgcn_implicitarg_ptr();
        const unsigned long long p = *(const __attribute__((address_space(4))) unsigned long long*)(ia + 88);
        unsigned* bar = (unsigned*)(p + 32);
        const unsigned nwg = *(const unsigned*)(p + 40);
        const unsigned old = __hip_atomic_fetch_add(bar, 1u, __ATOMIC_RELAXED, __HIP_MEMORY_SCOPE_AGENT);
        if ((old & 0xffffu) == nwg - 1u) (void)__hip_atomic_fetch_add(bar, 65536u - nwg, __ATOMIC_RELAXED, __HIP_MEMORY_SCOPE_AGENT);
        const unsigned gen = old & 0xffff0000u;
        while ((__hip_atomic_load(bar, __ATOMIC_RELAXED, __HIP_MEMORY_SCOPE_AGENT) & 0xffff0000u) == gen) __builtin_amdgcn_s_sleep(1);
        __builtin_amdgcn_fence(__ATOMIC_ACQUIRE, "agent");
        __builtin_amdgcn_fence(__ATOMIC_RELEASE, "workgroup");
    }
    __builtin_amdgcn_s_barrier();
    __builtin_amdgcn_fence(__ATOMIC_ACQUIRE, "workgroup");
}

__global__ void __launch_bounds__(NTHR) mk_fwd(Args a) {
    extern __shared__ __attribute__((aligned(16))) unsigned char lds_raw[];
    LAS unsigned char* lds = (LAS unsigned char*)lds_raw;
    const int G = gridDim.x, blk = blockIdx.x;
    const int wv = __builtin_amdgcn_readfirstlane(threadIdx.x >> 6);
    volatile LAS unsigned* bst = (volatile LAS unsigned*)(lds + XB_LDS_OFF);
    if (wg_tid_local(wv) < 4) bst[wg_tid_local(wv)] = 0u;
    __syncthreads();
    (void)xcd_barrier_post((unsigned*)(a.ws + WS_CTL) + 1024, bst, wg_tid_local(wv));
#define XBAR() do { XcdBarrier xb_; xb_.bar = (unsigned*)(a.ws + WS_CTL) + 1024; xb_.x = xb_xcc_id(); xb_.st = (volatile LAS unsigned*)(lds + XB_LDS_OFF); xcd_barrier(xb_, wg_tid_local(wv)); } while (0)
    unsigned char* ws = a.ws;
    const int lo = a.ph_lo, hi = a.ph_hi;
    bf16* XN = (bf16*)(ws + WS_XN); bf16* WIN = (bf16*)(ws + WS_WIN);
#ifndef PH_MASK
#define PH_MASK 0x7fff
#endif
#define IN(k) (((PH_MASK >> (k)) & 1) && lo <= (k) && (k) < hi)
#ifndef REP_MASK
#define REP_MASK 0
#endif
#define REPEAT(k, body) do { body; if ((REP_MASK >> (k)) & 1) { XBAR(); body; } } while (0)
#define SEAM(k) do { if (IN(k) && IN((k) + 1)) { if (lo < 0) grid_sync_(wg_tid_local(wv)); XBAR(); } } while (0)
#define GEMM_PHASE(EPI, E, Aop, Bop, NN, KK) do { pg8::Gemm g{(const pg8::bf16_t*)(Aop), (const pg8::bf16_t*)(Bop), MTOK, (NN), (KK)}; pg8::StaticOrder S; S.init(MTOK, (NN), G, blk); \
        pg8::gemm_phase<EPI, pg8::StaticOrder, true, true>(lds, g, S, E, wg_tid_local(wv)); } while (0)

    if (IN(0)) { REPEAT(0, prologue(a, lds, G, blk, wv)); } SEAM(0);
    if (IN(1)) {
        pg8::EpiXM E{(bf16*)(ws + WS_R0), (bf16*)(ws + WS_HALO)};
        REPEAT(1, GEMM_PHASE(pg8::EpiXM, E, XN, WIN + (size_t)C_XM * DM, MW, DM));
    } SEAM(1);
    if (IN(2)) {
        const float* tab = (const float*)(ws + WS_TAB);
        mpre::Tensors T{(const bf16*)(ws + WS_R0), (const bf16*)(ws + WS_HALO), (bf16*)(ws + WS_R1), (bf16*)a.out, (bf16*)(ws + WS_R2), (float*)(ws + WS_GP), (bf16*)(ws + WS_S), a.in[4], a.in[5], (const bf16*)(tab + TAB_WC), (const bf16*)(tab + TAB_WM), tab + TAB_G};
        REPEAT(2, mpre::phase(lds, T, G, blk, wv));
    } SEAM(2);
    if (IN(3)) {
        mscan::Tensors T{(const bf16*)(ws + WS_R2), (const bf16*)(ws + WS_R1), (const bf16*)a.out, (const bf16*)(ws + WS_S), (const float*)(ws + WS_GP), a.in[10], (float*)(ws + WS_SCAL), (bf16*)(ws + WS_R0)};
        mscan::phase<0>(lds, T, G, blk, wv);
#ifdef SCAN_PROBE
        XBAR(); mscan::phase<SCAN_PROBE>(lds, T, G, blk, wv);
#endif
    } SEAM(3);
    if (IN(4)) {
        pg8::EpiSig E{(bf16*)(ws + WS_R2), MW, nullptr};
        REPEAT(4, GEMM_PHASE(pg8::EpiSig, E, XN, WIN + (size_t)C_OM * DM, MW, DM));
    } SEAM(4);
    if (IN(5)) {
        mpost::Tensors T{(bf16*)(ws + WS_R0), (const bf16*)(ws + WS_R2), (const bf16*)(ws + WS_R1), a.in[8], a.in[11], a.in[12]};
        mpost::phase(lds, T, G, blk, wv);
    } SEAM(5);
    if (IN(6)) {
        pg8::EpiZM E{(bf16*)(ws + WS_R0)};
        GEMM_PHASE(pg8::EpiZM, E, XN, WIN + (size_t)C_ZM * DM, MW, DM);
    }
    if (IN(7)) {
        pg8::EpiQKV E{(bf16*)(ws + WS_QA), (size_t)(WS_KA - WS_QA) / 2};
        REPEAT(7, GEMM_PHASE(pg8::EpiQKV, E, XN, WIN + (size_t)C_QA * DM, 3 * AW, DM));
    } SEAM(7);
    if (IN(8)) {
        att::Tensors T{(const bf16*)(ws + WS_QA), (const bf16*)(ws + WS_KA), (const bf16*)(ws + WS_VA), (bf16*)(ws + WS_O1), (bf16*)a.out, (float*)(ws + WS_ST), (const float*)(ws + WS_TAB) + TAB_BIAS};
        REPEAT(8, att::phase(lds, T, G, blk, wv));
    } SEAM(8);
    if (IN(9)) {
        pg8::EpiZA E{(const bf16*)(ws + WS_O1), (const bf16*)a.out, (const bf16*)a.out + (size_t)MTOK * AW, (const float*)(ws + WS_ST), (bf16*)(ws + WS_A1)};
        REPEAT(9, GEMM_PHASE(pg8::EpiZA, E, XN, WIN + (size_t)C_ZA * DM, AW, DM));
    }
    if (IN(10)) {
        pg8::EpiSig E{(bf16*)(ws + WS_G), 2 * DM, a.in[3]};
        REPEAT(10, GEMM_PHASE(pg8::EpiSig, E, XN, WIN + (size_t)C_G * DM, 2 * DM, DM));
    } SEAM(10);
    if (IN(11)) {
        pg8::EpiYA E{(bf16*)(ws + WS_G)};
        GEMM_PHASE(pg8::EpiYA, E, ws + WS_A1, ws + WS_WPA, DM, AW);
    }
    if (IN(11) && IN(12)) {
        asm volatile("s_waitcnt vmcnt(0)" ::: "memory"); __syncthreads();
        if (wg_tid_local(wv) == 0) { __builtin_amdgcn_fence(__ATOMIC_ACQUIRE, "agent"); asm volatile("s_waitcnt vmcnt(0)" ::: "memory"); }
        __syncthreads();
    }
    if (IN(12)) {
        pg8::EpiYM E{(const bf16*)(ws + WS_G), (bf16*)(ws + WS_MRG)};
        REPEAT(12, GEMM_PHASE(pg8::EpiYM, E, ws + WS_R0, ws + WS_WPB, DM, MW));
    } SEAM(12);
    if (IN(13)) {
        pg8::EpiOut E{a.in[0], a.out};
        REPEAT(13, GEMM_PHASE(pg8::EpiOut, E, ws + WS_MRG, ws + WS_WOUT, DM, DM));
    } SEAM(13);
#ifdef EXTRA_SYNCS
    if (IN(13) && IN(14)) { for (int i = 0; i < EXTRA_SYNCS; ++i) XBAR(); }
#endif
    if (IN(14)) {
        const int lane = wg_tid_local(wv) & 63, wave = wv;
        for (int m = blk * NWAVES + wave; m < MTOK; m += G * NWAVES) rms_row_inplace(a.out + (size_t)m * DM, a.in[17], lane);
    }
#undef IN
#undef SEAM
#undef GEMM_PHASE
}

#ifndef MK_ONE_LAUNCH
#define MK_ONE_LAUNCH 0
#endif
extern "C" void kernel_launch(void* const* d_in, const int* in_sizes, int n_in, void* d_out, int out_size, void* d_ws, size_t ws_size, hipStream_t stream) {
    static int grid = 0;
    if (grid == 0) {
        if (n_in != 18 || in_sizes[0] != MTOK * DM || out_size != MTOK * DM || ws_size < WS_END) { fprintf(stderr, "kernel_launch: unexpected shapes (n_in %d, ws %zu)\n", n_in, ws_size); grid = -1; return; }
        int dev = 0, cus = 0, per_cu = 0;
        (void)hipGetDevice(&dev); (void)hipDeviceGetAttribute(&cus, hipDeviceAttributeMultiprocessorCount, dev);
        if (hipFuncSetAttribute((const void*)mk_fwd, hipFuncAttributeMaxDynamicSharedMemorySize, LDS_TOTAL) != hipSuccess) { fprintf(stderr, "kernel_launch: hipFuncSetAttribute failed\n"); grid = -1; return; }
        if (hipOccupancyMaxActiveBlocksPerMultiprocessor(&per_cu, (const void*)mk_fwd, NTHR, LDS_TOTAL) != hipSuccess || per_cu < 1) { fprintf(stderr, "kernel_launch: occupancy query says %d\n", per_cu); per_cu = 1; }
        (void)hipGetLastError();
        grid = cus * (per_cu > 1 ? 1 : per_cu);
    }
    if (grid < 0) return;
    if (hipMemsetAsync((char*)d_ws + WS_CTL, 0, 65536, stream) != hipSuccess) { fprintf(stderr, "kernel_launch: hipMemsetAsync failed\n"); return; }
    Args a{};
    for (int i = 0; i < 18; ++i) a.in[i] = (const float*)d_in[i];
    a.out = (float*)d_out; a.ws = (unsigned char*)d_ws;
#if MK_ONE_LAUNCH
    a.ph_lo = 0; a.ph_hi = N_PHASES;
    void* args[] = {&a};
    hipError_t e = hipLaunchCooperativeKernel((const void*)mk_fwd, dim3(grid), dim3(NTHR), args, LDS_TOTAL, stream);
    if (e != hipSuccess) fprintf(stderr, "cooperative launch failed: %s (grid %d)\n", hipGetErrorString(e), grid);
#else
    for (int p = 0; p < N_PHASES; ++p) {
        a.ph_lo = p; a.ph_hi = p + 1;
        hipLaunchKernelGGL(mk_fwd, dim3(grid), dim3(NTHR), LDS_TOTAL, stream, a);
    }
#endif
}
```

```cpp
#define MK_ONE_LAUNCH 1
#include <hip/hip_runtime.h>
#include <hip/hip_cooperative_groups.h>
#include <cstdio>
#include <cstdint>
namespace cg = cooperative_groups;
#define LAS __attribute__((address_space(3)))
#define GAS __attribute__((address_space(1)))
typedef unsigned short bf16;
typedef unsigned v4u __attribute__((ext_vector_type(4)));
typedef unsigned v2u __attribute__((ext_vector_type(2)));
typedef float f32x4 __attribute__((ext_vector_type(4)));
typedef float f32x16 __attribute__((ext_vector_type(16)));
typedef short bf16x8 __attribute__((ext_vector_type(8)));
typedef short s16x4 __attribute__((ext_vector_type(4)));
typedef float f32x2_t __attribute__((ext_vector_type(2)));
typedef __bf16 bf16x2_t __attribute__((ext_vector_type(2)));

constexpr int NWAVES = 8, NTHR = 512;
constexpr int BATCH = 8, SEQ = 4096, DM = 1024, MTOK = BATCH * SEQ;
constexpr int AH = 16, AHD = 64, AW = 1024;
constexpr int MH = 4, MHD = 512, MW = 2048;
constexpr int NIN = 12288;
constexpr int C_QA = 0, C_KA = 1024, C_VA = 2048, C_ZA = 3072, C_XM = 4096, C_ZM = 6144, C_OM = 8192, C_G = 10240;
constexpr int CHUNK = 64, NCHUNK = SEQ / CHUNK;
constexpr float EPS = 1e-6f;
constexpr float LOG2E = 1.4426950408889634f;
constexpr float QSCALE = 0.125f * 1.4426950408889634f;

constexpr size_t MiB = 1u << 20;
constexpr size_t WS_CTL = 0;
constexpr size_t WS_WIN = 1 * MiB;
constexpr size_t WS_WPA = 25 * MiB;
constexpr size_t WS_WPB = 27 * MiB;
constexpr size_t WS_WOUT = 31 * MiB;
constexpr size_t WS_TAB = 33 * MiB;
constexpr size_t WS_GP = 34 * MiB;
constexpr size_t WS_SCAL = 38 * MiB;
constexpr size_t WS_HALO = 40 * MiB;
constexpr size_t WS_ST = 34 * MiB;
constexpr size_t WS_XN = 46 * MiB;
constexpr size_t WS_R0 = 110 * MiB;
constexpr size_t WS_R1 = 238 * MiB;
constexpr size_t WS_R2 = 366 * MiB;
constexpr size_t WS_S = 494 * MiB;
constexpr size_t WS_END = 512 * MiB;
constexpr size_t WS_QA = 238 * MiB, WS_KA = 302 * MiB, WS_VA = 366 * MiB;
constexpr size_t WS_O1 = 430 * MiB;
constexpr size_t WS_A1 = 238 * MiB;
constexpr size_t WS_G = 302 * MiB;
constexpr size_t WS_MRG = 430 * MiB;
constexpr int TAB_WC = 0;
constexpr int TAB_WM = 2048 * 8;
constexpr int TAB_G = 2 * 2048 * 8;
constexpr int TAB_BIAS = TAB_G + 512 * 16;
constexpr int TAB_END = TAB_BIAS + 3 * 16 * 132;

__device__ const unsigned char BUCKET[3][132] = {
 {0,1,2,3,4,5,6,7,8,9,10,11,12,13,14,15,16,16,16,16,16,16,17,17,17,17,17,17,17,17,18,18,18,18,18,18,18,18,18,18,19,19,19,19,19,19,19,19,19,19,19,19,19,19,20,20,20,20,20,20,20,20,20,20,20,20,20,20,20,20,20,20,20,21,21,21,21,21,21,21,21,21,21,21,21,21,21,21,21,21,21,21,21,21,21,21,21,21,21,22,22,22,22,22,22,22,22,22,22,22,22,22,22,22,22,22,22,22,22,22,22,22,22,22,22,22,22,22,22,0,0,0},
 {0,4,8,12,16,16,17,17,18,18,19,19,19,19,20,20,20,20,20,21,21,21,21,21,21,22,22,22,22,22,22,22,22,22,23,23,23,23,23,23,23,23,23,23,23,23,24,24,24,24,24,24,24,24,24,24,24,24,24,24,24,24,25,25,25,25,25,25,25,25,25,25,25,25,25,25,25,25,25,25,25,25,25,26,26,26,26,26,26,26,26,26,26,26,26,26,26,26,26,26,26,26,26,26,26,26,26,26,26,26,26,26,26,27,27,27,27,27,27,27,27,27,27,27,27,27,27,27,27,0,0,0},
 {0,16,18,19,20,21,21,22,22,23,23,23,24,24,24,24,25,25,25,25,25,26,26,26,26,26,26,26,26,27,27,27,27,27,27,27,27,27,27,28,28,28,28,28,28,28,28,28,28,28,28,28,29,29,29,29,29,29,29,29,29,29,29,29,29,29,29,29,29,29,30,30,30,30,30,30,30,30,30,30,30,30,30,30,30,30,30,30,30,30,30,30,30,30,30,31,31,31,31,31,31,31,31,31,31,31,31,31,31,31,31,31,31,31,31,31,31,31,31,31,31,31,31,31,31,31,31,31,31,0,0,0}};

#define DI __device__ __forceinline__
DI unsigned pk2(float lo, float hi) { f32x2_t v = {lo, hi}; bf16x2_t b = __builtin_convertvector(v, bf16x2_t); return __builtin_bit_cast(unsigned, b); }
DI float bflo(unsigned u) { return __uint_as_float(u << 16); }
DI float bfhi(unsigned u) { return __uint_as_float(u & 0xffff0000u); }
DI float rcpf_(float x) { return __builtin_amdgcn_rcpf(x); }
DI float sigmoidf_(float x) { return rcpf_(1.0f + __builtin_amdgcn_exp2f(-LOG2E * x)); }
DI float siluf_(float x) { return x * rcpf_(1.0f + __builtin_amdgcn_exp2f(-LOG2E * x)); }
DI float wave_sum(float v) {
#pragma unroll
    for (int o = 1; o < 64; o <<= 1) v += __shfl_xor(v, o);
    return v;
}
DI int wg_tid(int wv) { return wv * 64 + (int)__builtin_amdgcn_mbcnt_hi(~0u, __builtin_amdgcn_mbcnt_lo(~0u, 0u)); }
DI int wg_tid_local(int wv) { int z; asm volatile("v_mov_b32 %0, 0" : "=v"(z)); return wv * 64 + (int)__builtin_amdgcn_mbcnt_hi(~0u, __builtin_amdgcn_mbcnt_lo(~0u, (unsigned)z)); }
DI float dot2bf(unsigned a, unsigned b, float acc) { return __builtin_amdgcn_fdot2_f32_bf16(__builtin_bit_cast(bf16x2_t, a), __builtin_bit_cast(bf16x2_t, b), acc, false); }
DI float bperm(float v, int srclane) { return __int_as_float(__builtin_amdgcn_ds_bpermute(srclane << 2, __float_as_int(v))); }
DI int crow(int r, int hi) { return (r & 3) + 8 * (r >> 2) + 4 * hi; }
#define MFMA32(a, b, c) __builtin_amdgcn_mfma_f32_32x32x16_bf16((a), (b), (c), 0, 0, 0)
DI s16x4 tr_read(const LAS unsigned char* p) { return __builtin_bit_cast(s16x4, __builtin_amdgcn_ds_read_tr16_b64_v4i16((LAS s16x4*)p)); }
DI bf16x8 cat8(s16x4 lo, s16x4 hi) { return __builtin_shufflevector(lo, hi, 0, 1, 2, 3, 4, 5, 6, 7); }
DI bf16x8 pack8(float a0, float a1, float a2, float a3, float a4, float a5, float a6, float a7) {
    v4u p; p.x = pk2(a0, a1); p.y = pk2(a2, a3); p.z = pk2(a4, a5); p.w = pk2(a6, a7); return __builtin_bit_cast(bf16x8, p);
}
namespace pg8 {
#define PG8_LAS __attribute__((address_space(3)))
typedef unsigned short bf16_t;
typedef short bf16x8 __attribute__((ext_vector_type(8)));
typedef float f32x4 __attribute__((ext_vector_type(4)));
typedef unsigned u32x4 __attribute__((ext_vector_type(4)));
constexpr int BM = 256, BK = 64, HALF = 128, HTB = HALF * BK * 2  , STAGE_BYTES = 8 * HTB, NXCD = 8, WGM = 8;

__host__ __device__ __forceinline__ int lds_byte(int r, int c) { const int st = (r >> 4) * 2 + (c >> 5), rr = r & 15, cc = c & 31, ob = rr * 64 + cc * 2; return st * 1024 + (ob ^ (((ob >> 9) & 1) << 5)); }
__host__ __device__ __forceinline__ void stage_rc(int b, int& R, int& C) { const int st = b / 1024, sb = b % 1024, swz = sb ^ (((sb >> 9) & 1) << 5); R = (st >> 1) * 16 + swz / 64; C = (st & 1) * 32 + (swz % 64) / 2; }
__host__ __device__ __forceinline__ int perm32(int rho) { const int n = rho >> 4, i = rho & 15; return 8 * (i >> 2) + 4 * n + (i & 3); }

struct Unit { int pm, pn; };
struct Gemm { const bf16_t* A; const bf16_t* Bt; int M, N, K; };

struct StaticOrder {
    int nM, nN, nwg, G, c;
    __host__ __device__ void init(int M, int N, int G_, int c_) { nM = M / BM; nN = N / BM; nwg = nM * nN; G = G_; c = c_; }
    __host__ __device__ bool next(int i, Unit& u) const {
        const long L = (long)i * G + c; if (L >= nwg) return false;
        int wgid = (int)L; { const int q = nwg / NXCD, r = nwg % NXCD, xcd = wgid % NXCD, off = wgid / NXCD; wgid = (xcd < r ? xcd * (q + 1) : r * (q + 1) + (xcd - r) * q) + off; }
        const int nig = WGM * nN, gid = wgid / nig, fm = gid * WGM, gsz = (nM - fm) < WGM ? (nM - fm) : WGM;
        u.pm = fm + ((wgid % nig) % gsz); u.pn = (wgid % nig) / gsz; return true;
    }
    __device__ __forceinline__ void a_ready(const Unit&) const {}
    __device__ __forceinline__ void done(const Unit&) const {}
};

}
namespace pg8 {
#define EPI_OPERATOR \
    static constexpr bool PERM = true, AFTER_DRAIN = false; \
    __device__ __forceinline__ void operator()(const f32x4 (&acc)[2][2][4][2], const Unit& u, int wr, int wc, int fr, int fq) const { \
        const int row0 = u.pm * BM + wr * 64 + fr, col0 = u.pn * BM + wc * 32 + 8 * fq; \
        _Pragma("unroll") for (int ai = 0; ai < 2; ++ai) \
        _Pragma("unroll") for (int m = 0; m < 4; ++m) \
        _Pragma("unroll") for (int bj = 0; bj < 2; ++bj) store8(row0 + ai * HALF + m * 16, col0 + bj * HALF, acc[ai][bj][m][0], acc[ai][bj][m][1]); \
    }
DI ::v4u pack_bf16x8(f32x4 v0, f32x4 v1) { ::v4u w; w.x = ::pk2(v0[0], v0[1]); w.y = ::pk2(v0[2], v0[3]); w.z = ::pk2(v1[0], v1[1]); w.w = ::pk2(v1[2], v1[3]); return w; }
DI void unpack_bf16x8(::v4u w, f32x4& v0, f32x4& v1) { v0 = (f32x4){::bflo(w.x), ::bfhi(w.x), ::bflo(w.y), ::bfhi(w.y)}; v1 = (f32x4){::bflo(w.z), ::bfhi(w.z), ::bflo(w.w), ::bfhi(w.w)}; }

struct EpiXM {
    bf16_t* xm; bf16_t* halo;
    DI void store8(int row, int col, f32x4 v0, f32x4 v1) const {
        const ::v4u w = pack_bf16x8(v0, v1);
        *(::v4u*)(xm + (size_t)row * 2048 + col) = w;
        const int r = row & 63;
        if (r >= 61) *(::v4u*)(halo + ((size_t)(row >> 6) * 3 + (r - 61)) * 2048 + col) = w;
    }
    EPI_OPERATOR
};
struct EpiSig {
    bf16_t* out; int ldc; const float* bias;
    DI void store8(int row, int col, f32x4 v0, f32x4 v1) const {
        if (bias) { v0 += *(const f32x4*)(bias + col); v1 += *(const f32x4*)(bias + col + 4); }
#pragma unroll
        for (int i = 0; i < 4; ++i) { v0[i] = ::sigmoidf_(v0[i]); v1[i] = ::sigmoidf_(v1[i]); }
        *(::v4u*)(out + (size_t)row * ldc + col) = pack_bf16x8(v0, v1);
    }
    EPI_OPERATOR
};
struct EpiRaw2 {
    bf16_t* o0; bf16_t* o1;
    DI void store8(int row, int col, f32x4 v0, f32x4 v1) const {
        bf16_t* base = (col >> 11) ? o1 : o0;
        *(::v4u*)(base + (size_t)row * 2048 + (col & 2047)) = pack_bf16x8(v0, v1);
    }
    EPI_OPERATOR
};
struct EpiZM {
    bf16_t* buf;
    DI void store8(int row, int col, f32x4 v0, f32x4 v1) const {
        ::v4u* p = (::v4u*)(buf + (size_t)row * 2048 + col);
        f32x4 h0, h1; unpack_bf16x8(*p, h0, h1);
#pragma unroll
        for (int i = 0; i < 4; ++i) { h0[i] *= ::siluf_(v0[i]); h1[i] *= ::siluf_(v1[i]); }
        *p = pack_bf16x8(h0, h1);
    }
    EPI_OPERATOR
};
struct EpiQKV {
    bf16_t* q; size_t stride;
    DI void store8(int row, int col, f32x4 v0, f32x4 v1) const {
        const int t = col >> 10, c = col & 1023;
        bf16_t* base = q + (size_t)t * stride;
        if (t == 0) { v0 *= ::QSCALE; v1 *= ::QSCALE; }
        *(::v4u*)(base + (size_t)row * 1024 + c) = pack_bf16x8(v0, v1);
    }
    EPI_OPERATOR
};
struct EpiZA {
    const bf16_t* o0; const bf16_t* o1; const bf16_t* o2; const float* st; bf16_t* a1;
    DI void store8(int row, int col, f32x4 v0, f32x4 v1) const {
        const int head = col >> 6;
        const ::f32x2_t s0 = *(const ::f32x2_t*)(st + ((size_t)(0 * ::MTOK + row) * 16 + head) * 2);
        const ::f32x2_t s1 = *(const ::f32x2_t*)(st + ((size_t)(1 * ::MTOK + row) * 16 + head) * 2);
        const ::f32x2_t s2 = *(const ::f32x2_t*)(st + ((size_t)(2 * ::MTOK + row) * 16 + head) * 2);
        const float mx = fmaxf(s0.x, fmaxf(s1.x, s2.x));
        float w0 = __builtin_amdgcn_exp2f(s0.x - mx) * s0.y, w1 = __builtin_amdgcn_exp2f(s1.x - mx) * s1.y, w2 = __builtin_amdgcn_exp2f(s2.x - mx) * s2.y;
        const float inv = ::rcpf_(w0 + w1 + w2); w0 *= inv; w1 *= inv; w2 *= inv;
        const size_t off = (size_t)row * 1024 + col;
        f32x4 a0, a1v, b0, b1, c0, c1;
        unpack_bf16x8(*(const ::v4u*)(o0 + off), a0, a1v); unpack_bf16x8(*(const ::v4u*)(o1 + off), b0, b1); unpack_bf16x8(*(const ::v4u*)(o2 + off), c0, c1);
        f32x4 r0 = a0 * w0 + b0 * w1 + c0 * w2, r1 = a1v * w0 + b1 * w1 + c1 * w2;
#pragma unroll
        for (int i = 0; i < 4; ++i) { r0[i] *= ::siluf_(v0[i]); r1[i] *= ::siluf_(v1[i]); }
        *(::v4u*)(a1 + off) = pack_bf16x8(r0, r1);
    }
    EPI_OPERATOR
};
struct EpiYA {
    bf16_t* g;
    DI void store8(int row, int col, f32x4 v0, f32x4 v1) const {
        ::v4u* p = (::v4u*)(g + (size_t)row * 2048 + col);
        f32x4 h0, h1; unpack_bf16x8(*p, h0, h1);
        *p = pack_bf16x8(h0 * v0, h1 * v1);
    }
    EPI_OPERATOR
};
struct EpiYM {
    const bf16_t* g; bf16_t* mrg;
    DI void store8(int row, int col, f32x4 v0, f32x4 v1) const {
        f32x4 t0, t1, g0, g1;
        unpack_bf16x8(*(const ::v4u*)(g + (size_t)row * 2048 + col), t0, t1);
        unpack_bf16x8(*(const ::v4u*)(g + (size_t)row * 2048 + 1024 + col), g0, g1);
        *(::v4u*)(mrg + (size_t)row * 1024 + col) = pack_bf16x8(t0 + g0 * v0, t1 + g1 * v1);
    }
    EPI_OPERATOR
};
struct EpiOut {
    const float* x; float* out;
    DI void store8(int row, int col, f32x4 v0, f32x4 v1) const {
        const size_t off = (size_t)row * 1024 + col;
        *(f32x4*)(out + off) = *(const f32x4*)(x + off) + v0;
        *(f32x4*)(out + off + 4) = *(const f32x4*)(x + off + 4) + v1;
    }
    EPI_OPERATOR
};
struct EpiNull {
    float* sink;
    DI void store8(int row, int col, f32x4 v0, f32x4 v1) const { if (v0[0] == 1.234567e-30f && v1[3] == 7.654321e-31f) sink[(size_t)row * 1024 + (col & 1023)] = v0[1] + v1[2] + v0[2] + v0[3] + v1[0] + v1[1]; }
    EPI_OPERATOR
};
struct EpiProbe {
    bf16_t* out; int ldc; int rowmask;
    DI void store8(int row, int col, f32x4 v0, f32x4 v1) const {
#pragma unroll
        for (int i = 0; i < 4; ++i) { v0[i] = ::sigmoidf_(v0[i]); v1[i] = ::sigmoidf_(v1[i]); }
        *(::v4u*)(out + (size_t)(row & rowmask) * ldc + col) = pack_bf16x8(v0, v1);
    }
    EPI_OPERATOR
};
}
namespace pg8 {
template <class Epi, class Sched, bool ALIGN_EPI = false, bool SP2 = false>
__device__ __forceinline__ void gemm_phase(PG8_LAS unsigned char* lds, const Gemm g, const Sched& S, const Epi& E, const int tid_in) {
    const int tid = tid_in, wid = __builtin_amdgcn_readfirstlane(tid >> 6), lane = tid & 63, wr = wid >> 2, wc = wid & 3, fr = lane & 15, fq = lane >> 4;
    const int K = g.K, nt = K / BK;
    unsigned voffA[2], voffB[2];
#pragma unroll
    for (int i = 0; i < 2; ++i) { int R, C; stage_rc(tid * 16 + i * 8192, R, C); const int Rb = Epi::PERM ? ((R & ~31) + perm32(R & 31)) : R;
        voffA[i] = (unsigned)(R * K + C) * 2u; voffB[i] = (unsigned)(Rb * K + C) * 2u; }
    const size_t kstep = (size_t)(BK * 2);
    const size_t hstep = (size_t)HALF * K * 2;
    const size_t tstep = 2 * hstep;
    const unsigned ldsw = (unsigned)wid * 1024u;
    const int aoff = lds_byte(wr * 64 + fr, fq * 8), boff = lds_byte(wc * 32 + fr, fq * 8);
#define PG8_SA(b, h) (((b) * 2 + (h)) * HTB)
#define PG8_SB(b, h) ((4 + (b) * 2 + (h)) * HTB)
#define PG8_STAGE(bufoff, gbase, voff) do { _Pragma("unroll") for (int _i = 0; _i < 2; ++_i) \
        __builtin_amdgcn_global_load_lds((const unsigned*)((const char*)(gbase) + (voff)[_i]), (PG8_LAS unsigned*)(lds + (bufoff) + ldsw + _i * 8192), 16, 0, 0); } while (0)
#define PG8_LDA(dst, b, h) do { _Pragma("unroll") for (int m = 0; m < 4; ++m) _Pragma("unroll") for (int k = 0; k < 2; ++k) dst[m][k] = *(const PG8_LAS bf16x8*)(lds + PG8_SA(b, h) + aoff + m * 2048 + k * 1024); } while (0)
#define PG8_LDB(dst, b, h) do { _Pragma("unroll") for (int n = 0; n < 2; ++n) _Pragma("unroll") for (int k = 0; k < 2; ++k) dst[n][k] = *(const PG8_LAS bf16x8*)(lds + PG8_SB(b, h) + boff + n * 2048 + k * 1024); } while (0)
#define PG8_MMA(ai, bj, At, Bt) do { __builtin_amdgcn_s_setprio(1); _Pragma("unroll") for (int m = 0; m < 4; ++m) _Pragma("unroll") for (int n = 0; n < 2; ++n) _Pragma("unroll") for (int k = 0; k < 2; ++k) \
        acc[ai][bj][m][n] = __builtin_amdgcn_mfma_f32_16x16x32_bf16(Bt[n][k], At[m][k], acc[ai][bj][m][n], 0, 0, 0); __builtin_amdgcn_s_setprio(0); } while (0)
#define PG8_WAIT_V(n) asm volatile("s_waitcnt vmcnt(" #n ")" ::: "memory")
#define PG8_WAIT_L(n) asm volatile("s_waitcnt lgkmcnt(" #n ")" ::: "memory")
#define PG8_BAR __builtin_amdgcn_s_barrier()
#define PG8_SCHED __builtin_amdgcn_sched_barrier(0)
    Unit cur, nxt; int ui = 0;
    if (!S.next(0, cur)) return;
    f32x4 acc[2][2][4][2];
#pragma unroll
    for (int a = 0; a < 2; ++a)
#pragma unroll
        for (int b = 0; b < 2; ++b)
#pragma unroll
            for (int m = 0; m < 4; ++m)
#pragma unroll
                for (int n = 0; n < 2; ++n) acc[a][b][m][n] = (f32x4){0.f, 0.f, 0.f, 0.f};
    bf16x8 At[4][2], B0[2][2], B1[2][2];
    const char* cA = (const char*)g.A + (size_t)cur.pm * tstep; const char* cB = (const char*)g.Bt + (size_t)cur.pn * tstep;
    S.a_ready(cur);
    if constexpr (SP2) {
        PG8_STAGE(PG8_SB(0, 0), cB, voffB); PG8_STAGE(PG8_SB(0, 1), cB + hstep, voffB); PG8_STAGE(PG8_SA(0, 0), cA, voffA); PG8_STAGE(PG8_SA(0, 1), cA + hstep, voffA);
        if (wr == 1) PG8_BAR;
        PG8_WAIT_V(2); PG8_BAR;
        PG8_STAGE(PG8_SB(1, 0), cB + kstep, voffB); PG8_STAGE(PG8_SA(1, 0), cA + kstep, voffA); PG8_STAGE(PG8_SB(1, 1), cB + hstep + kstep, voffB);
        PG8_WAIT_V(6); PG8_BAR;
    } else {
        PG8_STAGE(PG8_SB(0, 0), cB, voffB); PG8_STAGE(PG8_SA(0, 0), cA, voffA); PG8_STAGE(PG8_SB(0, 1), cB + hstep, voffB); PG8_STAGE(PG8_SA(0, 1), cA + hstep, voffA);
        if (wr == 1) PG8_BAR;
        PG8_WAIT_V(4); PG8_BAR;
        PG8_STAGE(PG8_SB(1, 0), cB + kstep, voffB); PG8_STAGE(PG8_SA(1, 0), cA + kstep, voffA); PG8_STAGE(PG8_SB(1, 1), cB + hstep + kstep, voffB);
        PG8_WAIT_V(6); PG8_BAR;
    }
    for (;;) {
        const bool has_next = S.next(ui + 1, nxt);
        const char* nA = has_next ? (const char*)g.A + (size_t)nxt.pm * tstep : cA; const char* nB = has_next ? (const char*)g.Bt + (size_t)nxt.pn * tstep : cB;
        for (int t = 0; t < nt; t += 2) {
            const bool last = (t == nt - 2);
            const char* a1 = cA + (size_t)(t + 1) * kstep;
            const char* a2 = last ? nA : cA + (size_t)(t + 2) * kstep; const char* b2 = last ? nB : cB + (size_t)(t + 2) * kstep;
            const char* a3 = a2 + kstep; const char* b3 = b2 + kstep;
            if (last && has_next) S.a_ready(nxt);
            if constexpr (SP2) {
            PG8_LDB(B0, 0, 0); PG8_LDB(B1, 0, 1); PG8_SCHED; PG8_LDA(At, 0, 0); PG8_STAGE(PG8_SA(1, 1), a1 + hstep, voffA);
            PG8_WAIT_V(8); PG8_WAIT_L(0); PG8_BAR; PG8_MMA(0, 0, At, B0); PG8_MMA(0, 1, At, B1); PG8_BAR; PG8_SCHED;
            PG8_LDA(At, 0, 1); PG8_STAGE(PG8_SB(0, 0), b2, voffB); PG8_STAGE(PG8_SB(0, 1), b2 + hstep, voffB); PG8_STAGE(PG8_SA(0, 0), a2, voffA);
            PG8_WAIT_V(8); PG8_WAIT_L(0); PG8_BAR; PG8_MMA(1, 0, At, B0); PG8_MMA(1, 1, At, B1); PG8_BAR; PG8_SCHED;
            PG8_LDB(B0, 1, 0); PG8_LDB(B1, 1, 1); PG8_SCHED; PG8_LDA(At, 1, 0); PG8_STAGE(PG8_SA(0, 1), a2 + hstep, voffA);
            PG8_WAIT_V(8); PG8_WAIT_L(0); PG8_BAR; PG8_MMA(0, 0, At, B0); PG8_MMA(0, 1, At, B1); PG8_BAR; PG8_SCHED;
            PG8_LDA(At, 1, 1); PG8_STAGE(PG8_SB(1, 0), b3, voffB); PG8_STAGE(PG8_SB(1, 1), b3 + hstep, voffB); PG8_STAGE(PG8_SA(1, 0), a3, voffA);
            PG8_WAIT_V(8); PG8_WAIT_L(0); PG8_BAR; PG8_MMA(1, 0, At, B0); PG8_MMA(1, 1, At, B1); PG8_BAR; PG8_SCHED;
            } else {
            PG8_LDB(B0, 0, 0); PG8_SCHED; PG8_LDA(At, 0, 0); PG8_STAGE(PG8_SA(1, 1), a1 + hstep, voffA);
            PG8_WAIT_L(8); PG8_BAR; PG8_WAIT_L(0); PG8_MMA(0, 0, At, B0); PG8_BAR; PG8_SCHED;
            PG8_LDB(B1, 0, 1); PG8_STAGE(PG8_SB(0, 0), b2, voffB);
            PG8_BAR; PG8_WAIT_L(0); PG8_MMA(0, 1, At, B1); PG8_BAR;
            PG8_LDA(At, 0, 1); PG8_STAGE(PG8_SA(0, 0), a2, voffA);
            PG8_BAR; PG8_WAIT_L(0); PG8_MMA(1, 0, At, B0); PG8_BAR; PG8_SCHED;
            PG8_STAGE(PG8_SB(0, 1), b2 + hstep, voffB);
            PG8_WAIT_V(6); PG8_BAR; PG8_MMA(1, 1, At, B1); PG8_BAR;
            PG8_LDB(B0, 1, 0); PG8_SCHED; PG8_LDA(At, 1, 0); PG8_STAGE(PG8_SA(0, 1), a2 + hstep, voffA);
            PG8_WAIT_L(8); PG8_BAR; PG8_WAIT_L(0); PG8_MMA(0, 0, At, B0); PG8_BAR; PG8_SCHED;
            PG8_LDB(B1, 1, 1); PG8_STAGE(PG8_SB(1, 0), b3, voffB);
            PG8_BAR; PG8_WAIT_L(0); PG8_MMA(0, 1, At, B1); PG8_BAR;
            PG8_LDA(At, 1, 1); PG8_STAGE(PG8_SA(1, 0), a3, voffA);
            PG8_BAR; PG8_WAIT_L(0); PG8_MMA(1, 0, At, B0); PG8_BAR; PG8_SCHED;
            PG8_STAGE(PG8_SB(1, 1), b3 + hstep, voffB);
            PG8_WAIT_V(6); PG8_BAR; PG8_MMA(1, 1, At, B1); PG8_BAR;
            }
        }
        if constexpr (ALIGN_EPI) { if (wr == 0) PG8_BAR; }
        if constexpr (!Epi::AFTER_DRAIN) { E(acc, cur, wr, wc, fr, fq); S.done(cur); }
        if (!has_next) break;
#pragma unroll
        for (int a = 0; a < 2; ++a)
#pragma unroll
            for (int b = 0; b < 2; ++b)
#pragma unroll
                for (int m = 0; m < 4; ++m)
#pragma unroll
                    for (int n = 0; n < 2; ++n) acc[a][b][m][n] = (f32x4){0.f, 0.f, 0.f, 0.f};
        cur = nxt; cA = nA; cB = nB; ++ui;
        if constexpr (ALIGN_EPI) { if (wr == 1) PG8_BAR; }
    }
    PG8_WAIT_V(0);
    if constexpr (!ALIGN_EPI) { if (wr == 0) PG8_BAR; }
    PG8_BAR;
    if constexpr (Epi::AFTER_DRAIN) { E.fused(acc, cur, wr, wc, fr, fq, lds, wid, lane); S.done(cur); }
#undef PG8_SA
#undef PG8_SB
#undef PG8_STAGE
#undef PG8_LDA
#undef PG8_LDB
#undef PG8_MMA
#undef PG8_WAIT_V
#undef PG8_WAIT_L
#undef PG8_BAR
#undef PG8_SCHED
}
}
namespace att {
constexpr int KP = 144;
constexpr int K_OFF = 0, V_OFF = 384 * KP, B_OFF = 2 * 384 * KP, LDS_BYTES = B_OFF + 132 * 4;
struct Tensors { const bf16* Q; const bf16* K; const bf16* V; bf16* Oa; bf16* Ob; float* st; const float* biasL2; };

struct UnitId { int b, h, p, dsh, r, qblk; };
DI UnitId decode(int u) { UnitId d; const int bh = u / 48, rem = u % 48; d.p = rem >> 4; const int w16 = rem & 15; d.b = bh >> 4; d.h = bh & 15; d.dsh = 2 * d.p; const int nqb = 16 >> d.dsh; d.r = w16 / nqb; d.qblk = w16 % nqb; return d; }

DI void phase(LAS unsigned char* lds, const Tensors& T, int G, int blk, int wv) {
    const int tid_ = wg_tid_local(wv);
    const int tid = tid_, lane = tid & 63, l31 = lane & 31, hi = lane >> 5, w = __builtin_amdgcn_readfirstlane(tid >> 6);
    const int NU = BATCH * AH * 48;
    const int i16 = lane & 15, q4 = i16 >> 2, p4 = i16 & 3, gidx = (lane >> 4) & 1;
    v4u kreg[6], vreg[6]; bf16x8 qf[4]; float breg = 0.f;
    auto fetch = [&](int u) {
        const UnitId d = decode(u);
        const size_t rowb = (size_t)d.b * SEQ;
#pragma unroll
        for (int k = 0; k < 6; ++k) {
            const int id = tid + 512 * k, j = id >> 3, pc = id & 7;
            int pos = 256 * d.qblk - 128 + j; pos = pos < 0 ? 0 : pos;
            const size_t off = (rowb + d.r + ((size_t)pos << d.dsh)) * 1024 + d.h * 64 + pc * 8;
            kreg[k] = *(const v4u*)(T.K + off); vreg[k] = *(const v4u*)(T.V + off);
        }
        const int qpos = 256 * d.qblk + 32 * w + l31;
        const size_t qrow = rowb + d.r + ((size_t)qpos << d.dsh);
#pragma unroll
        for (int d0 = 0; d0 < 4; ++d0) qf[d0] = *(const bf16x8*)(T.Q + qrow * 1024 + d.h * 64 + d0 * 16 + hi * 8);
        if (tid < 132) breg = T.biasL2[(d.p * 16 + d.h) * 132 + tid];
    };
    int u = blk;
    if (u < NU) fetch(u);
#pragma unroll 1
    for (; u < NU; u += G) {
        const UnitId d = decode(u);
        const size_t rowb = (size_t)d.b * SEQ;
        const int qpos = 256 * d.qblk + 32 * w + l31;
        const size_t qrow = rowb + d.r + ((size_t)qpos << d.dsh);
#pragma unroll
        for (int k = 0; k < 6; ++k) {
            const int id = tid + 512 * k, j = id >> 3, pc = id & 7;
            *(LAS v4u*)(lds + K_OFF + j * KP + pc * 16) = kreg[k];
            *(LAS v4u*)(lds + V_OFF + j * KP + pc * 16) = vreg[k];
        }
        if (tid < 132) ((LAS float*)(lds + B_OFF))[tid] = breg;
        bf16x8 qc[4];
#pragma unroll
        for (int d0 = 0; d0 < 4; ++d0) qc[d0] = qf[d0];
        __syncthreads();
        fetch(u + G < NU ? u + G : u);
        f32x16 st[5];
#pragma unroll
        for (int kt = 0; kt < 5; ++kt) {
            f32x16 a = {};
#pragma unroll
            for (int d0 = 0; d0 < 4; ++d0) {
                const bf16x8 kf = *(const LAS bf16x8*)(lds + K_OFF + (32 * w + 32 * kt + l31) * KP + (16 * d0 + 8 * hi) * 2);
                a = MFMA32(kf, qc[d0], a);
            }
            st[kt] = a;
        }
        const LAS float* bl = (const LAS float*)(lds + B_OFF);
        float mx = -1e30f;
#pragma unroll
        for (int kt = 0; kt < 5; ++kt) {
            float bv[16];
#pragma unroll
            for (int rr = 0; rr < 16; ++rr) {
                const int delta = 128 + l31 - 32 * kt - crow(rr, hi);
                bv[rr] = bl[delta < 0 ? 0 : (delta > 128 ? 128 : delta)];
            }
            asm volatile("" : "+v"(bv[0]), "+v"(bv[1]), "+v"(bv[2]), "+v"(bv[3]), "+v"(bv[4]), "+v"(bv[5]), "+v"(bv[6]), "+v"(bv[7]), "+v"(bv[8]), "+v"(bv[9]), "+v"(bv[10]), "+v"(bv[11]), "+v"(bv[12]), "+v"(bv[13]), "+v"(bv[14]), "+v"(bv[15]));
#pragma unroll
            for (int rr = 0; rr < 16; ++rr) {
                const int kl = crow(rr, hi);
                const int delta = 128 + l31 - 32 * kt - kl;
                const int pk = 256 * d.qblk - 128 + 32 * w + 32 * kt + kl;
                const bool valid = (delta >= 0) && (delta <= 128) && (pk >= 0);
                const float s_ = valid ? st[kt][rr] + bv[rr] : -1e30f;
                st[kt][rr] = s_; mx = fmaxf(mx, s_);
            }
        }
        mx = fmaxf(mx, bperm(mx, lane ^ 32));
        float lsum = 0.f;
#pragma unroll
        for (int kt = 0; kt < 5; ++kt)
#pragma unroll
            for (int rr = 0; rr < 16; ++rr) { const float e = __builtin_amdgcn_exp2f(st[kt][rr] - mx); st[kt][rr] = e; lsum += e; }
        lsum += bperm(lsum, lane ^ 32);
        f32x16 o[2]; o[0] = (f32x16){}; o[1] = (f32x16){};
#pragma unroll
        for (int kt = 0; kt < 5; ++kt)
#pragma unroll
            for (int s2 = 0; s2 < 2; ++s2) {
                const bf16x8 pb = pack8(st[kt][8 * s2 + 0], st[kt][8 * s2 + 1], st[kt][8 * s2 + 2], st[kt][8 * s2 + 3], st[kt][8 * s2 + 4], st[kt][8 * s2 + 5], st[kt][8 * s2 + 6], st[kt][8 * s2 + 7]);
                const int jrow = 32 * w + 32 * kt + 16 * s2 + 4 * hi + q4;
#pragma unroll
                for (int dt = 0; dt < 2; ++dt) {
                    const LAS unsigned char* a0 = lds + V_OFF + jrow * KP + (32 * dt + 16 * gidx + 4 * p4) * 2;
                    const bf16x8 va = cat8(tr_read(a0), tr_read(a0 + 8 * KP));
                    o[dt] = MFMA32(va, pb, o[dt]);
                }
            }
        const float inv = rcpf_(lsum);
        bf16* orow = (d.p == 0 ? T.Oa : T.Ob + (size_t)(d.p - 1) * MTOK * AW) + qrow * 1024 + d.h * 64;
#pragma unroll
        for (int dt = 0; dt < 2; ++dt)
#pragma unroll
            for (int g4 = 0; g4 < 4; ++g4) {
                v2u wv_; wv_.x = pk2(o[dt][4 * g4] * inv, o[dt][4 * g4 + 1] * inv); wv_.y = pk2(o[dt][4 * g4 + 2] * inv, o[dt][4 * g4 + 3] * inv);
                *(v2u*)(orow + 32 * dt + 8 * g4 + 4 * hi) = wv_;
            }
        if (hi == 0) { f32x2_t sv = {mx, lsum}; *(f32x2_t*)(T.st + ((size_t)d.p * MTOK + qrow) * 32 + d.h * 2) = sv; }
        __syncthreads();
    }
}
}
namespace mpre {
constexpr int TP = 144;
constexpr int XC_OFF = 0, XM_OFF = 256 * TP, QT_OFF = 2 * 256 * TP, W_OFF = 3 * 256 * TP;
constexpr int RED_OFF = 0, GRED_OFF = 4 * 4096;
constexpr int WCV_OFF = W_OFF, WCB_OFF = WCV_OFF + 8192, WG_OFF = WCB_OFF + 2048, WGC_OFF = WG_OFF + 8192, WGM_OFF = WGC_OFF + 8192, LDS_BYTES = WGM_OFF + 8192;
struct Tensors { const bf16* xm; const bf16* halo; bf16* kimg; bf16* vimg; bf16* qimg; float* gp; bf16* S; const float* convw; const float* convb; const bf16* WcT; const bf16* WmT; const float* G; };

DI void phase(LAS unsigned char* lds, const Tensors& T, int G, int blk, int wv) {
    const int tid_ = wg_tid_local(wv);
    const int tid = tid_, lane = tid & 63, l31 = lane & 31, hi = lane >> 5, w = __builtin_amdgcn_readfirstlane(tid >> 6);
    const int g6 = lane, tp = w;
    const int ti = w & 1, si = (w >> 1) & 1, kh = w >> 2, kq = w >> 1;
    const int i16 = lane & 15, q4 = i16 >> 2, p4 = i16 & 3, gidx = (lane >> 4) & 1;
    const int NU = BATCH * NCHUNK * MH;
    if (blk >= NU) return;
    const int nitems = 2 * ((NU - blk + G - 1) / G);
    f32x16 sacc = {}, gacc = {};
    int hcache = -1;
    v2u xr[11];
    auto fetch = [&](int it) {
        const int u_ = blk + (it >> 1) * G, hh_ = it & 1, h_ = u_ & 3, c_ = (u_ >> 2) & 63, b_ = u_ >> 8;
        const int ch_ = 4 * (128 * h_ + 64 * hh_ + g6);
        const bf16* xrow = T.xm + ((size_t)b_ * SEQ + 64 * c_) * 2048 + ch_;
        const bf16* hrow = T.halo + ((size_t)(b_ * 64 + (c_ > 0 ? c_ - 1 : 0)) * 3) * 2048 + ch_;
#pragma unroll
        for (int k = 0; k < 11; ++k) {
            const int tl = 8 * tp - 3 + k;
            const bf16* p = tl >= 0 ? xrow + (size_t)tl * 2048 : hrow + (size_t)(3 + tl) * 2048;
            xr[k] = *(const v2u*)p;
        }
    };
    fetch(0);
#pragma unroll
    for (int k = 0; k < 11; ++k) asm volatile("" : "+v"(xr[k].x), "+v"(xr[k].y));
#pragma unroll 1
    for (int it = 0; it < nitems; ++it) {
        const int u = blk + (it >> 1) * G, hh = it & 1;
        const int h = u & 3, c = (u >> 2) & 63, b = u >> 8;
        const size_t tok0 = (size_t)b * SEQ + 64 * c;
        if (hh == 0) { sacc = (f32x16){}; gacc = (f32x16){}; }
        const int gg = 128 * h + 64 * hh + g6, ch = 4 * gg;
        float xmv[11][4];
#pragma unroll
        for (int k = 0; k < 11; ++k) {
            const bool zero = (8 * tp - 3 + k < 0) && (c == 0);
            const unsigned x0 = zero ? 0u : xr[k].x, x1 = zero ? 0u : xr[k].y;
            xmv[k][0] = bflo(x0); xmv[k][1] = bfhi(x0); xmv[k][2] = bflo(x1); xmv[k][3] = bfhi(x1);
        }
        if (h != hcache) {
            __syncthreads();
            for (int i = tid; i < 2048; i += NTHR) ((LAS float*)(lds + WCV_OFF))[i] = T.convw[(i >> 9) * 2048 + 512 * h + (i & 511)];
            ((LAS float*)(lds + WCB_OFF))[tid] = T.convb[512 * h + tid];
            for (int i = tid; i < 2048; i += NTHR) ((LAS float*)(lds + WG_OFF))[i] = T.G[(size_t)(128 * h) * 16 + i];
            for (int i = tid; i < 4096; i += NTHR) { ((LAS bf16*)(lds + WGC_OFF))[i] = T.WcT[(i >> 9) * 2048 + 512 * h + (i & 511)]; ((LAS bf16*)(lds + WGM_OFF))[i] = T.WmT[(i >> 9) * 2048 + 512 * h + (i & 511)]; }
            hcache = h;
            __syncthreads();
        }
        float cw[4][4], cb[4], Gm[4][4];
        {
            const int cl = 256 * hh + 4 * g6;
            const f32x4 b4 = *(const LAS f32x4*)(lds + WCB_OFF + cl * 4); cb[0] = b4[0]; cb[1] = b4[1]; cb[2] = b4[2]; cb[3] = b4[3];
#pragma unroll
            for (int tap = 0; tap < 4; ++tap) { const f32x4 w4 = *(const LAS f32x4*)(lds + WCV_OFF + (tap * 512 + cl) * 4); cw[tap][0] = w4[0]; cw[tap][1] = w4[1]; cw[tap][2] = w4[2]; cw[tap][3] = w4[3]; }
#pragma unroll
            for (int i = 0; i < 4; ++i) { const f32x4 g4 = *(const LAS f32x4*)(lds + WG_OFF + ((64 * hh + g6) * 16 + i * 4) * 4); Gm[i][0] = g4[0]; Gm[i][1] = g4[1]; Gm[i][2] = g4[2]; Gm[i][3] = g4[3]; }
        }
        __syncthreads();
        fetch(it + 1 < nitems ? it + 1 : it);
        unsigned xcp[4][4], xmp[4][4], qtp[4][4];
        float prev_xc[4], prev_q[4];
#pragma unroll
        for (int tl = 0; tl < 8; ++tl) {
            float xc[4], qt[4];
#pragma unroll
            for (int i = 0; i < 4; ++i) {
                float a = cb[i];
#pragma unroll
                for (int tap = 0; tap < 4; ++tap) a += cw[tap][i] * xmv[tl + tap][i];
                xc[i] = siluf_(a);
            }
#pragma unroll
            for (int i2 = 0; i2 < 4; ++i2) qt[i2] = xc[0] * Gm[0][i2] + xc[1] * Gm[1][i2] + xc[2] * Gm[2][i2] + xc[3] * Gm[3][i2];
            if (tl & 1) {
#pragma unroll
                for (int i = 0; i < 4; ++i) { xcp[i][tl >> 1] = pk2(prev_xc[i], xc[i]); qtp[i][tl >> 1] = pk2(prev_q[i], qt[i]); xmp[i][tl >> 1] = pk2(xmv[tl + 2][i], xmv[tl + 3][i]); }
            } else {
#pragma unroll
                for (int i = 0; i < 4; ++i) { prev_xc[i] = xc[i]; prev_q[i] = qt[i]; }
            }
        }
#pragma unroll
        for (int i = 0; i < 4; ++i) {
            const int off = (4 * g6 + i) * TP + 16 * tp;
            *(LAS v4u*)(lds + XC_OFF + off) = (v4u){xcp[i][0], xcp[i][1], xcp[i][2], xcp[i][3]};
            *(LAS v4u*)(lds + XM_OFF + off) = (v4u){xmp[i][0], xmp[i][1], xmp[i][2], xmp[i][3]};
            *(LAS v4u*)(lds + QT_OFF + off) = (v4u){qtp[i][0], qtp[i][1], qtp[i][2], qtp[i][3]};
        }
        __syncthreads();
#pragma unroll
        for (int k = 0; k < 11; ++k) asm volatile("" : "+v"(xr[k].x), "+v"(xr[k].y));
        {
            const size_t ibase = ((size_t)((b * 4 + h) * 64 + c) * 64 + 32 * hh) * 1024;
#pragma unroll
            for (int k = 0; k < 4; ++k) {
                const int id = tid + 512 * k, f = id >> 6, L = id & 63;
                const int row = 32 * (f >> 2) + (L & 31), colb = (16 * (f & 3) + 4 * (L >> 5)) * 2;
                const v2u k0 = *(const LAS v2u*)(lds + XC_OFF + row * TP + colb), k1 = *(const LAS v2u*)(lds + XC_OFF + row * TP + colb + 16);
                const v2u v0 = *(const LAS v2u*)(lds + XM_OFF + row * TP + colb), v1 = *(const LAS v2u*)(lds + XM_OFF + row * TP + colb + 16);
                *(v4u*)((char*)T.kimg + ibase + (size_t)id * 16) = (v4u){k0.x, k0.y, k1.x, k1.y};
                *(v4u*)((char*)T.vimg + ibase + (size_t)id * 16) = (v4u){v0.x, v0.y, v1.x, v1.y};
            }
#pragma unroll
            for (int k = 0; k < 4; ++k) {
                const int f = 4 * w + k, tt = f & 1, cb0 = 16 * (f >> 1) + 4 * hi + q4;
                const LAS unsigned char* pq = lds + QT_OFF + cb0 * TP + (32 * tt + 16 * gidx + 4 * p4) * 2;
                const s16x4 lo = tr_read(pq), hi4 = tr_read(pq + 8 * TP);
                *(bf16x8*)((char*)T.qimg + ibase + (size_t)f * 1024 + lane * 16) = cat8(lo, hi4);
            }
        }
#pragma unroll
        for (int ks = 0; ks < 8; ++ks) {
            const int crow0 = 128 * kh + 16 * ks + 8 * hi + q4;
            const LAS unsigned char* pa = lds + XC_OFF + crow0 * TP + (32 * si + 16 * gidx + 4 * p4) * 2;
            const LAS unsigned char* pb = lds + QT_OFF + crow0 * TP + (32 * ti + 16 * gidx + 4 * p4) * 2;
            const bf16x8 af = cat8(tr_read(pa), tr_read(pa + 4 * TP));
            const bf16x8 bfr = cat8(tr_read(pb), tr_read(pb + 4 * TP));
            sacc = MFMA32(af, bfr, sacc);
        }
#pragma unroll
        for (int ks = 0; ks < 4; ++ks) {
            const int crow1 = 64 * kq + 16 * ks + 8 * hi + q4;
            const LAS unsigned char* pc_ = lds + XC_OFF + crow1 * TP + (32 * ti + 16 * gidx + 4 * p4) * 2;
            const LAS unsigned char* pm_ = lds + XM_OFF + crow1 * TP + (32 * ti + 16 * gidx + 4 * p4) * 2;
            const bf16x8 ac = cat8(tr_read(pc_), tr_read(pc_ + 4 * TP));
            const bf16x8 am = cat8(tr_read(pm_), tr_read(pm_ + 4 * TP));
            const int cg = 256 * hh + 64 * kq + 16 * ks + 8 * hi;
            gacc = MFMA32(ac, *(const LAS bf16x8*)(lds + WGC_OFF + ((l31 & 7) * 512 + cg) * 2), gacc);
            gacc = MFMA32(am, *(const LAS bf16x8*)(lds + WGM_OFF + ((l31 & 7) * 512 + cg) * 2), gacc);
        }
        if (hh == 1) {
        __syncthreads();
        if (l31 < 8) {
#pragma unroll
            for (int r = 0; r < 16; ++r) ((LAS float*)(lds + GRED_OFF))[(kq * 64 + 32 * ti + crow(r, hi)) * 8 + l31] = gacc[r];
        }
        if (kh == 1) {
#pragma unroll
            for (int g4 = 0; g4 < 4; ++g4) *(LAS f32x4*)(lds + RED_OFF + ((w & 3) * 4 + g4) * 1024 + lane * 16) = (f32x4){sacc[4 * g4], sacc[4 * g4 + 1], sacc[4 * g4 + 2], sacc[4 * g4 + 3]};
        }
        __syncthreads();
        { const LAS float* gr = (const LAS float*)(lds + GRED_OFF);
          T.gp[((size_t)h * 8 + (tid & 7)) * MTOK + tok0 + (tid >> 3)] = gr[tid] + gr[512 + tid] + gr[1024 + tid] + gr[1536 + tid]; }
        if (kh == 0) {
            float tot[16];
#pragma unroll
            for (int g4 = 0; g4 < 4; ++g4) {
                const f32x4 o = *(const LAS f32x4*)(lds + RED_OFF + ((w & 3) * 4 + g4) * 1024 + lane * 16);
                tot[4 * g4] = sacc[4 * g4] + o[0]; tot[4 * g4 + 1] = sacc[4 * g4 + 1] + o[1]; tot[4 * g4 + 2] = sacc[4 * g4 + 2] + o[2]; tot[4 * g4 + 3] = sacc[4 * g4 + 3] + o[3];
            }
            char* sp = (char*)T.S + (size_t)((b * 4 + h) * 64 + c) * 8192;
#pragma unroll
            for (int kk = 0; kk < 2; ++kk)
                *(bf16x8*)(sp + ((2 * si + kk) * 2 + ti) * 1024 + lane * 16) = pack8(tot[8 * kk], tot[8 * kk + 1], tot[8 * kk + 2], tot[8 * kk + 3], tot[8 * kk + 4], tot[8 * kk + 5], tot[8 * kk + 6], tot[8 * kk + 7]);
        }
        __syncthreads();
        }
    }
}
}
namespace mscan {
constexpr int P_OFF = 0;
constexpr int V_OFF = 131072;
constexpr int DEN_OFF = V_OFF + 16384;
constexpr int NS_OFF = DEN_OFF + 4096;
constexpr int NSB_OFF = NS_OFF + 2048;
constexpr int TMP_OFF = NSB_OFF + 1024, SCW_OFF = TMP_OFF + 128, LDS_BYTES = SCW_OFF + 8 * 896;
static_assert(LDS_BYTES <= 163840 - 16, "scan LDS");
struct Tensors { const bf16* q; const bf16* k; const bf16* v; const bf16* S; const float* gp; const float* bif; float* scal; bf16* hm; };

DI float logsigmoid_(float x) { return fminf(x, 0.f) - log1pf(__expf(-fabsf(x))); }
DI void unpack8(bf16x8 f, float (&o)[8]) {
    const v4u u = __builtin_bit_cast(v4u, f);
    o[0] = bflo(u.x); o[1] = bfhi(u.x); o[2] = bflo(u.y); o[3] = bfhi(u.y); o[4] = bflo(u.z); o[5] = bfhi(u.z); o[6] = bflo(u.w); o[7] = bfhi(u.w);
}

template <int VAR> DI void unit(LAS unsigned char* lds, const Tensors& T, int bh, int es, int tid_in) {
    const int tid_ = wg_tid_local(tid_in);
    const int tid = tid_, lane = tid & 63, l31 = lane & 31, hi = lane >> 5, wid = __builtin_amdgcn_readfirstlane(tid >> 6);
    const int b = bh >> 2, h = bh & 3;
    LAS float* sTmp = (LAS float*)(lds + TMP_OFF);
    float* scal = T.scal + (size_t)bh * 3 * SEQ;
    {
        float li[8], cs[8];
        const float bi = T.bif[h], bf_ = T.bif[4 + h];
        float run = 0.f;
        const float* gpb = T.gp + (size_t)b * SEQ;
        const unsigned toff = (unsigned)tid * 8u;
#pragma unroll
        for (int k = 0; k < 8; ++k) { li[k] = bi; cs[k] = bf_; }
#pragma unroll
        for (int hh = 0; hh < 4; ++hh) {
            const float* pi = gpb + ((size_t)hh * 8 + h) * MTOK; const float* pf_ = gpb + ((size_t)hh * 8 + 4 + h) * MTOK;
            const f32x4 i0 = *(const f32x4*)(pi + toff), i1 = *(const f32x4*)(pi + toff + 4), f0 = *(const f32x4*)(pf_ + toff), f1 = *(const f32x4*)(pf_ + toff + 4);
#pragma unroll
            for (int k = 0; k < 4; ++k) { li[k] += i0[k]; li[4 + k] += i1[k]; cs[k] += f0[k]; cs[4 + k] += f1[k]; }
        }
#pragma unroll
        for (int k = 0; k < 8; ++k) { run += logsigmoid_(cs[k]); cs[k] = run; }
        float inc = run;
#pragma unroll
        for (int o = 1; o < 64; o <<= 1) { const float t = bperm(inc, lane >= o ? lane - o : lane); if (lane >= o) inc += t; }
        if (lane == 63) sTmp[wid] = inc;
        __syncthreads();
        float base = inc - run;
        for (int w2 = 0; w2 < wid; ++w2) base += sTmp[w2];
        __syncthreads();
        float av[8], mloc = -3.0e38f, cm[8];
#pragma unroll
        for (int k = 0; k < 8; ++k) { cs[k] += base; av[k] = li[k] - cs[k]; mloc = fmaxf(mloc, av[k]); cm[k] = mloc; }
        float minc = mloc;
#pragma unroll
        for (int o = 1; o < 64; o <<= 1) { const float t = bperm(minc, lane >= o ? lane - o : lane); if (lane >= o) minc = fmaxf(minc, t); }
        if (lane == 63) sTmp[wid] = minc;
        __syncthreads();
        float mbase = bperm(minc, lane > 0 ? lane - 1 : 0); if (lane == 0) mbase = -3.0e38f;
        for (int w2 = 0; w2 < wid; ++w2) mbase = fmaxf(mbase, sTmp[w2]);
#pragma unroll
        for (int k = 0; k < 8; ++k) {
            const float Mt = fmaxf(mbase, cm[k]);
            scal[0 * SEQ + 8 * tid + k] = av[k]; scal[1 * SEQ + 8 * tid + k] = Mt; scal[2 * SEQ + 8 * tid + k] = __expf(-(cs[k] + Mt));
        }
        ((LAS float*)(lds + NS_OFF))[tid] = 0.f; ((LAS unsigned short*)(lds + NSB_OFF))[tid] = 0;
        __threadfence();
        __syncthreads();
    }
#define MFMAV(a_, b_, c_) (VAR == 3 ? (c_) : MFMA32((a_), (b_), (c_)))
    f32x16 cst[2][2];
#pragma unroll
    for (int id = 0; id < 2; ++id)
#pragma unroll
        for (int ie = 0; ie < 2; ++ie) cst[id][ie] = (f32x16){};
    const char* qb = (const char*)T.q + (size_t)bh * NCHUNK * 65536 + (size_t)wid * 8192;
    const char* kb = (const char*)T.k + (size_t)bh * NCHUNK * 65536 + (size_t)wid * 8192;
    const char* vb = (const char*)T.v + (size_t)bh * NCHUNK * 65536 + (size_t)es * 8192 + (size_t)wid * 1024;
    const char* sb = (const char*)T.S + (size_t)bh * NCHUNK * 8192 + (size_t)(wid & 3) * 2048;
    const unsigned loff = (unsigned)lane * 16u;
    const float* sa = scal; const float* sm = scal + SEQ; const float* sthr = scal + 2 * SEQ;
    bf16* hg = T.hm + (size_t)b * SEQ * 2048 + 512 * h + 64 * es;
    int zv = 0; asm volatile("" : "+v"(zv));
    float Mc = sm[zv];
    LAS float* sca = (LAS float*)(lds + SCW_OFF) + wid * 224;
    LAS float* nsw = (LAS float*)(lds + NS_OFF) + 64 * wid; LAS unsigned short* nsb = (LAS unsigned short*)(lds + NSB_OFF) + 64 * wid;
    bf16x8 fb[16]; bf16x8 sf[2]; bf16x8 vnext;
    float a_l, m_l, thr_l;
#pragma unroll
    for (int g = 0; g < 8; ++g) fb[g] = *(const bf16x8*)(qb + g * 1024 + loff);
#pragma unroll
    for (int g = 0; g < 8; ++g) fb[8 + g] = *(const bf16x8*)(kb + ((g & 1) * 4 + (g >> 1)) * 1024 + loff);
    sf[0] = *(const bf16x8*)(sb + loff); sf[1] = *(const bf16x8*)(sb + 1024 + loff);
    vnext = *(const bf16x8*)(vb + loff);
    a_l = sa[lane]; m_l = sm[lane]; thr_l = sthr[lane];
    const int ksw = wid & 3, iew = wid >> 2;
#define STAGE_VW(dst_) do { const float mend_ = bperm(m_l, 63 + zv); sca[160 + lane] = __expf(a_l - mend_); \
        const f32x4 w0_ = *(const LAS f32x4*)(sca + 160 + 16 * ksw + 4 * hi), w1_ = *(const LAS f32x4*)(sca + 160 + 16 * ksw + 8 + 4 * hi); \
        float vv_[8]; unpack8(vnext, vv_); \
        *(LAS bf16x8*)((dst_) + wid * 1024 + lane * 16) = pack8(vv_[0] * w0_[0], vv_[1] * w0_[1], vv_[2] * w0_[2], vv_[3] * w0_[3], vv_[4] * w1_[0], vv_[5] * w1_[1], vv_[6] * w1_[2], vv_[7] * w1_[3]); } while (0)
    STAGE_VW(lds + V_OFF);
    bf16x8 vown = vnext;
    asm volatile("" :: "v"(a_l), "v"(m_l), "v"(thr_l), "v"(sf[0]), "v"(sf[1]));
#pragma unroll
    for (int g = 0; g < 16; ++g) asm volatile("" :: "v"(fb[g]));
    __syncthreads();
#pragma unroll 1
    for (int c = 0; c < NCHUNK; ++c) {
        const int cur = c & 1;
        LAS float* denp = (LAS float*)(lds + DEN_OFF) + cur * 512;
        LAS unsigned char* pbuf = lds + P_OFF + cur * 65536;
        const LAS unsigned char* vcur = lds + V_OFF + cur * 8192; LAS unsigned char* vnxt = lds + V_OFF + (cur ^ 1) * 8192;
        const int cn = (c + 1 < NCHUNK) ? c + 1 : c;
        const char* qn_ = qb + (size_t)cn * 65536; const char* kn_ = kb + (size_t)cn * 65536; const char* sn_ = sb + (size_t)cn * 8192;
        vnext = *(const bf16x8*)(vb + (size_t)cn * 65536 + loff);
        const float Mc2 = bperm(m_l, 63 + zv);
        const float Mt0 = bperm(m_l, l31), Mt1 = bperm(m_l, 32 + l31);
        const float thr0 = bperm(thr_l, l31), thr1 = bperm(thr_l, 32 + l31);
        { const float cwl = __expf(a_l - Mc2); sca[lane] = a_l; sca[64 + lane] = cwl; ((LAS unsigned short*)(sca + 128))[lane] = (unsigned short)(pk2(cwl, 0.f) & 0xffffu); }
        a_l = sa[64 * cn + lane]; m_l = sm[64 * cn + lane]; thr_l = sthr[64 * cn + lane];
        bf16x8 pf[2]; float psum[2];
        {
            const f32x4 aown0 = *(const LAS f32x4*)(sca + 16 * ksw + 4 * hi), aown1 = *(const LAS f32x4*)(sca + 16 * ksw + 8 + 4 * hi);
            const float aw[8] = {aown0[0], aown0[1], aown0[2], aown0[3], aown1[0], aown1[1], aown1[2], aown1[3]};
#pragma unroll
            for (int tt = 0; tt < 2; ++tt) {
                const int t = 32 * tt + l31; const float Mt = tt ? Mt1 : Mt0;
                float sv[8]; unpack8(sf[tt], sv);
                float pw[8]; float ps = 0.f;
#pragma unroll
                for (int j = 0; j < 8; ++j) { const int s = 16 * ksw + 8 * (j >> 2) + 4 * hi + (j & 3); pw[j] = (s <= t) ? sv[j] * __expf(aw[j] - Mt) : 0.f; ps += pw[j]; }
                pf[tt] = pack8(pw[0], pw[1], pw[2], pw[3], pw[4], pw[5], pw[6], pw[7]);
                psum[tt] = ps;
            }
            sf[0] = *(const bf16x8*)(sn_ + loff); sf[1] = *(const bf16x8*)(sn_ + 1024 + loff);
        }
        const float rs0 = __expf(Mc - Mt0), rs1 = __expf(Mc - Mt1);
#pragma unroll
        for (int ie = 0; ie < 2; ++ie) {
            f32x16 ao[2]; ao[0] = (f32x16){}; ao[1] = (f32x16){};
            float qn[2] = {0.f, 0.f};
#pragma unroll
            for (int id = 0; id < 2; ++id)
#pragma unroll
                for (int s = 0; s < 2; ++s) {
                    const int g0 = (id * 2 + s) * 2;
                    const bf16x8 cb = pack8(cst[id][ie][8 * s + 0], cst[id][ie][8 * s + 1], cst[id][ie][8 * s + 2], cst[id][ie][8 * s + 3], cst[id][ie][8 * s + 4], cst[id][ie][8 * s + 5], cst[id][ie][8 * s + 6], cst[id][ie][8 * s + 7]);
                    ao[0] = MFMAV(cb, fb[g0], ao[0]);
                    ao[1] = MFMAV(cb, fb[g0 + 1], ao[1]);
                    if (ie == 0) {
                        const v2u n0 = *(const LAS v2u*)(nsb + 32 * id + 16 * s + 4 * hi), n1 = *(const LAS v2u*)(nsb + 32 * id + 16 * s + 8 + 4 * hi);
#pragma unroll
                        for (int tt = 0; tt < 2; ++tt) {
                            const v4u qv = __builtin_bit_cast(v4u, fb[g0 + tt]);
                            float q_ = qn[tt];
                            q_ = dot2bf(qv.x, n0.x, q_); q_ = dot2bf(qv.y, n0.y, q_); q_ = dot2bf(qv.z, n1.x, q_); q_ = dot2bf(qv.w, n1.y, q_);
                            asm volatile("" : "+v"(q_));
                            qn[tt] = q_;
                        }
                    } else {
                        __builtin_amdgcn_sched_barrier(0);
                        if (VAR != 2) { fb[g0] = *(const bf16x8*)(qn_ + g0 * 1024 + loff);
                        fb[g0 + 1] = *(const bf16x8*)(qn_ + (g0 + 1) * 1024 + loff); }
                    }
                    __builtin_amdgcn_sched_barrier(0);
                }
            if (ie == 0) {
                float d0 = rs0 * qn[0] + (wid < 4 ? psum[0] : 0.f), d1 = rs1 * qn[1] + (wid < 4 ? psum[1] : 0.f);
                d0 += bperm(d0, lane ^ 32); d1 += bperm(d1, lane ^ 32);
                if (hi == 0) { denp[wid * 64 + l31] = d0; denp[wid * 64 + 32 + l31] = d1; }
            }
#pragma unroll
            for (int r = 0; r < 16; ++r) { ao[0][r] *= rs0; ao[1][r] *= rs1; }
            if (ie == iew) {
                ao[0] = MFMAV(vown, pf[0], ao[0]); ao[1] = MFMAV(vown, pf[1], ao[1]);
            }
#pragma unroll
            for (int tt = 0; tt < 2; ++tt)
#pragma unroll
                for (int g4 = 0; g4 < 4; ++g4) {
                    v2u pw_; pw_.x = pk2(ao[tt][4 * g4], ao[tt][4 * g4 + 1]); pw_.y = pk2(ao[tt][4 * g4 + 2], ao[tt][4 * g4 + 3]);
                    *(LAS v2u*)(pbuf + ((((wid * 2 + ie) * 2 + tt) * 4 + g4) * 512) + lane * 8) = pw_;
                }
        }
        const float decay = __expf(Mc - Mc2);
#pragma unroll
        for (int id = 0; id < 2; ++id)
#pragma unroll
            for (int ie = 0; ie < 2; ++ie)
#pragma unroll
                for (int r = 0; r < 16; ++r) cst[id][ie][r] *= decay;
        float nacc[2] = {0.f, 0.f};
#pragma unroll
        for (int ks = 0; ks < 4; ++ks) {
            const v2u cwb0 = *(const LAS v2u*)((const LAS unsigned short*)(sca + 128) + 16 * ks + 4 * hi), cwb1 = *(const LAS v2u*)((const LAS unsigned short*)(sca + 128) + 16 * ks + 8 + 4 * hi);
            bf16x8 vw[2];
            vw[0] = *(const LAS bf16x8*)(vcur + (0 * 4 + ks) * 1024 + lane * 16); vw[1] = *(const LAS bf16x8*)(vcur + (1 * 4 + ks) * 1024 + lane * 16);
#pragma unroll
            for (int id = 0; id < 2; ++id) {
                const int g = 8 + ks * 2 + id;
                cst[id][0] = MFMAV(fb[g], vw[0], cst[id][0]);
                cst[id][1] = MFMAV(fb[g], vw[1], cst[id][1]);
                {
                    const v4u kv = __builtin_bit_cast(v4u, fb[g]);
                    float na = nacc[id];
                    na = dot2bf(kv.x, cwb0.x, na); na = dot2bf(kv.y, cwb0.y, na); na = dot2bf(kv.z, cwb1.x, na); na = dot2bf(kv.w, cwb1.y, na);
                    asm volatile("" : "+v"(na));
                    nacc[id] = na;
                }
                __builtin_amdgcn_sched_barrier(0);
                if (VAR != 2) fb[g] = *(const bf16x8*)(kn_ + (id * 4 + ks) * 1024 + loff);
            }
            __builtin_amdgcn_sched_barrier(0);
        }
#pragma unroll
        for (int id = 0; id < 2; ++id) {
            float v = nacc[id]; v += bperm(v, lane ^ 32);
            if (hi == 0) { const float nv = decay * nsw[32 * id + l31] + v; nsw[32 * id + l31] = nv; nsb[32 * id + l31] = (unsigned short)(pk2(nv, 0.f) & 0xffffu); }
        }
        STAGE_VW(vnxt);
        vown = vnext;
        if (VAR != 4) __syncthreads();
#pragma unroll
        for (int tt = 0; tt < 2; ++tt) {
            float nm[4] = {0.f, 0.f, 0.f, 0.f};
#pragma unroll
            for (int src = 0; src < 8; ++src) {
                const v2u pv = *(const LAS v2u*)(pbuf + ((((src * 2 + iew) * 2 + tt) * 4 + ksw) * 512) + lane * 8);
                nm[0] += bflo(pv.x); nm[1] += bfhi(pv.x); nm[2] += bflo(pv.y); nm[3] += bfhi(pv.y);
            }
            const int t = 32 * tt + l31;
            float den = 0.f;
#pragma unroll
            for (int src = 0; src < 8; ++src) den += denp[src * 64 + t];
            const float dn = fmaxf(fabsf(den), tt ? thr1 : thr0);
            const float inv = rcpf_(dn);
            v2u wv; wv.x = pk2(nm[0] * inv, nm[1] * inv); wv.y = pk2(nm[2] * inv, nm[3] * inv);
            if (VAR == 0 || (VAR != 0 && wv.x == 0x12345678u && wv.y == 0x9abcdef0u)) *(v2u*)(hg + (size_t)(64 * c + t) * 2048 + 32 * iew + 8 * ksw + 4 * hi) = wv;
        }
        Mc = Mc2;
    }
    __syncthreads();
}
#undef MFMAV
#undef STAGE_VW
template <int VAR> DI void phase(LAS unsigned char* lds, const Tensors& T, int G, int blk, int wv) {
#pragma unroll 1
    for (int u = blk; u < 256; u += G) {
        const int xcd = u & 7, j = u >> 3;
        unit<VAR>(lds, T, xcd * 4 + (j >> 3), j & 7, wv);
    }
}
}
namespace mpost {
constexpr int GSTR = 576;
constexpr int XC_OFF = 0, WV_OFF = 128 * GSTR, PRM_OFF = WV_OFF + 128 * 64, LDS_BYTES = PRM_OFF + 4096;
struct Tensors { bf16* hm; const bf16* om; const bf16* zm; const bf16* kimg; const float* wv; const float* hng; const float* skip; };

DI void phase(LAS unsigned char* lds, const Tensors& T, int G, int blk, int wv) {
    const int tid_ = wg_tid_local(wv);
    int tid = tid_, t5 = tid >> 4, seg = tid & 15;
    const int NU = BATCH * NCHUNK * MH;
    if (blk >= NU) return;
    const int nitems = 2 * ((NU - blk + G - 1) / G);
    unsigned voff = (unsigned)(t5 * 4096 + seg * 8);
    v2u hxv[8], ogv[8], res[8]; v4u sr[8];
    auto rowbase = [&](int it) -> size_t { const int u_ = blk + (it >> 1) * G; return ((size_t)(u_ >> 8) * SEQ + 64 * ((u_ >> 2) & 63) + 32 * (it & 1)) * 2048 + 512 * (u_ & 3); };
    auto fetch_ho = [&](int it) {
        const size_t rb = rowbase(it);
        const char* hb = (const char*)(T.hm + rb); const char* ob = (const char*)(T.om + rb);
#pragma unroll
        for (int k = 0; k < 8; ++k) { hxv[k] = *(const v2u*)(hb + voff + k * 128); ogv[k] = *(const v2u*)(ob + voff + k * 128); }
    };
    auto fetch_stage = [&](int un) {
        const int u_ = blk + un * G, h_ = u_ & 3, c_ = (u_ >> 2) & 63, b_ = u_ >> 8;
        const char* base = (const char*)T.kimg + (size_t)((b_ * 4 + h_) * 64 + c_) * 65536;
        const int tq = tid;
#pragma unroll
        for (int k = 0; k < 2; ++k) {
            const int id = tq + 512 * k, pb = id & 7, g = id >> 3, ks = pb >> 1, hi_ = pb & 1;
            const char* src = base + (unsigned)(((g >> 3) * 4 + ks) * 1024 + (4 * (g & 7) + 32 * hi_) * 16);
            sr[4 * k] = *(const v4u*)(src); sr[4 * k + 1] = *(const v4u*)(src + 16); sr[4 * k + 2] = *(const v4u*)(src + 32); sr[4 * k + 3] = *(const v4u*)(src + 48);
        }
    };
    fetch_stage(0); fetch_ho(0);
#pragma unroll
    for (int k = 0; k < 8; ++k) asm volatile("" : "+v"(hxv[k].x), "+v"(hxv[k].y), "+v"(ogv[k].x), "+v"(ogv[k].y), "+v"(sr[k].x), "+v"(sr[k].y), "+v"(sr[k].z), "+v"(sr[k].w));
    int hcache = -1;
#pragma unroll 1
    for (int it = 0; it < nitems; ++it) {
        { int tq = tid_; asm volatile("" : "+v"(tq)); tid = tq; t5 = tq >> 4; seg = tq & 15; voff = (unsigned)(t5 * 4096 + seg * 8); }
        const int u = blk + (it >> 1) * G, pass = it & 1, h = u & 3;
        const int t = t5 + 32 * pass;
        if (pass == 0) {
            if (h != hcache) {
                __syncthreads();
                *(LAS f32x4*)(lds + WV_OFF + tid * 16) = *(const f32x4*)(T.wv + (size_t)(128 * h) * 16 + tid * 4);
                ((LAS float*)(lds + PRM_OFF))[tid] = T.hng[512 * h + tid]; ((LAS float*)(lds + PRM_OFF))[512 + tid] = T.skip[512 * h + tid];
                hcache = h;
            }
#pragma unroll
            for (int k = 0; k < 2; ++k) {
                const int id = tid + 512 * k, pb = id & 7, g = id >> 3, ks = pb >> 1, hi_ = pb & 1;
                const unsigned a0[4] = {sr[4 * k].x, sr[4 * k].y, sr[4 * k].z, sr[4 * k].w}, a1[4] = {sr[4 * k + 1].x, sr[4 * k + 1].y, sr[4 * k + 1].z, sr[4 * k + 1].w};
                const unsigned a2[4] = {sr[4 * k + 2].x, sr[4 * k + 2].y, sr[4 * k + 2].z, sr[4 * k + 2].w}, a3[4] = {sr[4 * k + 3].x, sr[4 * k + 3].y, sr[4 * k + 3].z, sr[4 * k + 3].w};
#pragma unroll
                for (int m = 0; m < 4; ++m) {
                    const int tok = 16 * ks + 8 * (m >> 1) + 4 * hi_ + 2 * (m & 1);
                    v2u e0, e1;
                    e0.x = (a0[m] & 0xffffu) | (a1[m] << 16); e0.y = (a2[m] & 0xffffu) | (a3[m] << 16);
                    e1.x = (a0[m] >> 16) | (a1[m] & 0xffff0000u); e1.y = (a2[m] >> 16) | (a3[m] & 0xffff0000u);
                    *(LAS v2u*)(lds + XC_OFF + g * GSTR + tok * 8) = e0;
                    *(LAS v2u*)(lds + XC_OFF + g * GSTR + (tok + 1) * 8) = e1;
                }
            }
            __syncthreads();
        }
        float uv[32]; float sum = 0.f;
#pragma unroll
        for (int k = 0; k < 8; ++k) {
            const int gi = seg + 16 * k;
            const float hv[4] = {bflo(hxv[k].x), bfhi(hxv[k].x), bflo(hxv[k].y), bfhi(hxv[k].y)};
            const float ov[4] = {sigmoidf_(bflo(ogv[k].x)), sigmoidf_(bfhi(ogv[k].x)), sigmoidf_(bflo(ogv[k].y)), sigmoidf_(bfhi(ogv[k].y))};
            const LAS f32x4* wp = (const LAS f32x4*)(lds + WV_OFF + gi * 64);
            const f32x4 w0 = wp[0], w1 = wp[1], w2 = wp[2], w3 = wp[3];
#pragma unroll
            for (int o = 0; o < 4; ++o) {
                const float v = hv[0] * w0[o] + hv[1] * w1[o] + hv[2] * w2[o] + hv[3] * w3[o];
                const float x = v * ov[o];
                uv[4 * k + o] = x; sum += x;
            }
            __builtin_amdgcn_sched_barrier(0);
        }
        if (it > 0) {
            char* pb_ = (char*)(T.hm + rowbase(it - 1));
#pragma unroll
            for (int k = 0; k < 8; ++k) *(v2u*)(pb_ + voff + k * 128) = res[k];
        }
        v2u zc[8];
        { const char* zb = (const char*)(T.zm + rowbase(it));
#pragma unroll
          for (int k = 0; k < 8; ++k) zc[k] = *(const v2u*)(zb + voff + k * 128); }
        fetch_ho(it + 1 < nitems ? it + 1 : it);
        if (pass == 1) fetch_stage((it >> 1) + 1 < (nitems >> 1) ? (it >> 1) + 1 : (it >> 1));
        sum += bperm(sum, tid ^ 1); sum += bperm(sum, tid ^ 2); sum += bperm(sum, tid ^ 4); sum += bperm(sum, tid ^ 8);
        const float mean = sum * (1.0f / 512.0f);
        float sq = 0.f;
#pragma unroll
        for (int i = 0; i < 32; ++i) { const float d = uv[i] - mean; sq += d * d; }
        sq += bperm(sq, tid ^ 1); sq += bperm(sq, tid ^ 2); sq += bperm(sq, tid ^ 4); sq += bperm(sq, tid ^ 8);
        const float rstd = __builtin_amdgcn_rsqf(sq * (1.0f / 512.0f) + EPS);
#pragma unroll
        for (int k = 0; k < 8; ++k) {
            const int gi = seg + 16 * k;
            const f32x4 gn = *(const LAS f32x4*)(lds + PRM_OFF + gi * 16), sk = *(const LAS f32x4*)(lds + PRM_OFF + 2048 + gi * 16);
            const v2u xc = *(const LAS v2u*)(lds + XC_OFF + gi * GSTR + t * 8);
            const float xv[4] = {bflo(xc.x), bfhi(xc.x), bflo(xc.y), bfhi(xc.y)};
            float r[4];
            const float zv[4] = {bflo(zc[k].x), bfhi(zc[k].x), bflo(zc[k].y), bfhi(zc[k].y)};
#pragma unroll
            for (int o = 0; o < 4; ++o) r[o] = ((uv[4 * k + o] - mean) * rstd * gn[o] + sk[o] * xv[o]) * siluf_(zv[o]);
            res[k].x = pk2(r[0], r[1]); res[k].y = pk2(r[2], r[3]);
            if (k & 1) __builtin_amdgcn_sched_barrier(0);
        }
#pragma unroll
        for (int k = 0; k < 8; ++k) asm volatile("" : "+v"(hxv[k].x), "+v"(hxv[k].y), "+v"(ogv[k].x), "+v"(ogv[k].y));
        if (pass == 1) {
#pragma unroll
            for (int k = 0; k < 8; ++k) asm volatile("" : "+v"(sr[k].x), "+v"(sr[k].y), "+v"(sr[k].z), "+v"(sr[k].w));
            __syncthreads();
        }
    }
    {
        char* pb_ = (char*)(T.hm + rowbase(nitems - 1));
#pragma unroll
        for (int k = 0; k < 8; ++k) *(v2u*)(pb_ + voff + k * 128) = res[k];
    }
}
}

DI void transpose_item(const float* W, int K, int N, bf16* WT, const float* kscale, LAS float* scr, int item, int lane) {
    const int nblk = N / 32, kb = item / nblk, nb = item % nblk, k0 = 64 * kb, n0 = 32 * nb;
#pragma unroll 8
    for (int i = 0; i < 32; ++i) { const int kk = 2 * i + (lane >> 5); float v = W[(size_t)(k0 + kk) * N + n0 + (lane & 31)]; if (kscale) v *= kscale[k0 + kk]; scr[kk * 33 + (lane & 31)] = v; }
    asm volatile("s_waitcnt lgkmcnt(0)" ::: "memory");
    const int cc = lane & 7;
#pragma unroll
    for (int j = 0; j < 4; ++j) { const int n = (lane >> 3) + 8 * j; const LAS float* s = scr + (8 * cc) * 33 + n;
        v4u o; o.x = pk2(s[0 * 33], s[1 * 33]); o.y = pk2(s[2 * 33], s[3 * 33]); o.z = pk2(s[4 * 33], s[5 * 33]); o.w = pk2(s[6 * 33], s[7 * 33]);
        *(v4u*)(WT + (size_t)(n0 + n) * K + k0 + 8 * cc) = o; }
    asm volatile("s_waitcnt lgkmcnt(0)" ::: "memory");
}
DI void rms_row_to_bf16(const float* xrow, bf16* orow, int lane) {
    const f32x4* xr = (const f32x4*)xrow + lane;
    f32x4 v[4]; float s = 0.f;
#pragma unroll
    for (int j = 0; j < 4; ++j) { v[j] = xr[64 * j]; s += (v[j][0] * v[j][0] + v[j][1] * v[j][1]) + (v[j][2] * v[j][2] + v[j][3] * v[j][3]); }
    const float r = __builtin_amdgcn_rsqf(wave_sum(s) * (1.0f / 1024.0f) + EPS);
    v2u* o8 = (v2u*)orow + lane;
#pragma unroll
    for (int j = 0; j < 4; ++j) { v2u w; w.x = pk2(v[j][0] * r, v[j][1] * r); w.y = pk2(v[j][2] * r, v[j][3] * r); o8[64 * j] = w; }
}
DI void rms_row_inplace(float* row, const float* g, int lane) {
    f32x4* xr = (f32x4*)row + lane; const f32x4* gr = (const f32x4*)g + lane;
    f32x4 v[4]; float s = 0.f;
#pragma unroll
    for (int j = 0; j < 4; ++j) { v[j] = xr[64 * j]; s += (v[j][0] * v[j][0] + v[j][1] * v[j][1]) + (v[j][2] * v[j][2] + v[j][3] * v[j][3]); }
    const float r = __builtin_amdgcn_rsqf(wave_sum(s) * (1.0f / 1024.0f) + EPS);
#pragma unroll
    for (int j = 0; j < 4; ++j) xr[64 * j] = v[j] * r * gr[64 * j];
}
constexpr int N_PHASES = 15;
constexpr int LDS_TOTAL = 163840, XB_LDS_OFF = 163840 - 16;
static_assert(pg8::STAGE_BYTES <= XB_LDS_OFF && att::LDS_BYTES <= XB_LDS_OFF && mpre::LDS_BYTES <= XB_LDS_OFF && mscan::LDS_BYTES <= XB_LDS_OFF && mpost::LDS_BYTES <= XB_LDS_OFF, "LDS map vs barrier words");
static_assert(pg8::STAGE_BYTES <= LDS_TOTAL && att::LDS_BYTES <= LDS_TOTAL && mpre::LDS_BYTES <= LDS_TOTAL && mscan::LDS_BYTES <= LDS_TOTAL && mpost::LDS_BYTES <= LDS_TOTAL, "LDS map");

struct Args { const float* in[18]; float* out; unsigned char* ws; int ph_lo, ph_hi; };

DI void prologue(const Args& a, LAS unsigned char* lds, int G, int blk, int wvi) {
    const int tid = wg_tid_local(wvi), lane = tid & 63, wave = __builtin_amdgcn_readfirstlane(tid >> 6);
    unsigned char* ws = a.ws;
    LAS float* scr = (LAS float*)(lds + wave * 16384);
    const int gw = blk * NWAVES + wave, NGW = G * NWAVES;
    constexpr int I_IN = (DM / 64) * (NIN / 32), I_PA = (AW / 64) * (DM / 32), I_PB = (MW / 64) * (DM / 32), I_OUT = (DM / 64) * (DM / 32);
    constexpr int NITEMS = I_IN + I_PA + I_PB + I_OUT;
    for (int it = gw; it < NITEMS; it += NGW) {
        int r = it;
        if (r < I_IN) { transpose_item(a.in[2], DM, NIN, (bf16*)(ws + WS_WIN), a.in[1], scr, r, lane); continue; } r -= I_IN;
        if (r < I_PA) { transpose_item(a.in[13], AW, DM, (bf16*)(ws + WS_WPA), nullptr, scr, r, lane); continue; } r -= I_PA;
        if (r < I_PB) { transpose_item(a.in[14], MW, DM, (bf16*)(ws + WS_WPB), nullptr, scr, r, lane); continue; } r -= I_PB;
        transpose_item(a.in[15], DM, DM, (bf16*)(ws + WS_WOUT), nullptr, scr, r, lane);
    }
    for (int m = gw; m < MTOK; m += NGW) rms_row_to_bf16(a.in[0] + (size_t)m * DM, (bf16*)(ws + WS_XN) + (size_t)m * DM, lane);
    float* tab = (float*)(ws + WS_TAB);
    const float* wq = a.in[6]; const float* wk = a.in[7]; const float* wv = a.in[8]; const float* wif = a.in[9]; const float* rb = a.in[16];
    const int gt = blk * NTHR + tid, NGT = G * NTHR;
    for (int i = gt; i < 2048 * 8; i += NGT) {
        const int c = i >> 3, j = i & 7, g = c >> 2, ii = c & 3;
        float sc = 0.f, sm = 0.f;
#pragma unroll
        for (int o = 0; o < 4; ++o) {
            sc += wq[g * 16 + ii * 4 + o] * wif[(size_t)(4 * g + o) * 8 + j] + wk[g * 16 + ii * 4 + o] * wif[(size_t)(2048 + 4 * g + o) * 8 + j];
            sm += wv[g * 16 + ii * 4 + o] * wif[(size_t)(4096 + 4 * g + o) * 8 + j];
        }
        ((bf16*)(tab + TAB_WC))[j * 2048 + c] = (bf16)(pk2(sc, 0.f) & 0xffffu); ((bf16*)(tab + TAB_WM))[j * 2048 + c] = (bf16)(pk2(sm, 0.f) & 0xffffu);
    }
    for (int i = gt; i < 512 * 16; i += NGT) {
        const int g = i >> 4, ii = (i >> 2) & 3, i2 = i & 3;
        float s = 0.f;
#pragma unroll
        for (int o = 0; o < 4; ++o) s += wq[g * 16 + ii * 4 + o] * wk[g * 16 + i2 * 4 + o];
        tab[TAB_G + i] = s * 0.04419417382415922f;
    }
    for (int i = gt; i < 3 * 16 * 132; i += NGT) {
        const int d = i % 132, ph = i / 132, p = ph >> 4, hh = ph & 15;
        tab[TAB_BIAS + i] = rb[BUCKET[p][d] * 16 + hh] * LOG2E;
    }
}

#define XB_TMO      128
#define XB_XCNT(j)  (256  + 64 * (j))
#define XB_XSUB(j)  (1280 + 64 * (j))
#define XB_XGEN(j)  (2304 + 64 * (j))
#define XB_TOP      3328
#define XB_TOPGEN   3392
#define XCD_BAR_WORDS 3456
#define XB_SPIN_CAP (1u << 18)
DI unsigned xb_ld(unsigned* p)              { return __hip_atomic_load(p, __ATOMIC_RELAXED, __HIP_MEMORY_SCOPE_AGENT); }
DI unsigned xb_add(unsigned* p, unsigned v) { return __hip_atomic_fetch_add(p, v, __ATOMIC_RELAXED, __HIP_MEMORY_SCOPE_AGENT); }
DI unsigned xb_xcc_id() { return (unsigned)__builtin_amdgcn_s_getreg((3 << 11) | 20) & 0xFu; }
#define XB_SPIN(cond, bar) do { unsigned _sp = 0; while (cond) { __builtin_amdgcn_s_sleep(1); \
    if ((++_sp & 255u) == 0u) { if (xb_ld(&(bar)[XB_TMO])) break; if (_sp > XB_SPIN_CAP) { atomicAdd(&(bar)[XB_TMO], 1u); break; } } } } while (0)
struct XcdBarrier { unsigned* bar; unsigned x; volatile LAS unsigned* st; };
DI XcdBarrier xcd_barrier_post(unsigned* bar, volatile LAS unsigned* st, int tid) {
    XcdBarrier b; b.bar = bar; b.x = xb_xcc_id(); b.st = st;
    if (tid == 0) (void)xb_add(&bar[XB_XCNT(b.x)], 1u);
    return b;
}
DI void xcd_barrier_complete(unsigned* bar, unsigned x, unsigned& nloc, unsigned& nx) {
    const unsigned G = gridDim.x * gridDim.y * gridDim.z;
    unsigned sum, cnt, mine, sp = 0u;
    for (;;) {
        sum = 0u; cnt = 0u; mine = 0u;
#pragma unroll
        for (unsigned j = 0; j < 16; ++j) { const unsigned c = xb_ld(&bar[XB_XCNT(j)]); sum += c; cnt += (c > 0u) ? 1u : 0u; mine = (j == x) ? c : mine; }
        if (sum == G) break;
        __builtin_amdgcn_s_sleep(1);
        if ((++sp & 255u) == 0u) { if (xb_ld(&bar[XB_TMO])) break; if (sp > XB_SPIN_CAP) { atomicAdd(&bar[XB_TMO], 1u); break; } }
    }
    nloc = mine > 0u ? mine : 1u; nx = cnt > 0u ? cnt : 1u;
}
DI void xcd_barrier(const XcdBarrier& b, int tid) {
    asm volatile("s_waitcnt vmcnt(0)" ::: "memory");
    __syncthreads();
    if (tid == 0) {
        unsigned* bar = b.bar;
        __builtin_amdgcn_s_waitcnt(0);
        unsigned nloc = b.st[0], nx = b.st[1];
        if (nloc == 0u) { xcd_barrier_complete(bar, b.x, nloc, nx); b.st[0] = nloc; b.st[1] = nx; }
        const unsigned old = xb_add(&bar[XB_XSUB(b.x)], 1u);
        const unsigned gen = old / nloc;
        if (old + 1u == (gen + 1u) * nloc) {
            __builtin_amdgcn_fence(__ATOMIC_RELEASE, "agent");
            asm volatile("s_waitcnt vmcnt(0)" ::: "memory");
            const unsigned og = xb_add(&bar[XB_TOP], 1u);
            const unsigned tg = og / nx;
            if (og + 1u == (tg + 1u) * nx) xb_add(&bar[XB_TOPGEN], 1u);
            else XB_SPIN(xb_ld(&bar[XB_TOPGEN]) == tg, bar);
            __builtin_amdgcn_fence(__ATOMIC_ACQUIRE, "agent");
            xb_add(&bar[XB_XGEN(b.x)], 1u);
            asm volatile("s_waitcnt vmcnt(0)" ::: "memory");
        } else {
            XB_SPIN(xb_ld(&bar[XB_XGEN(b.x)]) == gen, bar);
            __builtin_amdgcn_fence(__ATOMIC_ACQUIRE, "agent");
            asm volatile("s_waitcnt vmcnt(0)" ::: "memory");
        }
    }
    __syncthreads();
}

DI void grid_sync_(int tid) {
    asm volatile("s_waitcnt vmcnt(0) lgkmcnt(0)" ::: "memory");
    __builtin_amdgcn_fence(__ATOMIC_RELEASE, "workgroup");
    __builtin_amdgcn_s_barrier();
    if (tid == 0) {
        __builtin_amdgcn_fence(__ATOMIC_ACQUIRE, "workgroup");
        __builtin_amdgcn_fence(__ATOMIC_RELEASE, "agent");
        const __attribute__((address_space(4))) char* ia = (const __attribute__((address_space(4))) char*)__builtin_amdgcn_implicitarg_ptr();
        const unsigned long long p = *(const __attribute__((address_space(4))) unsigned long long*)(ia + 88);
        unsigned* bar = (unsigned*)(p + 32);
        const unsigned nwg = *(const unsigned*)(p + 40);
        const unsigned old = __hip_atomic_fetch_add(bar, 1u, __ATOMIC_RELAXED, __HIP_MEMORY_SCOPE_AGENT);
        if ((old & 0xffffu) == nwg - 1u) (void)__hip_atomic_fetch_add(bar, 65536u - nwg, __ATOMIC_RELAXED, __HIP_MEMORY_SCOPE_AGENT);
        const unsigned gen = old & 0xffff0000u;
        while ((__hip_atomic_load(bar, __ATOMIC_RELAXED, __HIP_MEMORY_SCOPE_AGENT) & 0xffff0000u) == gen) __builtin_amdgcn_s_sleep(1);
        __builtin_amdgcn_fence(__ATOMIC_ACQUIRE, "agent");
        __builtin_amdgcn_fence(__ATOMIC_RELEASE, "workgroup");
    }
    __builtin_amdgcn_s_barrier();
    __builtin_amdgcn_fence(__ATOMIC_ACQUIRE, "workgroup");
}

__global__ void __launch_bounds__(NTHR) mk_fwd(Args a) {
    extern __shared__ __attribute__((aligned(16))) unsigned char lds_raw[];
    LAS unsigned char* lds = (LAS unsigned char*)lds_raw;
    const int G = gridDim.x, blk = blockIdx.x;
    const int wv = __builtin_amdgcn_readfirstlane(threadIdx.x >> 6);
    volatile LAS unsigned* bst = (volatile LAS unsigned*)(lds + XB_LDS_OFF);
    if (wg_tid_local(wv) < 4) bst[wg_tid_local(wv)] = 0u;
    __syncthreads();
    (void)xcd_barrier_post((unsigned*)(a.ws + WS_CTL) + 1024, bst, wg_tid_local(wv));
#define XBAR() do { XcdBarrier xb_; xb_.bar = (unsigned*)(a.ws + WS_CTL) + 1024; xb_.x = xb_xcc_id(); xb_.st = (volatile LAS unsigned*)(lds + XB_LDS_OFF); xcd_barrier(xb_, wg_tid_local(wv)); } while (0)
    unsigned char* ws = a.ws;
    const int lo = a.ph_lo, hi = a.ph_hi;
    bf16* XN = (bf16*)(ws + WS_XN); bf16* WIN = (bf16*)(ws + WS_WIN);
#ifndef PH_MASK
#define PH_MASK 0x7fff
#endif
#define IN(k) (((PH_MASK >> (k)) & 1) && lo <= (k) && (k) < hi)
#ifndef REP_MASK
#define REP_MASK 0
#endif
#ifdef NULL_EPI_PROBE
#define REPEAT(k, body) do { body; if ((REP_MASK >> (k)) & 1) { XBAR(); { pg8::EpiNull En{a.out}; pg8::Gemm g2{(const pg8::bf16_t*)XN, (const pg8::bf16_t*)WIN, MTOK, NULL_EPI_PROBE, DM}; pg8::StaticOrder S2; S2.init(MTOK, NULL_EPI_PROBE, G, blk); pg8::gemm_phase<pg8::EpiNull, pg8::StaticOrder, true, true>(lds, g2, S2, En, wg_tid_local(wv)); } } } while (0)
#else
#define REPEAT(k, body) do { body; if ((REP_MASK >> (k)) & 1) { XBAR(); body; } } while (0)
#endif
#define SEAM(k) do { if (IN(k) && IN((k) + 1)) { if (lo < 0) grid_sync_(wg_tid_local(wv)); XBAR(); } } while (0)
#define GEMM_PHASE(EPI, E, Aop, Bop, NN, KK) do { pg8::Gemm g{(const pg8::bf16_t*)(Aop), (const pg8::bf16_t*)(Bop), MTOK, (NN), (KK)}; pg8::StaticOrder S; S.init(MTOK, (NN), G, blk); \
        pg8::gemm_phase<EPI, pg8::StaticOrder, true, true>(lds, g, S, E, wg_tid_local(wv)); } while (0)

    if (IN(0)) { REPEAT(0, prologue(a, lds, G, blk, wv)); } SEAM(0);
    if (IN(1)) {
        pg8::EpiXM E{(bf16*)(ws + WS_R0), (bf16*)(ws + WS_HALO)};
        REPEAT(1, GEMM_PHASE(pg8::EpiXM, E, XN, WIN + (size_t)C_XM * DM, MW, DM));
    } SEAM(1);
    if (IN(2)) {
        const float* tab = (const float*)(ws + WS_TAB);
        mpre::Tensors T{(const bf16*)(ws + WS_R0), (const bf16*)(ws + WS_HALO), (bf16*)(ws + WS_R1), (bf16*)a.out, (bf16*)(ws + WS_R2), (float*)(ws + WS_GP), (bf16*)(ws + WS_S), a.in[4], a.in[5], (const bf16*)(tab + TAB_WC), (const bf16*)(tab + TAB_WM), tab + TAB_G};
        REPEAT(2, mpre::phase(lds, T, G, blk, wv));
    } SEAM(2);
    if (IN(3)) {
        mscan::Tensors T{(const bf16*)(ws + WS_R2), (const bf16*)(ws + WS_R1), (const bf16*)a.out, (const bf16*)(ws + WS_S), (const float*)(ws + WS_GP), a.in[10], (float*)(ws + WS_SCAL), (bf16*)(ws + WS_R0)};
        mscan::phase<0>(lds, T, G, blk, wv);
#ifdef SCAN_PROBE
        XBAR(); mscan::phase<SCAN_PROBE>(lds, T, G, blk, wv);
#endif
    } SEAM(3);
    if (IN(4)) {
        pg8::EpiRaw2 E{(bf16*)a.out, (bf16*)(ws + WS_R2)};
        REPEAT(4, GEMM_PHASE(pg8::EpiRaw2, E, XN, WIN + (size_t)C_ZM * DM, 2 * MW, DM));
    } SEAM(4);
    if (IN(5)) {
        mpost::Tensors T{(bf16*)(ws + WS_R0), (const bf16*)(ws + WS_R2), (const bf16*)a.out, (const bf16*)(ws + WS_R1), a.in[8], a.in[11], a.in[12]};
        mpost::phase(lds, T, G, blk, wv);
    } SEAM(5);
    if (IN(7)) {
        pg8::EpiQKV E{(bf16*)(ws + WS_QA), (size_t)(WS_KA - WS_QA) / 2};
        REPEAT(7, GEMM_PHASE(pg8::EpiQKV, E, XN, WIN + (size_t)C_QA * DM, 3 * AW, DM));
    } SEAM(7);
    if (IN(8)) {
        att::Tensors T{(const bf16*)(ws + WS_QA), (const bf16*)(ws + WS_KA), (const bf16*)(ws + WS_VA), (bf16*)(ws + WS_O1), (bf16*)a.out, (float*)(ws + WS_ST), (const float*)(ws + WS_TAB) + TAB_BIAS};
        REPEAT(8, att::phase(lds, T, G, blk, wv));
    } SEAM(8);
    if (IN(9)) {
        pg8::EpiZA E{(const bf16*)(ws + WS_O1), (const bf16*)a.out, (const bf16*)a.out + (size_t)MTOK * AW, (const float*)(ws + WS_ST), (bf16*)(ws + WS_A1)};
        REPEAT(9, GEMM_PHASE(pg8::EpiZA, E, XN, WIN + (size_t)C_ZA * DM, AW, DM));
    }
    if (IN(10)) {
        pg8::EpiSig E{(bf16*)(ws + WS_G), 2 * DM, a.in[3]};
        REPEAT(10, GEMM_PHASE(pg8::EpiSig, E, XN, WIN + (size_t)C_G * DM, 2 * DM, DM));
    } SEAM(10);
    if (IN(11)) {
        pg8::EpiYA E{(bf16*)(ws + WS_G)};
        GEMM_PHASE(pg8::EpiYA, E, ws + WS_A1, ws + WS_WPA, DM, AW);
    }
    if (IN(11) && IN(12)) {
        asm volatile("s_waitcnt vmcnt(0)" ::: "memory"); __syncthreads();
        if (wg_tid_local(wv) == 0) { __builtin_amdgcn_fence(__ATOMIC_ACQUIRE, "agent"); asm volatile("s_waitcnt vmcnt(0)" ::: "memory"); }
        __syncthreads();
    }
    if (IN(12)) {
        pg8::EpiYM E{(const bf16*)(ws + WS_G), (bf16*)(ws + WS_MRG)};
        REPEAT(12, GEMM_PHASE(pg8::EpiYM, E, ws + WS_R0, ws + WS_WPB, DM, MW));
    } SEAM(12);
    if (IN(13)) {
        pg8::EpiOut E{a.in[0], a.out};
        REPEAT(13, GEMM_PHASE(pg8::EpiOut, E, ws + WS_MRG, ws + WS_WOUT, DM, DM));
    } SEAM(13);
#ifdef EXTRA_SYNCS
    if (IN(13) && IN(14)) { for (int i = 0; i < EXTRA_SYNCS; ++i) XBAR(); }
#endif
    if (IN(14)) {
        const int lane = wg_tid_local(wv) & 63, wave = wv;
        for (int m = blk * NWAVES + wave; m < MTOK; m += G * NWAVES) rms_row_inplace(a.out + (size_t)m * DM, a.in[17], lane);
    }
#ifdef END_PROBE
    if (IN(14)) {
        XBAR();
        pg8::Gemm g2{(const pg8::bf16_t*)XN, (const pg8::bf16_t*)WIN, MTOK, 6144, DM}; pg8::StaticOrder S2; S2.init(MTOK, 6144, G, blk);
#if END_PROBE == 1
        pg8::EpiNull En{(float*)(ws + WS_R0)};
        pg8::gemm_phase<pg8::EpiNull, pg8::StaticOrder, true, true>(lds, g2, S2, En, wg_tid_local(wv));
#elif END_PROBE == 2
        pg8::EpiProbe En{(pg8::bf16_t*)(ws + WS_R0), 6144, 0x7fffffff};
        pg8::gemm_phase<pg8::EpiProbe, pg8::StaticOrder, true, true>(lds, g2, S2, En, wg_tid_local(wv));
#else
        pg8::EpiProbe En{(pg8::bf16_t*)(ws + WS_R0), 6144, 255};
        pg8::gemm_phase<pg8::EpiProbe, pg8::StaticOrder, true, true>(lds, g2, S2, En, wg_tid_local(wv));
#endif
    }
#endif
#undef IN
#undef SEAM
#undef GEMM_PHASE
}

#ifndef MK_ONE_LAUNCH
#define MK_ONE_LAUNCH 0
#endif
extern "C" void kernel_launch(void* const* d_in, const int* in_sizes, int n_in, void* d_out, int out_size, void* d_ws, size_t ws_size, hipStream_t stream) {
    static int grid = 0;
    if (grid == 0) {
        if (n_in != 18 || in_sizes[0] != MTOK * DM || out_size != MTOK * DM || ws_size < WS_END) { fprintf(stderr, "kernel_launch: unexpected shapes (n_in %d, ws %zu)\n", n_in, ws_size); grid = -1; return; }
        int dev = 0, cus = 0, per_cu = 0;
        (void)hipGetDevice(&dev); (void)hipDeviceGetAttribute(&cus, hipDeviceAttributeMultiprocessorCount, dev);
        if (hipFuncSetAttribute((const void*)mk_fwd, hipFuncAttributeMaxDynamicSharedMemorySize, LDS_TOTAL) != hipSuccess) { fprintf(stderr, "kernel_launch: hipFuncSetAttribute failed\n"); grid = -1; return; }
        if (hipOccupancyMaxActiveBlocksPerMultiprocessor(&per_cu, (const void*)mk_fwd, NTHR, LDS_TOTAL) != hipSuccess || per_cu < 1) { fprintf(stderr, "kernel_launch: occupancy query says %d\n", per_cu); per_cu = 1; }
        (void)hipGetLastError();
        grid = cus * (per_cu > 1 ? 1 : per_cu);
    }
    if (grid < 0) return;
    if (hipMemsetAsync((char*)d_ws + WS_CTL, 0, 65536, stream) != hipSuccess) { fprintf(stderr, "kernel_launch: hipMemsetAsync failed\n"); return; }
    Args a{};
    for (int i = 0; i < 18; ++i) a.in[i] = (const float*)d_in[i];
    a.out = (float*)d_out; a.ws = (unsigned char*)d_ws;
#if MK_ONE_LAUNCH
    a.ph_lo = 0; a.ph_hi = N_PHASES;
    void* args[] = {&a};
    hipError_t e = hipLaunchCooperativeKernel((const void*)mk_fwd, dim3(grid), dim3(NTHR), args, LDS_TOTAL, stream);
    if (e != hipSuccess) fprintf(stderr, "cooperative launch failed: %s (grid %d)\n", hipGetErrorString(e), grid);
#else
    for (int p = 0; p < N_PHASES; ++p) {
        a.ph_lo = p; a.ph_hi = p + 1;
        hipLaunchKernelGGL(mk_fwd, dim3(grid), dim3(NTHR), LDS_TOTAL, stream, a);
    }
#endif
}
```
